# Optimizing an MI355X kernel written in HIP

```python
import math
import jax, jax.numpy as jnp
from jax import lax
import numpy as np


D_MODEL = 1024
BATCH = 2
SEQ = 8192
DEPTH = 1

NSA_HEADS = 8
NSA_KV_GROUPS = 2
NSA_HPG = NSA_HEADS // NSA_KV_GROUPS
NSA_HEAD_DIM = 64
CMP_BLOCK = 32
CMP_STRIDE = 16
CMP_HIDDEN = 256
SLC_BLOCK = 64
SLC_TOPK = 16
WINDOW = 512
Q_BLOCK = 128
GDN_HEADS = 4
GDN_HEAD_DIM = 128
GDN_CONV = 4
GDN_CHUNK = 64
N_EXPERTS = 32
TOP_K = 4
D_EXPERT = 1024
SWIGLU_LIMIT = 7.0
SWIGLU_ALPHA = 1.702
MOE_ROW_BLOCK = 256

EPS = 1e-6
NEG = -1e30
NSA_WIDTH = NSA_HEADS * NSA_HEAD_DIM
NSA_KV_WIDTH = NSA_KV_GROUPS * NSA_HEAD_DIM
GDN_WIDTH = GDN_HEADS * GDN_HEAD_DIM
MIX_WIDTH = NSA_WIDTH + GDN_WIDTH
IN_SPLITS = (NSA_WIDTH, NSA_KV_WIDTH, NSA_KV_WIDTH, NSA_KV_WIDTH, NSA_KV_WIDTH, NSA_KV_WIDTH,
             NSA_KV_WIDTH, 3 * NSA_HEADS, 3 * GDN_WIDTH, GDN_WIDTH, GDN_HEADS, GDN_HEADS)
IN_WIDTH = sum(IN_SPLITS)

kernel_name = 'hybrid_nsa_gdn_moe_block'


def rms_norm(x, g):
    xf = x.astype(jnp.float32)
    y = xf * lax.rsqrt(jnp.mean(xf * xf, axis=-1, keepdims=True) + EPS)
    return (y * g.astype(jnp.float32)).astype(x.dtype)


def l2_norm(x):
    return x * lax.rsqrt(jnp.sum(x * x, axis=-1, keepdims=True) + EPS)


def masked_probs(s, mask):
    s = jnp.where(mask, s.astype(jnp.float32), NEG)
    m = jnp.max(s, axis=-1, keepdims=True)
    p = jnp.where(mask, jnp.exp(s - m), 0.0)
    return p / jnp.maximum(jnp.sum(p, axis=-1, keepdims=True), 1e-30)


def nsa_compress(u, pos, w1, b1, w2, b2):
    B, T = u.shape[:2]
    n_cmp = (T - CMP_BLOCK) // CMP_STRIDE + 1
    idx = jnp.arange(n_cmp)[:, None] * CMP_STRIDE + jnp.arange(CMP_BLOCK)[None, :]
    kv = u.reshape(B, T, NSA_KV_GROUPS, NSA_HEAD_DIM)
    blocks = kv[:, idx] + pos[:, None, :]
    blocks = blocks.transpose(0, 3, 1, 2, 4).reshape(B, NSA_KV_GROUPS, n_cmp, CMP_BLOCK * NSA_HEAD_DIM)
    hid = jax.nn.gelu(blocks @ w1 + b1)
    return hid @ w2 + b2


def nsa_mixer(u_q, u_kc, u_vc, u_ks, u_vs, u_kw, u_vw, u_gate, q_norm_g, kc_norm_g, ks_norm_g, kw_norm_g,
              ck_pos, ck_w1, ck_b1, ck_w2, ck_b2, cv_pos, cv_w1, cv_b1, cv_w2, cv_b2):
    B, T = u_q.shape[:2]
    G, HPG, DH = NSA_KV_GROUPS, NSA_HPG, NSA_HEAD_DIM
    n_slc = T // SLC_BLOCK
    n_top = min(SLC_TOPK, n_slc)
    q = rms_norm(u_q.reshape(B, T, G, HPG, DH), q_norm_g) * (DH ** -0.5)
    q = q.transpose(0, 2, 3, 1, 4)
    gate = jax.nn.sigmoid(u_gate.reshape(B, T, G, HPG, 3)).transpose(0, 2, 3, 1, 4)
    kc = rms_norm(nsa_compress(u_kc, ck_pos, ck_w1, ck_b1, ck_w2, ck_b2), kc_norm_g)
    vc = nsa_compress(u_vc, cv_pos, cv_w1, cv_b1, cv_w2, cv_b2)
    n_cmp = kc.shape[2]
    ks = rms_norm(u_ks.reshape(B, T, G, DH), ks_norm_g).transpose(0, 2, 1, 3).reshape(B, G, n_slc, SLC_BLOCK, DH)
    vs = u_vs.reshape(B, T, G, DH).transpose(0, 2, 1, 3).reshape(B, G, n_slc, SLC_BLOCK, DH)
    pad = ((0, 0), (0, 0), (WINDOW, 0), (0, 0))
    kw = jnp.pad(rms_norm(u_kw.reshape(B, T, G, DH), kw_norm_g).transpose(0, 2, 1, 3), pad)
    vw = jnp.pad(u_vw.reshape(B, T, G, DH).transpose(0, 2, 1, 3), pad)

    cmp_start = jnp.arange(n_cmp) * CMP_STRIDE
    cmp_end = cmp_start + CMP_BLOCK - 1
    slc_start = jnp.arange(n_slc) * SLC_BLOCK
    overlap = ((cmp_start[:, None] < slc_start[None, :] + SLC_BLOCK) &
               (cmp_start[:, None] + CMP_BLOCK > slc_start[None, :])).astype(jnp.float32)
    blk = jnp.arange(n_slc)
    bi = jnp.arange(B)[:, None, None, None]
    gi = jnp.arange(G)[None, :, None, None]

    def q_block(i):
        s0 = i * Q_BLOCK
        qb = lax.dynamic_slice_in_dim(q, s0, Q_BLOCK, axis=3)
        gb = lax.dynamic_slice_in_dim(gate, s0, Q_BLOCK, axis=3)
        t = s0 + jnp.arange(Q_BLOCK)
        sc = jnp.einsum('bghqd,bgcd->bghqc', qb, kc)
        pc = masked_probs(sc, cmp_end[None, :] <= t[:, None])
        oc = jnp.einsum('bghqc,bgcd->bghqd', pc.astype(vc.dtype), vc)
        imp = jnp.einsum('bghqc,cn->bgqn', pc, overlap)
        cur = t // SLC_BLOCK
        imp = jnp.where(slc_start[None, :] > t[:, None], NEG, imp)
        forced = (blk[None, :] == 0) | (blk[None, :] == cur[:, None]) | (blk[None, :] == cur[:, None] - 1)
        imp = jnp.where(forced, -NEG, imp)
        _, sel = lax.top_k(imp, n_top)
        ksel = ks[bi, gi, sel]
        vsel = vs[bi, gi, sel].reshape(B, G, Q_BLOCK, n_top * SLC_BLOCK, DH)
        pos = sel[..., None] * SLC_BLOCK + jnp.arange(SLC_BLOCK)
        smask = (pos <= t[None, None, :, None, None]).reshape(B, G, 1, Q_BLOCK, n_top * SLC_BLOCK)
        ss = jnp.einsum('bghqd,bgqnsd->bghqns', qb, ksel).reshape(B, G, HPG, Q_BLOCK, n_top * SLC_BLOCK)
        ps = masked_probs(ss, smask)
        osl = jnp.einsum('bghqk,bgqkd->bghqd', ps.astype(vsel.dtype), vsel)
        kwb = lax.dynamic_slice_in_dim(kw, s0, WINDOW + Q_BLOCK, axis=2)
        vwb = lax.dynamic_slice_in_dim(vw, s0, WINDOW + Q_BLOCK, axis=2)
        kpos = s0 - WINDOW + jnp.arange(WINDOW + Q_BLOCK)
        wmask = (kpos[None, :] <= t[:, None]) & (kpos[None, :] > t[:, None] - WINDOW) & (kpos[None, :] >= 0)
        sw = jnp.einsum('bghqd,bgkd->bghqk', qb, kwb)
        pw = masked_probs(sw, wmask)
        ow = jnp.einsum('bghqk,bgkd->bghqd', pw.astype(vwb.dtype), vwb)
        return gb[..., 0:1] * oc + gb[..., 1:2] * osl + gb[..., 2:3] * ow

    outs = lax.map(q_block, jnp.arange(T // Q_BLOCK))
    return outs.transpose(1, 0, 4, 2, 3, 5).reshape(B, T, NSA_WIDTH)


def causal_dwconv(x, w):
    k = w.shape[0]
    return lax.conv_general_dilated(x, w[:, None, :], window_strides=(1,), padding=[(k - 1, 0)],
                                    dimension_numbers=('NWC', 'WIO', 'NWC'), feature_group_count=x.shape[-1])


def chunk_gated_delta(q, k, v, g, beta):
    B, H, T, DK = q.shape
    DV = v.shape[-1]
    C = GDN_CHUNK
    N = T // C
    q = q.reshape(B, H, N, C, DK)
    k = k.reshape(B, H, N, C, DK)
    v = v.reshape(B, H, N, C, DV)
    g = jnp.cumsum(g.reshape(B, H, N, C), axis=-1)
    beta = beta.reshape(B, H, N, C)
    kb = k * beta[..., None]
    vb = v * beta[..., None]
    incl = jnp.tril(jnp.ones((C, C), bool))
    strict = jnp.tril(jnp.ones((C, C), bool), -1)
    decay = jnp.exp(jnp.where(incl, g[..., :, None] - g[..., None, :], -jnp.inf))
    lmat = jnp.where(strict, jnp.einsum('bhncd,bhnsd->bhncs', kb, k) * decay, 0.0)
    eye = jnp.broadcast_to(jnp.eye(C, dtype=q.dtype), lmat.shape)
    tinv = lax.linalg.triangular_solve(eye + lmat, eye, left_side=True, lower=True, unit_diagonal=True)
    u = jnp.einsum('bhncs,bhnse->bhnce', tinv, vb)
    w = jnp.einsum('bhncs,bhnsd->bhncd', tinv, kb * jnp.exp(g)[..., None])
    qk = jnp.where(incl, jnp.einsum('bhncd,bhnsd->bhncs', q, k) * decay, 0.0)
    qg = q * jnp.exp(g)[..., None]
    kd = k * jnp.exp(g[..., -1:] - g)[..., None]
    gl = jnp.exp(g[..., -1])

    def step(S, xs):
        qg_i, kd_i, u_i, w_i, qk_i, gl_i = xs
        v_new = u_i - jnp.einsum('bhcd,bhde->bhce', w_i, S)
        o_i = jnp.einsum('bhcd,bhde->bhce', qg_i, S) + jnp.einsum('bhcs,bhse->bhce', qk_i, v_new)
        S = S * gl_i[..., None, None] + jnp.einsum('bhcd,bhce->bhde', kd_i, v_new)
        return S, o_i

    xs = (jnp.moveaxis(qg, 2, 0), jnp.moveaxis(kd, 2, 0), jnp.moveaxis(u, 2, 0),
          jnp.moveaxis(w, 2, 0), jnp.moveaxis(qk, 2, 0), jnp.moveaxis(gl, 2, 0))
    s0 = jnp.zeros((B, H, DK, DV), jnp.float32)
    _, o = lax.scan(step, s0, xs)
    return jnp.moveaxis(o, 0, 2).reshape(B, H, T, DV)


def gdn_mixer(u_qkv, u_z, u_a, u_b, conv_w, a_log, dt_bias, out_norm_g):
    B, T = u_qkv.shape[:2]
    H, D = GDN_HEADS, GDN_HEAD_DIM
    qkv = jax.nn.silu(causal_dwconv(u_qkv, conv_w)).astype(jnp.float32)
    q, k, v = jnp.split(qkv, 3, axis=-1)
    q, k, v = (a.reshape(B, T, H, D).transpose(0, 2, 1, 3) for a in (q, k, v))
    q = l2_norm(q) * (D ** -0.5)
    k = l2_norm(k)
    beta = jax.nn.sigmoid(u_b.astype(jnp.float32)).transpose(0, 2, 1)
    g = (-jnp.exp(a_log.astype(jnp.float32)) *
         jax.nn.softplus(u_a.astype(jnp.float32) + dt_bias.astype(jnp.float32))).transpose(0, 2, 1)
    o = chunk_gated_delta(q, k, v, g, beta).transpose(0, 2, 1, 3)
    o = rms_norm(o, out_norm_g) * jax.nn.silu(u_z.astype(jnp.float32).reshape(B, T, H, D))
    return o.reshape(B, T, GDN_WIDTH).astype(u_qkv.dtype)


def expert_ffn(xb, wg, bg, wu, bu, wd, bd):
    gate = jnp.minimum(xb @ wg + bg, SWIGLU_LIMIT)
    up = jnp.clip(xb @ wu + bu, -SWIGLU_LIMIT, SWIGLU_LIMIT)
    glu = gate * jax.nn.sigmoid(gate * SWIGLU_ALPHA)
    return ((up + 1.0) * glu) @ wd + bd


def moe_ffn(h, w_router, b_router, w_gate, b_gate, w_up, b_up, w_down, b_down):
    N, D = h.shape
    R = MOE_ROW_BLOCK
    logits = (h @ w_router + b_router).astype(jnp.float32)
    top_val, top_idx = lax.top_k(logits, TOP_K)
    gates = jax.nn.softmax(top_val, axis=-1)
    nk = N * TOP_K
    flat_e = top_idx.reshape(-1)
    order = jnp.argsort(flat_e)
    e_sorted = flat_e[order]
    tok_sorted = order // TOP_K
    gate_sorted = gates.reshape(-1)[order]
    counts = jnp.bincount(flat_e, length=N_EXPERTS)
    starts = jnp.cumsum(counts) - counts
    pcounts = (counts + R - 1) // R * R
    pends = jnp.cumsum(pcounts)
    pstarts = pends - pcounts
    dest = pstarts[e_sorted] + jnp.arange(nk) - starts[e_sorted]
    n_rows = (nk + R - 1) // R * R + N_EXPERTS * R
    n_blocks = n_rows // R
    row_tok = jnp.zeros((n_rows,), jnp.int32).at[dest].set(tok_sorted.astype(jnp.int32))
    row_gate = jnp.zeros((n_rows,), jnp.float32).at[dest].set(gate_sorted)
    blk_e = jnp.minimum(jnp.searchsorted(pends, jnp.arange(n_blocks) * R, side='right'), N_EXPERTS - 1)
    xs = h[row_tok].reshape(n_blocks, R, D)

    def run(args):
        xb, e = args
        return expert_ffn(xb, w_gate[e], b_gate[e], w_up[e], b_up[e], w_down[e], b_down[e])

    ys = lax.map(run, (xs, blk_e)).reshape(n_rows, D)
    ys = ys * row_gate[:, None].astype(ys.dtype)
    return jnp.zeros((N, D), h.dtype).at[row_tok].add(ys)


def setup_inputs(seed: int = 0) -> dict:
    key = jax.random.key(seed)
    keys = iter(list(jax.random.split(key, 64)))

    def normal(shape, scale):
        return jax.random.normal(next(keys), shape, jnp.float32) * scale

    def gain(shape):
        return 1.0 + normal(shape, 0.02)

    L, D, DH = DEPTH, D_MODEL, NSA_HEAD_DIM
    flat = CMP_BLOCK * DH
    dt = jnp.exp(jax.random.uniform(next(keys), (L, GDN_HEADS), jnp.float32, math.log(1e-3), math.log(1e-1)))
    a_log = jnp.log(jax.random.uniform(next(keys), (L, GDN_HEADS), jnp.float32, 1.0, 16.0))
    return {
        'x': normal((BATCH, SEQ, D), 1.0),
        'attn_norm_g': gain((L, D)),
        'w_in': normal((L, D, IN_WIDTH), D ** -0.5),
        'nsa_q_norm_g': gain((L, DH)),
        'nsa_kc_norm_g': gain((L, DH)),
        'nsa_ks_norm_g': gain((L, DH)),
        'nsa_kw_norm_g': gain((L, DH)),
        'cmp_k_pos': normal((L, CMP_BLOCK, DH), 0.1),
        'cmp_k_w1': normal((L, flat, CMP_HIDDEN), flat ** -0.5),
        'cmp_k_b1': normal((L, CMP_HIDDEN), 0.01),
        'cmp_k_w2': normal((L, CMP_HIDDEN, DH), CMP_HIDDEN ** -0.5),
        'cmp_k_b2': normal((L, DH), 0.01),
        'cmp_v_pos': normal((L, CMP_BLOCK, DH), 0.1),
        'cmp_v_w1': normal((L, flat, CMP_HIDDEN), flat ** -0.5),
        'cmp_v_b1': normal((L, CMP_HIDDEN), 0.01),
        'cmp_v_w2': normal((L, CMP_HIDDEN, DH), CMP_HIDDEN ** -0.5),
        'cmp_v_b2': normal((L, DH), 0.01),
        'nsa_out_norm_g': gain((L, NSA_WIDTH)),
        'gdn_conv_w': normal((L, GDN_CONV, 3 * GDN_WIDTH), GDN_CONV ** -0.5),
        'gdn_a_log': a_log,
        'gdn_dt_bias': dt + jnp.log(-jnp.expm1(-dt)),
        'gdn_out_norm_g': gain((L, GDN_HEAD_DIM)),
        'w_out': normal((L, MIX_WIDTH, D), MIX_WIDTH ** -0.5),
        'ffn_norm_g': gain((L, D)),
        'router_w': normal((L, D, N_EXPERTS), D ** -0.5),
        'router_b': normal((L, N_EXPERTS), 0.01),
        'exp_w_gate': normal((L, N_EXPERTS, D, D_EXPERT), D ** -0.5),
        'exp_b_gate': normal((L, N_EXPERTS, D_EXPERT), 0.01),
        'exp_w_up': normal((L, N_EXPERTS, D, D_EXPERT), D ** -0.5),
        'exp_b_up': normal((L, N_EXPERTS, D_EXPERT), 0.01),
        'exp_w_down': normal((L, N_EXPERTS, D_EXPERT, D), D_EXPERT ** -0.5),
        'exp_b_down': normal((L, N_EXPERTS, D), 0.01),
    }


def reference(x, attn_norm_g, w_in, nsa_q_norm_g, nsa_kc_norm_g, nsa_ks_norm_g, nsa_kw_norm_g,
              cmp_k_pos, cmp_k_w1, cmp_k_b1, cmp_k_w2, cmp_k_b2,
              cmp_v_pos, cmp_v_w1, cmp_v_b1, cmp_v_w2, cmp_v_b2,
              nsa_out_norm_g, gdn_conv_w, gdn_a_log, gdn_dt_bias, gdn_out_norm_g, w_out,
              ffn_norm_g, router_w, router_b, exp_w_gate, exp_b_gate, exp_w_up, exp_b_up,
              exp_w_down, exp_b_down):
    B, T, D = x.shape
    splits = [int(s) for s in np.cumsum(IN_SPLITS)[:-1]]
    for l in range(DEPTH):
        h = rms_norm(x, attn_norm_g[l])
        u = h @ w_in[l]
        (u_q, u_kc, u_vc, u_ks, u_vs, u_kw, u_vw, u_gate,
         u_qkv, u_z, u_a, u_b) = jnp.split(u, splits, axis=-1)
        o_nsa = nsa_mixer(u_q, u_kc, u_vc, u_ks, u_vs, u_kw, u_vw, u_gate,
                          nsa_q_norm_g[l], nsa_kc_norm_g[l], nsa_ks_norm_g[l], nsa_kw_norm_g[l],
                          cmp_k_pos[l], cmp_k_w1[l], cmp_k_b1[l], cmp_k_w2[l], cmp_k_b2[l],
                          cmp_v_pos[l], cmp_v_w1[l], cmp_v_b1[l], cmp_v_w2[l], cmp_v_b2[l])
        o_nsa = rms_norm(o_nsa, nsa_out_norm_g[l])
        o_gdn = gdn_mixer(u_qkv, u_z, u_a, u_b, gdn_conv_w[l], gdn_a_log[l], gdn_dt_bias[l], gdn_out_norm_g[l])
        x = x + jnp.concatenate([o_nsa, o_gdn], axis=-1) @ w_out[l]
        h = rms_norm(x, ffn_norm_g[l])
        y = moe_ffn(h.reshape(B * T, D), router_w[l], router_b[l], exp_w_gate[l], exp_b_gate[l],
                    exp_w_up[l], exp_b_up[l], exp_w_down[l], exp_b_down[l])
        x = x + y.reshape(B, T, D)
    return x
```

```cpp
#include <hip/hip_runtime.h>
#include <hip/hip_cooperative_groups.h>
#include <cstdio>
#include <cstdint>
namespace cg = cooperative_groups;

#define DI __device__ __forceinline__
#define LAS __attribute__((address_space(3)))
typedef unsigned short bf16_t;
typedef short bf16x8 __attribute__((ext_vector_type(8)));
typedef float f32x4 __attribute__((ext_vector_type(4)));
typedef float f32x16 __attribute__((ext_vector_type(16)));
typedef unsigned u32x4 __attribute__((ext_vector_type(4)));
typedef unsigned u32x2 __attribute__((ext_vector_type(2)));
typedef float f32x2_t __attribute__((ext_vector_type(2)));
typedef __bf16 bf16x2_t __attribute__((ext_vector_type(2)));

constexpr int NB = 2, T = 8192, D = 1024, NTOK = NB * T, INWP = 3584;
constexpr int C_Q = 0, C_KC = 512, C_VC = 640, C_KS = 768, C_VS = 896, C_KW = 1024, C_VW = 1152, C_GATE = 1280,
              C_GQ = 1304, C_GK = 1816, C_GV = 2328, C_GZ = 2840, C_GA = 3352, C_GB = 3356, INW = 3360;
constexpr float EPS = 1e-6f, LOG2E = 1.4426950408889634f;
constexpr int NEXP = 32, MAXROWS = 65536 + NEXP * 256, MAXTILES = MAXROWS / 256;

constexpr size_t MiB = 1u << 20;
constexpr size_t WS_CTL = 0, CTL_BYTES = 64 * 1024;
constexpr size_t WS_WTIN = 1 * MiB, WS_WTOUT = 8 * MiB, WS_WTC1K = 10 * MiB, WS_WTC1V = 11 * MiB;
constexpr size_t WS_MISC = 12 * MiB;
constexpr size_t WS_WTC2K = WS_MISC, WS_WTC2V = WS_MISC + 32 * 1024, WS_RSTD2 = WS_MISC + 64 * 1024, WS_TOKE = WS_MISC + 128 * 1024,
                 WS_TOKG = WS_MISC + 384 * 1024, WS_TOKPOS = WS_MISC + 640 * 1024, WS_DEST = WS_MISC + 896 * 1024,
                 WS_ROWG = WS_MISC + 1152 * 1024, WS_GL = WS_MISC + 1536 * 1024, WS_GATES = 14 * MiB;
constexpr size_t WS_EXPGU = 16 * MiB, WS_EXPD = 144 * MiB;
constexpr size_t WS_XN = 208 * MiB, WS_ONSA = 208 * MiB, WS_U = 240 * MiB, WS_QN = 352 * MiB, WS_KSN = 368 * MiB, WS_VST = 372 * MiB,
                 WS_KWN = 376 * MiB, WS_VWT = 380 * MiB, WS_KC = 384 * MiB, WS_VCT = 384 * MiB + 512 * 1024;
constexpr size_t WS_WP = 388 * MiB, WS_QGP = 404 * MiB, WS_KDTP = 420 * MiB, WS_QKP = 436 * MiB, WS_UP = 444 * MiB, WS_OG = 460 * MiB, WS_OCAT = 476 * MiB;
constexpr size_t WS_XS = 208 * MiB, WS_HID = 352 * MiB, WS_END = 508 * MiB;
constexpr int CW_Q2 = 0, CW_Q3 = 64, CW_CNT = 128, CW_PB1 = 256  , CW_NT = 1024, CW_TILEE = 1088  , CW_PSTART = 1536;

constexpr int LDS_BYTES = 147456, LDS_MISC = 140 * 1024;

DI unsigned pk2(float lo, float hi) { f32x2_t v = {lo, hi}; bf16x2_t b = __builtin_convertvector(v, bf16x2_t); return __builtin_bit_cast(unsigned, b); }
DI float bflo(unsigned w) { return __uint_as_float(w << 16); }
DI float bfhi(unsigned w) { return __uint_as_float(w & 0xffff0000u); }
DI float bf2f(bf16_t v) { return __uint_as_float((unsigned)v << 16); }
DI bf16_t f2bf(float f) { return (bf16_t)(pk2(f, 0.f) & 0xffffu); }
DI bf16x8 pack8(float a0, float a1, float a2, float a3, float a4, float a5, float a6, float a7) {
    u32x4 w; w.x = pk2(a0, a1); w.y = pk2(a2, a3); w.z = pk2(a4, a5); w.w = pk2(a6, a7); return __builtin_bit_cast(bf16x8, w); }
DI float wave_sum(float v) {
#pragma unroll
    for (int o = 1; o < 64; o <<= 1) v += __shfl_xor(v, o);
    return v; }
DI float sigm(float x) { return __builtin_amdgcn_rcpf(1.f + __builtin_amdgcn_exp2f(-x * LOG2E)); }
DI int crow(int r, int hi) { return (r & 3) + 8 * (r >> 2) + 4 * hi; }
DI int perm16(int p) { return 8 * ((p & 7) >> 2) + 4 * (p >> 3) + (p & 3); }
DI int perm16inv(int k) { return 8 * ((k >> 2) & 1) + 4 * (k >> 3) + (k & 3); }
#define MFMA32(a, b, c) __builtin_amdgcn_mfma_f32_32x32x16_bf16((a), (b), (c), 0, 0, 0)
#define MFMA16(a, b, c) __builtin_amdgcn_mfma_f32_16x16x32_bf16((a), (b), (c), 0, 0, 0)

namespace pg8 {
#define PG8_LAS __attribute__((address_space(3)))
constexpr int BM = 256, BK = 64, HALF = 128, HTB = HALF * BK * 2, STAGE_BYTES = 8 * HTB, NXCD = 8, WGM = 8;
__host__ __device__ __forceinline__ int lds_byte(int r, int c) { const int st = (r >> 4) * 2 + (c >> 5), rr = r & 15, cc = c & 31, ob = rr * 64 + cc * 2; return st * 1024 + (ob ^ (((ob >> 9) & 1) << 5)); }
__host__ __device__ __forceinline__ void stage_rc(int b, int& R, int& C) { const int st = b / 1024, sb = b % 1024, swz = sb ^ (((sb >> 9) & 1) << 5); R = (st >> 1) * 16 + swz / 64; C = (st & 1) * 32 + (swz % 64) / 2; }
__host__ __device__ __forceinline__ int perm32(int rho) { const int n = rho >> 4, i = rho & 15; return 8 * (i >> 2) + 4 * n + (i & 3); }
struct Unit { int pm, pn; };
struct Gemm { const bf16_t* A; const bf16_t* Bt; int M, N, K; };
struct StaticOrder {
    int nM, nN, nwg, G, c;
    __device__ void init(int M, int N, int G_, int c_) { nM = M / BM; nN = N / BM; nwg = nM * nN; G = G_; c = c_; }
    __device__ bool next(int i, Unit& u) const {
        const long L = (long)i * G + c; if (L >= nwg) return false;
        int wgid = (int)L; { const int q = nwg / NXCD, r = nwg % NXCD, xcd = wgid % NXCD, off = wgid / NXCD; wgid = (xcd < r ? xcd * (q + 1) : r * (q + 1) + (xcd - r) * q) + off; }
        const int nig = WGM * nN, gid = wgid / nig, fm = gid * WGM, gsz = (nM - fm) < WGM ? (nM - fm) : WGM;
        u.pm = fm + ((wgid % nig) % gsz); u.pn = (wgid % nig) / gsz; return true;
    }
};
struct MoeOrder {
    StaticOrder S; const int* tile_e;
    __device__ void init(int nM_, int nN_, int G_, int c_, const int* te) { S.nM = nM_; S.nN = nN_; S.nwg = nM_ * nN_; S.G = G_; S.c = c_; tile_e = te; }
    __device__ bool next(int i, Unit& u) const { if (!S.next(i, u)) return false; u.pn = tile_e[u.pm] * S.nN + u.pn; return true; }
};

template <class Epi, class Sched>
__device__ __forceinline__ void gemm_phase(PG8_LAS unsigned char* lds, const Gemm g, const Sched& S, const Epi& E) {
    const int tid = threadIdx.x, wid = __builtin_amdgcn_readfirstlane(tid >> 6), lane = tid & 63, wr = wid >> 2, wc = wid & 3, fr = lane & 15, fq = lane >> 4;
    const int K = g.K, nt = K / BK;
    unsigned voffA[2], voffB[2];
#pragma unroll
    for (int i = 0; i < 2; ++i) { int R, C; stage_rc(tid * 16 + i * 8192, R, C); const int Rb = Epi::PERM ? ((R & ~31) + perm32(R & 31)) : R;
        voffA[i] = (unsigned)(R * K + C) * 2u; voffB[i] = (unsigned)(Rb * K + C) * 2u; }
    const size_t kstep = (size_t)(BK * 2);
    const size_t hstep = (size_t)HALF * K * 2;
    const size_t tstep = 2 * hstep;
    const unsigned ldsw = (unsigned)wid * 1024u;
    const int aoff = lds_byte(wr * 64 + fr, fq * 8), boff = lds_byte(wc * 32 + fr, fq * 8);
#define PG8_SA(b, h) (((b) * 2 + (h)) * HTB)
#define PG8_SB(b, h) ((4 + (b) * 2 + (h)) * HTB)
#define PG8_STAGE(bufoff, gbase, voff) do { _Pragma("unroll") for (int _i = 0; _i < 2; ++_i) \
        __builtin_amdgcn_global_load_lds((const unsigned*)((const char*)(gbase) + (voff)[_i]), (PG8_LAS unsigned*)(lds + (bufoff) + ldsw + _i * 8192), 16, 0, 0); } while (0)
#define PG8_LDA(dst, b, h) do { _Pragma("unroll") for (int m = 0; m < 4; ++m) _Pragma("unroll") for (int k = 0; k < 2; ++k) dst[m][k] = *(const PG8_LAS bf16x8*)(lds + PG8_SA(b, h) + aoff + m * 2048 + k * 1024); } while (0)
#define PG8_LDB(dst, b, h) do { _Pragma("unroll") for (int n = 0; n < 2; ++n) _Pragma("unroll") for (int k = 0; k < 2; ++k) dst[n][k] = *(const PG8_LAS bf16x8*)(lds + PG8_SB(b, h) + boff + n * 2048 + k * 1024); } while (0)
#define PG8_MMA(ai, bj, At, Bt) do { __builtin_amdgcn_s_setprio(1); _Pragma("unroll") for (int m = 0; m < 4; ++m) _Pragma("unroll") for (int n = 0; n < 2; ++n) _Pragma("unroll") for (int k = 0; k < 2; ++k) \
        acc[ai][bj][m][n] = __builtin_amdgcn_mfma_f32_16x16x32_bf16(Bt[n][k], At[m][k], acc[ai][bj][m][n], 0, 0, 0); __builtin_amdgcn_s_setprio(0); } while (0)
#define PG8_WAIT_V(n) asm volatile("s_waitcnt vmcnt(" #n ")" ::: "memory")
#define PG8_WAIT_L(n) asm volatile("s_waitcnt lgkmcnt(" #n ")" ::: "memory")
#define PG8_BAR __builtin_amdgcn_s_barrier()
#define PG8_SCHED __builtin_amdgcn_sched_barrier(0)
    Unit cur, nxt; int ui = 0;
    if (!S.next(0, cur)) return;
    f32x4 acc[2][2][4][2];
#pragma unroll
    for (int a = 0; a < 2; ++a)
#pragma unroll
        for (int b = 0; b < 2; ++b)
#pragma unroll
            for (int m = 0; m < 4; ++m)
#pragma unroll
                for (int n = 0; n < 2; ++n) acc[a][b][m][n] = (f32x4){0.f, 0.f, 0.f, 0.f};
    bf16x8 At[4][2], B0[2][2], B1[2][2];
    const char* cA = (const char*)g.A + (size_t)cur.pm * tstep; const char* cB = (const char*)g.Bt + (size_t)cur.pn * tstep;
    PG8_STAGE(PG8_SB(0, 0), cB, voffB); PG8_STAGE(PG8_SB(0, 1), cB + hstep, voffB); PG8_STAGE(PG8_SA(0, 0), cA, voffA); PG8_STAGE(PG8_SA(0, 1), cA + hstep, voffA);
    if (wr == 1) PG8_BAR;
    PG8_WAIT_V(2); PG8_BAR;
    PG8_STAGE(PG8_SB(1, 0), cB + kstep, voffB); PG8_STAGE(PG8_SA(1, 0), cA + kstep, voffA); PG8_STAGE(PG8_SB(1, 1), cB + hstep + kstep, voffB);
    PG8_WAIT_V(6); PG8_BAR;
    for (;;) {
        const bool has_next = S.next(ui + 1, nxt);
        const char* nA = has_next ? (const char*)g.A + (size_t)nxt.pm * tstep : cA; const char* nB = has_next ? (const char*)g.Bt + (size_t)nxt.pn * tstep : cB;
        for (int t = 0; t < nt; t += 2) {
            const bool last = (t == nt - 2);
            const char* a1 = cA + (size_t)(t + 1) * kstep;
            const char* a2 = last ? nA : cA + (size_t)(t + 2) * kstep; const char* b2 = last ? nB : cB + (size_t)(t + 2) * kstep;
            const char* a3 = a2 + kstep; const char* b3 = b2 + kstep;
            PG8_LDB(B0, 0, 0); PG8_LDB(B1, 0, 1); PG8_SCHED; PG8_LDA(At, 0, 0); PG8_STAGE(PG8_SA(1, 1), a1 + hstep, voffA);
            PG8_WAIT_V(8); PG8_WAIT_L(0); PG8_BAR; PG8_MMA(0, 0, At, B0); PG8_MMA(0, 1, At, B1); PG8_BAR; PG8_SCHED;
            PG8_LDA(At, 0, 1); PG8_STAGE(PG8_SB(0, 0), b2, voffB); PG8_STAGE(PG8_SB(0, 1), b2 + hstep, voffB); PG8_STAGE(PG8_SA(0, 0), a2, voffA);
            PG8_WAIT_V(8); PG8_WAIT_L(0); PG8_BAR; PG8_MMA(1, 0, At, B0); PG8_MMA(1, 1, At, B1); PG8_BAR; PG8_SCHED;
            PG8_LDB(B0, 1, 0); PG8_LDB(B1, 1, 1); PG8_SCHED; PG8_LDA(At, 1, 0); PG8_STAGE(PG8_SA(0, 1), a2 + hstep, voffA);
            PG8_WAIT_V(8); PG8_WAIT_L(0); PG8_BAR; PG8_MMA(0, 0, At, B0); PG8_MMA(0, 1, At, B1); PG8_BAR; PG8_SCHED;
            PG8_LDA(At, 1, 1); PG8_STAGE(PG8_SB(1, 0), b3, voffB); PG8_STAGE(PG8_SB(1, 1), b3 + hstep, voffB); PG8_STAGE(PG8_SA(1, 0), a3, voffA);
            PG8_WAIT_V(8); PG8_WAIT_L(0); PG8_BAR; PG8_MMA(1, 0, At, B0); PG8_MMA(1, 1, At, B1); PG8_BAR; PG8_SCHED;
        }
        if (wr == 0) PG8_BAR;
        E(acc, cur, wr, wc, fr, fq);
        if (!has_next) break;
#pragma unroll
        for (int a = 0; a < 2; ++a)
#pragma unroll
            for (int b = 0; b < 2; ++b)
#pragma unroll
                for (int m = 0; m < 4; ++m)
#pragma unroll
                    for (int n = 0; n < 2; ++n) acc[a][b][m][n] = (f32x4){0.f, 0.f, 0.f, 0.f};
        cur = nxt; cA = nA; cB = nB; ++ui;
        if (wr == 1) PG8_BAR;
    }
    PG8_WAIT_V(0);
    PG8_BAR;
#undef PG8_SA
#undef PG8_SB
#undef PG8_STAGE
#undef PG8_LDA
#undef PG8_LDB
#undef PG8_MMA
#undef PG8_WAIT_V
#undef PG8_WAIT_L
#undef PG8_BAR
#undef PG8_SCHED
}

struct EpiU {
    static constexpr bool PERM = true;
    bf16_t* O; int ldc;
    __device__ __forceinline__ void operator()(const f32x4 (&acc)[2][2][4][2], const Unit& u, int wr, int wc, int fr, int fq) const {
        const int row0 = u.pm * BM + wr * 64 + fr, col0 = u.pn * BM + wc * 32 + 8 * fq;
#pragma unroll
        for (int ai = 0; ai < 2; ++ai)
#pragma unroll
            for (int m = 0; m < 4; ++m) { bf16_t* rowp = O + (size_t)(row0 + ai * HALF + m * 16) * ldc + col0;
#pragma unroll
                for (int bj = 0; bj < 2; ++bj) { const f32x4 v0 = acc[ai][bj][m][0], v1 = acc[ai][bj][m][1];
                    u32x4 w; w.x = pk2(v0[0], v0[1]); w.y = pk2(v0[2], v0[3]); w.z = pk2(v1[0], v1[1]); w.w = pk2(v1[2], v1[3]);
                    *(u32x4*)(rowp + bj * HALF) = w; } }
    }
};
struct EpiRes {
    static constexpr bool PERM = false;
    const float* base; float* out; int ldc;
    __device__ __forceinline__ void operator()(const f32x4 (&acc)[2][2][4][2], const Unit& u, int wr, int wc, int fr, int fq) const {
        const int col0 = u.pn * BM + wc * 32 + 4 * fq;
#pragma unroll
        for (int ai = 0; ai < 2; ++ai)
#pragma unroll
            for (int m = 0; m < 4; ++m) { const size_t off = (size_t)(u.pm * BM + ai * HALF + wr * 64 + m * 16 + fr) * ldc + col0;
#pragma unroll
                for (int bj = 0; bj < 2; ++bj)
#pragma unroll
                    for (int n = 0; n < 2; ++n) { const f32x4 bs = *(const f32x4*)(base + off + bj * HALF + n * 16); *(f32x4*)(out + off + bj * HALF + n * 16) = bs + acc[ai][bj][m][n]; } }
    }
};
struct EpiSwiglu {
    static constexpr bool PERM = true;
    bf16_t* H; const float* bg; const float* bu;
    __device__ __forceinline__ void operator()(const f32x4 (&acc)[2][2][4][2], const Unit& u, int wr, int wc, int fr, int fq) const {
        const int e = u.pn >> 3, pnl = u.pn & 7, hc0 = pnl * 128 + wc * 32 + 8 * fq, row0 = u.pm * BM + wr * 64 + fr;
        float gb[8], ub[8];
#pragma unroll
        for (int i = 0; i < 8; ++i) { gb[i] = bg[e * 1024 + hc0 + i]; ub[i] = bu[e * 1024 + hc0 + i]; }
#pragma unroll
        for (int ai = 0; ai < 2; ++ai)
#pragma unroll
            for (int m = 0; m < 4; ++m) {
                float o[8];
#pragma unroll
                for (int n = 0; n < 2; ++n)
#pragma unroll
                    for (int i = 0; i < 4; ++i) {
                        const float gg = fminf(acc[ai][0][m][n][i] + gb[4 * n + i], 7.0f);
                        const float uu = fminf(fmaxf(acc[ai][1][m][n][i] + ub[4 * n + i], -7.0f), 7.0f);
                        o[4 * n + i] = (uu + 1.0f) * gg * sigm(gg * 1.702f); }
                u32x4 w; w.x = pk2(o[0], o[1]); w.y = pk2(o[2], o[3]); w.z = pk2(o[4], o[5]); w.w = pk2(o[6], o[7]);
                *(u32x4*)(H + (size_t)(row0 + ai * HALF + m * 16) * 1024 + hc0) = w; }
    }
};
struct EpiDown {
    static constexpr bool PERM = true;
    bf16_t* Y; const float* bd; const float* rowg;
    __device__ __forceinline__ void operator()(const f32x4 (&acc)[2][2][4][2], const Unit& u, int wr, int wc, int fr, int fq) const {
        const int e = u.pn >> 2, pnl = u.pn & 3, col0 = pnl * BM + wc * 32 + 8 * fq, row0 = u.pm * BM + wr * 64 + fr;
        float bv[2][8];
#pragma unroll
        for (int bj = 0; bj < 2; ++bj)
#pragma unroll
            for (int i = 0; i < 8; ++i) bv[bj][i] = bd[e * 1024 + col0 + bj * HALF + i];
#pragma unroll
        for (int ai = 0; ai < 2; ++ai)
#pragma unroll
            for (int m = 0; m < 4; ++m) { const int row = row0 + ai * HALF + m * 16; const float sc = rowg[row];
#pragma unroll
                for (int bj = 0; bj < 2; ++bj) { const f32x4 v0 = acc[ai][bj][m][0], v1 = acc[ai][bj][m][1];
                    u32x4 w; w.x = pk2((v0[0] + bv[bj][0]) * sc, (v0[1] + bv[bj][1]) * sc); w.y = pk2((v0[2] + bv[bj][2]) * sc, (v0[3] + bv[bj][3]) * sc);
                    w.z = pk2((v1[0] + bv[bj][4]) * sc, (v1[1] + bv[bj][5]) * sc); w.w = pk2((v1[2] + bv[bj][6]) * sc, (v1[3] + bv[bj][7]) * sc);
                    *(u32x4*)(Y + (size_t)row * 1024 + col0 + bj * HALF) = w; } }
    }
};
}

struct Args { const float* in[32]; float* out; unsigned char* ws; int ph_lo, ph_hi; };
enum { I_X = 0, I_ANG, I_WIN, I_QG, I_KCG, I_KSG, I_KWG, I_CKPOS, I_CKW1, I_CKB1, I_CKW2, I_CKB2, I_CVPOS, I_CVW1, I_CVB1, I_CVW2, I_CVB2,
       I_NSAOG, I_CONVW, I_ALOG, I_DTB, I_GDNOG, I_WOUT, I_FFNG, I_RW, I_RB, I_EWG, I_EBG, I_EWU, I_EBU, I_EWD, I_EBD };

DI void p0_transpose_item(const float* W, int K, int N, bf16_t* WT, long row_off, float* scr, int item, int lane) {
    const int nblk = N / 32, kb = item / nblk, nb = item % nblk, k0 = 64 * kb, n0 = 32 * nb;
#pragma unroll 8
    for (int i = 0; i < 32; ++i) { const int kk = 2 * i + (lane >> 5); scr[kk * 33 + (lane & 31)] = W[(size_t)(k0 + kk) * N + n0 + (lane & 31)]; }
    __builtin_amdgcn_s_waitcnt(0xC07F); asm volatile("" ::: "memory");
    const int c = lane & 7;
#pragma unroll
    for (int j = 0; j < 4; ++j) { const int n = (lane >> 3) + 8 * j; const float* s = scr + (8 * c) * 33 + n;
        u32x4 o; o.x = pk2(s[0 * 33], s[1 * 33]); o.y = pk2(s[2 * 33], s[3 * 33]); o.z = pk2(s[4 * 33], s[5 * 33]); o.w = pk2(s[6 * 33], s[7 * 33]);
        *(u32x4*)(WT + (size_t)(row_off + n0 + n) * K + k0 + 8 * c) = o; }
    __builtin_amdgcn_s_waitcnt(0xC07F); asm volatile("" ::: "memory");
}

DI void phase0(const Args& A, unsigned char* lds) {
    const int tid = threadIdx.x, lane = tid & 63, wave = tid >> 6, G = gridDim.x;
    const int gw = blockIdx.x * 8 + wave, NGW = G * 8;
    float* scr = (float*)(lds + wave * 16384);
    unsigned char* ws = A.ws;
    constexpr int I_IN = 16 * 105, I_OUT = 16 * 32, I_C1 = 32 * 8, I_C2 = 4 * 2, I_EX = 16 * 32;
    constexpr int NIT = I_IN + I_OUT + 2 * I_C1 + 2 * I_C2 + 96 * I_EX;
    for (int it = gw; it < NIT; it += NGW) {
        int r = it;
        if (r < I_IN) { p0_transpose_item(A.in[I_WIN], 1024, INW, (bf16_t*)(ws + WS_WTIN), 0, scr, r, lane); continue; } r -= I_IN;
        if (r < I_OUT) { p0_transpose_item(A.in[I_WOUT], 1024, 1024, (bf16_t*)(ws + WS_WTOUT), 0, scr, r, lane); continue; } r -= I_OUT;
        if (r < I_C1) { p0_transpose_item(A.in[I_CKW1], 2048, 256, (bf16_t*)(ws + WS_WTC1K), 0, scr, r, lane); continue; } r -= I_C1;
        if (r < I_C1) { p0_transpose_item(A.in[I_CVW1], 2048, 256, (bf16_t*)(ws + WS_WTC1V), 0, scr, r, lane); continue; } r -= I_C1;
        if (r < I_C2) { p0_transpose_item(A.in[I_CKW2], 256, 64, (bf16_t*)(ws + WS_WTC2K), 0, scr, r, lane); continue; } r -= I_C2;
        if (r < I_C2) { p0_transpose_item(A.in[I_CVW2], 256, 64, (bf16_t*)(ws + WS_WTC2V), 0, scr, r, lane); continue; } r -= I_C2;
        const int mat = r / I_EX, item = r % I_EX, e = mat / 3, which = mat % 3;
        if (which == 2) { p0_transpose_item(A.in[I_EWD] + (size_t)e * 1048576, 1024, 1024, (bf16_t*)(ws + WS_EXPD), (long)e * 1024, scr, item, lane); }
        else { const int nb = item % 32, n0 = 32 * nb; const long dest0 = (long)e * 2048 + (n0 >> 7) * 256 + (n0 & 127) + (which ? 128 : 0);
            p0_transpose_item(A.in[which ? I_EWU : I_EWG] + (size_t)e * 1048576, 1024, 1024, (bf16_t*)(ws + WS_EXPGU), dest0 - n0, scr, item, lane); }
    }
    { const float* gain = A.in[I_ANG]; f32x4 gv[4];
#pragma unroll
      for (int j = 0; j < 4; ++j) gv[j] = *(const f32x4*)(gain + 4 * lane + 256 * j);
      for (int m = gw; m < NTOK; m += NGW) { const f32x4* xr = (const f32x4*)(A.in[I_X] + (size_t)m * D) + lane; f32x4 v[4]; float s = 0.f;
#pragma unroll
        for (int j = 0; j < 4; ++j) { v[j] = xr[64 * j]; s += v[j].x * v[j].x + v[j].y * v[j].y + v[j].z * v[j].z + v[j].w * v[j].w; }
        const float rs = rsqrtf(wave_sum(s) * (1.f / D) + EPS);
        u32x2* o = (u32x2*)((bf16_t*)(ws + WS_XN) + (size_t)m * D) + lane;
#pragma unroll
        for (int j = 0; j < 4; ++j) { u32x2 w; w.x = pk2(v[j].x * rs * gv[j].x, v[j].y * rs * gv[j].y); w.y = pk2(v[j].z * rs * gv[j].z, v[j].w * rs * gv[j].w); o[64 * j] = w; } } }
    { u32x4* p = (u32x4*)((bf16_t*)(ws + WS_WTIN) + (size_t)INW * 1024); const int n16 = (INWP - INW) * 1024 * 2 / 16;
      for (int i = blockIdx.x * 512 + tid; i < n16; i += G * 512) p[i] = (u32x4){0u, 0u, 0u, 0u}; }
    if (blockIdx.x < 32 && tid < 256) { const int kv = blockIdx.x >> 4, seg = blockIdx.x & 15, j = tid;
        const float* pos = A.in[kv ? I_CVPOS : I_CKPOS]; const float* w1 = A.in[kv ? I_CVW1 : I_CKW1]; float s = (seg == 0) ? A.in[kv ? I_CVB1 : I_CKB1][j] : 0.f;
        for (int k = seg * 128; k < seg * 128 + 128; ++k) s += pos[k] * w1[(size_t)k * 256 + j];
        atomicAdd((float*)(ws + WS_CTL) + CW_PB1 + kv * 256 + j, s); }
}

DI void nsa_prep_task(const Args& A, int task, unsigned char* lds) {
    const int tid = threadIdx.x, lane = tid & 63, wave = tid >> 6;
    const int b = task >> 7, n = task & 127;
    unsigned char* ws = A.ws; const bf16_t* U = (const bf16_t*)(ws + WS_U);
    bf16_t* vsL = (bf16_t*)lds;
    for (int ti = 0; ti < 8; ++ti) {
        const int tl = wave * 8 + ti, t = n * 64 + tl; const size_t tok = (size_t)b * T + t; const bf16_t* ur = U + tok * INWP;
        { const u32x4 w = *(const u32x4*)(ur + C_Q + 8 * lane); float f[8] = {bflo(w.x), bfhi(w.x), bflo(w.y), bfhi(w.y), bflo(w.z), bfhi(w.z), bflo(w.w), bfhi(w.w)};
          float s = 0.f;
#pragma unroll
          for (int i = 0; i < 8; ++i) s += f[i] * f[i];
          s += __shfl_xor(s, 1); s += __shfl_xor(s, 2); s += __shfl_xor(s, 4);
          const float rs = rsqrtf(s * (1.f / 64.f) + EPS) * (0.125f * LOG2E); const float* gq = A.in[I_QG] + (8 * lane & 63);
          u32x4 o; o.x = pk2(f[0] * rs * gq[0], f[1] * rs * gq[1]); o.y = pk2(f[2] * rs * gq[2], f[3] * rs * gq[3]); o.z = pk2(f[4] * rs * gq[4], f[5] * rs * gq[5]); o.w = pk2(f[6] * rs * gq[6], f[7] * rs * gq[7]);
          *(u32x4*)((bf16_t*)(ws + WS_QN) + tok * 512 + 8 * lane) = o; }
        if (lane < 32) { const int sel = lane >> 4, l16 = lane & 15, g = l16 >> 3, d0 = (l16 & 7) * 8;
          const u32x4 w = *(const u32x4*)(ur + (sel ? C_KW : C_KS) + 8 * l16); float f[8] = {bflo(w.x), bfhi(w.x), bflo(w.y), bfhi(w.y), bflo(w.z), bfhi(w.z), bflo(w.w), bfhi(w.w)};
          float s = 0.f;
#pragma unroll
          for (int i = 0; i < 8; ++i) s += f[i] * f[i];
          s += __shfl_xor(s, 1); s += __shfl_xor(s, 2); s += __shfl_xor(s, 4);
          const float rs = rsqrtf(s * (1.f / 64.f) + EPS); const float* gk = A.in[sel ? I_KWG : I_KSG] + d0;
          u32x4 o; o.x = pk2(f[0] * rs * gk[0], f[1] * rs * gk[1]); o.y = pk2(f[2] * rs * gk[2], f[3] * rs * gk[3]); o.z = pk2(f[4] * rs * gk[4], f[5] * rs * gk[5]); o.w = pk2(f[6] * rs * gk[6], f[7] * rs * gk[7]);
          *(u32x4*)((bf16_t*)(ws + (sel ? WS_KWN : WS_KSN)) + ((size_t)(b * 2 + g) * T + t) * 64 + d0) = o; }
        else { const int l32 = lane - 32, sel = l32 >> 4, l16 = l32 & 15, g = l16 >> 3, d0 = (l16 & 7) * 8;
          const u32x4 w = *(const u32x4*)(ur + (sel ? C_VW : C_VS) + 8 * l16);
          const int pos = (tl & ~15) + perm16inv(tl & 15); bf16_t* dst = vsL + ((sel * 2 + g) * 64 + d0) * 64 + pos;
          dst[0 * 64] = (bf16_t)(w.x & 0xffff); dst[1 * 64] = (bf16_t)(w.x >> 16); dst[2 * 64] = (bf16_t)(w.y & 0xffff); dst[3 * 64] = (bf16_t)(w.y >> 16);
          dst[4 * 64] = (bf16_t)(w.z & 0xffff); dst[5 * 64] = (bf16_t)(w.z >> 16); dst[6 * 64] = (bf16_t)(w.w & 0xffff); dst[7 * 64] = (bf16_t)(w.w >> 16); }
        if (lane < 24) ((float*)(ws + WS_GATES))[tok * 24 + lane] = sigm(bf2f(ur[C_GATE + lane]));
    }
    __syncthreads();
    for (int c = tid; c < 2048; c += 512) { const int sel = c >> 10, g = (c >> 9) & 1, rem = c & 511;
        const u32x4 v = *(const u32x4*)(vsL + ((sel * 2 + g) * 64) * 64 + rem * 8);
        *(u32x4*)((bf16_t*)(ws + (sel ? WS_VWT : WS_VST)) + ((size_t)(b * 2 + g) * 128 + n) * 4096 + rem * 8) = v; }
    __syncthreads();
}

DI void compress_task(const Args& A, int task, unsigned char* lds) {
    const int tid = threadIdx.x, lane = tid & 63, wave = __builtin_amdgcn_readfirstlane(tid >> 6), r32 = lane & 31, hh = lane >> 5;
    const int kv = task >> 6, b = (task >> 5) & 1, g = (task >> 4) & 1, ct = task & 15, c0 = 32 * ct;
    unsigned char* ws = A.ws; const bf16_t* U = (const bf16_t*)(ws + WS_U);
    bf16_t* hidL = (bf16_t*)lds;
    float* outL = (float*)(lds + 16896);
    const int colbase = (kv ? C_VC : C_KC) + g * 64;
    const bf16_t* W1T = (const bf16_t*)(ws + (kv ? WS_WTC1V : WS_WTC1K));
    const bf16_t* W2T = (const bf16_t*)(ws + (kv ? WS_WTC2V : WS_WTC2K));
    {   int c = c0 + r32; if (c > 510) c = 510;
        const bf16_t* arow = U + ((size_t)b * T + 16 * c) * INWP + colbase + 8 * hh;
        const bf16_t* brow = W1T + (size_t)(32 * wave + r32) * 2048 + 8 * hh;
        f32x16 acc; for (int i = 0; i < 16; ++i) acc[i] = 0.f;
#pragma unroll 4
        for (int l = 0; l < 32; ++l) {
#pragma unroll
            for (int s = 0; s < 4; ++s) { const bf16x8 af = *(const bf16x8*)(arow + (size_t)l * INWP + 16 * s); const bf16x8 bf = *(const bf16x8*)(brow + l * 64 + 16 * s); acc = MFMA32(af, bf, acc); } }
        const int j = 32 * wave + r32; const float pb = ((const float*)(ws + WS_CTL))[CW_PB1 + kv * 256 + j];
#pragma unroll
        for (int r = 0; r < 16; ++r) { const float x = acc[r] + pb; const float y = x * sigm(1.5957691216057308f * (x + 0.044715f * x * x * x)); hidL[crow(r, hh) * 264 + j] = f2bf(y); }
    }
    __syncthreads();
    if (wave < 2) { f32x16 acc; for (int i = 0; i < 16; ++i) acc[i] = 0.f;
#pragma unroll
        for (int s = 0; s < 16; ++s) { const bf16x8 af = *(const bf16x8*)(hidL + r32 * 264 + 16 * s + 8 * hh); const bf16x8 bf = *(const bf16x8*)(W2T + (size_t)(32 * wave + r32) * 256 + 16 * s + 8 * hh); acc = MFMA32(af, bf, acc); }
        const int d = 32 * wave + r32; const float b2 = A.in[kv ? I_CVB2 : I_CKB2][d];
#pragma unroll
        for (int r = 0; r < 16; ++r) outL[crow(r, hh) * 65 + d] = acc[r] + b2; }
    __syncthreads();
    if (kv == 0) { if (tid < 256) { const int cl = tid >> 3, sub = tid & 7; float f[8]; float s = 0.f;
#pragma unroll
            for (int i = 0; i < 8; ++i) { f[i] = outL[cl * 65 + 8 * sub + i]; s += f[i] * f[i]; }
            s += __shfl_xor(s, 1); s += __shfl_xor(s, 2); s += __shfl_xor(s, 4);
            const float rs = (c0 + cl > 510) ? 0.f : rsqrtf(s * (1.f / 64.f) + EPS); const float* gk = A.in[I_KCG] + 8 * sub;
            u32x4 o; o.x = pk2(f[0] * rs * gk[0], f[1] * rs * gk[1]); o.y = pk2(f[2] * rs * gk[2], f[3] * rs * gk[3]); o.z = pk2(f[4] * rs * gk[4], f[5] * rs * gk[5]); o.w = pk2(f[6] * rs * gk[6], f[7] * rs * gk[7]);
            *(u32x4*)((bf16_t*)(ws + WS_KC) + ((size_t)(b * 2 + g) * 512 + c0 + cl) * 64 + 8 * sub) = o; } }
    else { const int d = tid >> 3, part = tid & 7, p0 = 4 * part, gi = p0 >> 4, cl0 = 16 * gi + perm16(p0 & 15); float f[4];
#pragma unroll
        for (int i = 0; i < 4; ++i) f[i] = (c0 + cl0 + i > 510) ? 0.f : outL[(cl0 + i) * 65 + d];
        u32x2 o; o.x = pk2(f[0], f[1]); o.y = pk2(f[2], f[3]);
        *(u32x2*)((bf16_t*)(ws + WS_VCT) + ((size_t)(b * 2 + g) * 64 + d) * 512 + c0 + p0) = o; }
    __syncthreads();
}

DI void gdn_chunk_task(const Args& A, int task, unsigned char* lds) {
    const int tid = threadIdx.x, lane = tid & 63, wave = __builtin_amdgcn_readfirstlane(tid >> 6), r32 = lane & 31, hh = lane >> 5;
    const int b = task >> 9, h = (task >> 7) & 3, ch = task & 127, t0 = ch * 64; const size_t tok0 = (size_t)b * T + t0;
    unsigned char* ws = A.ws; const bf16_t* U = (const bf16_t*)(ws + WS_U);
    float* qL = (float*)lds; float* kL = qL + 64 * 132; float* vL = kL + 64 * 132; float* Lm = vL + 64 * 132; float* Qm = Lm + 64 * 68;
    float* gcL = Qm + 64 * 68; float* betaL = gcL + 64; float* egL = betaL + 64; float* kdsL = egL + 64;
    { const int c = tid & 127, part = tid >> 7;
#pragma unroll
      for (int s = 0; s < 3; ++s) { const int col = (s == 0 ? C_GQ : s == 1 ? C_GK : C_GV) + h * 128 + c; const float* cw = A.in[I_CONVW] + s * 512 + h * 128 + c;
        const float w0 = cw[0], w1 = cw[1536], w2 = cw[3072], w3 = cw[4608]; float* dst = (s == 0 ? qL : s == 1 ? kL : vL);
        const int tl0 = 16 * part; float x3, x2, x1;
        { const int tg = t0 + tl0; x3 = (tg - 3 >= 0) ? bf2f(U[(tok0 + tl0 - 3) * INWP + col]) : 0.f; x2 = (tg - 2 >= 0) ? bf2f(U[(tok0 + tl0 - 2) * INWP + col]) : 0.f; x1 = (tg - 1 >= 0) ? bf2f(U[(tok0 + tl0 - 1) * INWP + col]) : 0.f; }
#pragma unroll 4
        for (int i = 0; i < 16; ++i) { const float xt = bf2f(U[(tok0 + tl0 + i) * INWP + col]); const float y = w0 * x3 + w1 * x2 + w2 * x1 + w3 * xt;
            dst[(tl0 + i) * 132 + c] = y * sigm(y); x3 = x2; x2 = x1; x1 = xt; } } }
    if (tid < 64) { const int tl = tid; const float a = bf2f(U[(tok0 + tl) * INWP + C_GA + h]), bb = bf2f(U[(tok0 + tl) * INWP + C_GB + h]);
        const float x = a + A.in[I_DTB][h]; const float sp = (x > 20.f) ? x : log1pf(__expf(x)); float gt = -__expf(A.in[I_ALOG][h]) * sp;
#pragma unroll
        for (int o = 1; o < 64; o <<= 1) { const float v = __shfl_up(gt, o); if (lane >= o) gt += v; }
        const float g63 = __shfl(gt, 63);
        gcL[tl] = gt; betaL[tl] = sigm(bb); egL[tl] = __expf(gt); kdsL[tl] = __expf(g63 - gt);
        if (tl == 63) ((float*)(ws + WS_GL))[task] = __expf(gt); }
    __syncthreads();
    { const int tl = tid >> 3, sub = tid & 7; float sq = 0.f, sk = 0.f;
#pragma unroll
      for (int i = 0; i < 16; ++i) { const float a = qL[tl * 132 + sub * 16 + i], c = kL[tl * 132 + sub * 16 + i]; sq += a * a; sk += c * c; }
      sq += __shfl_xor(sq, 1); sq += __shfl_xor(sq, 2); sq += __shfl_xor(sq, 4); sk += __shfl_xor(sk, 1); sk += __shfl_xor(sk, 2); sk += __shfl_xor(sk, 4);
      const float rq = rsqrtf(sq + EPS) * 0.08838834764831845f, rk = rsqrtf(sk + EPS);
#pragma unroll
      for (int i = 0; i < 16; ++i) { qL[tl * 132 + sub * 16 + i] *= rq; kL[tl * 132 + sub * 16 + i] *= rk; } }
    __syncthreads();
    { const int mat = wave >> 2, mi = (wave >> 1) & 1, ni = wave & 1; const float* X = mat ? qL : kL;
      f32x16 acc; for (int i = 0; i < 16; ++i) acc[i] = 0.f;
#pragma unroll
      for (int s = 0; s < 8; ++s) { const f32x4 a0 = *(const f32x4*)(X + (32 * mi + r32) * 132 + 16 * s + 8 * hh), a1 = *(const f32x4*)(X + (32 * mi + r32) * 132 + 16 * s + 8 * hh + 4);
          const f32x4 b0 = *(const f32x4*)(kL + (32 * ni + r32) * 132 + 16 * s + 8 * hh), b1 = *(const f32x4*)(kL + (32 * ni + r32) * 132 + 16 * s + 8 * hh + 4);
          acc = MFMA32(pack8(a0[0], a0[1], a0[2], a0[3], a1[0], a1[1], a1[2], a1[3]), pack8(b0[0], b0[1], b0[2], b0[3], b1[0], b1[1], b1[2], b1[3]), acc); }
      const int sc = 32 * ni + r32; const float gs = gcL[sc];
#pragma unroll
      for (int r = 0; r < 16; ++r) { const int c = 32 * mi + crow(r, hh); const float dec = __expf(gcL[c] - gs);
          if (mat == 0) Lm[c * 68 + sc] = (c > sc) ? betaL[c] * acc[r] * dec : 0.f; else Qm[c * 68 + sc] = (c >= sc) ? acc[r] * dec : 0.f; } }
    __syncthreads();
    {   bf16_t* QGp = (bf16_t*)(ws + WS_QGP) + (size_t)task * 8192; bf16_t* KDTp = (bf16_t*)(ws + WS_KDTP) + (size_t)task * 8192; bf16_t* QKp = (bf16_t*)(ws + WS_QKP) + (size_t)task * 4096;
        for (int id = tid; id < 1024; id += 512) { const int c = id >> 4, chn = id & 15, ks = chn >> 2, q = chn & 3; const float e = egL[c];
            const f32x4 a = *(const f32x4*)(qL + c * 132 + 32 * ks + 4 * q), bq = *(const f32x4*)(qL + c * 132 + 32 * ks + 16 + 4 * q);
            *(bf16x8*)(QGp + id * 8) = pack8(a[0] * e, a[1] * e, a[2] * e, a[3] * e, bq[0] * e, bq[1] * e, bq[2] * e, bq[3] * e); }
        for (int id = tid; id < 1024; id += 512) { const int d = id >> 3, chn = id & 7, ks = chn >> 2, q = chn & 3; float f[8];
#pragma unroll
            for (int j = 0; j < 8; ++j) { const int s = 32 * ks + 16 * (j >> 2) + 4 * q + (j & 3); f[j] = kL[s * 132 + d] * kdsL[s]; }
            *(bf16x8*)(KDTp + id * 8) = pack8(f[0], f[1], f[2], f[3], f[4], f[5], f[6], f[7]); }
        { const int id = tid; const int c = id >> 3, chn = id & 7, ks = chn >> 2, q = chn & 3;
            const f32x4 a = *(const f32x4*)(Qm + c * 68 + 32 * ks + 4 * q), bq = *(const f32x4*)(Qm + c * 68 + 32 * ks + 16 + 4 * q);
            *(bf16x8*)(QKp + id * 8) = pack8(a[0], a[1], a[2], a[3], bq[0], bq[1], bq[2], bq[3]); } }
    __syncthreads();
    if (tid < 256) { const bool isW = tid >= 128; float* col = (isW ? kL : vL) + (tid & 127);
#pragma unroll 1
        for (int bi = 0; bi < 4; ++bi) {
            float r[16];
#pragma unroll
            for (int ii = 0; ii < 16; ++ii) { const int i = 16 * bi + ii; float v = col[i * 132] * betaL[i]; if (isW) v *= egL[i]; r[ii] = v; }
#pragma unroll 1
            for (int j = 0; j < 16 * bi; j += 4) {
                const float x0 = col[j * 132], x1 = col[(j + 1) * 132], x2 = col[(j + 2) * 132], x3 = col[(j + 3) * 132];
#pragma unroll
                for (int ii = 0; ii < 16; ++ii) { const f32x4 l4 = *(const f32x4*)(Lm + (16 * bi + ii) * 68 + j); r[ii] -= (l4[0] * x0 + l4[1] * x1) + (l4[2] * x2 + l4[3] * x3); } }
#pragma unroll
            for (int ii = 1; ii < 16; ++ii) {
#pragma unroll
                for (int j4 = 0; j4 < (ii + 3) / 4; ++j4) { const f32x4 l4 = *(const f32x4*)(Lm + (16 * bi + ii) * 68 + 16 * bi + 4 * j4);
#pragma unroll
                    for (int jj = 0; jj < 4; ++jj) if (4 * j4 + jj < ii) r[ii] -= l4[jj] * r[4 * j4 + jj]; } }
#pragma unroll
            for (int ii = 0; ii < 16; ++ii) col[(16 * bi + ii) * 132] = r[ii];
        } }
    __syncthreads();
    { bf16_t* Wp = (bf16_t*)(ws + WS_WP) + (size_t)task * 8192; bf16_t* Up = (bf16_t*)(ws + WS_UP) + (size_t)task * 8192;
      for (int id = tid; id < 1024; id += 512) { const int c = id >> 4, chn = id & 15, ks = chn >> 2, q = chn & 3;
          const f32x4 a = *(const f32x4*)(kL + c * 132 + 32 * ks + 4 * q), bq = *(const f32x4*)(kL + c * 132 + 32 * ks + 16 + 4 * q);
          *(bf16x8*)(Wp + id * 8) = pack8(a[0], a[1], a[2], a[3], bq[0], bq[1], bq[2], bq[3]); }
      for (int id = tid; id < 2048; id += 512) { const int ln = id & 63, mt = (id >> 6) & 3, es = id >> 8, q = ln >> 4, e = ln & 15; const int c = 16 * mt + 4 * q, col = 16 * es + e;
          u32x2 o; o.x = pk2(vL[c * 132 + col], vL[(c + 1) * 132 + col]); o.y = pk2(vL[(c + 2) * 132 + col], vL[(c + 3) * 132 + col]);
          *(u32x2*)(Up + id * 4) = o; } }
    __syncthreads();
}

DI void gdn_scan_wave(const Args& A, int sidx, int lane) {
    const int es = sidx & 7, bh = sidx >> 3, b = bh >> 2, h = bh & 3, r16 = lane & 15, q = lane >> 4;
    unsigned char* ws = A.ws;
    const bf16_t* WP = (const bf16_t*)(ws + WS_WP) + (size_t)bh * 128 * 8192; const bf16_t* QGP = (const bf16_t*)(ws + WS_QGP) + (size_t)bh * 128 * 8192;
    const bf16_t* KDTP = (const bf16_t*)(ws + WS_KDTP) + (size_t)bh * 128 * 8192; const bf16_t* QKP = (const bf16_t*)(ws + WS_QKP) + (size_t)bh * 128 * 4096;
    const bf16_t* UP = (const bf16_t*)(ws + WS_UP) + (size_t)bh * 128 * 8192; const float* GL = (const float*)(ws + WS_GL) + bh * 128;
    bf16_t* OG = (bf16_t*)(ws + WS_OG);
    f32x4 S[8];
#pragma unroll
    for (int m = 0; m < 8; ++m) S[m] = (f32x4){0.f, 0.f, 0.f, 0.f};
    for (int i = 0; i < 128; ++i) {
        const bf16_t* wp = WP + (size_t)i * 8192 + r16 * 128 + 8 * q; const bf16_t* qgp = QGP + (size_t)i * 8192 + r16 * 128 + 8 * q;
        const bf16_t* kdp = KDTP + (size_t)i * 8192 + r16 * 64 + 8 * q; const bf16_t* qkp = QKP + (size_t)i * 4096 + r16 * 64 + 8 * q;
        const bf16_t* up = UP + (size_t)i * 8192 + (size_t)(es * 4) * 256 + lane * 4;
        const float gl = GL[i];
        bf16x8 Sb[4];
#pragma unroll
        for (int ks = 0; ks < 4; ++ks) Sb[ks] = pack8(S[2 * ks][0], S[2 * ks][1], S[2 * ks][2], S[2 * ks][3], S[2 * ks + 1][0], S[2 * ks + 1][1], S[2 * ks + 1][2], S[2 * ks + 1][3]);
        f32x4 vn[4];
#pragma unroll
        for (int mt = 0; mt < 4; ++mt) { f32x4 acc = (f32x4){0.f, 0.f, 0.f, 0.f};
#pragma unroll
            for (int ks = 0; ks < 4; ++ks) acc = MFMA16(*(const bf16x8*)(wp + mt * 2048 + ks * 32), Sb[ks], acc);
            const u32x2 uw = *(const u32x2*)(up + mt * 256);
            vn[mt] = (f32x4){bflo(uw.x) - acc[0], bfhi(uw.x) - acc[1], bflo(uw.y) - acc[2], bfhi(uw.y) - acc[3]}; }
        bf16x8 Vb[2];
#pragma unroll
        for (int k2 = 0; k2 < 2; ++k2) Vb[k2] = pack8(vn[2 * k2][0], vn[2 * k2][1], vn[2 * k2][2], vn[2 * k2][3], vn[2 * k2 + 1][0], vn[2 * k2 + 1][1], vn[2 * k2 + 1][2], vn[2 * k2 + 1][3]);
#pragma unroll
        for (int mt = 0; mt < 4; ++mt) { f32x4 acc = (f32x4){0.f, 0.f, 0.f, 0.f};
#pragma unroll
            for (int ks = 0; ks < 4; ++ks) acc = MFMA16(*(const bf16x8*)(qgp + mt * 2048 + ks * 32), Sb[ks], acc);
#pragma unroll
            for (int k2 = 0; k2 < 2; ++k2) acc = MFMA16(*(const bf16x8*)(qkp + mt * 1024 + k2 * 32), Vb[k2], acc);
            bf16_t* op = OG + ((size_t)b * T + i * 64 + 16 * mt + 4 * q) * 512 + h * 128 + es * 16 + r16;
            op[0] = f2bf(acc[0]); op[512] = f2bf(acc[1]); op[1024] = f2bf(acc[2]); op[1536] = f2bf(acc[3]); }
#pragma unroll
        for (int m = 0; m < 8; ++m) { f32x4 acc = S[m] * gl;
#pragma unroll
            for (int k2 = 0; k2 < 2; ++k2) acc = MFMA16(*(const bf16x8*)(kdp + m * 1024 + k2 * 32), Vb[k2], acc);
            S[m] = acc; }
    }
}

template <bool MASK>
DI f32x16 tile32(const bf16_t* __restrict__ K, const bf16_t* __restrict__ VT, int vp, const bf16x8 (&qf)[4], f32x16 (&o)[2], float& l, float negM,
                 int kidx0, int hi, int lo, int r32, int hh) {
    bf16x8 kf[4], vf[2][2];
#pragma unroll
    for (int s = 0; s < 4; ++s) kf[s] = *(const bf16x8*)(K + r32 * 64 + 16 * s + 8 * hh);
#pragma unroll
    for (int dt = 0; dt < 2; ++dt)
#pragma unroll
        for (int ks = 0; ks < 2; ++ks) vf[dt][ks] = *(const bf16x8*)(VT + (size_t)(32 * dt + r32) * vp + 16 * ks + 8 * hh);
    f32x16 st;
#pragma unroll
    for (int i = 0; i < 16; ++i) st[i] = negM;
#pragma unroll
    for (int s = 0; s < 4; ++s) st = MFMA32(kf[s], qf[s], st);
#pragma unroll
    for (int r = 0; r < 16; ++r) { const int kidx = kidx0 + crow(r, hh); float pv = __builtin_amdgcn_exp2f(st[r]);
        if (MASK) pv = (kidx <= hi && kidx > lo) ? pv : 0.f;
        st[r] = pv; l += pv; }
    const bf16x8 pb0 = pack8(st[0], st[1], st[2], st[3], st[4], st[5], st[6], st[7]), pb1 = pack8(st[8], st[9], st[10], st[11], st[12], st[13], st[14], st[15]);
#pragma unroll
    for (int dt = 0; dt < 2; ++dt) { o[dt] = MFMA32(vf[dt][0], pb0, o[dt]); o[dt] = MFMA32(vf[dt][1], pb1, o[dt]); }
    return st;
}

DI float maxabs64(const float* g, int lane) { float v = fabsf(g[lane]);
#pragma unroll
    for (int o = 1; o < 64; o <<= 1) v = fmaxf(v, __shfl_xor(v, o));
    return v; }

DI float tile32_l(const bf16_t* __restrict__ K, const bf16x8 (&qf)[4], float negM, int kidx0, int hi, int r32, int hh) {
    bf16x8 kf[4];
#pragma unroll
    for (int s = 0; s < 4; ++s) kf[s] = *(const bf16x8*)(K + r32 * 64 + 16 * s + 8 * hh);
    f32x16 st;
#pragma unroll
    for (int i = 0; i < 16; ++i) st[i] = negM;
#pragma unroll
    for (int s = 0; s < 4; ++s) st = MFMA32(kf[s], qf[s], st);
    float l = 0.f;
#pragma unroll
    for (int r = 0; r < 16; ++r) { const int kidx = kidx0 + crow(r, hh); const float pv = __builtin_amdgcn_exp2f(st[r]); l += (kidx <= hi) ? pv : 0.f; }
    return l;
}

DI void nsa_unit(const Args& A, int unit, unsigned char* lds) {
    const int tid = threadIdx.x, lane = tid & 63, wave = __builtin_amdgcn_readfirstlane(tid >> 6), r32 = lane & 31, hh = lane >> 5;
    const int ti = 127 - (unit >> 2), bg = unit & 3, b = bg >> 1, g = bg & 1;
    unsigned char* ws = A.ws;
    bf16_t* QL = (bf16_t*)lds;
    float* OL = (float*)(lds + 36864);
    float* LL = (float*)(lds + 36864 + 67584);
    unsigned* BM = (unsigned*)(lds + 36864 + 67584 + 1024);
    int* CNT = (int*)(lds + 36864 + 67584 + 2048);
    float* IMP = (float*)(lds + 108544);
    const int slot = r32 >> 2, hd = r32 & 3, tl = wave * 8 + slot, trow = ti * 64 + tl; const size_t tokg = (size_t)b * T + trow;
    const int row = wave * 32 + r32;
    const float mq = maxabs64(A.in[I_QG], lane) * 8.08f * LOG2E;
    const float negMc = -mq * maxabs64(A.in[I_KCG], lane), negMs = -mq * maxabs64(A.in[I_KSG], lane), negMw = -mq * maxabs64(A.in[I_KWG], lane);
    for (int i = tid; i < 512 + 16; i += 512) BM[i] = 0u;
    bf16x8 qf[4];
    { const bf16_t* qp = (const bf16_t*)(ws + WS_QN) + tokg * 512 + (g * 4 + hd) * 64 + 8 * hh;
#pragma unroll
      for (int s = 0; s < 4; ++s) { qf[s] = *(const bf16x8*)(qp + 16 * s); *(bf16x8*)(QL + row * 72 + 16 * s + 8 * hh) = qf[s]; } }
    const float* gp = (const float*)(ws + WS_GATES) + tokg * 24 + (g * 4 + hd) * 3; const float g0 = gp[0], g1 = gp[1], g2 = gp[2];
    __syncthreads();
    f32x16 outA[2];
    {   const int cmax_row = (trow >= 31) ? ((trow - 31) >> 4) : -1; const int tmaxw = ti * 64 + wave * 8 + 7; const int ntc = (tmaxw >= 31) ? ((((tmaxw - 31) >> 4) >> 5) + 1) : 0;
        const bf16_t* Kc = (const bf16_t*)(ws + WS_KC) + (size_t)(b * 2 + g) * 512 * 64; const bf16_t* VcT = (const bf16_t*)(ws + WS_VCT) + (size_t)(b * 2 + g) * 64 * 512;
        float lc = 0.f;
#pragma unroll 1
        for (int ct = 0; ct < ntc; ++ct) lc += tile32_l(Kc + ct * 32 * 64, qf, negMc, 32 * ct, cmax_row, r32, hh);
        lc += __shfl_xor(lc, 32);
        const float inv = (lc > 0.f) ? 1.f / lc : 0.f;
        f32x16 oc[2]; for (int i = 0; i < 16; ++i) { oc[0][i] = 0.f; oc[1][i] = 0.f; }
        float carry = 0.f, ldummy = 0.f;
#pragma unroll 1
        for (int ct = 0; ct < 16; ++ct) {
            float v = 0.f;
            if (ct < ntc) { const f32x16 p = tile32<true>(Kc + ct * 32 * 64, VcT + ct * 32, 512, qf, oc, ldummy, negMc, 32 * ct, cmax_row, -1, r32, hh);
                float recv[4], bq[4];
#pragma unroll
                for (int jq = 0; jq < 4; ++jq) recv[jq] = __shfl_xor(p[4 * jq + 3], 32);
#pragma unroll
                for (int jq = 0; jq < 4; ++jq) { const float pred = hh ? recv[jq] : (jq ? recv[jq - 1] : carry); float s = ((p[4 * jq] + p[4 * jq + 1]) + (p[4 * jq + 2] + p[4 * jq + 3]) + pred) * inv;
                    s += __shfl_xor(s, 1); s += __shfl_xor(s, 2); bq[jq] = s; }
                carry = recv[3];
                v = (hd == 0) ? bq[0] : (hd == 1) ? bq[1] : (hd == 2) ? bq[2] : bq[3]; }
            IMP[tl * 128 + 8 * ct + 2 * hd + hh] = v; }
        const float sc = g0 * inv;
#pragma unroll
        for (int i = 0; i < 16; ++i) { outA[0][i] = oc[0][i] * sc; outA[1][i] = oc[1][i] * sc; }
    }
    if (ti >= 3) {
        __builtin_amdgcn_s_waitcnt(0xC07F); asm volatile("" ::: "memory");
        unsigned key[16]; const int li = hd + 4 * hh;
#pragma unroll
        for (int i4 = 0; i4 < 4; ++i4) { const f32x4 v4 = *(const f32x4*)(IMP + tl * 128 + li * 16 + 4 * i4);
#pragma unroll
            for (int i = 0; i < 4; ++i) { const int n = li * 16 + 4 * i4 + i; key[4 * i4 + i] = (n >= 1 && n <= ti - 2) ? ((__float_as_uint(fmaxf(v4[i], 0.f)) & ~0xFFu) | (unsigned)(128 - n)) : 0u; } }
#pragma unroll 1
        for (int it = 0; it < 13; ++it) { unsigned m = key[0];
#pragma unroll
            for (int i = 1; i < 16; ++i) m = (key[i] > m) ? key[i] : m;
            { unsigned o_; o_ = __shfl_xor(m, 1); m = o_ > m ? o_ : m; o_ = __shfl_xor(m, 2); m = o_ > m ? o_ : m; o_ = __shfl_xor(m, 32); m = o_ > m ? o_ : m; }
#pragma unroll
            for (int i = 0; i < 16; ++i) key[i] = (key[i] == m) ? 0u : key[i];
            if (m != 0u && hd == 0 && hh == 0) { const int nsel = 128 - (int)(m & 0xFFu); atomicOr(&BM[nsel * 2 + (tl >> 5)], 1u << (tl & 31)); } }
    }
    { const bf16_t* KS = (const bf16_t*)(ws + WS_KSN) + (size_t)(b * 2 + g) * T * 64; const bf16_t* VS = (const bf16_t*)(ws + WS_VST) + (size_t)(b * 2 + g) * 128 * 4096;
      f32x16 os[2]; float lsel = 0.f; for (int i = 0; i < 16; ++i) { os[0][i] = 0.f; os[1][i] = 0.f; }
      const int nf = (ti == 0) ? 1 : (ti == 1) ? 2 : 3;
#pragma unroll 1
      for (int f = 0; f < nf; ++f) { const int n = (f == 0) ? ti : (f == 1) ? ti - 1 : 0;
#pragma unroll 1
          for (int half = 0; half < 2; ++half) tile32<true>(KS + ((size_t)n * 64 + 32 * half) * 64, VS + (size_t)n * 4096 + 32 * half, 64, qf, os, lsel, negMs, n * 64 + 32 * half, trow, -1, r32, hh); }
      lsel += __shfl_xor(lsel, 32);
#pragma unroll
      for (int dt = 0; dt < 2; ++dt)
#pragma unroll
          for (int r = 0; r < 16; ++r) OL[row * 66 + 32 * dt + crow(r, hh)] = os[dt][r];
      if (hh == 0) LL[row] = lsel; }
    { const bf16_t* KW = (const bf16_t*)(ws + WS_KWN) + (size_t)(b * 2 + g) * T * 64; const bf16_t* VW = (const bf16_t*)(ws + WS_VWT) + (size_t)(b * 2 + g) * 128 * 4096;
      f32x16 ow[2]; float lw = 0.f; for (int i = 0; i < 16; ++i) { ow[0][i] = 0.f; ow[1][i] = 0.f; }
      const int tw0 = ti * 64 + wave * 8; const int nlo = (tw0 - 511 > 0) ? ((tw0 - 511) >> 6) : 0;
#pragma unroll 1
      for (int n = nlo; n <= ti; ++n) {
#pragma unroll 1
          for (int half = 0; half < 2; ++half) tile32<true>(KW + ((size_t)n * 64 + 32 * half) * 64, VW + (size_t)n * 4096 + 32 * half, 64, qf, ow, lw, negMw, n * 64 + 32 * half, trow, trow - 512, r32, hh); }
      lw += __shfl_xor(lw, 32); const float sc = g2 / lw;
#pragma unroll
      for (int i = 0; i < 16; ++i) { outA[0][i] += ow[0][i] * sc; outA[1][i] += ow[1][i] * sc; } }
    { bf16_t* PA = (bf16_t*)IMP + row * 64;
#pragma unroll
      for (int dt = 0; dt < 2; ++dt)
#pragma unroll
          for (int r4 = 0; r4 < 4; ++r4) { u32x2 o; o.x = pk2(outA[dt][4 * r4], outA[dt][4 * r4 + 1]); o.y = pk2(outA[dt][4 * r4 + 2], outA[dt][4 * r4 + 3]);
              *(u32x2*)(PA + 32 * dt + 8 * r4 + 4 * hh) = o; } }
    __syncthreads();
    if (ti >= 3) {
        const bf16_t* KS = (const bf16_t*)(ws + WS_KSN) + (size_t)(b * 2 + g) * T * 64; const bf16_t* VS = (const bf16_t*)(ws + WS_VST) + (size_t)(b * 2 + g) * 128 * 4096;
        for (;;) {
            int k = 0; if (lane == 0) k = atomicAdd(CNT, 1); k = __builtin_amdgcn_readfirstlane(k);
            if (k >= ti - 2) break;
            const int n = ti - 2 - k;
            const unsigned mlo = __builtin_amdgcn_readfirstlane(BM[n * 2]), mhi = __builtin_amdgcn_readfirstlane(BM[n * 2 + 1]);
            unsigned long long m64 = ((unsigned long long)mhi << 32) | mlo;
            if (m64 == 0ull) continue;
            bf16x8 kf[2][4], vf[2][4];
            { const bf16_t* Kb = KS + (size_t)n * 64 * 64; const bf16_t* Vb = VS + (size_t)n * 4096;
#pragma unroll
              for (int kt = 0; kt < 2; ++kt)
#pragma unroll
                  for (int s = 0; s < 4; ++s) kf[kt][s] = *(const bf16x8*)(Kb + (32 * kt + r32) * 64 + 16 * s + 8 * hh);
#pragma unroll
              for (int dt = 0; dt < 2; ++dt)
#pragma unroll
                  for (int ks = 0; ks < 4; ++ks) vf[dt][ks] = *(const bf16x8*)(Vb + (32 * dt + r32) * 64 + 16 * ks + 8 * hh); }
            while (m64 != 0ull) {
                unsigned long long mm = m64; for (int i = 0; i < slot; ++i) mm &= mm - 1ull;
                const bool active = mm != 0ull; const int tt = active ? (__ffsll((long long)mm) - 1) : (__ffsll((long long)m64) - 1);
                const int grow = tt * 4 + hd;
                bf16x8 qg[4];
#pragma unroll
                for (int s = 0; s < 4; ++s) qg[s] = *(const bf16x8*)(QL + grow * 72 + 16 * s + 8 * hh);
                f32x16 oo[2]; for (int i = 0; i < 16; ++i) { oo[0][i] = 0.f; oo[1][i] = 0.f; }
                float lp = 0.f;
#pragma unroll
                for (int kt = 0; kt < 2; ++kt) {
                    f32x16 st;
#pragma unroll
                    for (int i = 0; i < 16; ++i) st[i] = negMs;
#pragma unroll
                    for (int s = 0; s < 4; ++s) st = MFMA32(kf[kt][s], qg[s], st);
#pragma unroll
                    for (int r = 0; r < 16; ++r) { const float pv = active ? __builtin_amdgcn_exp2f(st[r]) : 0.f; st[r] = pv; lp += pv; }
                    const bf16x8 pb0 = pack8(st[0], st[1], st[2], st[3], st[4], st[5], st[6], st[7]);
                    const bf16x8 pb1 = pack8(st[8], st[9], st[10], st[11], st[12], st[13], st[14], st[15]);
#pragma unroll
                    for (int dt = 0; dt < 2; ++dt) { oo[dt] = MFMA32(vf[dt][2 * kt], pb0, oo[dt]); oo[dt] = MFMA32(vf[dt][2 * kt + 1], pb1, oo[dt]); } }
                if (active) {
#pragma unroll
                    for (int dt = 0; dt < 2; ++dt)
#pragma unroll
                        for (int r = 0; r < 16; ++r) atomicAdd(&OL[grow * 66 + 32 * dt + crow(r, hh)], oo[dt][r]);
                    atomicAdd(&LL[grow], lp); }
                for (int i = 0; i < 8; ++i) m64 &= m64 - 1ull;
            }
        }
    }
    __syncthreads();
    { const float sc = g1 / LL[row];
      bf16_t* op = (bf16_t*)(ws + WS_ONSA) + tokg * 512 + (g * 4 + hd) * 64;
#pragma unroll
      for (int dt = 0; dt < 2; ++dt)
#pragma unroll
          for (int r4 = 0; r4 < 4; ++r4) { float f[4];
              const u32x2 pa = *(const u32x2*)((const bf16_t*)IMP + row * 64 + 32 * dt + 8 * r4 + 4 * hh); const float pf[4] = {bflo(pa.x), bfhi(pa.x), bflo(pa.y), bfhi(pa.y)};
#pragma unroll
              for (int i = 0; i < 4; ++i) { const int r = 4 * r4 + i; f[i] = pf[i] + OL[row * 66 + 32 * dt + crow(r, hh)] * sc; }
              u32x2 o; o.x = pk2(f[0], f[1]); o.y = pk2(f[2], f[3]);
              *(u32x2*)(op + 32 * dt + 8 * r4 + 4 * hh) = o; } }
    __syncthreads();
}

DI void phase_finalize(const Args& A) {
    const int tid = threadIdx.x, lane = tid & 63, wave = tid >> 6; const int gw = blockIdx.x * 8 + wave, NGW = gridDim.x * 8;
    unsigned char* ws = A.ws;
    for (int tok = gw; tok < NTOK; tok += NGW) {
        bf16_t* oc = (bf16_t*)(ws + WS_OCAT) + (size_t)tok * 1024;
        { const u32x4 w = *(const u32x4*)((const bf16_t*)(ws + WS_ONSA) + (size_t)tok * 512 + 8 * lane);
          float f[8] = {bflo(w.x), bfhi(w.x), bflo(w.y), bfhi(w.y), bflo(w.z), bfhi(w.z), bflo(w.w), bfhi(w.w)}; float s = 0.f;
#pragma unroll
          for (int i = 0; i < 8; ++i) s += f[i] * f[i];
          const float rs = rsqrtf(wave_sum(s) * (1.f / 512.f) + EPS); const float* gn = A.in[I_NSAOG] + 8 * lane;
          u32x4 o; o.x = pk2(f[0] * rs * gn[0], f[1] * rs * gn[1]); o.y = pk2(f[2] * rs * gn[2], f[3] * rs * gn[3]); o.z = pk2(f[4] * rs * gn[4], f[5] * rs * gn[5]); o.w = pk2(f[6] * rs * gn[6], f[7] * rs * gn[7]);
          *(u32x4*)(oc + 8 * lane) = o; }
        { const u32x4 w = *(const u32x4*)((const bf16_t*)(ws + WS_OG) + (size_t)tok * 512 + 8 * lane);
          const u32x4 zw = *(const u32x4*)((const bf16_t*)(ws + WS_U) + (size_t)tok * INWP + C_GZ + 8 * lane);
          float f[8] = {bflo(w.x), bfhi(w.x), bflo(w.y), bfhi(w.y), bflo(w.z), bfhi(w.z), bflo(w.w), bfhi(w.w)};
          float z[8] = {bflo(zw.x), bfhi(zw.x), bflo(zw.y), bfhi(zw.y), bflo(zw.z), bfhi(zw.z), bflo(zw.w), bfhi(zw.w)}; float s = 0.f;
#pragma unroll
          for (int i = 0; i < 8; ++i) s += f[i] * f[i];
          s += __shfl_xor(s, 1); s += __shfl_xor(s, 2); s += __shfl_xor(s, 4); s += __shfl_xor(s, 8);
          const float rs = rsqrtf(s * (1.f / 128.f) + EPS); const float* gn = A.in[I_GDNOG] + (8 * lane & 127); float o8[8];
#pragma unroll
          for (int i = 0; i < 8; ++i) o8[i] = f[i] * rs * gn[i] * z[i] * sigm(z[i]);
          u32x4 o; o.x = pk2(o8[0], o8[1]); o.y = pk2(o8[2], o8[3]); o.z = pk2(o8[4], o8[5]); o.w = pk2(o8[6], o8[7]);
          *(u32x4*)(oc + 512 + 8 * lane) = o; }
    }
}

DI void phase_router(const Args& A, unsigned char* lds) {
    const int tid = threadIdx.x, lane = tid & 63, wave = tid >> 6; const int gw = blockIdx.x * 8 + wave, NGW = gridDim.x * 8;
    unsigned char* ws = A.ws; const float* x1 = A.out; const float* rw = A.in[I_RW]; const float* fg = A.in[I_FFNG];
    float* lgL = (float*)(lds + wave * 8192); float* rsL = lgL + 32 * 33;
    const int i32 = lane & 31, kh = lane >> 5;
    for (int task = gw; task < NTOK / 32; task += NGW) {
        const int tok = task * 32 + i32; const float* xr = x1 + (size_t)tok * D;
        f32x16 acc; for (int i = 0; i < 16; ++i) acc[i] = 0.f; float ss = 0.f;
#pragma unroll 2
        for (int kb = 0; kb < 128; ++kb) { const int k0 = 8 * kb + 4 * kh; const f32x4 av = *(const f32x4*)(xr + k0); const f32x4 gv = *(const f32x4*)(fg + k0);
            ss += av[0] * av[0] + av[1] * av[1] + av[2] * av[2] + av[3] * av[3];
#pragma unroll
            for (int s = 0; s < 4; ++s) acc = __builtin_amdgcn_mfma_f32_32x32x2f32(av[s], rw[(size_t)(k0 + s) * 32 + i32] * gv[s], acc, 0, 0, 0); }
        ss += __shfl_xor(ss, 32); const float rstd = rsqrtf(ss * (1.f / D) + EPS);
        if (kh == 0) { rsL[i32] = rstd; ((float*)(ws + WS_RSTD2))[tok] = rstd; }
#pragma unroll
        for (int r = 0; r < 16; ++r) lgL[crow(r, kh) * 33 + i32] = acc[r];
        __builtin_amdgcn_s_waitcnt(0xC07F); asm volatile("" ::: "memory");
        if (lane < 32) { float v[4] = {-3.0e38f, -3.0e38f, -3.0e38f, -3.0e38f}; int id[4] = {0, 0, 0, 0}; const float* rb = A.in[I_RB];
            for (int e = 0; e < 32; ++e) { const float x = lgL[lane * 33 + e] * rstd + rb[e];
                if (x > v[3]) { if (x > v[0]) { v[3] = v[2]; id[3] = id[2]; v[2] = v[1]; id[2] = id[1]; v[1] = v[0]; id[1] = id[0]; v[0] = x; id[0] = e; }
                    else if (x > v[1]) { v[3] = v[2]; id[3] = id[2]; v[2] = v[1]; id[2] = id[1]; v[1] = x; id[1] = e; }
                    else if (x > v[2]) { v[3] = v[2]; id[3] = id[2]; v[2] = x; id[2] = e; }
                    else { v[3] = x; id[3] = e; } } }
            const float e0 = 1.f, e1 = __expf(v[1] - v[0]), e2 = __expf(v[2] - v[0]), e3 = __expf(v[3] - v[0]); const float inv = 1.f / (e0 + e1 + e2 + e3);
            const float gt[4] = {e0 * inv, e1 * inv, e2 * inv, e3 * inv};
#pragma unroll
            for (int k = 0; k < 4; ++k) { const int pos = atomicAdd((unsigned*)(ws + WS_CTL) + CW_CNT + id[k], 1u);
                ((int*)(ws + WS_TOKE))[tok * 4 + k] = id[k]; ((float*)(ws + WS_TOKG))[tok * 4 + k] = gt[k]; ((int*)(ws + WS_TOKPOS))[tok * 4 + k] = pos; } }
        __builtin_amdgcn_s_waitcnt(0xC07F); asm volatile("" ::: "memory");
    }
}

DI void phase_gather(const Args& A, unsigned char* lds) {
    const int tid = threadIdx.x, lane = tid & 63, wave = tid >> 6; const int gw = blockIdx.x * 8 + wave, NGW = gridDim.x * 8;
    unsigned char* ws = A.ws; int* psL = (int*)lds;
    if (tid == 0) { const unsigned* cnt = (const unsigned*)(ws + WS_CTL) + CW_CNT; int acc = 0;
        for (int e = 0; e < 32; ++e) { psL[e] = acc; acc += ((int)cnt[e] + 255) & ~255; }
        psL[32] = acc;
        if (blockIdx.x == 0) { int* ctl = (int*)(ws + WS_CTL); ctl[CW_NT] = acc >> 8; int e = 0;
            for (int r = 0; r < (acc >> 8); ++r) { while (r * 256 >= psL[e + 1]) ++e; ctl[CW_TILEE + r] = e; } } }
    __syncthreads();
    const float* x1 = A.out; const float* fg = A.in[I_FFNG]; f32x4 gv[4];
#pragma unroll
    for (int j = 0; j < 4; ++j) gv[j] = *(const f32x4*)(fg + 4 * lane + 256 * j);
    for (int pr = gw; pr < NTOK * 4; pr += NGW) { const int tok = pr >> 2;
        const int e = ((const int*)(ws + WS_TOKE))[pr], pos = ((const int*)(ws + WS_TOKPOS))[pr]; const int dest = psL[e] + pos;
        if (lane == 0) { ((int*)(ws + WS_DEST))[pr] = dest; ((float*)(ws + WS_ROWG))[dest] = ((const float*)(ws + WS_TOKG))[pr]; }
        const float rs = ((const float*)(ws + WS_RSTD2))[tok]; const f32x4* xr = (const f32x4*)(x1 + (size_t)tok * D) + lane;
        u32x2* o = (u32x2*)((bf16_t*)(ws + WS_XS) + (size_t)dest * D) + lane;
#pragma unroll
        for (int j = 0; j < 4; ++j) { const f32x4 v = xr[64 * j]; u32x2 w; w.x = pk2(v.x * rs * gv[j].x, v.y * rs * gv[j].y); w.y = pk2(v.z * rs * gv[j].z, v.w * rs * gv[j].w); o[64 * j] = w; } }
}

DI void phase_combine(const Args& A) {
    const int tid = threadIdx.x, lane = tid & 63, wave = tid >> 6; const int gw = blockIdx.x * 8 + wave, NGW = gridDim.x * 8;
    unsigned char* ws = A.ws; const bf16_t* YS = (const bf16_t*)(ws + WS_XS);
    for (int tok = gw; tok < NTOK; tok += NGW) { f32x4* xr = (f32x4*)(A.out + (size_t)tok * D) + lane; f32x4 v[4];
#pragma unroll
        for (int j = 0; j < 4; ++j) v[j] = xr[64 * j];
#pragma unroll
        for (int k = 0; k < 4; ++k) { const int dest = ((const int*)(ws + WS_DEST))[tok * 4 + k]; const u32x2* yr = (const u32x2*)(YS + (size_t)dest * D) + lane;
#pragma unroll
            for (int j = 0; j < 4; ++j) { const u32x2 w = yr[64 * j]; v[j].x += bflo(w.x); v[j].y += bfhi(w.x); v[j].z += bflo(w.y); v[j].w += bfhi(w.y); } }
#pragma unroll
        for (int j = 0; j < 4; ++j) xr[64 * j] = v[j]; }
}

__global__ void __launch_bounds__(512, 2) mega(Args A) {
    extern __shared__ __attribute__((aligned(16))) unsigned char lds[];
    cg::grid_group grid = cg::this_grid();
    const int lo = A.ph_lo, hi = A.ph_hi, tid = threadIdx.x;
    unsigned char* ws = A.ws;
    int* taskL = (int*)(lds + LDS_MISC);
#define IN(k) (lo <= (k) && (k) < hi)
#define SEAM(k) do { if (IN(k) && IN((k) + 1)) grid.sync(); } while (0)

    if (IN(0)) phase0(A, lds);
    SEAM(0);
    if (IN(1)) { pg8::Gemm g{(const bf16_t*)(ws + WS_XN), (const bf16_t*)(ws + WS_WTIN), NTOK, INWP, D}; pg8::StaticOrder S; S.init(NTOK, INWP, gridDim.x, blockIdx.x);
        pg8::EpiU E{(bf16_t*)(ws + WS_U), INWP}; pg8::gemm_phase<pg8::EpiU, pg8::StaticOrder>((PG8_LAS unsigned char*)lds, g, S, E); }
    SEAM(1);
    if (IN(2)) {
        for (;;) { if (tid == 0) *taskL = atomicAdd((int*)(ws + WS_CTL) + CW_Q2, 1); __syncthreads(); const int task = *taskL; __syncthreads();
            if (task >= 1408) break;
            if (task < 128) compress_task(A, task, lds); else if (task < 1152) gdn_chunk_task(A, task - 128, lds); else nsa_prep_task(A, task - 1152, lds); } }
    SEAM(2);
    if (IN(3)) {
        if (blockIdx.x < 64) { if (tid < 64) gdn_scan_wave(A, blockIdx.x, tid); __syncthreads(); }
        for (;;) { if (tid == 0) *taskL = atomicAdd((int*)(ws + WS_CTL) + CW_Q3, 1); __syncthreads(); const int unit = *taskL; __syncthreads();
            if (unit >= 512) break;
            nsa_unit(A, unit, lds); } }
    SEAM(3);
    if (IN(4)) phase_finalize(A);
    SEAM(4);
    if (IN(5)) { pg8::Gemm g{(const bf16_t*)(ws + WS_OCAT), (const bf16_t*)(ws + WS_WTOUT), NTOK, D, D}; pg8::StaticOrder S; S.init(NTOK, D, gridDim.x, blockIdx.x);
        pg8::EpiRes E{A.in[I_X], A.out, D}; pg8::gemm_phase<pg8::EpiRes, pg8::StaticOrder>((PG8_LAS unsigned char*)lds, g, S, E); }
    SEAM(5);
    if (IN(6)) phase_router(A, lds);
    SEAM(6);
    if (IN(7)) phase_gather(A, lds);
    SEAM(7);
    if (IN(8)) { const int* ctl = (const int*)(ws + WS_CTL); const int nM = ctl[CW_NT];
        pg8::Gemm g{(const bf16_t*)(ws + WS_XS), (const bf16_t*)(ws + WS_EXPGU), 0, 0, D}; pg8::MoeOrder S; S.init(nM, 8, gridDim.x, blockIdx.x, ctl + CW_TILEE);
        pg8::EpiSwiglu E{(bf16_t*)(ws + WS_HID), A.in[I_EBG], A.in[I_EBU]}; pg8::gemm_phase<pg8::EpiSwiglu, pg8::MoeOrder>((PG8_LAS unsigned char*)lds, g, S, E); }
    SEAM(8);
    if (IN(9)) { const int* ctl = (const int*)(ws + WS_CTL); const int nM = ctl[CW_NT];
        pg8::Gemm g{(const bf16_t*)(ws + WS_HID), (const bf16_t*)(ws + WS_EXPD), 0, 0, D}; pg8::MoeOrder S; S.init(nM, 4, gridDim.x, blockIdx.x, ctl + CW_TILEE);
        pg8::EpiDown E{(bf16_t*)(ws + WS_XS), A.in[I_EBD], (const float*)(ws + WS_ROWG)}; pg8::gemm_phase<pg8::EpiDown, pg8::MoeOrder>((PG8_LAS unsigned char*)lds, g, S, E); }
    SEAM(9);
    if (IN(10)) phase_combine(A);
#undef IN
#undef SEAM
}

constexpr int NPHASE = 11;
#ifndef N_LAUNCHES
#define N_LAUNCHES 1
#endif
extern "C" void kernel_launch(void* const* d_in, const int* in_sizes, int n_in, void* d_out, int out_size, void* d_ws, size_t ws_size, hipStream_t stream) {
    static int grid = 0;
    if (grid == 0) {
        if (n_in != 32 || out_size != NTOK * D || ws_size < WS_END) { fprintf(stderr, "kernel_launch: unexpected shapes (n_in %d out %d ws %zu)\n", n_in, out_size, ws_size); grid = -1; return; }
        int dev = 0, cus = 0, per_cu = 0;
        hipGetDevice(&dev); hipDeviceGetAttribute(&cus, hipDeviceAttributeMultiprocessorCount, dev);
        hipFuncSetAttribute((const void*)mega, hipFuncAttributeMaxDynamicSharedMemorySize, LDS_BYTES);
        hipOccupancyMaxActiveBlocksPerMultiprocessor(&per_cu, (const void*)mega, 512, LDS_BYTES);
        if (per_cu < 1) { fprintf(stderr, "kernel_launch: occupancy query says %d blocks per CU\n", per_cu); per_cu = 1; }
        (void)hipGetLastError();
        grid = cus;
    }
    if (grid < 0) return;
    hipMemsetAsync((char*)d_ws + WS_CTL, 0, CTL_BYTES, stream);
    Args a{};
    for (int i = 0; i < 32; ++i) a.in[i] = (const float*)d_in[i];
    a.out = (float*)d_out; a.ws = (unsigned char*)d_ws;
    if (N_LAUNCHES == 1) { a.ph_lo = 0; a.ph_hi = NPHASE; void* args[] = {&a};
        hipError_t e = hipLaunchCooperativeKernel((const void*)mega, dim3(grid), dim3(512), args, LDS_BYTES, stream);
        if (e != hipSuccess) fprintf(stderr, "cooperative launch failed: %s (grid %d)\n", hipGetErrorString(e), grid); }
    else { for (int p = 0; p < NPHASE; ++p) { a.ph_lo = p; a.ph_hi = p + 1; void* args[] = {&a};
            hipError_t e = hipLaunchCooperativeKernel((const void*)mega, dim3(grid), dim3(512), args, LDS_BYTES, stream);
            if (e != hipSuccess) { fprintf(stderr, "launch %d failed: %s\n", p, hipGetErrorString(e)); break; } } }
}
```

```cpp
#include <hip/hip_runtime.h>
#include <hip/hip_cooperative_groups.h>
#include <cstdio>
#include <cstdint>
namespace cg = cooperative_groups;

#define DI __device__ __forceinline__
#define LAS __attribute__((address_space(3)))
typedef unsigned short bf16_t;
typedef short bf16x8 __attribute__((ext_vector_type(8)));
typedef float f32x4 __attribute__((ext_vector_type(4)));
typedef float f32x16 __attribute__((ext_vector_type(16)));
typedef unsigned u32x4 __attribute__((ext_vector_type(4)));
typedef unsigned u32x2 __attribute__((ext_vector_type(2)));
typedef float f32x2_t __attribute__((ext_vector_type(2)));
typedef __bf16 bf16x2_t __attribute__((ext_vector_type(2)));

constexpr int NB = 2, T = 8192, D = 1024, NTOK = NB * T, INWP = 3584;
constexpr int C_Q = 0, C_KC = 512, C_VC = 640, C_KS = 768, C_VS = 896, C_KW = 1024, C_VW = 1152, C_GATE = 1280,
              C_GQ = 1304, C_GK = 1816, C_GV = 2328, C_GZ = 2840, C_GA = 3352, C_GB = 3356, INW = 3360;
constexpr float EPS = 1e-6f, LOG2E = 1.4426950408889634f;
constexpr int NEXP = 32, MAXROWS = 65536 + NEXP * 256, MAXTILES = MAXROWS / 256;

constexpr size_t MiB = 1u << 20;
constexpr size_t WS_CTL = 0, CTL_BYTES = 64 * 1024;
constexpr size_t WS_WTIN = 1 * MiB, WS_WTOUT = 8 * MiB, WS_WTC1K = 10 * MiB, WS_WTC1V = 11 * MiB;
constexpr size_t WS_MISC = 12 * MiB;
constexpr size_t WS_WTC2K = WS_MISC, WS_WTC2V = WS_MISC + 32 * 1024, WS_RSTD2 = WS_MISC + 64 * 1024, WS_TOKE = WS_MISC + 128 * 1024,
                 WS_TOKG = WS_MISC + 384 * 1024, WS_TOKPOS = WS_MISC + 640 * 1024, WS_DEST = WS_MISC + 896 * 1024,
                 WS_ROWG = WS_MISC + 1152 * 1024, WS_GL = WS_MISC + 1536 * 1024, WS_GATES = 14 * MiB;
constexpr size_t WS_EXPGU = 16 * MiB, WS_EXPD = 144 * MiB;
constexpr size_t WS_XN = 208 * MiB, WS_ONSA = 208 * MiB, WS_U = 240 * MiB, WS_QN = 352 * MiB, WS_KSN = 368 * MiB, WS_VST = 372 * MiB,
                 WS_KWN = 376 * MiB, WS_VWT = 380 * MiB, WS_KC = 384 * MiB, WS_VCT = 384 * MiB + 512 * 1024;
constexpr size_t WS_WP = 388 * MiB, WS_QGP = 404 * MiB, WS_KDTP = 420 * MiB, WS_QKP = 436 * MiB, WS_UP = 444 * MiB, WS_OG = 460 * MiB, WS_OCAT = 476 * MiB;
constexpr size_t WS_XS = 208 * MiB, WS_HID = 352 * MiB, WS_END = 508 * MiB;
constexpr int CW_Q2 = 0, CW_Q3 = 64, CW_Q2B = 32, CW_Q3B = 96, CW_CNT = 128, CW_PB1 = 4096  , CW_NT = 1024, CW_TILEE = 1088  , CW_PSTART = 1536;

constexpr int LDS_BYTES = 147456, LDS_MISC = 140 * 1024;

DI unsigned pk2(float lo, float hi) { f32x2_t v = {lo, hi}; bf16x2_t b = __builtin_convertvector(v, bf16x2_t); return __builtin_bit_cast(unsigned, b); }
DI float bflo(unsigned w) { return __uint_as_float(w << 16); }
DI float bfhi(unsigned w) { return __uint_as_float(w & 0xffff0000u); }
DI float bf2f(bf16_t v) { return __uint_as_float((unsigned)v << 16); }
DI bf16_t f2bf(float f) { return (bf16_t)(pk2(f, 0.f) & 0xffffu); }
DI bf16x8 pack8(float a0, float a1, float a2, float a3, float a4, float a5, float a6, float a7) {
    u32x4 w; w.x = pk2(a0, a1); w.y = pk2(a2, a3); w.z = pk2(a4, a5); w.w = pk2(a6, a7); return __builtin_bit_cast(bf16x8, w); }
DI float wave_sum(float v) {
#pragma unroll
    for (int o = 1; o < 64; o <<= 1) v += __shfl_xor(v, o);
    return v; }
DI float sigm(float x) { return __builtin_amdgcn_rcpf(1.f + __builtin_amdgcn_exp2f(-x * LOG2E)); }
DI int crow(int r, int hi) { return (r & 3) + 8 * (r >> 2) + 4 * hi; }
DI int perm16(int p) { return 8 * ((p & 7) >> 2) + 4 * (p >> 3) + (p & 3); }
DI int perm16inv(int k) { return 8 * ((k >> 2) & 1) + 4 * (k >> 3) + (k & 3); }
#define MFMA32(a, b, c) __builtin_amdgcn_mfma_f32_32x32x16_bf16((a), (b), (c), 0, 0, 0)
#define MFMA16(a, b, c) __builtin_amdgcn_mfma_f32_16x16x32_bf16((a), (b), (c), 0, 0, 0)

namespace pg8 {
#define PG8_LAS __attribute__((address_space(3)))
constexpr int BM = 256, BK = 64, HALF = 128, HTB = HALF * BK * 2, STAGE_BYTES = 8 * HTB, NXCD = 8, WGM = 8;
__host__ __device__ __forceinline__ int lds_byte(int r, int c) { const int st = (r >> 4) * 2 + (c >> 5), rr = r & 15, cc = c & 31, ob = rr * 64 + cc * 2; return st * 1024 + (ob ^ (((ob >> 9) & 1) << 5)); }
__host__ __device__ __forceinline__ void stage_rc(int b, int& R, int& C) { const int st = b / 1024, sb = b % 1024, swz = sb ^ (((sb >> 9) & 1) << 5); R = (st >> 1) * 16 + swz / 64; C = (st & 1) * 32 + (swz % 64) / 2; }
__host__ __device__ __forceinline__ int perm32(int rho) { const int n = rho >> 4, i = rho & 15; return 8 * (i >> 2) + 4 * n + (i & 3); }
struct Unit { int pm, pn; };
struct Gemm { const bf16_t* A; const bf16_t* Bt; int M, N, K; };
struct StaticOrder {
    int nM, nN, nwg, G, c;
    __device__ void init(int M, int N, int G_, int c_) { nM = M / BM; nN = N / BM; nwg = nM * nN; G = G_; c = c_; }
    __device__ bool next(int i, Unit& u) const {
        const long L = (long)i * G + c; if (L >= nwg) return false;
        int wgid = (int)L; { const int q = nwg / NXCD, r = nwg % NXCD, xcd = wgid % NXCD, off = wgid / NXCD; wgid = (xcd < r ? xcd * (q + 1) : r * (q + 1) + (xcd - r) * q) + off; }
        const int nig = WGM * nN, gid = wgid / nig, fm = gid * WGM, gsz = (nM - fm) < WGM ? (nM - fm) : WGM;
        u.pm = fm + ((wgid % nig) % gsz); u.pn = (wgid % nig) / gsz; return true;
    }
};
struct MoeOrder {
    StaticOrder S; const int* tile_e;
    __device__ void init(int nM_, int nN_, int G_, int c_, const int* te) { S.nM = nM_; S.nN = nN_; S.nwg = nM_ * nN_; S.G = G_; S.c = c_; tile_e = te; }
    __device__ bool next(int i, Unit& u) const { if (!S.next(i, u)) return false; u.pn = tile_e[u.pm] * S.nN + u.pn; return true; }
};

template <class Epi, class Sched>
__device__ __forceinline__ void gemm_phase(PG8_LAS unsigned char* lds, const Gemm g, const Sched& S, const Epi& E) {
    const int tid = threadIdx.x, wid = __builtin_amdgcn_readfirstlane(tid >> 6), lane = tid & 63, wr = wid >> 2, wc = wid & 3, fr = lane & 15, fq = lane >> 4;
    const int K = g.K, nt = K / BK;
    unsigned voffA[2], voffB[2];
#pragma unroll
    for (int i = 0; i < 2; ++i) { int R, C; stage_rc(tid * 16 + i * 8192, R, C); const int Rb = Epi::PERM ? ((R & ~31) + perm32(R & 31)) : R;
        voffA[i] = (unsigned)(R * K + C) * 2u; voffB[i] = (unsigned)(Rb * K + C) * 2u; }
    const size_t kstep = (size_t)(BK * 2);
    const size_t hstep = (size_t)HALF * K * 2;
    const size_t tstep = 2 * hstep;
    const unsigned ldsw = (unsigned)wid * 1024u;
    const int aoff = lds_byte(wr * 64 + fr, fq * 8), boff = lds_byte(wc * 32 + fr, fq * 8);
#define PG8_SA(b, h) (((b) * 2 + (h)) * HTB)
#define PG8_SB(b, h) ((4 + (b) * 2 + (h)) * HTB)
#define PG8_STAGE(bufoff, gbase, voff) do { _Pragma("unroll") for (int _i = 0; _i < 2; ++_i) \
        __builtin_amdgcn_global_load_lds((const unsigned*)((const char*)(gbase) + (voff)[_i]), (PG8_LAS unsigned*)(lds + (bufoff) + ldsw + _i * 8192), 16, 0, 0); } while (0)
#define PG8_LDA(dst, b, h) do { _Pragma("unroll") for (int m = 0; m < 4; ++m) _Pragma("unroll") for (int k = 0; k < 2; ++k) dst[m][k] = *(const PG8_LAS bf16x8*)(lds + PG8_SA(b, h) + aoff + m * 2048 + k * 1024); } while (0)
#define PG8_LDB(dst, b, h) do { _Pragma("unroll") for (int n = 0; n < 2; ++n) _Pragma("unroll") for (int k = 0; k < 2; ++k) dst[n][k] = *(const PG8_LAS bf16x8*)(lds + PG8_SB(b, h) + boff + n * 2048 + k * 1024); } while (0)
#define PG8_MMA(ai, bj, At, Bt) do { __builtin_amdgcn_s_setprio(1); _Pragma("unroll") for (int m = 0; m < 4; ++m) _Pragma("unroll") for (int n = 0; n < 2; ++n) _Pragma("unroll") for (int k = 0; k < 2; ++k) \
        acc[ai][bj][m][n] = __builtin_amdgcn_mfma_f32_16x16x32_bf16(Bt[n][k], At[m][k], acc[ai][bj][m][n], 0, 0, 0); __builtin_amdgcn_s_setprio(0); } while (0)
#define PG8_WAIT_V(n) asm volatile("s_waitcnt vmcnt(" #n ")" ::: "memory")
#define PG8_WAIT_L(n) asm volatile("s_waitcnt lgkmcnt(" #n ")" ::: "memory")
#define PG8_BAR __builtin_amdgcn_s_barrier()
#define PG8_SCHED __builtin_amdgcn_sched_barrier(0)
    Unit cur, nxt; int ui = 0;
    if (!S.next(0, cur)) return;
    f32x4 acc[2][2][4][2];
#pragma unroll
    for (int a = 0; a < 2; ++a)
#pragma unroll
        for (int b = 0; b < 2; ++b)
#pragma unroll
            for (int m = 0; m < 4; ++m)
#pragma unroll
                for (int n = 0; n < 2; ++n) acc[a][b][m][n] = (f32x4){0.f, 0.f, 0.f, 0.f};
    bf16x8 At[4][2], B0[2][2], B1[2][2];
    const char* cA = (const char*)g.A + (size_t)cur.pm * tstep; const char* cB = (const char*)g.Bt + (size_t)cur.pn * tstep;
    PG8_STAGE(PG8_SB(0, 0), cB, voffB); PG8_STAGE(PG8_SB(0, 1), cB + hstep, voffB); PG8_STAGE(PG8_SA(0, 0), cA, voffA); PG8_STAGE(PG8_SA(0, 1), cA + hstep, voffA);
    if (wr == 1) PG8_BAR;
    PG8_WAIT_V(2); PG8_BAR;
    PG8_STAGE(PG8_SB(1, 0), cB + kstep, voffB); PG8_STAGE(PG8_SA(1, 0), cA + kstep, voffA); PG8_STAGE(PG8_SB(1, 1), cB + hstep + kstep, voffB);
    PG8_WAIT_V(6); PG8_BAR;
    for (;;) {
        const bool has_next = S.next(ui + 1, nxt);
        const char* nA = has_next ? (const char*)g.A + (size_t)nxt.pm * tstep : cA; const char* nB = has_next ? (const char*)g.Bt + (size_t)nxt.pn * tstep : cB;
        for (int t = 0; t < nt; t += 2) {
            const bool last = (t == nt - 2);
            const char* a1 = cA + (size_t)(t + 1) * kstep;
            const char* a2 = last ? nA : cA + (size_t)(t + 2) * kstep; const char* b2 = last ? nB : cB + (size_t)(t + 2) * kstep;
            const char* a3 = a2 + kstep; const char* b3 = b2 + kstep;
            PG8_LDB(B0, 0, 0); PG8_LDB(B1, 0, 1); PG8_SCHED; PG8_LDA(At, 0, 0); PG8_STAGE(PG8_SA(1, 1), a1 + hstep, voffA);
            PG8_WAIT_V(8); PG8_WAIT_L(0); PG8_BAR; PG8_MMA(0, 0, At, B0); PG8_MMA(0, 1, At, B1); PG8_BAR; PG8_SCHED;
            PG8_LDA(At, 0, 1); PG8_STAGE(PG8_SB(0, 0), b2, voffB); PG8_STAGE(PG8_SB(0, 1), b2 + hstep, voffB); PG8_STAGE(PG8_SA(0, 0), a2, voffA);
            PG8_WAIT_V(8); PG8_WAIT_L(0); PG8_BAR; PG8_MMA(1, 0, At, B0); PG8_MMA(1, 1, At, B1); PG8_BAR; PG8_SCHED;
            PG8_LDB(B0, 1, 0); PG8_LDB(B1, 1, 1); PG8_SCHED; PG8_LDA(At, 1, 0); PG8_STAGE(PG8_SA(0, 1), a2 + hstep, voffA);
            PG8_WAIT_V(8); PG8_WAIT_L(0); PG8_BAR; PG8_MMA(0, 0, At, B0); PG8_MMA(0, 1, At, B1); PG8_BAR; PG8_SCHED;
            PG8_LDA(At, 1, 1); PG8_STAGE(PG8_SB(1, 0), b3, voffB); PG8_STAGE(PG8_SB(1, 1), b3 + hstep, voffB); PG8_STAGE(PG8_SA(1, 0), a3, voffA);
            PG8_WAIT_V(8); PG8_WAIT_L(0); PG8_BAR; PG8_MMA(1, 0, At, B0); PG8_MMA(1, 1, At, B1); PG8_BAR; PG8_SCHED;
        }
        if (wr == 0) PG8_BAR;
        E(acc, cur, wr, wc, fr, fq);
        if (!has_next) break;
#pragma unroll
        for (int a = 0; a < 2; ++a)
#pragma unroll
            for (int b = 0; b < 2; ++b)
#pragma unroll
                for (int m = 0; m < 4; ++m)
#pragma unroll
                    for (int n = 0; n < 2; ++n) acc[a][b][m][n] = (f32x4){0.f, 0.f, 0.f, 0.f};
        cur = nxt; cA = nA; cB = nB; ++ui;
        if (wr == 1) PG8_BAR;
    }
    PG8_WAIT_V(0);
    PG8_BAR;
#undef PG8_SA
#undef PG8_SB
#undef PG8_STAGE
#undef PG8_LDA
#undef PG8_LDB
#undef PG8_MMA
#undef PG8_WAIT_V
#undef PG8_WAIT_L
#undef PG8_BAR
#undef PG8_SCHED
}

struct EpiU {
    static constexpr bool PERM = true;
    bf16_t* O; int ldc;
    __device__ __forceinline__ void operator()(const f32x4 (&acc)[2][2][4][2], const Unit& u, int wr, int wc, int fr, int fq) const {
        const int row0 = u.pm * BM + wr * 64 + fr, col0 = u.pn * BM + wc * 32 + 8 * fq;
#pragma unroll
        for (int ai = 0; ai < 2; ++ai)
#pragma unroll
            for (int m = 0; m < 4; ++m) { bf16_t* rowp = O + (size_t)(row0 + ai * HALF + m * 16) * ldc + col0;
#pragma unroll
                for (int bj = 0; bj < 2; ++bj) { const f32x4 v0 = acc[ai][bj][m][0], v1 = acc[ai][bj][m][1];
                    u32x4 w; w.x = pk2(v0[0], v0[1]); w.y = pk2(v0[2], v0[3]); w.z = pk2(v1[0], v1[1]); w.w = pk2(v1[2], v1[3]);
                    *(u32x4*)(rowp + bj * HALF) = w; } }
    }
};
struct EpiRes {
    static constexpr bool PERM = false;
    const float* base; float* out; int ldc;
    __device__ __forceinline__ void operator()(const f32x4 (&acc)[2][2][4][2], const Unit& u, int wr, int wc, int fr, int fq) const {
        const int col0 = u.pn * BM + wc * 32 + 4 * fq;
#pragma unroll
        for (int ai = 0; ai < 2; ++ai)
#pragma unroll
            for (int m = 0; m < 4; ++m) { const size_t off = (size_t)(u.pm * BM + ai * HALF + wr * 64 + m * 16 + fr) * ldc + col0;
#pragma unroll
                for (int bj = 0; bj < 2; ++bj)
#pragma unroll
                    for (int n = 0; n < 2; ++n) { const f32x4 bs = *(const f32x4*)(base + off + bj * HALF + n * 16); *(f32x4*)(out + off + bj * HALF + n * 16) = bs + acc[ai][bj][m][n]; } }
    }
};
struct EpiSwiglu {
    static constexpr bool PERM = true;
    bf16_t* H; const float* bg; const float* bu;
    __device__ __forceinline__ void operator()(const f32x4 (&acc)[2][2][4][2], const Unit& u, int wr, int wc, int fr, int fq) const {
        const int e = u.pn >> 3, pnl = u.pn & 7, hc0 = pnl * 128 + wc * 32 + 8 * fq, row0 = u.pm * BM + wr * 64 + fr;
        float gb[8], ub[8];
#pragma unroll
        for (int i = 0; i < 8; ++i) { gb[i] = bg[e * 1024 + hc0 + i]; ub[i] = bu[e * 1024 + hc0 + i]; }
#pragma unroll
        for (int ai = 0; ai < 2; ++ai)
#pragma unroll
            for (int m = 0; m < 4; ++m) {
                float o[8];
#pragma unroll
                for (int n = 0; n < 2; ++n)
#pragma unroll
                    for (int i = 0; i < 4; ++i) {
                        const float gg = fminf(acc[ai][0][m][n][i] + gb[4 * n + i], 7.0f);
                        const float uu = fminf(fmaxf(acc[ai][1][m][n][i] + ub[4 * n + i], -7.0f), 7.0f);
                        o[4 * n + i] = (uu + 1.0f) * gg * sigm(gg * 1.702f); }
                u32x4 w; w.x = pk2(o[0], o[1]); w.y = pk2(o[2], o[3]); w.z = pk2(o[4], o[5]); w.w = pk2(o[6], o[7]);
                *(u32x4*)(H + (size_t)(row0 + ai * HALF + m * 16) * 1024 + hc0) = w; }
    }
};
struct EpiDown {
    static constexpr bool PERM = true;
    bf16_t* Y; const float* bd; const float* rowg;
    __device__ __forceinline__ void operator()(const f32x4 (&acc)[2][2][4][2], const Unit& u, int wr, int wc, int fr, int fq) const {
        const int e = u.pn >> 2, pnl = u.pn & 3, col0 = pnl * BM + wc * 32 + 8 * fq, row0 = u.pm * BM + wr * 64 + fr;
        float bv[2][8];
#pragma unroll
        for (int bj = 0; bj < 2; ++bj)
#pragma unroll
            for (int i = 0; i < 8; ++i) bv[bj][i] = bd[e * 1024 + col0 + bj * HALF + i];
#pragma unroll
        for (int ai = 0; ai < 2; ++ai)
#pragma unroll
            for (int m = 0; m < 4; ++m) { const int row = row0 + ai * HALF + m * 16; const float sc = rowg[row];
#pragma unroll
                for (int bj = 0; bj < 2; ++bj) { const f32x4 v0 = acc[ai][bj][m][0], v1 = acc[ai][bj][m][1];
                    u32x4 w; w.x = pk2((v0[0] + bv[bj][0]) * sc, (v0[1] + bv[bj][1]) * sc); w.y = pk2((v0[2] + bv[bj][2]) * sc, (v0[3] + bv[bj][3]) * sc);
                    w.z = pk2((v1[0] + bv[bj][4]) * sc, (v1[1] + bv[bj][5]) * sc); w.w = pk2((v1[2] + bv[bj][6]) * sc, (v1[3] + bv[bj][7]) * sc);
                    *(u32x4*)(Y + (size_t)row * 1024 + col0 + bj * HALF) = w; } }
    }
};
}

struct Args { const float* in[32]; float* out; unsigned char* ws; int ph_lo, ph_hi; };
enum { I_X = 0, I_ANG, I_WIN, I_QG, I_KCG, I_KSG, I_KWG, I_CKPOS, I_CKW1, I_CKB1, I_CKW2, I_CKB2, I_CVPOS, I_CVW1, I_CVB1, I_CVW2, I_CVB2,
       I_NSAOG, I_CONVW, I_ALOG, I_DTB, I_GDNOG, I_WOUT, I_FFNG, I_RW, I_RB, I_EWG, I_EBG, I_EWU, I_EBU, I_EWD, I_EBD };

DI void p0_transpose_item(const float* W, int K, int N, bf16_t* WT, long row_off, float* scr, int item, int lane) {
    const int nblk = N / 32, kb = item / nblk, nb = item % nblk, k0 = 64 * kb, n0 = 32 * nb;
#pragma unroll 8
    for (int i = 0; i < 32; ++i) { const int kk = 2 * i + (lane >> 5); scr[kk * 33 + (lane & 31)] = W[(size_t)(k0 + kk) * N + n0 + (lane & 31)]; }
    __builtin_amdgcn_s_waitcnt(0xC07F); asm volatile("" ::: "memory");
    const int c = lane & 7;
#pragma unroll
    for (int j = 0; j < 4; ++j) { const int n = (lane >> 3) + 8 * j; const float* s = scr + (8 * c) * 33 + n;
        u32x4 o; o.x = pk2(s[0 * 33], s[1 * 33]); o.y = pk2(s[2 * 33], s[3 * 33]); o.z = pk2(s[4 * 33], s[5 * 33]); o.w = pk2(s[6 * 33], s[7 * 33]);
        *(u32x4*)(WT + (size_t)(row_off + n0 + n) * K + k0 + 8 * c) = o; }
    __builtin_amdgcn_s_waitcnt(0xC07F); asm volatile("" ::: "memory");
}

DI void phase0(const Args& A, unsigned char* lds, bool first) {
    const int tid = threadIdx.x, lane = tid & 63, wave = tid >> 6, G = gridDim.x;
    const int gw = blockIdx.x * 8 + wave, NGW = G * 8;
    float* scr = (float*)(lds + wave * 16384);
    unsigned char* ws = A.ws;
    constexpr int I_IN = 16 * 105, I_OUT = 16 * 32, I_C1 = 32 * 8, I_C2 = 4 * 2, I_EX = 16 * 32;
    constexpr int NIT = I_IN + I_OUT + 2 * I_C1 + 2 * I_C2 + 96 * I_EX;
    for (int it = gw; it < NIT; it += NGW) {
        int r = it;
        if (r < I_IN) { p0_transpose_item(A.in[I_WIN], 1024, INW, (bf16_t*)(ws + WS_WTIN), 0, scr, r, lane); continue; } r -= I_IN;
        if (r < I_OUT) { p0_transpose_item(A.in[I_WOUT], 1024, 1024, (bf16_t*)(ws + WS_WTOUT), 0, scr, r, lane); continue; } r -= I_OUT;
        if (r < I_C1) { p0_transpose_item(A.in[I_CKW1], 2048, 256, (bf16_t*)(ws + WS_WTC1K), 0, scr, r, lane); continue; } r -= I_C1;
        if (r < I_C1) { p0_transpose_item(A.in[I_CVW1], 2048, 256, (bf16_t*)(ws + WS_WTC1V), 0, scr, r, lane); continue; } r -= I_C1;
        if (r < I_C2) { p0_transpose_item(A.in[I_CKW2], 256, 64, (bf16_t*)(ws + WS_WTC2K), 0, scr, r, lane); continue; } r -= I_C2;
        if (r < I_C2) { p0_transpose_item(A.in[I_CVW2], 256, 64, (bf16_t*)(ws + WS_WTC2V), 0, scr, r, lane); continue; } r -= I_C2;
        const int mat = r / I_EX, item = r % I_EX, e = mat / 3, which = mat % 3;
        if (which == 2) { p0_transpose_item(A.in[I_EWD] + (size_t)e * 1048576, 1024, 1024, (bf16_t*)(ws + WS_EXPD), (long)e * 1024, scr, item, lane); }
        else { const int nb = item % 32, n0 = 32 * nb; const long dest0 = (long)e * 2048 + (n0 >> 7) * 256 + (n0 & 127) + (which ? 128 : 0);
            p0_transpose_item(A.in[which ? I_EWU : I_EWG] + (size_t)e * 1048576, 1024, 1024, (bf16_t*)(ws + WS_EXPGU), dest0 - n0, scr, item, lane); }
    }
    { const float* gain = A.in[I_ANG]; f32x4 gv[4];
#pragma unroll
      for (int j = 0; j < 4; ++j) gv[j] = *(const f32x4*)(gain + 4 * lane + 256 * j);
      for (int m = gw; m < NTOK; m += NGW) { const f32x4* xr = (const f32x4*)(A.in[I_X] + (size_t)m * D) + lane; f32x4 v[4]; float s = 0.f;
#pragma unroll
        for (int j = 0; j < 4; ++j) { v[j] = xr[64 * j]; s += v[j].x * v[j].x + v[j].y * v[j].y + v[j].z * v[j].z + v[j].w * v[j].w; }
        const float rs = rsqrtf(wave_sum(s) * (1.f / D) + EPS);
        u32x2* o = (u32x2*)((bf16_t*)(ws + WS_XN) + (size_t)m * D) + lane;
#pragma unroll
        for (int j = 0; j < 4; ++j) { u32x2 w; w.x = pk2(v[j].x * rs * gv[j].x, v[j].y * rs * gv[j].y); w.y = pk2(v[j].z * rs * gv[j].z, v[j].w * rs * gv[j].w); o[64 * j] = w; } } }
    { u32x4* p = (u32x4*)((bf16_t*)(ws + WS_WTIN) + (size_t)INW * 1024); const int n16 = (INWP - INW) * 1024 * 2 / 16;
      for (int i = blockIdx.x * 512 + tid; i < n16; i += G * 512) p[i] = (u32x4){0u, 0u, 0u, 0u}; }
    if (first && blockIdx.x < 32 && tid < 256) { const int kv = blockIdx.x >> 4, seg = blockIdx.x & 15, j = tid;
        const float* pos = A.in[kv ? I_CVPOS : I_CKPOS]; const float* w1 = A.in[kv ? I_CVW1 : I_CKW1]; float s = 0.f;
        for (int k = seg * 128; k < seg * 128 + 128; ++k) s += pos[k] * w1[(size_t)k * 256 + j];
        ((float*)(ws + WS_CTL))[CW_PB1 + seg * 512 + kv * 256 + j] = s; }
}

DI void nsa_prep_task(const Args& A, int task, unsigned char* lds) {
    const int tid = threadIdx.x, lane = tid & 63, wave = tid >> 6;
    const int b = task >> 7, n = task & 127;
    unsigned char* ws = A.ws; const bf16_t* U = (const bf16_t*)(ws + WS_U);
    bf16_t* vsL = (bf16_t*)lds;
    for (int ti = 0; ti < 8; ++ti) {
        const int tl = wave * 8 + ti, t = n * 64 + tl; const size_t tok = (size_t)b * T + t; const bf16_t* ur = U + tok * INWP;
        { const u32x4 w = *(const u32x4*)(ur + C_Q + 8 * lane); float f[8] = {bflo(w.x), bfhi(w.x), bflo(w.y), bfhi(w.y), bflo(w.z), bfhi(w.z), bflo(w.w), bfhi(w.w)};
          float s = 0.f;
#pragma unroll
          for (int i = 0; i < 8; ++i) s += f[i] * f[i];
          s += __shfl_xor(s, 1); s += __shfl_xor(s, 2); s += __shfl_xor(s, 4);
          const float rs = rsqrtf(s * (1.f / 64.f) + EPS) * (0.125f * LOG2E); const float* gq = A.in[I_QG] + (8 * lane & 63);
          u32x4 o; o.x = pk2(f[0] * rs * gq[0], f[1] * rs * gq[1]); o.y = pk2(f[2] * rs * gq[2], f[3] * rs * gq[3]); o.z = pk2(f[4] * rs * gq[4], f[5] * rs * gq[5]); o.w = pk2(f[6] * rs * gq[6], f[7] * rs * gq[7]);
          *(u32x4*)((bf16_t*)(ws + WS_QN) + tok * 512 + 8 * lane) = o; }
        if (lane < 32) { const int sel = lane >> 4, l16 = lane & 15, g = l16 >> 3, d0 = (l16 & 7) * 8;
          const u32x4 w = *(const u32x4*)(ur + (sel ? C_KW : C_KS) + 8 * l16); float f[8] = {bflo(w.x), bfhi(w.x), bflo(w.y), bfhi(w.y), bflo(w.z), bfhi(w.z), bflo(w.w), bfhi(w.w)};
          float s = 0.f;
#pragma unroll
          for (int i = 0; i < 8; ++i) s += f[i] * f[i];
          s += __shfl_xor(s, 1); s += __shfl_xor(s, 2); s += __shfl_xor(s, 4);
          const float rs = rsqrtf(s * (1.f / 64.f) + EPS); const float* gk = A.in[sel ? I_KWG : I_KSG] + d0;
          u32x4 o; o.x = pk2(f[0] * rs * gk[0], f[1] * rs * gk[1]); o.y = pk2(f[2] * rs * gk[2], f[3] * rs * gk[3]); o.z = pk2(f[4] * rs * gk[4], f[5] * rs * gk[5]); o.w = pk2(f[6] * rs * gk[6], f[7] * rs * gk[7]);
          *(u32x4*)((bf16_t*)(ws + (sel ? WS_KWN : WS_KSN)) + ((size_t)(b * 2 + g) * T + t) * 64 + d0) = o; }
        else { const int l32 = lane - 32, sel = l32 >> 4, l16 = l32 & 15, g = l16 >> 3, d0 = (l16 & 7) * 8;
          const u32x4 w = *(const u32x4*)(ur + (sel ? C_VW : C_VS) + 8 * l16);
          const int pos = (tl & ~15) + perm16inv(tl & 15); bf16_t* dst = vsL + ((sel * 2 + g) * 64 + d0) * 64 + pos;
          dst[0 * 64] = (bf16_t)(w.x & 0xffff); dst[1 * 64] = (bf16_t)(w.x >> 16); dst[2 * 64] = (bf16_t)(w.y & 0xffff); dst[3 * 64] = (bf16_t)(w.y >> 16);
          dst[4 * 64] = (bf16_t)(w.z & 0xffff); dst[5 * 64] = (bf16_t)(w.z >> 16); dst[6 * 64] = (bf16_t)(w.w & 0xffff); dst[7 * 64] = (bf16_t)(w.w >> 16); }
        if (lane < 24) ((float*)(ws + WS_GATES))[tok * 24 + lane] = sigm(bf2f(ur[C_GATE + lane]));
    }
    __syncthreads();
    for (int c = tid; c < 2048; c += 512) { const int sel = c >> 10, g = (c >> 9) & 1, rem = c & 511;
        const u32x4 v = *(const u32x4*)(vsL + ((sel * 2 + g) * 64) * 64 + rem * 8);
        *(u32x4*)((bf16_t*)(ws + (sel ? WS_VWT : WS_VST)) + ((size_t)(b * 2 + g) * 128 + n) * 4096 + rem * 8) = v; }
    __syncthreads();
}

DI void compress_task(const Args& A, int task, unsigned char* lds) {
    const int tid = threadIdx.x, lane = tid & 63, wave = __builtin_amdgcn_readfirstlane(tid >> 6), r32 = lane & 31, hh = lane >> 5;
    const int kv = task >> 6, b = (task >> 5) & 1, g = (task >> 4) & 1, ct = task & 15, c0 = 32 * ct;
    unsigned char* ws = A.ws; const bf16_t* U = (const bf16_t*)(ws + WS_U);
    bf16_t* hidL = (bf16_t*)lds;
    float* outL = (float*)(lds + 16896);
    const int colbase = (kv ? C_VC : C_KC) + g * 64;
    const bf16_t* W1T = (const bf16_t*)(ws + (kv ? WS_WTC1V : WS_WTC1K));
    const bf16_t* W2T = (const bf16_t*)(ws + (kv ? WS_WTC2V : WS_WTC2K));
    {   int c = c0 + r32; if (c > 510) c = 510;
        const bf16_t* arow = U + ((size_t)b * T + 16 * c) * INWP + colbase + 8 * hh;
        const bf16_t* brow = W1T + (size_t)(32 * wave + r32) * 2048 + 8 * hh;
        f32x16 acc; for (int i = 0; i < 16; ++i) acc[i] = 0.f;
#pragma unroll 4
        for (int l = 0; l < 32; ++l) {
#pragma unroll
            for (int s = 0; s < 4; ++s) { const bf16x8 af = *(const bf16x8*)(arow + (size_t)l * INWP + 16 * s); const bf16x8 bf = *(const bf16x8*)(brow + l * 64 + 16 * s); acc = MFMA32(af, bf, acc); } }
        const int j = 32 * wave + r32; float pb = A.in[kv ? I_CVB1 : I_CKB1][j];
#pragma unroll
        for (int sg = 0; sg < 16; ++sg) pb += ((const float*)(ws + WS_CTL))[CW_PB1 + sg * 512 + kv * 256 + j];
#pragma unroll
        for (int r = 0; r < 16; ++r) { const float x = acc[r] + pb; const float y = x * sigm(1.5957691216057308f * (x + 0.044715f * x * x * x)); hidL[crow(r, hh) * 264 + j] = f2bf(y); }
    }
    __syncthreads();
    if (wave < 2) { f32x16 acc; for (int i = 0; i < 16; ++i) acc[i] = 0.f;
#pragma unroll
        for (int s = 0; s < 16; ++s) { const bf16x8 af = *(const bf16x8*)(hidL + r32 * 264 + 16 * s + 8 * hh); const bf16x8 bf = *(const bf16x8*)(W2T + (size_t)(32 * wave + r32) * 256 + 16 * s + 8 * hh); acc = MFMA32(af, bf, acc); }
        const int d = 32 * wave + r32; const float b2 = A.in[kv ? I_CVB2 : I_CKB2][d];
#pragma unroll
        for (int r = 0; r < 16; ++r) outL[crow(r, hh) * 65 + d] = acc[r] + b2; }
    __syncthreads();
    if (kv == 0) { if (tid < 256) { const int cl = tid >> 3, sub = tid & 7; float f[8]; float s = 0.f;
#pragma unroll
            for (int i = 0; i < 8; ++i) { f[i] = outL[cl * 65 + 8 * sub + i]; s += f[i] * f[i]; }
            s += __shfl_xor(s, 1); s += __shfl_xor(s, 2); s += __shfl_xor(s, 4);
            const float rs = (c0 + cl > 510) ? 0.f : rsqrtf(s * (1.f / 64.f) + EPS); const float* gk = A.in[I_KCG] + 8 * sub;
            u32x4 o; o.x = pk2(f[0] * rs * gk[0], f[1] * rs * gk[1]); o.y = pk2(f[2] * rs * gk[2], f[3] * rs * gk[3]); o.z = pk2(f[4] * rs * gk[4], f[5] * rs * gk[5]); o.w = pk2(f[6] * rs * gk[6], f[7] * rs * gk[7]);
            *(u32x4*)((bf16_t*)(ws + WS_KC) + ((size_t)(b * 2 + g) * 512 + c0 + cl) * 64 + 8 * sub) = o; } }
    else { const int d = tid >> 3, part = tid & 7, p0 = 4 * part, gi = p0 >> 4, cl0 = 16 * gi + perm16(p0 & 15); float f[4];
#pragma unroll
        for (int i = 0; i < 4; ++i) f[i] = (c0 + cl0 + i > 510) ? 0.f : outL[(cl0 + i) * 65 + d];
        u32x2 o; o.x = pk2(f[0], f[1]); o.y = pk2(f[2], f[3]);
        *(u32x2*)((bf16_t*)(ws + WS_VCT) + ((size_t)(b * 2 + g) * 64 + d) * 512 + c0 + p0) = o; }
    __syncthreads();
}

DI void gdn_chunk_task(const Args& A, int task, unsigned char* lds) {
    const int tid = threadIdx.x, lane = tid & 63, wave = __builtin_amdgcn_readfirstlane(tid >> 6), r32 = lane & 31, hh = lane >> 5;
    const int b = task >> 9, h = (task >> 7) & 3, ch = task & 127, t0 = ch * 64; const size_t tok0 = (size_t)b * T + t0;
    unsigned char* ws = A.ws; const bf16_t* U = (const bf16_t*)(ws + WS_U);
    float* qL = (float*)lds; float* kL = qL + 64 * 132; float* vL = kL + 64 * 132; float* Lm = vL + 64 * 132; float* Qm = Lm + 64 * 68;
    float* gcL = Qm + 64 * 68; float* betaL = gcL + 64; float* egL = betaL + 64; float* kdsL = egL + 64;
    { const int c = tid & 127, part = tid >> 7;
#pragma unroll
      for (int s = 0; s < 3; ++s) { const int col = (s == 0 ? C_GQ : s == 1 ? C_GK : C_GV) + h * 128 + c; const float* cw = A.in[I_CONVW] + s * 512 + h * 128 + c;
        const float w0 = cw[0], w1 = cw[1536], w2 = cw[3072], w3 = cw[4608]; float* dst = (s == 0 ? qL : s == 1 ? kL : vL);
        const int tl0 = 16 * part; float x3, x2, x1;
        { const int tg = t0 + tl0; x3 = (tg - 3 >= 0) ? bf2f(U[(tok0 + tl0 - 3) * INWP + col]) : 0.f; x2 = (tg - 2 >= 0) ? bf2f(U[(tok0 + tl0 - 2) * INWP + col]) : 0.f; x1 = (tg - 1 >= 0) ? bf2f(U[(tok0 + tl0 - 1) * INWP + col]) : 0.f; }
#pragma unroll 4
        for (int i = 0; i < 16; ++i) { const float xt = bf2f(U[(tok0 + tl0 + i) * INWP + col]); const float y = w0 * x3 + w1 * x2 + w2 * x1 + w3 * xt;
            dst[(tl0 + i) * 132 + c] = y * sigm(y); x3 = x2; x2 = x1; x1 = xt; } } }
    if (tid < 64) { const int tl = tid; const float a = bf2f(U[(tok0 + tl) * INWP + C_GA + h]), bb = bf2f(U[(tok0 + tl) * INWP + C_GB + h]);
        const float x = a + A.in[I_DTB][h]; const float sp = (x > 20.f) ? x : log1pf(__expf(x)); float gt = -__expf(A.in[I_ALOG][h]) * sp;
#pragma unroll
        for (int o = 1; o < 64; o <<= 1) { const float v = __shfl_up(gt, o); if (lane >= o) gt += v; }
        const float g63 = __shfl(gt, 63);
        gcL[tl] = gt; betaL[tl] = sigm(bb); egL[tl] = __expf(gt); kdsL[tl] = __expf(g63 - gt);
        if (tl == 63) ((float*)(ws + WS_GL))[task] = __expf(gt); }
    __syncthreads();
    { const int tl = tid >> 3, sub = tid & 7; float sq = 0.f, sk = 0.f;
#pragma unroll
      for (int i = 0; i < 16; ++i) { const float a = qL[tl * 132 + sub * 16 + i], c = kL[tl * 132 + sub * 16 + i]; sq += a * a; sk += c * c; }
      sq += __shfl_xor(sq, 1); sq += __shfl_xor(sq, 2); sq += __shfl_xor(sq, 4); sk += __shfl_xor(sk, 1); sk += __shfl_xor(sk, 2); sk += __shfl_xor(sk, 4);
      const float rq = rsqrtf(sq + EPS) * 0.08838834764831845f, rk = rsqrtf(sk + EPS);
#pragma unroll
      for (int i = 0; i < 16; ++i) { qL[tl * 132 + sub * 16 + i] *= rq; kL[tl * 132 + sub * 16 + i] *= rk; } }
    __syncthreads();
    { const int mat = wave >> 2, mi = (wave >> 1) & 1, ni = wave & 1; const float* X = mat ? qL : kL;
      f32x16 acc; for (int i = 0; i < 16; ++i) acc[i] = 0.f;
#pragma unroll
      for (int s = 0; s < 8; ++s) { const f32x4 a0 = *(const f32x4*)(X + (32 * mi + r32) * 132 + 16 * s + 8 * hh), a1 = *(const f32x4*)(X + (32 * mi + r32) * 132 + 16 * s + 8 * hh + 4);
          const f32x4 b0 = *(const f32x4*)(kL + (32 * ni + r32) * 132 + 16 * s + 8 * hh), b1 = *(const f32x4*)(kL + (32 * ni + r32) * 132 + 16 * s + 8 * hh + 4);
          acc = MFMA32(pack8(a0[0], a0[1], a0[2], a0[3], a1[0], a1[1], a1[2], a1[3]), pack8(b0[0], b0[1], b0[2], b0[3], b1[0], b1[1], b1[2], b1[3]), acc); }
      const int sc = 32 * ni + r32; const float gs = gcL[sc];
#pragma unroll
      for (int r = 0; r < 16; ++r) { const int c = 32 * mi + crow(r, hh); const float dec = __expf(gcL[c] - gs);
          if (mat == 0) Lm[c * 68 + sc] = (c > sc) ? betaL[c] * acc[r] * dec : 0.f; else Qm[c * 68 + sc] = (c >= sc) ? acc[r] * dec : 0.f; } }
    __syncthreads();
    {   bf16_t* QGp = (bf16_t*)(ws + WS_QGP) + (size_t)task * 8192; bf16_t* KDTp = (bf16_t*)(ws + WS_KDTP) + (size_t)task * 8192; bf16_t* QKp = (bf16_t*)(ws + WS_QKP) + (size_t)task * 4096;
        for (int id = tid; id < 1024; id += 512) { const int c = id >> 4, chn = id & 15, ks = chn >> 2, q = chn & 3; const float e = egL[c];
            const f32x4 a = *(const f32x4*)(qL + c * 132 + 32 * ks + 4 * q), bq = *(const f32x4*)(qL + c * 132 + 32 * ks + 16 + 4 * q);
            *(bf16x8*)(QGp + id * 8) = pack8(a[0] * e, a[1] * e, a[2] * e, a[3] * e, bq[0] * e, bq[1] * e, bq[2] * e, bq[3] * e); }
        for (int id = tid; id < 1024; id += 512) { const int d = id >> 3, chn = id & 7, ks = chn >> 2, q = chn & 3; float f[8];
#pragma unroll
            for (int j = 0; j < 8; ++j) { const int s = 32 * ks + 16 * (j >> 2) + 4 * q + (j & 3); f[j] = kL[s * 132 + d] * kdsL[s]; }
            *(bf16x8*)(KDTp + id * 8) = pack8(f[0], f[1], f[2], f[3], f[4], f[5], f[6], f[7]); }
        { const int id = tid; const int c = id >> 3, chn = id & 7, ks = chn >> 2, q = chn & 3;
            const f32x4 a = *(const f32x4*)(Qm + c * 68 + 32 * ks + 4 * q), bq = *(const f32x4*)(Qm + c * 68 + 32 * ks + 16 + 4 * q);
            *(bf16x8*)(QKp + id * 8) = pack8(a[0], a[1], a[2], a[3], bq[0], bq[1], bq[2], bq[3]); } }
    __syncthreads();
    if (tid < 256) { const bool isW = tid >= 128; float* col = (isW ? kL : vL) + (tid & 127);
#pragma unroll 1
        for (int bi = 0; bi < 4; ++bi) {
            float r[16];
#pragma unroll
            for (int ii = 0; ii < 16; ++ii) { const int i = 16 * bi + ii; float v = col[i * 132] * betaL[i]; if (isW) v *= egL[i]; r[ii] = v; }
#pragma unroll 1
            for (int j = 0; j < 16 * bi; j += 4) {
                const float x0 = col[j * 132], x1 = col[(j + 1) * 132], x2 = col[(j + 2) * 132], x3 = col[(j + 3) * 132];
#pragma unroll
                for (int ii = 0; ii < 16; ++ii) { const f32x4 l4 = *(const f32x4*)(Lm + (16 * bi + ii) * 68 + j); r[ii] -= (l4[0] * x0 + l4[1] * x1) + (l4[2] * x2 + l4[3] * x3); } }
#pragma unroll
            for (int ii = 1; ii < 16; ++ii) {
#pragma unroll
                for (int j4 = 0; j4 < (ii + 3) / 4; ++j4) { const f32x4 l4 = *(const f32x4*)(Lm + (16 * bi + ii) * 68 + 16 * bi + 4 * j4);
#pragma unroll
                    for (int jj = 0; jj < 4; ++jj) if (4 * j4 + jj < ii) r[ii] -= l4[jj] * r[4 * j4 + jj]; } }
#pragma unroll
            for (int ii = 0; ii < 16; ++ii) col[(16 * bi + ii) * 132] = r[ii];
        } }
    __syncthreads();
    { bf16_t* Wp = (bf16_t*)(ws + WS_WP) + (size_t)task * 8192; bf16_t* Up = (bf16_t*)(ws + WS_UP) + (size_t)task * 8192;
      for (int id = tid; id < 1024; id += 512) { const int c = id >> 4, chn = id & 15, ks = chn >> 2, q = chn & 3;
          const f32x4 a = *(const f32x4*)(kL + c * 132 + 32 * ks + 4 * q), bq = *(const f32x4*)(kL + c * 132 + 32 * ks + 16 + 4 * q);
          *(bf16x8*)(Wp + id * 8) = pack8(a[0], a[1], a[2], a[3], bq[0], bq[1], bq[2], bq[3]); }
      for (int id = tid; id < 2048; id += 512) { const int ln = id & 63, mt = (id >> 6) & 3, es = id >> 8, q = ln >> 4, e = ln & 15; const int c = 16 * mt + 4 * q, col = 16 * es + e;
          u32x2 o; o.x = pk2(vL[c * 132 + col], vL[(c + 1) * 132 + col]); o.y = pk2(vL[(c + 2) * 132 + col], vL[(c + 3) * 132 + col]);
          *(u32x2*)(Up + id * 4) = o; } }
    __syncthreads();
}

constexpr int SC_W = 0, SC_QG = 17408, SC_KD = 34816, SC_QK = 53248, SC_UP = 62464, SC_BUF = 64512;
DI void gdn_scan_block(const Args& A, int sidx, unsigned char* lds) {
    const int tid = threadIdx.x, lane = tid & 63, wave = __builtin_amdgcn_readfirstlane(tid >> 6);
    const int es = sidx & 7, bh = sidx >> 3, b = bh >> 2, h = bh & 3, r16 = lane & 15, q = lane >> 4;
    unsigned char* ws = A.ws;
    const bf16_t* WP = (const bf16_t*)(ws + WS_WP) + (size_t)bh * 128 * 8192; const bf16_t* QGP = (const bf16_t*)(ws + WS_QGP) + (size_t)bh * 128 * 8192;
    const bf16_t* KDTP = (const bf16_t*)(ws + WS_KDTP) + (size_t)bh * 128 * 8192; const bf16_t* QKP = (const bf16_t*)(ws + WS_QKP) + (size_t)bh * 128 * 4096;
    const bf16_t* UP = (const bf16_t*)(ws + WS_UP) + (size_t)bh * 128 * 8192 + es * 1024;
    if (wave != 0) {
        const int lt = tid - 64; u32x4 R[9]; const u32x4 z4 = (u32x4){0u, 0u, 0u, 0u};
        const bf16_t* sp[9]; int dof[9], stp[9];
#pragma unroll
        for (int j = 0; j < 9; ++j) { const int c = lt + 448 * j;
            if (c < 1024) { sp[j] = WP + c * 8; dof[j] = SC_W + (c >> 4) * 272 + (c & 15) * 16; stp[j] = 8192; }
            else if (c < 2048) { const int cc = c - 1024; sp[j] = QGP + cc * 8; dof[j] = SC_QG + (cc >> 4) * 272 + (cc & 15) * 16; stp[j] = 8192; }
            else if (c < 3072) { const int cc = c - 2048; sp[j] = KDTP + cc * 8; dof[j] = SC_KD + (cc >> 3) * 144 + (cc & 7) * 16; stp[j] = 8192; }
            else if (c < 3584) { const int cc = c - 3072; sp[j] = QKP + cc * 8; dof[j] = SC_QK + (cc >> 3) * 144 + (cc & 7) * 16; stp[j] = 4096; }
            else if (c < 3712) { const int cc = c - 3584; sp[j] = UP + cc * 8; dof[j] = SC_UP + cc * 16; stp[j] = 8192; }
            else { sp[j] = nullptr; dof[j] = 0; stp[j] = 0; } }
#define SC_LOAD(i_) do { _Pragma("unroll") for (int j = 0; j < 9; ++j) R[j] = sp[j] ? *(const u32x4*)(sp[j] + (size_t)(i_) * stp[j]) : z4; } while (0)
#define SC_WRITE(bufi_) do { _Pragma("unroll") for (int j = 0; j < 9; ++j) if (sp[j]) *(u32x4*)(lds + (bufi_) * SC_BUF + dof[j]) = R[j]; } while (0)
        SC_LOAD(0); SC_WRITE(0); SC_LOAD(1);
        __syncthreads();
        for (int i = 0; i < 128; ++i) {
            if (i + 1 < 128) SC_WRITE((i + 1) & 1);
            if (i + 2 < 128) SC_LOAD(i + 2);
            __syncthreads(); }
#undef SC_LOAD
#undef SC_WRITE
        return;
    }
    const float* GL = (const float*)(ws + WS_GL) + bh * 128;
    bf16_t* OG = (bf16_t*)(ws + WS_OG);
    f32x4 S[8];
#pragma unroll
    for (int m = 0; m < 8; ++m) S[m] = (f32x4){0.f, 0.f, 0.f, 0.f};
    __syncthreads();
    float gl = GL[0];
    for (int i = 0; i < 128; ++i) {
        const unsigned char* bufp = lds + (i & 1) * SC_BUF;
        const unsigned char* wp = bufp + SC_W + r16 * 272 + 16 * q; const unsigned char* qgp = bufp + SC_QG + r16 * 272 + 16 * q;
        const unsigned char* kdp = bufp + SC_KD + r16 * 144 + 16 * q; const unsigned char* qkp = bufp + SC_QK + r16 * 144 + 16 * q;
        const unsigned char* up = bufp + SC_UP + lane * 8;
        const float gln = GL[(i + 1) & 127];
        bf16x8 Sb[4];
#pragma unroll
        for (int ks = 0; ks < 4; ++ks) Sb[ks] = pack8(S[2 * ks][0], S[2 * ks][1], S[2 * ks][2], S[2 * ks][3], S[2 * ks + 1][0], S[2 * ks + 1][1], S[2 * ks + 1][2], S[2 * ks + 1][3]);
        f32x4 vn[4];
#pragma unroll
        for (int mt = 0; mt < 4; ++mt) { f32x4 acc = (f32x4){0.f, 0.f, 0.f, 0.f};
#pragma unroll
            for (int ks = 0; ks < 4; ++ks) acc = MFMA16(*(const bf16x8*)(wp + mt * 16 * 272 + ks * 64), Sb[ks], acc);
            const u32x2 uw = *(const u32x2*)(up + mt * 512);
            vn[mt] = (f32x4){bflo(uw.x) - acc[0], bfhi(uw.x) - acc[1], bflo(uw.y) - acc[2], bfhi(uw.y) - acc[3]}; }
        bf16x8 Vb[2];
#pragma unroll
        for (int k2 = 0; k2 < 2; ++k2) Vb[k2] = pack8(vn[2 * k2][0], vn[2 * k2][1], vn[2 * k2][2], vn[2 * k2][3], vn[2 * k2 + 1][0], vn[2 * k2 + 1][1], vn[2 * k2 + 1][2], vn[2 * k2 + 1][3]);
        f32x4 Sn[8];
#pragma unroll
        for (int m = 0; m < 8; ++m) { f32x4 acc = S[m] * gl;
#pragma unroll
            for (int k2 = 0; k2 < 2; ++k2) acc = MFMA16(*(const bf16x8*)(kdp + m * 16 * 144 + k2 * 64), Vb[k2], acc);
            Sn[m] = acc; }
#pragma unroll
        for (int mt = 0; mt < 4; ++mt) { f32x4 acc = (f32x4){0.f, 0.f, 0.f, 0.f};
#pragma unroll
            for (int ks = 0; ks < 4; ++ks) acc = MFMA16(*(const bf16x8*)(qgp + mt * 16 * 272 + ks * 64), Sb[ks], acc);
#pragma unroll
            for (int k2 = 0; k2 < 2; ++k2) acc = MFMA16(*(const bf16x8*)(qkp + mt * 16 * 144 + k2 * 64), Vb[k2], acc);
            bf16_t* op = OG + ((size_t)b * T + i * 64 + 16 * mt + 4 * q) * 512 + h * 128 + es * 16 + r16;
            op[0] = f2bf(acc[0]); op[512] = f2bf(acc[1]); op[1024] = f2bf(acc[2]); op[1536] = f2bf(acc[3]); }
#pragma unroll
        for (int m = 0; m < 8; ++m) S[m] = Sn[m];
        gl = gln;
        __syncthreads();
    }
}

DI void tile_load_k(bf16x8 (&kf)[4], const bf16_t* __restrict__ K, int r32, int hh) {
#pragma unroll
    for (int s = 0; s < 4; ++s) kf[s] = *(const bf16x8*)(K + r32 * 64 + 16 * s + 8 * hh); }
DI void tile_load_v(bf16x8 (&vf)[2][2], const bf16_t* __restrict__ VT, int vp, int r32, int hh) {
#pragma unroll
    for (int dt = 0; dt < 2; ++dt)
#pragma unroll
        for (int ks = 0; ks < 2; ++ks) vf[dt][ks] = *(const bf16x8*)(VT + (size_t)(32 * dt + r32) * vp + 16 * ks + 8 * hh); }
DI f32x16 tile_scores(const bf16x8 (&kf)[4], const bf16x8 (&qf)[4], float negM, int hi2, int lo2, float& l) {
    f32x16 st;
#pragma unroll
    for (int i = 0; i < 16; ++i) st[i] = negM;
#pragma unroll
    for (int s = 0; s < 4; ++s) st = MFMA32(kf[s], qf[s], st);
#pragma unroll
    for (int r = 0; r < 16; ++r) { const int cr = (r & 3) + 8 * (r >> 2); float pv = __builtin_amdgcn_exp2f(st[r]); pv = (cr <= hi2 && cr > lo2) ? pv : 0.f; st[r] = pv; l += pv; }
    return st; }
DI void tile_pv(const f32x16& p, const bf16x8 (&vf)[2][2], f32x16 (&o)[2]) {
    const bf16x8 pb0 = pack8(p[0], p[1], p[2], p[3], p[4], p[5], p[6], p[7]), pb1 = pack8(p[8], p[9], p[10], p[11], p[12], p[13], p[14], p[15]);
#pragma unroll
    for (int dt = 0; dt < 2; ++dt) { o[dt] = MFMA32(vf[dt][0], pb0, o[dt]); o[dt] = MFMA32(vf[dt][1], pb1, o[dt]); } }

DI void block_stream(const bf16_t* __restrict__ KB, const bf16_t* __restrict__ VB, int f0, int f1, const bf16x8 (&qf)[4], f32x16 (&o)[2], float& l, float negM, int hi, int lo, int r32, int hh) {
    if (f0 >= f1) return;
    bf16x8 ka[4], kb[4], va[2][2], vb[2][2];
#define BS_LOAD(kx, vx, f_) do { const int n_ = (f_) >> 1, hf_ = (f_) & 1; tile_load_k(kx, KB + ((size_t)n_ * 64 + 32 * hf_) * 64, r32, hh); tile_load_v(vx, VB + (size_t)n_ * 4096 + 32 * hf_, 64, r32, hh); } while (0)
#define BS_COMP(kx, vx, f_) do { const int k0_ = 32 * (f_) + 4 * hh; const f32x16 p_ = tile_scores(kx, qf, negM, hi - k0_, lo - k0_, l); tile_pv(p_, vx, o); } while (0)
    BS_LOAD(ka, va, f0);
#pragma unroll 1
    for (int f = f0; f < f1; f += 2) {
        const bool h1 = f + 1 < f1;
        if (h1) BS_LOAD(kb, vb, f + 1);
        BS_COMP(ka, va, f);
        if (h1) { if (f + 2 < f1) BS_LOAD(ka, va, f + 2); BS_COMP(kb, vb, f + 1); } }
#undef BS_LOAD
#undef BS_COMP
}

DI float maxabs64(const float* g, int lane) { float v = fabsf(g[lane]);
#pragma unroll
    for (int o = 1; o < 64; o <<= 1) v = fmaxf(v, __shfl_xor(v, o));
    return v; }

#define LOADQF(qf) do { _Pragma("unroll") for (int s_ = 0; s_ < 4; ++s_) qf[s_] = *(const bf16x8*)(QL + row * 72 + 16 * s_ + 8 * hh); } while (0)
DI void nsa_unit(const Args& A, int unit, unsigned char* lds) {
    const int tid = threadIdx.x, lane = tid & 63, wave = __builtin_amdgcn_readfirstlane(tid >> 6), r32 = lane & 31, hh = lane >> 5;
    const int ti = 127 - (unit >> 2), bg = unit & 3, b = bg >> 1, g = bg & 1;
    unsigned char* ws = A.ws;
    bf16_t* QL = (bf16_t*)lds;
    int* OL = (int*)(lds + 36864);
    int* LL = (int*)(lds + 36864 + 67584);
    unsigned* BM = (unsigned*)(lds + 36864 + 67584 + 1024);
    int* CNT = (int*)(lds + 36864 + 67584 + 2048);
    float* SCL = (float*)(lds + 36864 + 67584 + 2048 + 64);
    float* IMP = (float*)(lds + 108544);
    const int slot = r32 >> 2, hd = r32 & 3, tl = wave * 8 + slot, trow = ti * 64 + tl; const size_t tokg = (size_t)b * T + trow;
    const int row = wave * 32 + r32;
    bf16_t* PA = (bf16_t*)IMP + row * 64;
    const float mq = maxabs64(A.in[I_QG], lane) * 8.08f * LOG2E;
    for (int i = tid; i < 256 + 16; i += 512) BM[i] = 0u;
    { const bf16_t* qp = (const bf16_t*)(ws + WS_QN) + tokg * 512 + (g * 4 + hd) * 64 + 8 * hh;
#pragma unroll
      for (int s = 0; s < 4; ++s) *(bf16x8*)(QL + row * 72 + 16 * s + 8 * hh) = *(const bf16x8*)(qp + 16 * s); }
    const float* gp = (const float*)(ws + WS_GATES) + tokg * 24 + (g * 4 + hd) * 3;
    __syncthreads();
    {   const float negMc = -mq * maxabs64(A.in[I_KCG], lane);
        bf16x8 qf[4]; LOADQF(qf);
        const int cmax_row = (trow >= 31) ? ((trow - 31) >> 4) : -1; const int tmaxw = ti * 64 + wave * 8 + 7; const int ntc = (tmaxw >= 31) ? ((((tmaxw - 31) >> 4) >> 5) + 1) : 0;
        const bf16_t* Kc = (const bf16_t*)(ws + WS_KC) + (size_t)(b * 2 + g) * 512 * 64; const bf16_t* VcT = (const bf16_t*)(ws + WS_VCT) + (size_t)(b * 2 + g) * 64 * 512;
        float lc = 0.f;
        if (ntc > 0) { bf16x8 ka[4], kb[4]; tile_load_k(ka, Kc, r32, hh);
#pragma unroll 1
            for (int ct = 0; ct < ntc; ct += 2) { const bool h1 = ct + 1 < ntc;
                if (h1) tile_load_k(kb, Kc + (ct + 1) * 2048, r32, hh);
                tile_scores(ka, qf, negMc, cmax_row - 32 * ct - 4 * hh, -1000000, lc);
                if (h1) { if (ct + 2 < ntc) tile_load_k(ka, Kc + (ct + 2) * 2048, r32, hh); tile_scores(kb, qf, negMc, cmax_row - 32 * (ct + 1) - 4 * hh, -1000000, lc); } } }
        lc += __shfl_xor(lc, 32);
        const float inv = (lc > 0.f) ? 1.f / lc : 0.f;
        f32x16 oc[2]; for (int i = 0; i < 16; ++i) { oc[0][i] = 0.f; oc[1][i] = 0.f; }
        float carry = 0.f, ldummy = 0.f;
#define CM_POST(p, ct_) do { float recv[4], bq[4]; \
            _Pragma("unroll") for (int jq = 0; jq < 4; ++jq) recv[jq] = __shfl_xor(p[4 * jq + 3], 32); \
            _Pragma("unroll") for (int jq = 0; jq < 4; ++jq) { const float pred = hh ? recv[jq] : (jq ? recv[jq - 1] : carry); float s_ = ((p[4 * jq] + p[4 * jq + 1]) + (p[4 * jq + 2] + p[4 * jq + 3]) + pred) * inv; \
                s_ += __shfl_xor(s_, 1); s_ += __shfl_xor(s_, 2); bq[jq] = s_; } \
            carry = recv[3]; \
            IMP[tl * 128 + 8 * (ct_) + 2 * hd + hh] = (hd == 0) ? bq[0] : (hd == 1) ? bq[1] : (hd == 2) ? bq[2] : bq[3]; } while (0)
        if (ntc > 0) { bf16x8 ka[4], kb[4], va[2][2], vb[2][2]; tile_load_k(ka, Kc, r32, hh); tile_load_v(va, VcT, 512, r32, hh);
#pragma unroll 1
            for (int ct = 0; ct < ntc; ct += 2) { const bool h1 = ct + 1 < ntc;
                if (h1) { tile_load_k(kb, Kc + (ct + 1) * 2048, r32, hh); tile_load_v(vb, VcT + (ct + 1) * 32, 512, r32, hh); }
                { const f32x16 p = tile_scores(ka, qf, negMc, cmax_row - 32 * ct - 4 * hh, -1000000, ldummy); tile_pv(p, va, oc); CM_POST(p, ct); }
                if (h1) { if (ct + 2 < ntc) { tile_load_k(ka, Kc + (ct + 2) * 2048, r32, hh); tile_load_v(va, VcT + (ct + 2) * 32, 512, r32, hh); }
                    const f32x16 p = tile_scores(kb, qf, negMc, cmax_row - 32 * (ct + 1) - 4 * hh, -1000000, ldummy); tile_pv(p, vb, oc); CM_POST(p, ct + 1); } } }
#undef CM_POST
        for (int ct = ntc; ct < 16; ++ct) IMP[tl * 128 + 8 * ct + 2 * hd + hh] = 0.f;
        if (ti >= 3) {
            __builtin_amdgcn_s_waitcnt(0xC07F); asm volatile("" ::: "memory");
            unsigned key[16]; const int li = hd + 4 * hh;
#pragma unroll
            for (int i4 = 0; i4 < 4; ++i4) { const f32x4 v4 = *(const f32x4*)(IMP + tl * 128 + li * 16 + 4 * i4);
#pragma unroll
                for (int i = 0; i < 4; ++i) { const int n = li * 16 + 4 * i4 + i; key[4 * i4 + i] = (n >= 1 && n <= ti - 2) ? ((__float_as_uint(fmaxf(v4[i], 0.f)) & ~0xFFu) | (unsigned)(128 - n)) : 0u; } }
#pragma unroll 1
            for (int it = 0; it < 13; ++it) { unsigned m = key[0];
#pragma unroll
                for (int i = 1; i < 16; ++i) m = (key[i] > m) ? key[i] : m;
                { unsigned o_; o_ = __shfl_xor(m, 1); m = o_ > m ? o_ : m; o_ = __shfl_xor(m, 2); m = o_ > m ? o_ : m; o_ = __shfl_xor(m, 32); m = o_ > m ? o_ : m; }
#pragma unroll
                for (int i = 0; i < 16; ++i) key[i] = (key[i] == m) ? 0u : key[i];
                if (m != 0u && hd == 0 && hh == 0) { const int nsel = 128 - (int)(m & 0xFFu); atomicOr(&BM[nsel * 2 + (tl >> 5)], 1u << (tl & 31)); } }
        }
        __builtin_amdgcn_s_waitcnt(0xC07F); asm volatile("" ::: "memory");
        { const float sc = gp[0] * inv;
#pragma unroll
          for (int dt = 0; dt < 2; ++dt)
#pragma unroll
              for (int r4 = 0; r4 < 4; ++r4) { u32x2 o; o.x = pk2(oc[dt][4 * r4] * sc, oc[dt][4 * r4 + 1] * sc); o.y = pk2(oc[dt][4 * r4 + 2] * sc, oc[dt][4 * r4 + 3] * sc);
                  *(u32x2*)(PA + 32 * dt + 8 * r4 + 4 * hh) = o; } }
    }
    const float negMs = -mq * maxabs64(A.in[I_KSG], lane);
    const bf16_t* KS = (const bf16_t*)(ws + WS_KSN) + (size_t)(b * 2 + g) * T * 64; const bf16_t* VS = (const bf16_t*)(ws + WS_VST) + (size_t)(b * 2 + g) * 128 * 4096;
    { bf16x8 qf[4]; LOADQF(qf);
      f32x16 os[2]; float lsel = 0.f; for (int i = 0; i < 16; ++i) { os[0][i] = 0.f; os[1][i] = 0.f; }
      block_stream(KS, VS, (ti >= 1 ? 2 * ti - 2 : 0), 2 * ti + 2, qf, os, lsel, negMs, trow, -1, r32, hh);
      if (ti >= 2) block_stream(KS, VS, 0, 2, qf, os, lsel, negMs, trow, -1, r32, hh);
      lsel += __shfl_xor(lsel, 32);
      const float scl = 1048576.0f / lsel;
#pragma unroll
      for (int dt = 0; dt < 2; ++dt)
#pragma unroll
          for (int r = 0; r < 16; ++r) OL[row * 66 + 32 * dt + crow(r, hh)] = __float2int_rn(os[dt][r] * scl);
      if (hh == 0) { LL[row] = __float2int_rn(lsel * scl); SCL[row] = scl; } }
    { const bf16_t* KW = (const bf16_t*)(ws + WS_KWN) + (size_t)(b * 2 + g) * T * 64; const bf16_t* VW = (const bf16_t*)(ws + WS_VWT) + (size_t)(b * 2 + g) * 128 * 4096;
      const float negMw = -mq * maxabs64(A.in[I_KWG], lane);
      bf16x8 qf[4]; LOADQF(qf);
      f32x16 ow[2]; float lw = 0.f; for (int i = 0; i < 16; ++i) { ow[0][i] = 0.f; ow[1][i] = 0.f; }
      const int tw0 = ti * 64 + wave * 8; const int nlo = (tw0 - 511 > 0) ? ((tw0 - 511) >> 6) : 0;
      block_stream(KW, VW, 2 * nlo, 2 * ti + 2, qf, ow, lw, negMw, trow, trow - 512, r32, hh);
      lw += __shfl_xor(lw, 32); const float sc = gp[2] / lw;
#pragma unroll
      for (int dt = 0; dt < 2; ++dt)
#pragma unroll
          for (int r4 = 0; r4 < 4; ++r4) { bf16_t* pp = PA + 32 * dt + 8 * r4 + 4 * hh; const u32x2 pa = *(const u32x2*)pp;
              u32x2 o; o.x = pk2(bflo(pa.x) + ow[dt][4 * r4] * sc, bfhi(pa.x) + ow[dt][4 * r4 + 1] * sc); o.y = pk2(bflo(pa.y) + ow[dt][4 * r4 + 2] * sc, bfhi(pa.y) + ow[dt][4 * r4 + 3] * sc);
              *(u32x2*)pp = o; } }
    __syncthreads();
    if (ti >= 3) {
        unsigned long long m_cur = 0ull; int n_cur = 0;
        int n_a = 0, n_b = 0; unsigned long long m_a = 0ull, m_b = 0ull;
#define ADVANCE(n_it, m_it, ok) do { ok = true; while (m_cur == 0ull) { int k_ = 0; if (lane == 0) k_ = atomicAdd(CNT, 1); k_ = __builtin_amdgcn_readfirstlane(k_); \
                if (k_ >= ti - 2) { ok = false; break; } n_cur = ti - 2 - k_; \
                m_cur = ((unsigned long long)__builtin_amdgcn_readfirstlane(BM[n_cur * 2 + 1]) << 32) | (unsigned)__builtin_amdgcn_readfirstlane(BM[n_cur * 2]); } \
            if (ok) { n_it = n_cur; m_it = m_cur; for (int i_ = 0; i_ < 8; ++i_) m_cur &= m_cur - 1ull; } } while (0)
        bool have; ADVANCE(n_a, m_a, have);
        bf16x8 ka[2][4], kb[2][4];
        if (have) { tile_load_k(ka[0], KS + (size_t)n_a * 4096, r32, hh); tile_load_k(ka[1], KS + (size_t)n_a * 4096 + 2048, r32, hh); }
        while (have) {
            bool have_b; ADVANCE(n_b, m_b, have_b);
            if (have_b) { tile_load_k(kb[0], KS + (size_t)n_b * 4096, r32, hh); tile_load_k(kb[1], KS + (size_t)n_b * 4096 + 2048, r32, hh); }
            bf16x8 va[2][2][2];
            tile_load_v(va[0], VS + (size_t)n_a * 4096, 64, r32, hh); tile_load_v(va[1], VS + (size_t)n_a * 4096 + 32, 64, r32, hh);
            unsigned long long mm = m_a; for (int i = 0; i < slot; ++i) mm &= mm - 1ull;
            const bool active = mm != 0ull; const int tt = active ? (__ffsll((long long)mm) - 1) : (__ffsll((long long)m_a) - 1);
            const int grow = tt * 4 + hd;
            bf16x8 qg[4];
#pragma unroll
            for (int s = 0; s < 4; ++s) qg[s] = *(const bf16x8*)(QL + grow * 72 + 16 * s + 8 * hh);
            f32x16 oo[2]; for (int i = 0; i < 16; ++i) { oo[0][i] = 0.f; oo[1][i] = 0.f; }
            float lp = 0.f; const int hi2 = active ? 1000000 : -1000000;
#pragma unroll
            for (int kt = 0; kt < 2; ++kt) { const f32x16 p = tile_scores(ka[kt], qg, negMs, hi2, -1000000, lp); tile_pv(p, va[kt], oo); }
            if (active) { const float scl = SCL[grow];
#pragma unroll
                for (int dt = 0; dt < 2; ++dt)
#pragma unroll
                    for (int r = 0; r < 16; ++r) atomicAdd(&OL[grow * 66 + 32 * dt + crow(r, hh)], __float2int_rn(oo[dt][r] * scl));
                atomicAdd(&LL[grow], __float2int_rn(lp * scl)); }
#pragma unroll
            for (int kt = 0; kt < 2; ++kt)
#pragma unroll
                for (int s = 0; s < 4; ++s) ka[kt][s] = kb[kt][s];
            n_a = n_b; m_a = m_b; have = have_b;
        }
#undef ADVANCE
    }
    __syncthreads();
    { const float sc = gp[1] / (float)LL[row];
      bf16_t* op = (bf16_t*)(ws + WS_ONSA) + tokg * 512 + (g * 4 + hd) * 64;
#pragma unroll
      for (int dt = 0; dt < 2; ++dt)
#pragma unroll
          for (int r4 = 0; r4 < 4; ++r4) { float f[4];
              const u32x2 pa = *(const u32x2*)(PA + 32 * dt + 8 * r4 + 4 * hh); const float pf[4] = {bflo(pa.x), bfhi(pa.x), bflo(pa.y), bfhi(pa.y)};
#pragma unroll
              for (int i = 0; i < 4; ++i) { const int r = 4 * r4 + i; f[i] = pf[i] + (float)OL[row * 66 + 32 * dt + crow(r, hh)] * sc; }
              u32x2 o; o.x = pk2(f[0], f[1]); o.y = pk2(f[2], f[3]);
              *(u32x2*)(op + 32 * dt + 8 * r4 + 4 * hh) = o; } }
    __syncthreads();
}

DI void phase_finalize(const Args& A) {
    const int tid = threadIdx.x, lane = tid & 63, wave = tid >> 6; const int gw = blockIdx.x * 8 + wave, NGW = gridDim.x * 8;
    unsigned char* ws = A.ws;
    for (int tok = gw; tok < NTOK; tok += NGW) {
        bf16_t* oc = (bf16_t*)(ws + WS_OCAT) + (size_t)tok * 1024;
        { const u32x4 w = *(const u32x4*)((const bf16_t*)(ws + WS_ONSA) + (size_t)tok * 512 + 8 * lane);
          float f[8] = {bflo(w.x), bfhi(w.x), bflo(w.y), bfhi(w.y), bflo(w.z), bfhi(w.z), bflo(w.w), bfhi(w.w)}; float s = 0.f;
#pragma unroll
          for (int i = 0; i < 8; ++i) s += f[i] * f[i];
          const float rs = rsqrtf(wave_sum(s) * (1.f / 512.f) + EPS); const float* gn = A.in[I_NSAOG] + 8 * lane;
          u32x4 o; o.x = pk2(f[0] * rs * gn[0], f[1] * rs * gn[1]); o.y = pk2(f[2] * rs * gn[2], f[3] * rs * gn[3]); o.z = pk2(f[4] * rs * gn[4], f[5] * rs * gn[5]); o.w = pk2(f[6] * rs * gn[6], f[7] * rs * gn[7]);
          *(u32x4*)(oc + 8 * lane) = o; }
        { const u32x4 w = *(const u32x4*)((const bf16_t*)(ws + WS_OG) + (size_t)tok * 512 + 8 * lane);
          const u32x4 zw = *(const u32x4*)((const bf16_t*)(ws + WS_U) + (size_t)tok * INWP + C_GZ + 8 * lane);
          float f[8] = {bflo(w.x), bfhi(w.x), bflo(w.y), bfhi(w.y), bflo(w.z), bfhi(w.z), bflo(w.w), bfhi(w.w)};
          float z[8] = {bflo(zw.x), bfhi(zw.x), bflo(zw.y), bfhi(zw.y), bflo(zw.z), bfhi(zw.z), bflo(zw.w), bfhi(zw.w)}; float s = 0.f;
#pragma unroll
          for (int i = 0; i < 8; ++i) s += f[i] * f[i];
          s += __shfl_xor(s, 1); s += __shfl_xor(s, 2); s += __shfl_xor(s, 4); s += __shfl_xor(s, 8);
          const float rs = rsqrtf(s * (1.f / 128.f) + EPS); const float* gn = A.in[I_GDNOG] + (8 * lane & 127); float o8[8];
#pragma unroll
          for (int i = 0; i < 8; ++i) o8[i] = f[i] * rs * gn[i] * z[i] * sigm(z[i]);
          u32x4 o; o.x = pk2(o8[0], o8[1]); o.y = pk2(o8[2], o8[3]); o.z = pk2(o8[4], o8[5]); o.w = pk2(o8[6], o8[7]);
          *(u32x4*)(oc + 512 + 8 * lane) = o; }
    }
}

DI void phase_router(const Args& A, unsigned char* lds) {
    const int tid = threadIdx.x, lane = tid & 63, wave = tid >> 6; const int gw = blockIdx.x * 8 + wave, NGW = gridDim.x * 8;
    unsigned char* ws = A.ws; const float* x1 = A.out; const float* rw = A.in[I_RW]; const float* fg = A.in[I_FFNG];
    float* lgL = (float*)(lds + wave * 8192); float* rsL = lgL + 32 * 33;
    const int i32 = lane & 31, kh = lane >> 5;
    for (int task = gw; task < NTOK / 32; task += NGW) {
        const int tok = task * 32 + i32; const float* xr = x1 + (size_t)tok * D;
        f32x16 acc; for (int i = 0; i < 16; ++i) acc[i] = 0.f; float ss = 0.f;
#pragma unroll 2
        for (int kb = 0; kb < 128; ++kb) { const int k0 = 8 * kb + 4 * kh; const f32x4 av = *(const f32x4*)(xr + k0); const f32x4 gv = *(const f32x4*)(fg + k0);
            ss += av[0] * av[0] + av[1] * av[1] + av[2] * av[2] + av[3] * av[3];
#pragma unroll
            for (int s = 0; s < 4; ++s) acc = __builtin_amdgcn_mfma_f32_32x32x2f32(av[s], rw[(size_t)(k0 + s) * 32 + i32] * gv[s], acc, 0, 0, 0); }
        ss += __shfl_xor(ss, 32); const float rstd = rsqrtf(ss * (1.f / D) + EPS);
        if (kh == 0) { rsL[i32] = rstd; ((float*)(ws + WS_RSTD2))[tok] = rstd; }
#pragma unroll
        for (int r = 0; r < 16; ++r) lgL[crow(r, kh) * 33 + i32] = acc[r];
        __builtin_amdgcn_s_waitcnt(0xC07F); asm volatile("" ::: "memory");
        if (lane < 32) { float v[4] = {-3.0e38f, -3.0e38f, -3.0e38f, -3.0e38f}; int id[4] = {0, 0, 0, 0}; const float* rb = A.in[I_RB];
            for (int e = 0; e < 32; ++e) { const float x = lgL[lane * 33 + e] * rstd + rb[e];
                if (x > v[3]) { if (x > v[0]) { v[3] = v[2]; id[3] = id[2]; v[2] = v[1]; id[2] = id[1]; v[1] = v[0]; id[1] = id[0]; v[0] = x; id[0] = e; }
                    else if (x > v[1]) { v[3] = v[2]; id[3] = id[2]; v[2] = v[1]; id[2] = id[1]; v[1] = x; id[1] = e; }
                    else if (x > v[2]) { v[3] = v[2]; id[3] = id[2]; v[2] = x; id[2] = e; }
                    else { v[3] = x; id[3] = e; } } }
            const float e0 = 1.f, e1 = __expf(v[1] - v[0]), e2 = __expf(v[2] - v[0]), e3 = __expf(v[3] - v[0]); const float inv = 1.f / (e0 + e1 + e2 + e3);
            const float gt[4] = {e0 * inv, e1 * inv, e2 * inv, e3 * inv};
#pragma unroll
            for (int k = 0; k < 4; ++k) { const int pos = atomicAdd((unsigned*)(ws + WS_CTL) + CW_CNT + id[k], 1u);
                ((int*)(ws + WS_TOKE))[tok * 4 + k] = id[k]; ((float*)(ws + WS_TOKG))[tok * 4 + k] = gt[k]; ((int*)(ws + WS_TOKPOS))[tok * 4 + k] = pos; } }
        __builtin_amdgcn_s_waitcnt(0xC07F); asm volatile("" ::: "memory");
    }
}

DI void phase_gather(const Args& A, unsigned char* lds) {
    const int tid = threadIdx.x, lane = tid & 63, wave = tid >> 6; const int gw = blockIdx.x * 8 + wave, NGW = gridDim.x * 8;
    unsigned char* ws = A.ws; int* psL = (int*)lds;
    if (tid == 0) { const unsigned* cnt = (const unsigned*)(ws + WS_CTL) + CW_CNT; int acc = 0;
        for (int e = 0; e < 32; ++e) { psL[e] = acc; acc += ((int)cnt[e] + 255) & ~255; }
        psL[32] = acc;
        if (blockIdx.x == 0) { int* ctl = (int*)(ws + WS_CTL); ctl[CW_NT] = acc >> 8; int e = 0;
            for (int r = 0; r < (acc >> 8); ++r) { while (r * 256 >= psL[e + 1]) ++e; ctl[CW_TILEE + r] = e; } } }
    __syncthreads();
    const float* x1 = A.out; const float* fg = A.in[I_FFNG]; f32x4 gv[4];
#pragma unroll
    for (int j = 0; j < 4; ++j) gv[j] = *(const f32x4*)(fg + 4 * lane + 256 * j);
    for (int pr = gw; pr < NTOK * 4; pr += NGW) { const int tok = pr >> 2;
        const int e = ((const int*)(ws + WS_TOKE))[pr], pos = ((const int*)(ws + WS_TOKPOS))[pr]; const int dest = psL[e] + pos;
        if (lane == 0) { ((int*)(ws + WS_DEST))[pr] = dest; ((float*)(ws + WS_ROWG))[dest] = ((const float*)(ws + WS_TOKG))[pr]; }
        const float rs = ((const float*)(ws + WS_RSTD2))[tok]; const f32x4* xr = (const f32x4*)(x1 + (size_t)tok * D) + lane;
        u32x2* o = (u32x2*)((bf16_t*)(ws + WS_XS) + (size_t)dest * D) + lane;
#pragma unroll
        for (int j = 0; j < 4; ++j) { const f32x4 v = xr[64 * j]; u32x2 w; w.x = pk2(v.x * rs * gv[j].x, v.y * rs * gv[j].y); w.y = pk2(v.z * rs * gv[j].z, v.w * rs * gv[j].w); o[64 * j] = w; } }
}

DI void phase_combine(const Args& A) {
    const int tid = threadIdx.x, lane = tid & 63, wave = tid >> 6; const int gw = blockIdx.x * 8 + wave, NGW = gridDim.x * 8;
    unsigned char* ws = A.ws; const bf16_t* YS = (const bf16_t*)(ws + WS_XS);
    for (int tok = gw; tok < NTOK; tok += NGW) { f32x4* xr = (f32x4*)(A.out + (size_t)tok * D) + lane; f32x4 v[4];
#pragma unroll
        for (int j = 0; j < 4; ++j) v[j] = xr[64 * j];
#pragma unroll
        for (int k = 0; k < 4; ++k) { const int dest = ((const int*)(ws + WS_DEST))[tok * 4 + k]; const u32x2* yr = (const u32x2*)(YS + (size_t)dest * D) + lane;
#pragma unroll
            for (int j = 0; j < 4; ++j) { const u32x2 w = yr[64 * j]; v[j].x += bflo(w.x); v[j].y += bfhi(w.x); v[j].z += bflo(w.y); v[j].w += bfhi(w.y); } }
#pragma unroll
        for (int j = 0; j < 4; ++j) xr[64 * j] = v[j]; }
}

__global__ void __launch_bounds__(512, 2) mega(Args A) {
    extern __shared__ __attribute__((aligned(16))) unsigned char lds[];
    cg::grid_group grid = cg::this_grid();
    const int lo = A.ph_lo, hi = A.ph_hi, tid = threadIdx.x;
    unsigned char* ws = A.ws;
    int* taskL = (int*)(lds + LDS_MISC);
#define IN(k) (lo <= (k) && (k) < hi)
#define SEAM(k) do { if (IN(k) && IN((k) + 1)) grid.sync(); } while (0)

#ifndef REPEAT_PH
#define REPEAT_PH -1
#endif
#define REP(k) (REPEAT_PH == (k) ? 2 : 1)
    for (int rep = 0; rep < REP(0); ++rep) { if (IN(0)) phase0(A, lds, rep == 0); if (rep + 1 < REP(0)) grid.sync(); }
    SEAM(0);
    for (int rep = 0; rep < REP(1); ++rep) { if (IN(1)) { pg8::Gemm g{(const bf16_t*)(ws + WS_XN), (const bf16_t*)(ws + WS_WTIN), NTOK, INWP, D}; pg8::StaticOrder S; S.init(NTOK, INWP, gridDim.x, blockIdx.x);
        pg8::EpiU E{(bf16_t*)(ws + WS_U), INWP}; pg8::gemm_phase<pg8::EpiU, pg8::StaticOrder>((PG8_LAS unsigned char*)lds, g, S, E); } if (rep + 1 < REP(1)) grid.sync(); }
    SEAM(1);
    for (int rep = 0; rep < REP(2); ++rep) { if (IN(2)) {
        for (;;) { if (tid == 0) *taskL = atomicAdd((int*)(ws + WS_CTL) + (rep ? CW_Q2B : CW_Q2), 1); __syncthreads(); const int task = *taskL; __syncthreads();
            if (task >= 1408) break;
            if (task < 128) compress_task(A, task, lds); else if (task < 1152) gdn_chunk_task(A, task - 128, lds); else nsa_prep_task(A, task - 1152, lds); } } if (rep + 1 < REP(2)) grid.sync(); }
    SEAM(2);
    for (int rep = 0; rep < REP(3); ++rep) { if (IN(3)) {
        if (blockIdx.x < 64) { gdn_scan_block(A, blockIdx.x, lds); __syncthreads(); }
        for (;;) { if (tid == 0) *taskL = atomicAdd((int*)(ws + WS_CTL) + (rep ? CW_Q3B : CW_Q3), 1); __syncthreads(); const int unit = *taskL; __syncthreads();
            if (unit >= 512) break;
            nsa_unit(A, unit, lds); } } if (rep + 1 < REP(3)) grid.sync(); }
    SEAM(3);
    for (int rep = 0; rep < REP(4); ++rep) { if (IN(4)) phase_finalize(A); if (rep + 1 < REP(4)) grid.sync(); }
    SEAM(4);
    for (int rep = 0; rep < REP(5); ++rep) { if (IN(5)) { pg8::Gemm g{(const bf16_t*)(ws + WS_OCAT), (const bf16_t*)(ws + WS_WTOUT), NTOK, D, D}; pg8::StaticOrder S; S.init(NTOK, D, gridDim.x, blockIdx.x);
        pg8::EpiRes E{A.in[I_X], A.out, D}; pg8::gemm_phase<pg8::EpiRes, pg8::StaticOrder>((PG8_LAS unsigned char*)lds, g, S, E); } if (rep + 1 < REP(5)) grid.sync(); }
    SEAM(5);
    for (int rep = 0; rep < REP(6); ++rep) { if (IN(6)) phase_router(A, lds);
        if (rep + 1 < REP(6)) { grid.sync(); if (blockIdx.x == 0 && tid < 32) ((unsigned*)(ws + WS_CTL))[CW_CNT + tid] = 0u; grid.sync(); } }
    SEAM(6);
    for (int rep = 0; rep < REP(7); ++rep) { if (IN(7)) phase_gather(A, lds); if (rep + 1 < REP(7)) grid.sync(); }
    SEAM(7);
    for (int rep = 0; rep < REP(8); ++rep) { if (IN(8)) { const int* ctl = (const int*)(ws + WS_CTL); const int nM = ctl[CW_NT];
        pg8::Gemm g{(const bf16_t*)(ws + WS_XS), (const bf16_t*)(ws + WS_EXPGU), 0, 0, D}; pg8::MoeOrder S; S.init(nM, 8, gridDim.x, blockIdx.x, ctl + CW_TILEE);
        pg8::EpiSwiglu E{(bf16_t*)(ws + WS_HID), A.in[I_EBG], A.in[I_EBU]}; pg8::gemm_phase<pg8::EpiSwiglu, pg8::MoeOrder>((PG8_LAS unsigned char*)lds, g, S, E); } if (rep + 1 < REP(8)) grid.sync(); }
    SEAM(8);
    for (int rep = 0; rep < REP(9); ++rep) { if (IN(9)) { const int* ctl = (const int*)(ws + WS_CTL); const int nM = ctl[CW_NT];
        pg8::Gemm g{(const bf16_t*)(ws + WS_HID), (const bf16_t*)(ws + WS_EXPD), 0, 0, D}; pg8::MoeOrder S; S.init(nM, 4, gridDim.x, blockIdx.x, ctl + CW_TILEE);
        pg8::EpiDown E{(bf16_t*)(ws + WS_XS), A.in[I_EBD], (const float*)(ws + WS_ROWG)}; pg8::gemm_phase<pg8::EpiDown, pg8::MoeOrder>((PG8_LAS unsigned char*)lds, g, S, E); } if (rep + 1 < REP(9)) grid.sync(); }
    SEAM(9);
    if (IN(10)) phase_combine(A);
#undef IN
#undef SEAM
}

constexpr int NPHASE = 11;
#ifndef N_LAUNCHES
#define N_LAUNCHES 1
#endif
extern "C" void kernel_launch(void* const* d_in, const int* in_sizes, int n_in, void* d_out, int out_size, void* d_ws, size_t ws_size, hipStream_t stream) {
    static int grid = 0;
    if (grid == 0) {
        if (n_in != 32 || out_size != NTOK * D || ws_size < WS_END) { fprintf(stderr, "kernel_launch: unexpected shapes (n_in %d out %d ws %zu)\n", n_in, out_size, ws_size); grid = -1; return; }
        int dev = 0, cus = 0, per_cu = 0;
        hipGetDevice(&dev); hipDeviceGetAttribute(&cus, hipDeviceAttributeMultiprocessorCount, dev);
        hipFuncSetAttribute((const void*)mega, hipFuncAttributeMaxDynamicSharedMemorySize, LDS_BYTES);
        hipOccupancyMaxActiveBlocksPerMultiprocessor(&per_cu, (const void*)mega, 512, LDS_BYTES);
        if (per_cu < 1) { fprintf(stderr, "kernel_launch: occupancy query says %d blocks per CU\n", per_cu); per_cu = 1; }
        (void)hipGetLastError();
        grid = cus;
    }
    if (grid < 0) return;
    hipMemsetAsync((char*)d_ws + WS_CTL, 0, CTL_BYTES, stream);
    Args a{};
    for (int i = 0; i < 32; ++i) a.in[i] = (const float*)d_in[i];
    a.out = (float*)d_out; a.ws = (unsigned char*)d_ws;
    if (N_LAUNCHES == 1) { a.ph_lo = 0; a.ph_hi = NPHASE; void* args[] = {&a};
        hipError_t e = hipLaunchCooperativeKernel((const void*)mega, dim3(grid), dim3(512), args, LDS_BYTES, stream);
        if (e != hipSuccess) fprintf(stderr, "cooperative launch failed: %s (grid %d)\n", hipGetErrorString(e), grid); }
    else { for (int p = 0; p < NPHASE; ++p) { a.ph_lo = p; a.ph_hi = p + 1; void* args[] = {&a};
            hipError_t e = hipLaunchCooperativeKernel((const void*)mega, dim3(grid), dim3(512), args, LDS_BYTES, stream);
            if (e != hipSuccess) { fprintf(stderr, "launch %d failed: %s\n", p, hipGetErrorString(e)); break; } } }
}
```

```cpp
#include <hip/hip_runtime.h>
#include <hip/hip_cooperative_groups.h>
#include <cstdio>
#include <cstdint>
namespace cg = cooperative_groups;

#define DI __device__ __forceinline__
#define LAS __attribute__((address_space(3)))
typedef unsigned short bf16_t;
typedef short bf16x8 __attribute__((ext_vector_type(8)));
typedef float f32x4 __attribute__((ext_vector_type(4)));
typedef float f32x16 __attribute__((ext_vector_type(16)));
typedef unsigned u32x4 __attribute__((ext_vector_type(4)));
typedef unsigned u32x2 __attribute__((ext_vector_type(2)));
typedef float f32x2_t __attribute__((ext_vector_type(2)));
typedef __bf16 bf16x2_t __attribute__((ext_vector_type(2)));

constexpr int NB = 2, T = 8192, D = 1024, NTOK = NB * T, INWP = 3584;
constexpr int C_Q = 0, C_KC = 512, C_VC = 640, C_KS = 768, C_VS = 896, C_KW = 1024, C_VW = 1152, C_GATE = 1280,
              C_GQ = 1304, C_GK = 1816, C_GV = 2328, C_GZ = 2840, C_GA = 3352, C_GB = 3356, INW = 3360;
constexpr float EPS = 1e-6f, LOG2E = 1.4426950408889634f;
constexpr int NEXP = 32, MAXROWS = 65536 + NEXP * 256, MAXTILES = MAXROWS / 256;

constexpr size_t MiB = 1u << 20;
constexpr size_t WS_CTL = 0, CTL_BYTES = 64 * 1024;
constexpr size_t WS_WTIN = 1 * MiB, WS_WTOUT = 8 * MiB, WS_WTC1K = 10 * MiB, WS_WTC1V = 11 * MiB;
constexpr size_t WS_MISC = 12 * MiB;
constexpr size_t WS_WTC2K = WS_MISC, WS_WTC2V = WS_MISC + 32 * 1024, WS_RSTD2 = WS_MISC + 64 * 1024, WS_TOKE = WS_MISC + 128 * 1024,
                 WS_TOKG = WS_MISC + 384 * 1024, WS_TOKPOS = WS_MISC + 640 * 1024, WS_DEST = WS_MISC + 896 * 1024,
                 WS_ROWG = WS_MISC + 1152 * 1024, WS_GL = WS_MISC + 1536 * 1024, WS_GATES = 14 * MiB;
constexpr size_t WS_EXPGU = 16 * MiB, WS_EXPD = 144 * MiB;
constexpr size_t WS_XN = 208 * MiB, WS_ONSA = 208 * MiB, WS_U = 240 * MiB, WS_QN = 352 * MiB, WS_KSN = 368 * MiB, WS_VST = 372 * MiB,
                 WS_KWN = 376 * MiB, WS_VWT = 380 * MiB, WS_KC = 384 * MiB, WS_VCT = 384 * MiB + 512 * 1024;
constexpr size_t WS_WP = 388 * MiB, WS_QGP = 404 * MiB, WS_KDTP = 420 * MiB, WS_QKP = 436 * MiB, WS_UP = 444 * MiB, WS_OG = 460 * MiB, WS_OCAT = 476 * MiB;
constexpr size_t WS_XS = 208 * MiB, WS_HID = 352 * MiB, WS_END = 508 * MiB;
constexpr int CW_Q2 = 0, CW_Q3 = 64, CW_Q2B = 32, CW_Q3B = 96, CW_CNT = 128, CW_PB1 = 4096  , CW_NT = 1024, CW_TILEE = 1088  , CW_PSTART = 1536, CW_BAR = 12288;

constexpr int LDS_BYTES = 147456, LDS_MISC = 140 * 1024;

DI unsigned pk2(float lo, float hi) { f32x2_t v = {lo, hi}; bf16x2_t b = __builtin_convertvector(v, bf16x2_t); return __builtin_bit_cast(unsigned, b); }
DI float bflo(unsigned w) { return __uint_as_float(w << 16); }
DI float bfhi(unsigned w) { return __uint_as_float(w & 0xffff0000u); }
DI float bf2f(bf16_t v) { return __uint_as_float((unsigned)v << 16); }
DI bf16_t f2bf(float f) { return (bf16_t)(pk2(f, 0.f) & 0xffffu); }
DI bf16x8 pack8(float a0, float a1, float a2, float a3, float a4, float a5, float a6, float a7) {
    u32x4 w; w.x = pk2(a0, a1); w.y = pk2(a2, a3); w.z = pk2(a4, a5); w.w = pk2(a6, a7); return __builtin_bit_cast(bf16x8, w); }
DI float wave_sum(float v) {
#pragma unroll
    for (int o = 1; o < 64; o <<= 1) v += __shfl_xor(v, o);
    return v; }
DI float sigm(float x) { return __builtin_amdgcn_rcpf(1.f + __builtin_amdgcn_exp2f(-x * LOG2E)); }
DI int crow(int r, int hi) { return (r & 3) + 8 * (r >> 2) + 4 * hi; }
DI int perm16(int p) { return 8 * ((p & 7) >> 2) + 4 * (p >> 3) + (p & 3); }
DI int perm16inv(int k) { return 8 * ((k >> 2) & 1) + 4 * (k >> 3) + (k & 3); }
#define MFMA32(a, b, c) __builtin_amdgcn_mfma_f32_32x32x16_bf16((a), (b), (c), 0, 0, 0)
#define MFMA16(a, b, c) __builtin_amdgcn_mfma_f32_16x16x32_bf16((a), (b), (c), 0, 0, 0)

namespace pg8 {
#define PG8_LAS __attribute__((address_space(3)))
constexpr int BM = 256, BK = 64, HALF = 128, HTB = HALF * BK * 2, STAGE_BYTES = 8 * HTB, NXCD = 8, WGM = 8;
__host__ __device__ __forceinline__ int lds_byte(int r, int c) { const int st = (r >> 4) * 2 + (c >> 5), rr = r & 15, cc = c & 31, ob = rr * 64 + cc * 2; return st * 1024 + (ob ^ (((ob >> 9) & 1) << 5)); }
__host__ __device__ __forceinline__ void stage_rc(int b, int& R, int& C) { const int st = b / 1024, sb = b % 1024, swz = sb ^ (((sb >> 9) & 1) << 5); R = (st >> 1) * 16 + swz / 64; C = (st & 1) * 32 + (swz % 64) / 2; }
__host__ __device__ __forceinline__ int perm32(int rho) { const int n = rho >> 4, i = rho & 15; return 8 * (i >> 2) + 4 * n + (i & 3); }
struct Unit { int pm, pn; };
struct Gemm { const bf16_t* A; const bf16_t* Bt; int M, N, K; };
struct StaticOrder {
    int nM, nN, nwg, G, c;
    __device__ void init(int M, int N, int G_, int c_) { nM = M / BM; nN = N / BM; nwg = nM * nN; G = G_; c = c_; }
    __device__ bool next(int i, Unit& u) const {
        const long L = (long)i * G + c; if (L >= nwg) return false;
        int wgid = (int)L; { const int q = nwg / NXCD, r = nwg % NXCD, xcd = wgid % NXCD, off = wgid / NXCD; wgid = (xcd < r ? xcd * (q + 1) : r * (q + 1) + (xcd - r) * q) + off; }
        const int nig = WGM * nN, gid = wgid / nig, fm = gid * WGM, gsz = (nM - fm) < WGM ? (nM - fm) : WGM;
        u.pm = fm + ((wgid % nig) % gsz); u.pn = (wgid % nig) / gsz; return true;
    }
};
struct MoeOrder {
    StaticOrder S; const int* tile_e;
    __device__ void init(int nM_, int nN_, int G_, int c_, const int* te) { S.nM = nM_; S.nN = nN_; S.nwg = nM_ * nN_; S.G = G_; S.c = c_; tile_e = te; }
    __device__ bool next(int i, Unit& u) const { if (!S.next(i, u)) return false; u.pn = tile_e[u.pm] * S.nN + u.pn; return true; }
};

template <class Epi, class Sched>
__device__ __forceinline__ void gemm_phase(PG8_LAS unsigned char* lds, const Gemm g, const Sched& S, const Epi& E) {
    const int tid = threadIdx.x, wid = __builtin_amdgcn_readfirstlane(tid >> 6), lane = tid & 63, wr = wid >> 2, wc = wid & 3, fr = lane & 15, fq = lane >> 4;
    const int K = g.K, nt = K / BK;
    unsigned voffA[2], voffB[2];
#pragma unroll
    for (int i = 0; i < 2; ++i) { int R, C; stage_rc(tid * 16 + i * 8192, R, C); const int Rb = Epi::PERM ? ((R & ~31) + perm32(R & 31)) : R;
        voffA[i] = (unsigned)(R * K + C) * 2u; voffB[i] = (unsigned)(Rb * K + C) * 2u; }
    const size_t kstep = (size_t)(BK * 2);
    const size_t hstep = (size_t)HALF * K * 2;
    const size_t tstep = 2 * hstep;
    const unsigned ldsw = (unsigned)wid * 1024u;
    const int aoff = lds_byte(wr * 64 + fr, fq * 8), boff = lds_byte(wc * 32 + fr, fq * 8);
#define PG8_SA(b, h) (((b) * 2 + (h)) * HTB)
#define PG8_SB(b, h) ((4 + (b) * 2 + (h)) * HTB)
#define PG8_STAGE(bufoff, gbase, voff) do { _Pragma("unroll") for (int _i = 0; _i < 2; ++_i) \
        __builtin_amdgcn_global_load_lds((const unsigned*)((const char*)(gbase) + (voff)[_i]), (PG8_LAS unsigned*)(lds + (bufoff) + ldsw + _i * 8192), 16, 0, 0); } while (0)
#define PG8_LDA(dst, b, h) do { _Pragma("unroll") for (int m = 0; m < 4; ++m) _Pragma("unroll") for (int k = 0; k < 2; ++k) dst[m][k] = *(const PG8_LAS bf16x8*)(lds + PG8_SA(b, h) + aoff + m * 2048 + k * 1024); } while (0)
#define PG8_LDB(dst, b, h) do { _Pragma("unroll") for (int n = 0; n < 2; ++n) _Pragma("unroll") for (int k = 0; k < 2; ++k) dst[n][k] = *(const PG8_LAS bf16x8*)(lds + PG8_SB(b, h) + boff + n * 2048 + k * 1024); } while (0)
#define PG8_MMA(ai, bj, At, Bt) do { __builtin_amdgcn_s_setprio(1); _Pragma("unroll") for (int m = 0; m < 4; ++m) _Pragma("unroll") for (int n = 0; n < 2; ++n) _Pragma("unroll") for (int k = 0; k < 2; ++k) \
        acc[ai][bj][m][n] = __builtin_amdgcn_mfma_f32_16x16x32_bf16(Bt[n][k], At[m][k], acc[ai][bj][m][n], 0, 0, 0); __builtin_amdgcn_s_setprio(0); } while (0)
#define PG8_WAIT_V(n) asm volatile("s_waitcnt vmcnt(" #n ")" ::: "memory")
#define PG8_WAIT_L(n) asm volatile("s_waitcnt lgkmcnt(" #n ")" ::: "memory")
#define PG8_BAR __builtin_amdgcn_s_barrier()
#define PG8_SCHED __builtin_amdgcn_sched_barrier(0)
    Unit cur, nxt; int ui = 0;
    if (!S.next(0, cur)) return;
    f32x4 acc[2][2][4][2];
#pragma unroll
    for (int a = 0; a < 2; ++a)
#pragma unroll
        for (int b = 0; b < 2; ++b)
#pragma unroll
            for (int m = 0; m < 4; ++m)
#pragma unroll
                for (int n = 0; n < 2; ++n) acc[a][b][m][n] = (f32x4){0.f, 0.f, 0.f, 0.f};
    bf16x8 At[4][2], B0[2][2], B1[2][2];
    const char* cA = (const char*)g.A + (size_t)cur.pm * tstep; const char* cB = (const char*)g.Bt + (size_t)cur.pn * tstep;
    PG8_STAGE(PG8_SB(0, 0), cB, voffB); PG8_STAGE(PG8_SB(0, 1), cB + hstep, voffB); PG8_STAGE(PG8_SA(0, 0), cA, voffA); PG8_STAGE(PG8_SA(0, 1), cA + hstep, voffA);
    if (wr == 1) PG8_BAR;
    PG8_WAIT_V(2); PG8_BAR;
    PG8_STAGE(PG8_SB(1, 0), cB + kstep, voffB); PG8_STAGE(PG8_SA(1, 0), cA + kstep, voffA); PG8_STAGE(PG8_SB(1, 1), cB + hstep + kstep, voffB);
    PG8_WAIT_V(6); PG8_BAR;
    for (;;) {
        const bool has_next = S.next(ui + 1, nxt);
        const char* nA = has_next ? (const char*)g.A + (size_t)nxt.pm * tstep : cA; const char* nB = has_next ? (const char*)g.Bt + (size_t)nxt.pn * tstep : cB;
        for (int t = 0; t < nt; t += 2) {
            const bool last = (t == nt - 2);
            const char* a1 = cA + (size_t)(t + 1) * kstep;
            const char* a2 = last ? nA : cA + (size_t)(t + 2) * kstep; const char* b2 = last ? nB : cB + (size_t)(t + 2) * kstep;
            const char* a3 = a2 + kstep; const char* b3 = b2 + kstep;
            PG8_LDB(B0, 0, 0); PG8_LDB(B1, 0, 1); PG8_SCHED; PG8_LDA(At, 0, 0); PG8_STAGE(PG8_SA(1, 1), a1 + hstep, voffA);
            PG8_WAIT_V(8); PG8_WAIT_L(0); PG8_BAR; PG8_MMA(0, 0, At, B0); PG8_MMA(0, 1, At, B1); PG8_BAR; PG8_SCHED;
            PG8_LDA(At, 0, 1); PG8_STAGE(PG8_SB(0, 0), b2, voffB); PG8_STAGE(PG8_SB(0, 1), b2 + hstep, voffB); PG8_STAGE(PG8_SA(0, 0), a2, voffA);
            PG8_WAIT_V(8); PG8_WAIT_L(0); PG8_BAR; PG8_MMA(1, 0, At, B0); PG8_MMA(1, 1, At, B1); PG8_BAR; PG8_SCHED;
            PG8_LDB(B0, 1, 0); PG8_LDB(B1, 1, 1); PG8_SCHED; PG8_LDA(At, 1, 0); PG8_STAGE(PG8_SA(0, 1), a2 + hstep, voffA);
            PG8_WAIT_V(8); PG8_WAIT_L(0); PG8_BAR; PG8_MMA(0, 0, At, B0); PG8_MMA(0, 1, At, B1); PG8_BAR; PG8_SCHED;
            PG8_LDA(At, 1, 1); PG8_STAGE(PG8_SB(1, 0), b3, voffB); PG8_STAGE(PG8_SB(1, 1), b3 + hstep, voffB); PG8_STAGE(PG8_SA(1, 0), a3, voffA);
            PG8_WAIT_V(8); PG8_WAIT_L(0); PG8_BAR; PG8_MMA(1, 0, At, B0); PG8_MMA(1, 1, At, B1); PG8_BAR; PG8_SCHED;
        }
        if (wr == 0) PG8_BAR;
        E(acc, cur, wr, wc, fr, fq);
        if (!has_next) break;
#pragma unroll
        for (int a = 0; a < 2; ++a)
#pragma unroll
            for (int b = 0; b < 2; ++b)
#pragma unroll
                for (int m = 0; m < 4; ++m)
#pragma unroll
                    for (int n = 0; n < 2; ++n) acc[a][b][m][n] = (f32x4){0.f, 0.f, 0.f, 0.f};
        cur = nxt; cA = nA; cB = nB; ++ui;
        if (wr == 1) PG8_BAR;
    }
    PG8_WAIT_V(0);
    PG8_BAR;
#undef PG8_SA
#undef PG8_SB
#undef PG8_STAGE
#undef PG8_LDA
#undef PG8_LDB
#undef PG8_MMA
#undef PG8_WAIT_V
#undef PG8_WAIT_L
#undef PG8_BAR
#undef PG8_SCHED
}

struct EpiU {
    static constexpr bool PERM = true;
    bf16_t* O; int ldc;
    __device__ __forceinline__ void operator()(const f32x4 (&acc)[2][2][4][2], const Unit& u, int wr, int wc, int fr, int fq) const {
        const int row0 = u.pm * BM + wr * 64 + fr, col0 = u.pn * BM + wc * 32 + 8 * fq;
#pragma unroll
        for (int ai = 0; ai < 2; ++ai)
#pragma unroll
            for (int m = 0; m < 4; ++m) { bf16_t* rowp = O + (size_t)(row0 + ai * HALF + m * 16) * ldc + col0;
#pragma unroll
                for (int bj = 0; bj < 2; ++bj) { const f32x4 v0 = acc[ai][bj][m][0], v1 = acc[ai][bj][m][1];
                    u32x4 w; w.x = pk2(v0[0], v0[1]); w.y = pk2(v0[2], v0[3]); w.z = pk2(v1[0], v1[1]); w.w = pk2(v1[2], v1[3]);
                    *(u32x4*)(rowp + bj * HALF) = w; } }
    }
};
struct EpiRes {
    static constexpr bool PERM = false;
    const float* base; float* out; int ldc;
    __device__ __forceinline__ void operator()(const f32x4 (&acc)[2][2][4][2], const Unit& u, int wr, int wc, int fr, int fq) const {
        const int col0 = u.pn * BM + wc * 32 + 4 * fq;
#pragma unroll
        for (int ai = 0; ai < 2; ++ai)
#pragma unroll
            for (int m = 0; m < 4; ++m) { const size_t off = (size_t)(u.pm * BM + ai * HALF + wr * 64 + m * 16 + fr) * ldc + col0;
#pragma unroll
                for (int bj = 0; bj < 2; ++bj)
#pragma unroll
                    for (int n = 0; n < 2; ++n) { const f32x4 bs = *(const f32x4*)(base + off + bj * HALF + n * 16); *(f32x4*)(out + off + bj * HALF + n * 16) = bs + acc[ai][bj][m][n]; } }
    }
};
struct EpiSwiglu {
    static constexpr bool PERM = true;
    bf16_t* H; const float* bg; const float* bu;
    __device__ __forceinline__ void operator()(const f32x4 (&acc)[2][2][4][2], const Unit& u, int wr, int wc, int fr, int fq) const {
        const int e = u.pn >> 3, pnl = u.pn & 7, hc0 = pnl * 128 + wc * 32 + 8 * fq, row0 = u.pm * BM + wr * 64 + fr;
        float gb[8], ub[8];
#pragma unroll
        for (int i = 0; i < 8; ++i) { gb[i] = bg[e * 1024 + hc0 + i]; ub[i] = bu[e * 1024 + hc0 + i]; }
#pragma unroll
        for (int ai = 0; ai < 2; ++ai)
#pragma unroll
            for (int m = 0; m < 4; ++m) {
                float o[8];
#pragma unroll
                for (int n = 0; n < 2; ++n)
#pragma unroll
                    for (int i = 0; i < 4; ++i) {
                        const float gg = fminf(acc[ai][0][m][n][i] + gb[4 * n + i], 7.0f);
                        const float uu = fminf(fmaxf(acc[ai][1][m][n][i] + ub[4 * n + i], -7.0f), 7.0f);
                        o[4 * n + i] = (uu + 1.0f) * gg * sigm(gg * 1.702f); }
                u32x4 w; w.x = pk2(o[0], o[1]); w.y = pk2(o[2], o[3]); w.z = pk2(o[4], o[5]); w.w = pk2(o[6], o[7]);
                *(u32x4*)(H + (size_t)(row0 + ai * HALF + m * 16) * 1024 + hc0) = w; }
    }
};
struct EpiDown {
    static constexpr bool PERM = true;
    bf16_t* Y; const float* bd; const float* rowg;
    __device__ __forceinline__ void operator()(const f32x4 (&acc)[2][2][4][2], const Unit& u, int wr, int wc, int fr, int fq) const {
        const int e = u.pn >> 2, pnl = u.pn & 3, col0 = pnl * BM + wc * 32 + 8 * fq, row0 = u.pm * BM + wr * 64 + fr;
        float bv[2][8];
#pragma unroll
        for (int bj = 0; bj < 2; ++bj)
#pragma unroll
            for (int i = 0; i < 8; ++i) bv[bj][i] = bd[e * 1024 + col0 + bj * HALF + i];
#pragma unroll
        for (int ai = 0; ai < 2; ++ai)
#pragma unroll
            for (int m = 0; m < 4; ++m) { const int row = row0 + ai * HALF + m * 16; const float sc = rowg[row];
#pragma unroll
                for (int bj = 0; bj < 2; ++bj) { const f32x4 v0 = acc[ai][bj][m][0], v1 = acc[ai][bj][m][1];
                    u32x4 w; w.x = pk2((v0[0] + bv[bj][0]) * sc, (v0[1] + bv[bj][1]) * sc); w.y = pk2((v0[2] + bv[bj][2]) * sc, (v0[3] + bv[bj][3]) * sc);
                    w.z = pk2((v1[0] + bv[bj][4]) * sc, (v1[1] + bv[bj][5]) * sc); w.w = pk2((v1[2] + bv[bj][6]) * sc, (v1[3] + bv[bj][7]) * sc);
                    *(u32x4*)(Y + (size_t)row * 1024 + col0 + bj * HALF) = w; } }
    }
};
}

struct Args { const float* in[32]; float* out; unsigned char* ws; int ph_lo, ph_hi; };
enum { I_X = 0, I_ANG, I_WIN, I_QG, I_KCG, I_KSG, I_KWG, I_CKPOS, I_CKW1, I_CKB1, I_CKW2, I_CKB2, I_CVPOS, I_CVW1, I_CVB1, I_CVW2, I_CVB2,
       I_NSAOG, I_CONVW, I_ALOG, I_DTB, I_GDNOG, I_WOUT, I_FFNG, I_RW, I_RB, I_EWG, I_EBG, I_EWU, I_EBU, I_EWD, I_EBD };

DI void p0_transpose_item(const float* W, int K, int N, bf16_t* WT, long row_off, float* scr, int item, int lane) {
    const int nblk = N / 32, kb = item / nblk, nb = item % nblk, k0 = 64 * kb, n0 = 32 * nb;
#pragma unroll 8
    for (int i = 0; i < 32; ++i) { const int kk = 2 * i + (lane >> 5); scr[kk * 33 + (lane & 31)] = W[(size_t)(k0 + kk) * N + n0 + (lane & 31)]; }
    __builtin_amdgcn_s_waitcnt(0xC07F); asm volatile("" ::: "memory");
    const int c = lane & 7;
#pragma unroll
    for (int j = 0; j < 4; ++j) { const int n = (lane >> 3) + 8 * j; const float* s = scr + (8 * c) * 33 + n;
        u32x4 o; o.x = pk2(s[0 * 33], s[1 * 33]); o.y = pk2(s[2 * 33], s[3 * 33]); o.z = pk2(s[4 * 33], s[5 * 33]); o.w = pk2(s[6 * 33], s[7 * 33]);
        *(u32x4*)(WT + (size_t)(row_off + n0 + n) * K + k0 + 8 * c) = o; }
    __builtin_amdgcn_s_waitcnt(0xC07F); asm volatile("" ::: "memory");
}

DI void phase0(const Args& A, unsigned char* lds, bool first) {
    const int tid = threadIdx.x, lane = tid & 63, wave = tid >> 6, G = gridDim.x;
    const int gw = blockIdx.x * 8 + wave, NGW = G * 8;
    float* scr = (float*)(lds + wave * 16384);
    unsigned char* ws = A.ws;
    constexpr int I_IN = 16 * 105, I_OUT = 16 * 32, I_C1 = 32 * 8, I_C2 = 4 * 2, I_EX = 16 * 32;
    constexpr int NIT = I_IN + I_OUT + 2 * I_C1 + 2 * I_C2 + 96 * I_EX;
    for (int it = gw; it < NIT; it += NGW) {
        int r = it;
        if (r < I_IN) { p0_transpose_item(A.in[I_WIN], 1024, INW, (bf16_t*)(ws + WS_WTIN), 0, scr, r, lane); continue; } r -= I_IN;
        if (r < I_OUT) { p0_transpose_item(A.in[I_WOUT], 1024, 1024, (bf16_t*)(ws + WS_WTOUT), 0, scr, r, lane); continue; } r -= I_OUT;
        if (r < I_C1) { p0_transpose_item(A.in[I_CKW1], 2048, 256, (bf16_t*)(ws + WS_WTC1K), 0, scr, r, lane); continue; } r -= I_C1;
        if (r < I_C1) { p0_transpose_item(A.in[I_CVW1], 2048, 256, (bf16_t*)(ws + WS_WTC1V), 0, scr, r, lane); continue; } r -= I_C1;
        if (r < I_C2) { p0_transpose_item(A.in[I_CKW2], 256, 64, (bf16_t*)(ws + WS_WTC2K), 0, scr, r, lane); continue; } r -= I_C2;
        if (r < I_C2) { p0_transpose_item(A.in[I_CVW2], 256, 64, (bf16_t*)(ws + WS_WTC2V), 0, scr, r, lane); continue; } r -= I_C2;
        const int mat = r / I_EX, item = r % I_EX, e = mat / 3, which = mat % 3;
        if (which == 2) { p0_transpose_item(A.in[I_EWD] + (size_t)e * 1048576, 1024, 1024, (bf16_t*)(ws + WS_EXPD), (long)e * 1024, scr, item, lane); }
        else { const int nb = item % 32, n0 = 32 * nb; const long dest0 = (long)e * 2048 + (n0 >> 7) * 256 + (n0 & 127) + (which ? 128 : 0);
            p0_transpose_item(A.in[which ? I_EWU : I_EWG] + (size_t)e * 1048576, 1024, 1024, (bf16_t*)(ws + WS_EXPGU), dest0 - n0, scr, item, lane); }
    }
    { const float* gain = A.in[I_ANG]; f32x4 gv[4];
#pragma unroll
      for (int j = 0; j < 4; ++j) gv[j] = *(const f32x4*)(gain + 4 * lane + 256 * j);
      for (int m = gw; m < NTOK; m += NGW) { const f32x4* xr = (const f32x4*)(A.in[I_X] + (size_t)m * D) + lane; f32x4 v[4]; float s = 0.f;
#pragma unroll
        for (int j = 0; j < 4; ++j) { v[j] = xr[64 * j]; s += v[j].x * v[j].x + v[j].y * v[j].y + v[j].z * v[j].z + v[j].w * v[j].w; }
        const float rs = rsqrtf(wave_sum(s) * (1.f / D) + EPS);
        u32x2* o = (u32x2*)((bf16_t*)(ws + WS_XN) + (size_t)m * D) + lane;
#pragma unroll
        for (int j = 0; j < 4; ++j) { u32x2 w; w.x = pk2(v[j].x * rs * gv[j].x, v[j].y * rs * gv[j].y); w.y = pk2(v[j].z * rs * gv[j].z, v[j].w * rs * gv[j].w); o[64 * j] = w; } } }
    { u32x4* p = (u32x4*)((bf16_t*)(ws + WS_WTIN) + (size_t)INW * 1024); const int n16 = (INWP - INW) * 1024 * 2 / 16;
      for (int i = blockIdx.x * 512 + tid; i < n16; i += G * 512) p[i] = (u32x4){0u, 0u, 0u, 0u}; }
    if (first && blockIdx.x < 32 && tid < 256) { const int kv = blockIdx.x >> 4, seg = blockIdx.x & 15, j = tid;
        const float* pos = A.in[kv ? I_CVPOS : I_CKPOS]; const float* w1 = A.in[kv ? I_CVW1 : I_CKW1]; float s = 0.f;
        for (int k = seg * 128; k < seg * 128 + 128; ++k) s += pos[k] * w1[(size_t)k * 256 + j];
        ((float*)(ws + WS_CTL))[CW_PB1 + seg * 512 + kv * 256 + j] = s; }
}

DI void nsa_prep_task(const Args& A, int task, unsigned char* lds) {
    const int tid = threadIdx.x, lane = tid & 63, wave = tid >> 6;
    const int b = task >> 7, n = task & 127;
    unsigned char* ws = A.ws; const bf16_t* U = (const bf16_t*)(ws + WS_U);
    bf16_t* vsL = (bf16_t*)lds;
    for (int ti = 0; ti < 8; ++ti) {
        const int tl = wave * 8 + ti, t = n * 64 + tl; const size_t tok = (size_t)b * T + t; const bf16_t* ur = U + tok * INWP;
        { const u32x4 w = *(const u32x4*)(ur + C_Q + 8 * lane); float f[8] = {bflo(w.x), bfhi(w.x), bflo(w.y), bfhi(w.y), bflo(w.z), bfhi(w.z), bflo(w.w), bfhi(w.w)};
          float s = 0.f;
#pragma unroll
          for (int i = 0; i < 8; ++i) s += f[i] * f[i];
          s += __shfl_xor(s, 1); s += __shfl_xor(s, 2); s += __shfl_xor(s, 4);
          const float rs = rsqrtf(s * (1.f / 64.f) + EPS) * (0.125f * LOG2E); const float* gq = A.in[I_QG] + (8 * lane & 63);
          u32x4 o; o.x = pk2(f[0] * rs * gq[0], f[1] * rs * gq[1]); o.y = pk2(f[2] * rs * gq[2], f[3] * rs * gq[3]); o.z = pk2(f[4] * rs * gq[4], f[5] * rs * gq[5]); o.w = pk2(f[6] * rs * gq[6], f[7] * rs * gq[7]);
          *(u32x4*)((bf16_t*)(ws + WS_QN) + tok * 512 + 8 * lane) = o; }
        if (lane < 32) { const int sel = lane >> 4, l16 = lane & 15, g = l16 >> 3, d0 = (l16 & 7) * 8;
          const u32x4 w = *(const u32x4*)(ur + (sel ? C_KW : C_KS) + 8 * l16); float f[8] = {bflo(w.x), bfhi(w.x), bflo(w.y), bfhi(w.y), bflo(w.z), bfhi(w.z), bflo(w.w), bfhi(w.w)};
          float s = 0.f;
#pragma unroll
          for (int i = 0; i < 8; ++i) s += f[i] * f[i];
          s += __shfl_xor(s, 1); s += __shfl_xor(s, 2); s += __shfl_xor(s, 4);
          const float rs = rsqrtf(s * (1.f / 64.f) + EPS); const float* gk = A.in[sel ? I_KWG : I_KSG] + d0;
          u32x4 o; o.x = pk2(f[0] * rs * gk[0], f[1] * rs * gk[1]); o.y = pk2(f[2] * rs * gk[2], f[3] * rs * gk[3]); o.z = pk2(f[4] * rs * gk[4], f[5] * rs * gk[5]); o.w = pk2(f[6] * rs * gk[6], f[7] * rs * gk[7]);
          *(u32x4*)((bf16_t*)(ws + (sel ? WS_KWN : WS_KSN)) + ((size_t)(b * 2 + g) * T + t) * 64 + d0) = o; }
        else { const int l32 = lane - 32, sel = l32 >> 4, l16 = l32 & 15, g = l16 >> 3, d0 = (l16 & 7) * 8;
          const u32x4 w = *(const u32x4*)(ur + (sel ? C_VW : C_VS) + 8 * l16);
          const int pos = (tl & ~15) + perm16inv(tl & 15); bf16_t* dst = vsL + ((sel * 2 + g) * 64 + d0) * 64 + pos;
          dst[0 * 64] = (bf16_t)(w.x & 0xffff); dst[1 * 64] = (bf16_t)(w.x >> 16); dst[2 * 64] = (bf16_t)(w.y & 0xffff); dst[3 * 64] = (bf16_t)(w.y >> 16);
          dst[4 * 64] = (bf16_t)(w.z & 0xffff); dst[5 * 64] = (bf16_t)(w.z >> 16); dst[6 * 64] = (bf16_t)(w.w & 0xffff); dst[7 * 64] = (bf16_t)(w.w >> 16); }
        if (lane < 24) ((float*)(ws + WS_GATES))[tok * 24 + lane] = sigm(bf2f(ur[C_GATE + lane]));
    }
    __syncthreads();
    for (int c = tid; c < 2048; c += 512) { const int sel = c >> 10, g = (c >> 9) & 1, rem = c & 511;
        const u32x4 v = *(const u32x4*)(vsL + ((sel * 2 + g) * 64) * 64 + rem * 8);
        *(u32x4*)((bf16_t*)(ws + (sel ? WS_VWT : WS_VST)) + ((size_t)(b * 2 + g) * 128 + n) * 4096 + rem * 8) = v; }
    __syncthreads();
}

DI void compress_task(const Args& A, int task, unsigned char* lds) {
    const int tid = threadIdx.x, lane = tid & 63, wave = __builtin_amdgcn_readfirstlane(tid >> 6), r32 = lane & 31, hh = lane >> 5;
    const int kv = task >> 6, b = (task >> 5) & 1, g = (task >> 4) & 1, ct = task & 15, c0 = 32 * ct;
    unsigned char* ws = A.ws; const bf16_t* U = (const bf16_t*)(ws + WS_U);
    bf16_t* hidL = (bf16_t*)lds;
    float* outL = (float*)(lds + 16896);
    const int colbase = (kv ? C_VC : C_KC) + g * 64;
    const bf16_t* W1T = (const bf16_t*)(ws + (kv ? WS_WTC1V : WS_WTC1K));
    const bf16_t* W2T = (const bf16_t*)(ws + (kv ? WS_WTC2V : WS_WTC2K));
    {   int c = c0 + r32; if (c > 510) c = 510;
        const bf16_t* arow = U + ((size_t)b * T + 16 * c) * INWP + colbase + 8 * hh;
        const bf16_t* brow = W1T + (size_t)(32 * wave + r32) * 2048 + 8 * hh;
        f32x16 acc; for (int i = 0; i < 16; ++i) acc[i] = 0.f;
#pragma unroll 4
        for (int l = 0; l < 32; ++l) {
#pragma unroll
            for (int s = 0; s < 4; ++s) { const bf16x8 af = *(const bf16x8*)(arow + (size_t)l * INWP + 16 * s); const bf16x8 bf = *(const bf16x8*)(brow + l * 64 + 16 * s); acc = MFMA32(af, bf, acc); } }
        const int j = 32 * wave + r32; float pb = A.in[kv ? I_CVB1 : I_CKB1][j];
#pragma unroll
        for (int sg = 0; sg < 16; ++sg) pb += ((const float*)(ws + WS_CTL))[CW_PB1 + sg * 512 + kv * 256 + j];
#pragma unroll
        for (int r = 0; r < 16; ++r) { const float x = acc[r] + pb; const float y = x * sigm(1.5957691216057308f * (x + 0.044715f * x * x * x)); hidL[crow(r, hh) * 264 + j] = f2bf(y); }
    }
    __syncthreads();
    if (wave < 2) { f32x16 acc; for (int i = 0; i < 16; ++i) acc[i] = 0.f;
#pragma unroll
        for (int s = 0; s < 16; ++s) { const bf16x8 af = *(const bf16x8*)(hidL + r32 * 264 + 16 * s + 8 * hh); const bf16x8 bf = *(const bf16x8*)(W2T + (size_t)(32 * wave + r32) * 256 + 16 * s + 8 * hh); acc = MFMA32(af, bf, acc); }
        const int d = 32 * wave + r32; const float b2 = A.in[kv ? I_CVB2 : I_CKB2][d];
#pragma unroll
        for (int r = 0; r < 16; ++r) outL[crow(r, hh) * 65 + d] = acc[r] + b2; }
    __syncthreads();
    if (kv == 0) { if (tid < 256) { const int cl = tid >> 3, sub = tid & 7; float f[8]; float s = 0.f;
#pragma unroll
            for (int i = 0; i < 8; ++i) { f[i] = outL[cl * 65 + 8 * sub + i]; s += f[i] * f[i]; }
            s += __shfl_xor(s, 1); s += __shfl_xor(s, 2); s += __shfl_xor(s, 4);
            const float rs = (c0 + cl > 510) ? 0.f : rsqrtf(s * (1.f / 64.f) + EPS); const float* gk = A.in[I_KCG] + 8 * sub;
            u32x4 o; o.x = pk2(f[0] * rs * gk[0], f[1] * rs * gk[1]); o.y = pk2(f[2] * rs * gk[2], f[3] * rs * gk[3]); o.z = pk2(f[4] * rs * gk[4], f[5] * rs * gk[5]); o.w = pk2(f[6] * rs * gk[6], f[7] * rs * gk[7]);
            *(u32x4*)((bf16_t*)(ws + WS_KC) + ((size_t)(b * 2 + g) * 512 + c0 + cl) * 64 + 8 * sub) = o; } }
    else { const int d = tid >> 3, part = tid & 7, p0 = 4 * part, gi = p0 >> 4, cl0 = 16 * gi + perm16(p0 & 15); float f[4];
#pragma unroll
        for (int i = 0; i < 4; ++i) f[i] = (c0 + cl0 + i > 510) ? 0.f : outL[(cl0 + i) * 65 + d];
        u32x2 o; o.x = pk2(f[0], f[1]); o.y = pk2(f[2], f[3]);
        *(u32x2*)((bf16_t*)(ws + WS_VCT) + ((size_t)(b * 2 + g) * 64 + d) * 512 + c0 + p0) = o; }
    __syncthreads();
}

DI void gdn_chunk_task(const Args& A, int task, unsigned char* lds) {
    const int tid = threadIdx.x, lane = tid & 63, wave = __builtin_amdgcn_readfirstlane(tid >> 6), r32 = lane & 31, hh = lane >> 5;
    const int b = task >> 9, h = (task >> 7) & 3, ch = task & 127, t0 = ch * 64; const size_t tok0 = (size_t)b * T + t0;
    unsigned char* ws = A.ws; const bf16_t* U = (const bf16_t*)(ws + WS_U);
    float* qL = (float*)lds; float* kL = qL + 64 * 132; float* vL = kL + 64 * 132; float* Lm = vL + 64 * 132; float* Qm = Lm + 64 * 68;
    float* gcL = Qm + 64 * 68; float* betaL = gcL + 64; float* egL = betaL + 64; float* kdsL = egL + 64;
    { const int c = tid & 127, part = tid >> 7;
#pragma unroll
      for (int s = 0; s < 3; ++s) { const int col = (s == 0 ? C_GQ : s == 1 ? C_GK : C_GV) + h * 128 + c; const float* cw = A.in[I_CONVW] + s * 512 + h * 128 + c;
        const float w0 = cw[0], w1 = cw[1536], w2 = cw[3072], w3 = cw[4608]; float* dst = (s == 0 ? qL : s == 1 ? kL : vL);
        const int tl0 = 16 * part; float x3, x2, x1;
        { const int tg = t0 + tl0; x3 = (tg - 3 >= 0) ? bf2f(U[(tok0 + tl0 - 3) * INWP + col]) : 0.f; x2 = (tg - 2 >= 0) ? bf2f(U[(tok0 + tl0 - 2) * INWP + col]) : 0.f; x1 = (tg - 1 >= 0) ? bf2f(U[(tok0 + tl0 - 1) * INWP + col]) : 0.f; }
#pragma unroll 4
        for (int i = 0; i < 16; ++i) { const float xt = bf2f(U[(tok0 + tl0 + i) * INWP + col]); const float y = w0 * x3 + w1 * x2 + w2 * x1 + w3 * xt;
            dst[(tl0 + i) * 132 + c] = y * sigm(y); x3 = x2; x2 = x1; x1 = xt; } } }
    if (tid < 64) { const int tl = tid; const float a = bf2f(U[(tok0 + tl) * INWP + C_GA + h]), bb = bf2f(U[(tok0 + tl) * INWP + C_GB + h]);
        const float x = a + A.in[I_DTB][h]; const float sp = (x > 20.f) ? x : log1pf(__expf(x)); float gt = -__expf(A.in[I_ALOG][h]) * sp;
#pragma unroll
        for (int o = 1; o < 64; o <<= 1) { const float v = __shfl_up(gt, o); if (lane >= o) gt += v; }
        const float g63 = __shfl(gt, 63);
        gcL[tl] = gt; betaL[tl] = sigm(bb); egL[tl] = __expf(gt); kdsL[tl] = __expf(g63 - gt);
        if (tl == 63) ((float*)(ws + WS_GL))[task] = __expf(gt); }
    __syncthreads();
    { const int tl = tid >> 3, sub = tid & 7; float sq = 0.f, sk = 0.f;
#pragma unroll
      for (int i = 0; i < 16; ++i) { const float a = qL[tl * 132 + sub * 16 + i], c = kL[tl * 132 + sub * 16 + i]; sq += a * a; sk += c * c; }
      sq += __shfl_xor(sq, 1); sq += __shfl_xor(sq, 2); sq += __shfl_xor(sq, 4); sk += __shfl_xor(sk, 1); sk += __shfl_xor(sk, 2); sk += __shfl_xor(sk, 4);
      const float rq = rsqrtf(sq + EPS) * 0.08838834764831845f, rk = rsqrtf(sk + EPS);
#pragma unroll
      for (int i = 0; i < 16; ++i) { qL[tl * 132 + sub * 16 + i] *= rq; kL[tl * 132 + sub * 16 + i] *= rk; } }
    __syncthreads();
    { const int mat = wave >> 2, mi = (wave >> 1) & 1, ni = wave & 1; const float* X = mat ? qL : kL;
      f32x16 acc; for (int i = 0; i < 16; ++i) acc[i] = 0.f;
#pragma unroll
      for (int s = 0; s < 8; ++s) { const f32x4 a0 = *(const f32x4*)(X + (32 * mi + r32) * 132 + 16 * s + 8 * hh), a1 = *(const f32x4*)(X + (32 * mi + r32) * 132 + 16 * s + 8 * hh + 4);
          const f32x4 b0 = *(const f32x4*)(kL + (32 * ni + r32) * 132 + 16 * s + 8 * hh), b1 = *(const f32x4*)(kL + (32 * ni + r32) * 132 + 16 * s + 8 * hh + 4);
          acc = MFMA32(pack8(a0[0], a0[1], a0[2], a0[3], a1[0], a1[1], a1[2], a1[3]), pack8(b0[0], b0[1], b0[2], b0[3], b1[0], b1[1], b1[2], b1[3]), acc); }
      const int sc = 32 * ni + r32; const float gs = gcL[sc];
#pragma unroll
      for (int r = 0; r < 16; ++r) { const int c = 32 * mi + crow(r, hh); const float dec = __expf(gcL[c] - gs);
          if (mat == 0) Lm[c * 68 + sc] = (c > sc) ? betaL[c] * acc[r] * dec : 0.f; else Qm[c * 68 + sc] = (c >= sc) ? acc[r] * dec : 0.f; } }
    __syncthreads();
    {   bf16_t* QGp = (bf16_t*)(ws + WS_QGP) + (size_t)task * 8192; bf16_t* KDTp = (bf16_t*)(ws + WS_KDTP) + (size_t)task * 8192; bf16_t* QKp = (bf16_t*)(ws + WS_QKP) + (size_t)task * 4096;
        for (int id = tid; id < 1024; id += 512) { const int c = id >> 4, chn = id & 15, ks = chn >> 2, q = chn & 3; const float e = egL[c];
            const f32x4 a = *(const f32x4*)(qL + c * 132 + 32 * ks + 4 * q), bq = *(const f32x4*)(qL + c * 132 + 32 * ks + 16 + 4 * q);
            *(bf16x8*)(QGp + id * 8) = pack8(a[0] * e, a[1] * e, a[2] * e, a[3] * e, bq[0] * e, bq[1] * e, bq[2] * e, bq[3] * e); }
        for (int id = tid; id < 1024; id += 512) { const int d = id >> 3, chn = id & 7, ks = chn >> 2, q = chn & 3; float f[8];
#pragma unroll
            for (int j = 0; j < 8; ++j) { const int s = 32 * ks + 16 * (j >> 2) + 4 * q + (j & 3); f[j] = kL[s * 132 + d] * kdsL[s]; }
            *(bf16x8*)(KDTp + id * 8) = pack8(f[0], f[1], f[2], f[3], f[4], f[5], f[6], f[7]); }
        { const int id = tid; const int c = id >> 3, chn = id & 7, ks = chn >> 2, q = chn & 3;
            const f32x4 a = *(const f32x4*)(Qm + c * 68 + 32 * ks + 4 * q), bq = *(const f32x4*)(Qm + c * 68 + 32 * ks + 16 + 4 * q);
            *(bf16x8*)(QKp + id * 8) = pack8(a[0], a[1], a[2], a[3], bq[0], bq[1], bq[2], bq[3]); } }
    __syncthreads();
    if (tid < 256) { const bool isW = tid >= 128; float* col = (isW ? kL : vL) + (tid & 127);
#pragma unroll 1
        for (int bi = 0; bi < 4; ++bi) {
            float r[16];
#pragma unroll
            for (int ii = 0; ii < 16; ++ii) { const int i = 16 * bi + ii; float v = col[i * 132] * betaL[i]; if (isW) v *= egL[i]; r[ii] = v; }
#pragma unroll 1
            for (int j = 0; j < 16 * bi; j += 4) {
                const float x0 = col[j * 132], x1 = col[(j + 1) * 132], x2 = col[(j + 2) * 132], x3 = col[(j + 3) * 132];
#pragma unroll
                for (int ii = 0; ii < 16; ++ii) { const f32x4 l4 = *(const f32x4*)(Lm + (16 * bi + ii) * 68 + j); r[ii] -= (l4[0] * x0 + l4[1] * x1) + (l4[2] * x2 + l4[3] * x3); } }
#pragma unroll
            for (int ii = 1; ii < 16; ++ii) {
#pragma unroll
                for (int j4 = 0; j4 < (ii + 3) / 4; ++j4) { const f32x4 l4 = *(const f32x4*)(Lm + (16 * bi + ii) * 68 + 16 * bi + 4 * j4);
#pragma unroll
                    for (int jj = 0; jj < 4; ++jj) if (4 * j4 + jj < ii) r[ii] -= l4[jj] * r[4 * j4 + jj]; } }
#pragma unroll
            for (int ii = 0; ii < 16; ++ii) col[(16 * bi + ii) * 132] = r[ii];
        } }
    __syncthreads();
    { bf16_t* Wp = (bf16_t*)(ws + WS_WP) + (size_t)task * 8192; bf16_t* Up = (bf16_t*)(ws + WS_UP) + (size_t)task * 8192;
      for (int id = tid; id < 1024; id += 512) { const int c = id >> 4, chn = id & 15, ks = chn >> 2, q = chn & 3;
          const f32x4 a = *(const f32x4*)(kL + c * 132 + 32 * ks + 4 * q), bq = *(const f32x4*)(kL + c * 132 + 32 * ks + 16 + 4 * q);
          *(bf16x8*)(Wp + id * 8) = pack8(a[0], a[1], a[2], a[3], bq[0], bq[1], bq[2], bq[3]); }
      for (int id = tid; id < 2048; id += 512) { const int ln = id & 63, mt = (id >> 6) & 3, es = id >> 8, q = ln >> 4, e = ln & 15; const int c = 16 * mt + 4 * q, col = 16 * es + e;
          u32x2 o; o.x = pk2(vL[c * 132 + col], vL[(c + 1) * 132 + col]); o.y = pk2(vL[(c + 2) * 132 + col], vL[(c + 3) * 132 + col]);
          *(u32x2*)(Up + id * 4) = o; } }
    __syncthreads();
}

constexpr int SC_W = 0, SC_QG = 17408, SC_KD = 34816, SC_QK = 53248, SC_UP = 62464, SC_BUF = 64512;
DI void gdn_scan_block(const Args& A, int sidx, unsigned char* lds) {
    const int tid = threadIdx.x, lane = tid & 63, wave = __builtin_amdgcn_readfirstlane(tid >> 6);
    const int es = sidx & 7, bh = sidx >> 3, b = bh >> 2, h = bh & 3, r16 = lane & 15, q = lane >> 4;
    unsigned char* ws = A.ws;
    const bf16_t* WP = (const bf16_t*)(ws + WS_WP) + (size_t)bh * 128 * 8192; const bf16_t* QGP = (const bf16_t*)(ws + WS_QGP) + (size_t)bh * 128 * 8192;
    const bf16_t* KDTP = (const bf16_t*)(ws + WS_KDTP) + (size_t)bh * 128 * 8192; const bf16_t* QKP = (const bf16_t*)(ws + WS_QKP) + (size_t)bh * 128 * 4096;
    const bf16_t* UP = (const bf16_t*)(ws + WS_UP) + (size_t)bh * 128 * 8192 + es * 1024;
    if (wave != 0) {
        const int lt = tid - 64; u32x4 R[9]; const u32x4 z4 = (u32x4){0u, 0u, 0u, 0u};
        const bf16_t* sp[9]; int dof[9], stp[9];
#pragma unroll
        for (int j = 0; j < 9; ++j) { const int c = lt + 448 * j;
            if (c < 1024) { sp[j] = WP + c * 8; dof[j] = SC_W + (c >> 4) * 272 + (c & 15) * 16; stp[j] = 8192; }
            else if (c < 2048) { const int cc = c - 1024; sp[j] = QGP + cc * 8; dof[j] = SC_QG + (cc >> 4) * 272 + (cc & 15) * 16; stp[j] = 8192; }
            else if (c < 3072) { const int cc = c - 2048; sp[j] = KDTP + cc * 8; dof[j] = SC_KD + (cc >> 3) * 144 + (cc & 7) * 16; stp[j] = 8192; }
            else if (c < 3584) { const int cc = c - 3072; sp[j] = QKP + cc * 8; dof[j] = SC_QK + (cc >> 3) * 144 + (cc & 7) * 16; stp[j] = 4096; }
            else if (c < 3712) { const int cc = c - 3584; sp[j] = UP + cc * 8; dof[j] = SC_UP + cc * 16; stp[j] = 8192; }
            else { sp[j] = nullptr; dof[j] = 0; stp[j] = 0; } }
#define SC_LOAD(i_) do { _Pragma("unroll") for (int j = 0; j < 9; ++j) R[j] = sp[j] ? *(const u32x4*)(sp[j] + (size_t)(i_) * stp[j]) : z4; } while (0)
#define SC_WRITE(bufi_) do { _Pragma("unroll") for (int j = 0; j < 9; ++j) if (sp[j]) *(u32x4*)(lds + (bufi_) * SC_BUF + dof[j]) = R[j]; } while (0)
        SC_LOAD(0); SC_WRITE(0); SC_LOAD(1);
        __syncthreads();
        for (int i = 0; i < 128; ++i) {
            if (i + 1 < 128) SC_WRITE((i + 1) & 1);
            if (i + 2 < 128) SC_LOAD(i + 2);
            __syncthreads(); }
#undef SC_LOAD
#undef SC_WRITE
        return;
    }
    const float* GL = (const float*)(ws + WS_GL) + bh * 128;
    bf16_t* OG = (bf16_t*)(ws + WS_OG);
    f32x4 S[8];
#pragma unroll
    for (int m = 0; m < 8; ++m) S[m] = (f32x4){0.f, 0.f, 0.f, 0.f};
    __syncthreads();
    float gl = GL[0];
    for (int i = 0; i < 128; ++i) {
        const unsigned char* bufp = lds + (i & 1) * SC_BUF;
        const unsigned char* wp = bufp + SC_W + r16 * 272 + 16 * q; const unsigned char* qgp = bufp + SC_QG + r16 * 272 + 16 * q;
        const unsigned char* kdp = bufp + SC_KD + r16 * 144 + 16 * q; const unsigned char* qkp = bufp + SC_QK + r16 * 144 + 16 * q;
        const unsigned char* up = bufp + SC_UP + lane * 8;
        const float gln = GL[(i + 1) & 127];
        bf16x8 Sb[4];
#pragma unroll
        for (int ks = 0; ks < 4; ++ks) Sb[ks] = pack8(S[2 * ks][0], S[2 * ks][1], S[2 * ks][2], S[2 * ks][3], S[2 * ks + 1][0], S[2 * ks + 1][1], S[2 * ks + 1][2], S[2 * ks + 1][3]);
        f32x4 vn[4];
#pragma unroll
        for (int mt = 0; mt < 4; ++mt) { f32x4 acc = (f32x4){0.f, 0.f, 0.f, 0.f};
#pragma unroll
            for (int ks = 0; ks < 4; ++ks) acc = MFMA16(*(const bf16x8*)(wp + mt * 16 * 272 + ks * 64), Sb[ks], acc);
            const u32x2 uw = *(const u32x2*)(up + mt * 512);
            vn[mt] = (f32x4){bflo(uw.x) - acc[0], bfhi(uw.x) - acc[1], bflo(uw.y) - acc[2], bfhi(uw.y) - acc[3]}; }
        bf16x8 Vb[2];
#pragma unroll
        for (int k2 = 0; k2 < 2; ++k2) Vb[k2] = pack8(vn[2 * k2][0], vn[2 * k2][1], vn[2 * k2][2], vn[2 * k2][3], vn[2 * k2 + 1][0], vn[2 * k2 + 1][1], vn[2 * k2 + 1][2], vn[2 * k2 + 1][3]);
        f32x4 Sn[8];
#pragma unroll
        for (int m = 0; m < 8; ++m) { f32x4 acc = S[m] * gl;
#pragma unroll
            for (int k2 = 0; k2 < 2; ++k2) acc = MFMA16(*(const bf16x8*)(kdp + m * 16 * 144 + k2 * 64), Vb[k2], acc);
            Sn[m] = acc; }
#pragma unroll
        for (int mt = 0; mt < 4; ++mt) { f32x4 acc = (f32x4){0.f, 0.f, 0.f, 0.f};
#pragma unroll
            for (int ks = 0; ks < 4; ++ks) acc = MFMA16(*(const bf16x8*)(qgp + mt * 16 * 272 + ks * 64), Sb[ks], acc);
#pragma unroll
            for (int k2 = 0; k2 < 2; ++k2) acc = MFMA16(*(const bf16x8*)(qkp + mt * 16 * 144 + k2 * 64), Vb[k2], acc);
            bf16_t* op = OG + ((size_t)b * T + i * 64 + 16 * mt + 4 * q) * 512 + h * 128 + es * 16 + r16;
            op[0] = f2bf(acc[0]); op[512] = f2bf(acc[1]); op[1024] = f2bf(acc[2]); op[1536] = f2bf(acc[3]); }
#pragma unroll
        for (int m = 0; m < 8; ++m) S[m] = Sn[m];
        gl = gln;
        __syncthreads();
    }
}

DI void tile_load_k(bf16x8 (&kf)[4], const bf16_t* __restrict__ K, int r32, int hh) {
#pragma unroll
    for (int s = 0; s < 4; ++s) kf[s] = *(const bf16x8*)(K + r32 * 64 + 16 * s + 8 * hh); }
DI void tile_load_v(bf16x8 (&vf)[2][2], const bf16_t* __restrict__ VT, int vp, int r32, int hh) {
#pragma unroll
    for (int dt = 0; dt < 2; ++dt)
#pragma unroll
        for (int ks = 0; ks < 2; ++ks) vf[dt][ks] = *(const bf16x8*)(VT + (size_t)(32 * dt + r32) * vp + 16 * ks + 8 * hh); }
DI f32x16 tile_scores(const bf16x8 (&kf)[4], const bf16x8 (&qf)[4], float negM, int hi2, int lo2, float& l) {
    f32x16 st;
#pragma unroll
    for (int i = 0; i < 16; ++i) st[i] = negM;
#pragma unroll
    for (int s = 0; s < 4; ++s) st = MFMA32(kf[s], qf[s], st);
#pragma unroll
    for (int r = 0; r < 16; ++r) { const int cr = (r & 3) + 8 * (r >> 2); float pv = __builtin_amdgcn_exp2f(st[r]); pv = (cr <= hi2 && cr > lo2) ? pv : 0.f; st[r] = pv; l += pv; }
    return st; }
DI void tile_pv(const f32x16& p, const bf16x8 (&vf)[2][2], f32x16 (&o)[2]) {
    const bf16x8 pb0 = pack8(p[0], p[1], p[2], p[3], p[4], p[5], p[6], p[7]), pb1 = pack8(p[8], p[9], p[10], p[11], p[12], p[13], p[14], p[15]);
#pragma unroll
    for (int dt = 0; dt < 2; ++dt) { o[dt] = MFMA32(vf[dt][0], pb0, o[dt]); o[dt] = MFMA32(vf[dt][1], pb1, o[dt]); } }

DI void block_stream(const bf16_t* __restrict__ KB, const bf16_t* __restrict__ VB, int f0, int f1, const bf16x8 (&qf)[4], f32x16 (&o)[2], float& l, float negM, int hi, int lo, int r32, int hh) {
    if (f0 >= f1) return;
    bf16x8 ka[4], kb[4], va[2][2], vb[2][2];
#define BS_LOAD(kx, vx, f_) do { const int n_ = (f_) >> 1, hf_ = (f_) & 1; tile_load_k(kx, KB + ((size_t)n_ * 64 + 32 * hf_) * 64, r32, hh); tile_load_v(vx, VB + (size_t)n_ * 4096 + 32 * hf_, 64, r32, hh); } while (0)
#define BS_COMP(kx, vx, f_) do { const int k0_ = 32 * (f_) + 4 * hh; const f32x16 p_ = tile_scores(kx, qf, negM, hi - k0_, lo - k0_, l); tile_pv(p_, vx, o); } while (0)
    BS_LOAD(ka, va, f0);
#pragma unroll 1
    for (int f = f0; f < f1; f += 2) {
        const bool h1 = f + 1 < f1;
        if (h1) BS_LOAD(kb, vb, f + 1);
        BS_COMP(ka, va, f);
        if (h1) { if (f + 2 < f1) BS_LOAD(ka, va, f + 2); BS_COMP(kb, vb, f + 1); } }
#undef BS_LOAD
#undef BS_COMP
}

DI float maxabs64(const float* g, int lane) { float v = fabsf(g[lane]);
#pragma unroll
    for (int o = 1; o < 64; o <<= 1) v = fmaxf(v, __shfl_xor(v, o));
    return v; }

#define LOADQF(qf) do { _Pragma("unroll") for (int s_ = 0; s_ < 4; ++s_) qf[s_] = *(const bf16x8*)(QL + row * 72 + 16 * s_ + 8 * hh); } while (0)
DI void nsa_unit(const Args& A, int unit, unsigned char* lds) {
    const int tid = threadIdx.x, lane = tid & 63, wave = __builtin_amdgcn_readfirstlane(tid >> 6), r32 = lane & 31, hh = lane >> 5;
    const int ti = 127 - (unit >> 2), bg = unit & 3, b = bg >> 1, g = bg & 1;
    unsigned char* ws = A.ws;
    bf16_t* QL = (bf16_t*)lds;
    int* OL = (int*)(lds + 36864);
    int* LL = (int*)(lds + 36864 + 67584);
    unsigned* BM = (unsigned*)(lds + 36864 + 67584 + 1024);
    int* CNT = (int*)(lds + 36864 + 67584 + 2048);
    float* SCL = (float*)(lds + 36864 + 67584 + 2048 + 64);
    float* IMP = (float*)(lds + 108544);
    const int slot = r32 >> 2, hd = r32 & 3, tl = wave * 8 + slot, trow = ti * 64 + tl; const size_t tokg = (size_t)b * T + trow;
    const int row = wave * 32 + r32;
    bf16_t* PA = (bf16_t*)IMP + row * 64;
    const float mq = maxabs64(A.in[I_QG], lane) * 8.08f * LOG2E;
    for (int i = tid; i < 256 + 16; i += 512) BM[i] = 0u;
    { const bf16_t* qp = (const bf16_t*)(ws + WS_QN) + tokg * 512 + (g * 4 + hd) * 64 + 8 * hh;
#pragma unroll
      for (int s = 0; s < 4; ++s) *(bf16x8*)(QL + row * 72 + 16 * s + 8 * hh) = *(const bf16x8*)(qp + 16 * s); }
    const float* gp = (const float*)(ws + WS_GATES) + tokg * 24 + (g * 4 + hd) * 3;
    __syncthreads();
    {   const float negMc = -mq * maxabs64(A.in[I_KCG], lane);
        bf16x8 qf[4]; LOADQF(qf);
        const int cmax_row = (trow >= 31) ? ((trow - 31) >> 4) : -1; const int tmaxw = ti * 64 + wave * 8 + 7; const int ntc = (tmaxw >= 31) ? ((((tmaxw - 31) >> 4) >> 5) + 1) : 0;
        const bf16_t* Kc = (const bf16_t*)(ws + WS_KC) + (size_t)(b * 2 + g) * 512 * 64; const bf16_t* VcT = (const bf16_t*)(ws + WS_VCT) + (size_t)(b * 2 + g) * 64 * 512;
        float lc = 0.f;
        if (ntc > 0) { bf16x8 ka[4], kb[4]; tile_load_k(ka, Kc, r32, hh);
#pragma unroll 1
            for (int ct = 0; ct < ntc; ct += 2) { const bool h1 = ct + 1 < ntc;
                if (h1) tile_load_k(kb, Kc + (ct + 1) * 2048, r32, hh);
                tile_scores(ka, qf, negMc, cmax_row - 32 * ct - 4 * hh, -1000000, lc);
                if (h1) { if (ct + 2 < ntc) tile_load_k(ka, Kc + (ct + 2) * 2048, r32, hh); tile_scores(kb, qf, negMc, cmax_row - 32 * (ct + 1) - 4 * hh, -1000000, lc); } } }
        lc += __shfl_xor(lc, 32);
        const float inv = (lc > 0.f) ? 1.f / lc : 0.f;
        f32x16 oc[2]; for (int i = 0; i < 16; ++i) { oc[0][i] = 0.f; oc[1][i] = 0.f; }
        float carry = 0.f, ldummy = 0.f;
#define CM_POST(p, ct_) do { float recv[4], bq[4]; \
            _Pragma("unroll") for (int jq = 0; jq < 4; ++jq) recv[jq] = __shfl_xor(p[4 * jq + 3], 32); \
            _Pragma("unroll") for (int jq = 0; jq < 4; ++jq) { const float pred = hh ? recv[jq] : (jq ? recv[jq - 1] : carry); float s_ = ((p[4 * jq] + p[4 * jq + 1]) + (p[4 * jq + 2] + p[4 * jq + 3]) + pred) * inv; \
                s_ += __shfl_xor(s_, 1); s_ += __shfl_xor(s_, 2); bq[jq] = s_; } \
            carry = recv[3]; \
            IMP[tl * 128 + 8 * (ct_) + 2 * hd + hh] = (hd == 0) ? bq[0] : (hd == 1) ? bq[1] : (hd == 2) ? bq[2] : bq[3]; } while (0)
        if (ntc > 0) { bf16x8 ka[4], kb[4], va[2][2], vb[2][2]; tile_load_k(ka, Kc, r32, hh); tile_load_v(va, VcT, 512, r32, hh);
#pragma unroll 1
            for (int ct = 0; ct < ntc; ct += 2) { const bool h1 = ct + 1 < ntc;
                if (h1) { tile_load_k(kb, Kc + (ct + 1) * 2048, r32, hh); tile_load_v(vb, VcT + (ct + 1) * 32, 512, r32, hh); }
                { const f32x16 p = tile_scores(ka, qf, negMc, cmax_row - 32 * ct - 4 * hh, -1000000, ldummy); tile_pv(p, va, oc); CM_POST(p, ct); }
                if (h1) { if (ct + 2 < ntc) { tile_load_k(ka, Kc + (ct + 2) * 2048, r32, hh); tile_load_v(va, VcT + (ct + 2) * 32, 512, r32, hh); }
                    const f32x16 p = tile_scores(kb, qf, negMc, cmax_row - 32 * (ct + 1) - 4 * hh, -1000000, ldummy); tile_pv(p, vb, oc); CM_POST(p, ct + 1); } } }
#undef CM_POST
        for (int ct = ntc; ct < 16; ++ct) IMP[tl * 128 + 8 * ct + 2 * hd + hh] = 0.f;
        if (ti >= 3) {
            __builtin_amdgcn_s_waitcnt(0xC07F); asm volatile("" ::: "memory");
            unsigned key[16]; const int li = hd + 4 * hh;
#pragma unroll
            for (int i4 = 0; i4 < 4; ++i4) { const f32x4 v4 = *(const f32x4*)(IMP + tl * 128 + li * 16 + 4 * i4);
#pragma unroll
                for (int i = 0; i < 4; ++i) { const int n = li * 16 + 4 * i4 + i; key[4 * i4 + i] = (n >= 1 && n <= ti - 2) ? ((__float_as_uint(fmaxf(v4[i], 0.f)) & ~0xFFu) | (unsigned)(128 - n)) : 0u; } }
#pragma unroll 1
            for (int it = 0; it < 13; ++it) { unsigned m = key[0];
#pragma unroll
                for (int i = 1; i < 16; ++i) m = (key[i] > m) ? key[i] : m;
                { unsigned o_; o_ = __shfl_xor(m, 1); m = o_ > m ? o_ : m; o_ = __shfl_xor(m, 2); m = o_ > m ? o_ : m; o_ = __shfl_xor(m, 32); m = o_ > m ? o_ : m; }
#pragma unroll
                for (int i = 0; i < 16; ++i) key[i] = (key[i] == m) ? 0u : key[i];
                if (m != 0u && hd == 0 && hh == 0) { const int nsel = 128 - (int)(m & 0xFFu); atomicOr(&BM[nsel * 2 + (tl >> 5)], 1u << (tl & 31)); } }
        }
        __builtin_amdgcn_s_waitcnt(0xC07F); asm volatile("" ::: "memory");
        { const float sc = gp[0] * inv;
#pragma unroll
          for (int dt = 0; dt < 2; ++dt)
#pragma unroll
              for (int r4 = 0; r4 < 4; ++r4) { u32x2 o; o.x = pk2(oc[dt][4 * r4] * sc, oc[dt][4 * r4 + 1] * sc); o.y = pk2(oc[dt][4 * r4 + 2] * sc, oc[dt][4 * r4 + 3] * sc);
                  *(u32x2*)(PA + 32 * dt + 8 * r4 + 4 * hh) = o; } }
    }
    const float negMs = -mq * maxabs64(A.in[I_KSG], lane);
    const bf16_t* KS = (const bf16_t*)(ws + WS_KSN) + (size_t)(b * 2 + g) * T * 64; const bf16_t* VS = (const bf16_t*)(ws + WS_VST) + (size_t)(b * 2 + g) * 128 * 4096;
    { bf16x8 qf[4]; LOADQF(qf);
      f32x16 os[2]; float lsel = 0.f; for (int i = 0; i < 16; ++i) { os[0][i] = 0.f; os[1][i] = 0.f; }
      block_stream(KS, VS, (ti >= 1 ? 2 * ti - 2 : 0), 2 * ti + 2, qf, os, lsel, negMs, trow, -1, r32, hh);
      if (ti >= 2) block_stream(KS, VS, 0, 2, qf, os, lsel, negMs, trow, -1, r32, hh);
      lsel += __shfl_xor(lsel, 32);
      const float scl = 1048576.0f / lsel;
#pragma unroll
      for (int dt = 0; dt < 2; ++dt)
#pragma unroll
          for (int r = 0; r < 16; ++r) OL[row * 66 + 32 * dt + crow(r, hh)] = __float2int_rn(os[dt][r] * scl);
      if (hh == 0) { LL[row] = __float2int_rn(lsel * scl); SCL[row] = scl; } }
    { const bf16_t* KW = (const bf16_t*)(ws + WS_KWN) + (size_t)(b * 2 + g) * T * 64; const bf16_t* VW = (const bf16_t*)(ws + WS_VWT) + (size_t)(b * 2 + g) * 128 * 4096;
      const float negMw = -mq * maxabs64(A.in[I_KWG], lane);
      bf16x8 qf[4]; LOADQF(qf);
      f32x16 ow[2]; float lw = 0.f; for (int i = 0; i < 16; ++i) { ow[0][i] = 0.f; ow[1][i] = 0.f; }
      const int tw0 = ti * 64 + wave * 8; const int nlo = (tw0 - 511 > 0) ? ((tw0 - 511) >> 6) : 0;
      block_stream(KW, VW, 2 * nlo, 2 * ti + 2, qf, ow, lw, negMw, trow, trow - 512, r32, hh);
      lw += __shfl_xor(lw, 32); const float sc = gp[2] / lw;
#pragma unroll
      for (int dt = 0; dt < 2; ++dt)
#pragma unroll
          for (int r4 = 0; r4 < 4; ++r4) { bf16_t* pp = PA + 32 * dt + 8 * r4 + 4 * hh; const u32x2 pa = *(const u32x2*)pp;
              u32x2 o; o.x = pk2(bflo(pa.x) + ow[dt][4 * r4] * sc, bfhi(pa.x) + ow[dt][4 * r4 + 1] * sc); o.y = pk2(bflo(pa.y) + ow[dt][4 * r4 + 2] * sc, bfhi(pa.y) + ow[dt][4 * r4 + 3] * sc);
              *(u32x2*)pp = o; } }
    __syncthreads();
    if (ti >= 3) {
        unsigned long long m_cur = 0ull; int n_cur = 0;
        int n_a = 0, n_b = 0; unsigned long long m_a = 0ull, m_b = 0ull;
#define ADVANCE(n_it, m_it, ok) do { ok = true; while (m_cur == 0ull) { int k_ = 0; if (lane == 0) k_ = atomicAdd(CNT, 1); k_ = __builtin_amdgcn_readfirstlane(k_); \
                if (k_ >= ti - 2) { ok = false; break; } n_cur = ti - 2 - k_; \
                m_cur = ((unsigned long long)__builtin_amdgcn_readfirstlane(BM[n_cur * 2 + 1]) << 32) | (unsigned)__builtin_amdgcn_readfirstlane(BM[n_cur * 2]); } \
            if (ok) { n_it = n_cur; m_it = m_cur; for (int i_ = 0; i_ < 8; ++i_) m_cur &= m_cur - 1ull; } } while (0)
        bool have; ADVANCE(n_a, m_a, have);
        bf16x8 ka[2][4], kb[2][4];
        if (have) { tile_load_k(ka[0], KS + (size_t)n_a * 4096, r32, hh); tile_load_k(ka[1], KS + (size_t)n_a * 4096 + 2048, r32, hh); }
        while (have) {
            bool have_b; ADVANCE(n_b, m_b, have_b);
            if (have_b) { tile_load_k(kb[0], KS + (size_t)n_b * 4096, r32, hh); tile_load_k(kb[1], KS + (size_t)n_b * 4096 + 2048, r32, hh); }
            bf16x8 va[2][2][2];
            tile_load_v(va[0], VS + (size_t)n_a * 4096, 64, r32, hh); tile_load_v(va[1], VS + (size_t)n_a * 4096 + 32, 64, r32, hh);
            unsigned long long mm = m_a; for (int i = 0; i < slot; ++i) mm &= mm - 1ull;
            const bool active = mm != 0ull; const int tt = active ? (__ffsll((long long)mm) - 1) : (__ffsll((long long)m_a) - 1);
            const int grow = tt * 4 + hd;
            bf16x8 qg[4];
#pragma unroll
            for (int s = 0; s < 4; ++s) qg[s] = *(const bf16x8*)(QL + grow * 72 + 16 * s + 8 * hh);
            f32x16 oo[2]; for (int i = 0; i < 16; ++i) { oo[0][i] = 0.f; oo[1][i] = 0.f; }
            float lp = 0.f; const int hi2 = active ? 1000000 : -1000000;
#pragma unroll
            for (int kt = 0; kt < 2; ++kt) { const f32x16 p = tile_scores(ka[kt], qg, negMs, hi2, -1000000, lp); tile_pv(p, va[kt], oo); }
            if (active) { const float scl = SCL[grow];
#pragma unroll
                for (int dt = 0; dt < 2; ++dt)
#pragma unroll
                    for (int r = 0; r < 16; ++r) atomicAdd(&OL[grow * 66 + 32 * dt + crow(r, hh)], __float2int_rn(oo[dt][r] * scl));
                atomicAdd(&LL[grow], __float2int_rn(lp * scl)); }
#pragma unroll
            for (int kt = 0; kt < 2; ++kt)
#pragma unroll
                for (int s = 0; s < 4; ++s) ka[kt][s] = kb[kt][s];
            n_a = n_b; m_a = m_b; have = have_b;
        }
#undef ADVANCE
    }
    __syncthreads();
    { const float sc = gp[1] / (float)LL[row];
      bf16_t* op = (bf16_t*)(ws + WS_ONSA) + tokg * 512 + (g * 4 + hd) * 64;
#pragma unroll
      for (int dt = 0; dt < 2; ++dt)
#pragma unroll
          for (int r4 = 0; r4 < 4; ++r4) { float f[4];
              const u32x2 pa = *(const u32x2*)(PA + 32 * dt + 8 * r4 + 4 * hh); const float pf[4] = {bflo(pa.x), bfhi(pa.x), bflo(pa.y), bfhi(pa.y)};
#pragma unroll
              for (int i = 0; i < 4; ++i) { const int r = 4 * r4 + i; f[i] = pf[i] + (float)OL[row * 66 + 32 * dt + crow(r, hh)] * sc; }
              u32x2 o; o.x = pk2(f[0], f[1]); o.y = pk2(f[2], f[3]);
              *(u32x2*)(op + 32 * dt + 8 * r4 + 4 * hh) = o; } }
    __syncthreads();
}

DI void phase_finalize(const Args& A) {
    const int tid = threadIdx.x, lane = tid & 63, wave = tid >> 6; const int gw = blockIdx.x * 8 + wave, NGW = gridDim.x * 8;
    unsigned char* ws = A.ws;
    for (int tok = gw; tok < NTOK; tok += NGW) {
        bf16_t* oc = (bf16_t*)(ws + WS_OCAT) + (size_t)tok * 1024;
        { const u32x4 w = *(const u32x4*)((const bf16_t*)(ws + WS_ONSA) + (size_t)tok * 512 + 8 * lane);
          float f[8] = {bflo(w.x), bfhi(w.x), bflo(w.y), bfhi(w.y), bflo(w.z), bfhi(w.z), bflo(w.w), bfhi(w.w)}; float s = 0.f;
#pragma unroll
          for (int i = 0; i < 8; ++i) s += f[i] * f[i];
          const float rs = rsqrtf(wave_sum(s) * (1.f / 512.f) + EPS); const float* gn = A.in[I_NSAOG] + 8 * lane;
          u32x4 o; o.x = pk2(f[0] * rs * gn[0], f[1] * rs * gn[1]); o.y = pk2(f[2] * rs * gn[2], f[3] * rs * gn[3]); o.z = pk2(f[4] * rs * gn[4], f[5] * rs * gn[5]); o.w = pk2(f[6] * rs * gn[6], f[7] * rs * gn[7]);
          *(u32x4*)(oc + 8 * lane) = o; }
        { const u32x4 w = *(const u32x4*)((const bf16_t*)(ws + WS_OG) + (size_t)tok * 512 + 8 * lane);
          const u32x4 zw = *(const u32x4*)((const bf16_t*)(ws + WS_U) + (size_t)tok * INWP + C_GZ + 8 * lane);
          float f[8] = {bflo(w.x), bfhi(w.x), bflo(w.y), bfhi(w.y), bflo(w.z), bfhi(w.z), bflo(w.w), bfhi(w.w)};
          float z[8] = {bflo(zw.x), bfhi(zw.x), bflo(zw.y), bfhi(zw.y), bflo(zw.z), bfhi(zw.z), bflo(zw.w), bfhi(zw.w)}; float s = 0.f;
#pragma unroll
          for (int i = 0; i < 8; ++i) s += f[i] * f[i];
          s += __shfl_xor(s, 1); s += __shfl_xor(s, 2); s += __shfl_xor(s, 4); s += __shfl_xor(s, 8);
          const float rs = rsqrtf(s * (1.f / 128.f) + EPS); const float* gn = A.in[I_GDNOG] + (8 * lane & 127); float o8[8];
#pragma unroll
          for (int i = 0; i < 8; ++i) o8[i] = f[i] * rs * gn[i] * z[i] * sigm(z[i]);
          u32x4 o; o.x = pk2(o8[0], o8[1]); o.y = pk2(o8[2], o8[3]); o.z = pk2(o8[4], o8[5]); o.w = pk2(o8[6], o8[7]);
          *(u32x4*)(oc + 512 + 8 * lane) = o; }
    }
}

DI void phase_router(const Args& A, unsigned char* lds) {
    const int tid = threadIdx.x, lane = tid & 63, wave = tid >> 6; const int gw = blockIdx.x * 8 + wave, NGW = gridDim.x * 8;
    unsigned char* ws = A.ws; const float* x1 = A.out; const float* rw = A.in[I_RW]; const float* fg = A.in[I_FFNG];
    float* lgL = (float*)(lds + wave * 8192); float* rsL = lgL + 32 * 33;
    const int i32 = lane & 31, kh = lane >> 5;
    for (int task = gw; task < NTOK / 32; task += NGW) {
        const int tok = task * 32 + i32; const float* xr = x1 + (size_t)tok * D;
        f32x16 acc; for (int i = 0; i < 16; ++i) acc[i] = 0.f; float ss = 0.f;
#pragma unroll 2
        for (int kb = 0; kb < 128; ++kb) { const int k0 = 8 * kb + 4 * kh; const f32x4 av = *(const f32x4*)(xr + k0); const f32x4 gv = *(const f32x4*)(fg + k0);
            ss += av[0] * av[0] + av[1] * av[1] + av[2] * av[2] + av[3] * av[3];
#pragma unroll
            for (int s = 0; s < 4; ++s) acc = __builtin_amdgcn_mfma_f32_32x32x2f32(av[s], rw[(size_t)(k0 + s) * 32 + i32] * gv[s], acc, 0, 0, 0); }
        ss += __shfl_xor(ss, 32); const float rstd = rsqrtf(ss * (1.f / D) + EPS);
        if (kh == 0) { rsL[i32] = rstd; ((float*)(ws + WS_RSTD2))[tok] = rstd; }
#pragma unroll
        for (int r = 0; r < 16; ++r) lgL[crow(r, kh) * 33 + i32] = acc[r];
        __builtin_amdgcn_s_waitcnt(0xC07F); asm volatile("" ::: "memory");
        if (lane < 32) { float v[4] = {-3.0e38f, -3.0e38f, -3.0e38f, -3.0e38f}; int id[4] = {0, 0, 0, 0}; const float* rb = A.in[I_RB];
            for (int e = 0; e < 32; ++e) { const float x = lgL[lane * 33 + e] * rstd + rb[e];
                if (x > v[3]) { if (x > v[0]) { v[3] = v[2]; id[3] = id[2]; v[2] = v[1]; id[2] = id[1]; v[1] = v[0]; id[1] = id[0]; v[0] = x; id[0] = e; }
                    else if (x > v[1]) { v[3] = v[2]; id[3] = id[2]; v[2] = v[1]; id[2] = id[1]; v[1] = x; id[1] = e; }
                    else if (x > v[2]) { v[3] = v[2]; id[3] = id[2]; v[2] = x; id[2] = e; }
                    else { v[3] = x; id[3] = e; } } }
            const float e0 = 1.f, e1 = __expf(v[1] - v[0]), e2 = __expf(v[2] - v[0]), e3 = __expf(v[3] - v[0]); const float inv = 1.f / (e0 + e1 + e2 + e3);
            const float gt[4] = {e0 * inv, e1 * inv, e2 * inv, e3 * inv};
#pragma unroll
            for (int k = 0; k < 4; ++k) { const int pos = atomicAdd((unsigned*)(ws + WS_CTL) + CW_CNT + id[k], 1u);
                ((int*)(ws + WS_TOKE))[tok * 4 + k] = id[k]; ((float*)(ws + WS_TOKG))[tok * 4 + k] = gt[k]; ((int*)(ws + WS_TOKPOS))[tok * 4 + k] = pos; } }
        __builtin_amdgcn_s_waitcnt(0xC07F); asm volatile("" ::: "memory");
    }
}

DI void phase_gather(const Args& A, unsigned char* lds) {
    const int tid = threadIdx.x, lane = tid & 63, wave = tid >> 6; const int gw = blockIdx.x * 8 + wave, NGW = gridDim.x * 8;
    unsigned char* ws = A.ws; int* psL = (int*)lds;
    if (tid == 0) { const unsigned* cnt = (const unsigned*)(ws + WS_CTL) + CW_CNT; int acc = 0;
        for (int e = 0; e < 32; ++e) { psL[e] = acc; acc += ((int)cnt[e] + 255) & ~255; }
        psL[32] = acc;
        if (blockIdx.x == 0) { int* ctl = (int*)(ws + WS_CTL); ctl[CW_NT] = acc >> 8; int e = 0;
            for (int r = 0; r < (acc >> 8); ++r) { while (r * 256 >= psL[e + 1]) ++e; ctl[CW_TILEE + r] = e; } } }
    __syncthreads();
    const float* x1 = A.out; const float* fg = A.in[I_FFNG]; f32x4 gv[4];
#pragma unroll
    for (int j = 0; j < 4; ++j) gv[j] = *(const f32x4*)(fg + 4 * lane + 256 * j);
    for (int pr = gw; pr < NTOK * 4; pr += NGW) { const int tok = pr >> 2;
        const int e = ((const int*)(ws + WS_TOKE))[pr], pos = ((const int*)(ws + WS_TOKPOS))[pr]; const int dest = psL[e] + pos;
        if (lane == 0) { ((int*)(ws + WS_DEST))[pr] = dest; ((float*)(ws + WS_ROWG))[dest] = ((const float*)(ws + WS_TOKG))[pr]; }
        const float rs = ((const float*)(ws + WS_RSTD2))[tok]; const f32x4* xr = (const f32x4*)(x1 + (size_t)tok * D) + lane;
        u32x2* o = (u32x2*)((bf16_t*)(ws + WS_XS) + (size_t)dest * D) + lane;
#pragma unroll
        for (int j = 0; j < 4; ++j) { const f32x4 v = xr[64 * j]; u32x2 w; w.x = pk2(v.x * rs * gv[j].x, v.y * rs * gv[j].y); w.y = pk2(v.z * rs * gv[j].z, v.w * rs * gv[j].w); o[64 * j] = w; } }
}

DI void phase_combine(const Args& A) {
    const int tid = threadIdx.x, lane = tid & 63, wave = tid >> 6; const int gw = blockIdx.x * 8 + wave, NGW = gridDim.x * 8;
    unsigned char* ws = A.ws; const bf16_t* YS = (const bf16_t*)(ws + WS_XS);
    for (int tok = gw; tok < NTOK; tok += NGW) { f32x4* xr = (f32x4*)(A.out + (size_t)tok * D) + lane; f32x4 v[4];
#pragma unroll
        for (int j = 0; j < 4; ++j) v[j] = xr[64 * j];
#pragma unroll
        for (int k = 0; k < 4; ++k) { const int dest = ((const int*)(ws + WS_DEST))[tok * 4 + k]; const u32x2* yr = (const u32x2*)(YS + (size_t)dest * D) + lane;
#pragma unroll
            for (int j = 0; j < 4; ++j) { const u32x2 w = yr[64 * j]; v[j].x += bflo(w.x); v[j].y += bfhi(w.x); v[j].z += bflo(w.y); v[j].w += bfhi(w.y); } }
#pragma unroll
        for (int j = 0; j < 4; ++j) xr[64 * j] = v[j]; }
}


#define XB_TMO      128
#define XB_XCNT(j)  (256  + 64 * (j))
#define XB_XSUB(j)  (1280 + 64 * (j))
#define XB_XGEN(j)  (2304 + 64 * (j))
#define XB_TOP      3328
#define XB_TOPGEN   3392
#define XCD_BAR_WORDS 3456
#define XB_SPIN_CAP (1u << 22)
DI unsigned xb_ld(unsigned* p)              { return __hip_atomic_load(p, __ATOMIC_RELAXED, __HIP_MEMORY_SCOPE_AGENT); }
DI unsigned xb_add(unsigned* p, unsigned v) { return __hip_atomic_fetch_add(p, v, __ATOMIC_RELAXED, __HIP_MEMORY_SCOPE_AGENT); }
DI unsigned xb_xcc_id() { return (unsigned)__builtin_amdgcn_s_getreg((3 << 11) | 20) & 0xFu; }
#define XB_SPIN(cond, bar) do { unsigned _sp = 0; while (cond) { __builtin_amdgcn_s_sleep(1); \
    if ((++_sp & 255u) == 0u) { if (xb_ld(&(bar)[XB_TMO])) break; if (_sp > XB_SPIN_CAP) { atomicAdd(&(bar)[XB_TMO], 1u); break; } } } } while (0)
struct XcdBarrier { unsigned* bar; unsigned x; volatile LAS unsigned* st; };
DI XcdBarrier xcd_barrier_post(unsigned* bar, volatile LAS unsigned* st) {
    XcdBarrier b; b.bar = bar; b.x = xb_xcc_id(); b.st = st;
    if (threadIdx.x == 0) (void)xb_add(&bar[XB_XCNT(b.x)], 1u);
    return b; }
DI void xcd_barrier_complete(unsigned* bar, unsigned x, unsigned& nloc, unsigned& nx) {
    const unsigned G = gridDim.x * gridDim.y * gridDim.z;
    unsigned sum, cnt, mine, sp = 0u;
    for (;;) {
        sum = 0u; cnt = 0u; mine = 0u;
#pragma unroll
        for (unsigned j = 0; j < 16; ++j) { const unsigned c = xb_ld(&bar[XB_XCNT(j)]); sum += c; cnt += (c > 0u) ? 1u : 0u; mine = (j == x) ? c : mine; }
        if (sum == G) break;
        __builtin_amdgcn_s_sleep(1);
        if ((++sp & 255u) == 0u) { if (xb_ld(&bar[XB_TMO])) break; if (sp > XB_SPIN_CAP) { atomicAdd(&bar[XB_TMO], 1u); break; } }
    }
    nloc = mine > 0u ? mine : 1u; nx = cnt > 0u ? cnt : 1u; }
DI void xcd_barrier(const XcdBarrier& b) {
    asm volatile("s_waitcnt vmcnt(0)" ::: "memory");
    __syncthreads();
    if (threadIdx.x == 0) {
        unsigned* bar = b.bar;
        __builtin_amdgcn_s_waitcnt(0);
        unsigned nloc = b.st[0], nx = b.st[1];
        if (nloc == 0u) { xcd_barrier_complete(bar, b.x, nloc, nx); b.st[0] = nloc; b.st[1] = nx; }
        const unsigned old = xb_add(&bar[XB_XSUB(b.x)], 1u);
        const unsigned gen = old / nloc;
        if (old + 1u == (gen + 1u) * nloc) {
            __builtin_amdgcn_fence(__ATOMIC_RELEASE, "agent");
            asm volatile("s_waitcnt vmcnt(0)" ::: "memory");
            const unsigned og = xb_add(&bar[XB_TOP], 1u);
            const unsigned tg = og / nx;
            if (og + 1u == (tg + 1u) * nx) xb_add(&bar[XB_TOPGEN], 1u);
            else XB_SPIN(xb_ld(&bar[XB_TOPGEN]) == tg, bar);
            __builtin_amdgcn_fence(__ATOMIC_ACQUIRE, "agent");
            xb_add(&bar[XB_XGEN(b.x)], 1u);
            asm volatile("s_waitcnt vmcnt(0)" ::: "memory");
        } else {
            XB_SPIN(xb_ld(&bar[XB_XGEN(b.x)]) == gen, bar);
            __builtin_amdgcn_fence(__ATOMIC_ACQUIRE, "agent");
            asm volatile("s_waitcnt vmcnt(0)" ::: "memory");
        }
    }
    __syncthreads();
}

__global__ void __launch_bounds__(512, 2) mega(Args A) {
    extern __shared__ __attribute__((aligned(16))) unsigned char lds[];
    cg::grid_group grid = cg::this_grid();
    const int lo = A.ph_lo, hi = A.ph_hi, tid = threadIdx.x;
    unsigned char* ws = A.ws;
    int* taskL = (int*)(lds + LDS_MISC);
    if (tid < 2) ((volatile LAS unsigned*)(lds + LDS_MISC + 16))[tid] = 0u;
    __syncthreads();
    XcdBarrier xbar = xcd_barrier_post((unsigned*)(ws + WS_CTL) + CW_BAR, (volatile LAS unsigned*)(lds + LDS_MISC + 16));
#define IN(k) (lo <= (k) && (k) < hi)
#define SEAM(k) do { if (IN(k) && IN((k) + 1)) { if ((k) == 0) grid.sync(); else xcd_barrier(xbar); } } while (0)

#ifndef REPEAT_PH
#define REPEAT_PH -1
#endif
#define REP(k) (REPEAT_PH == (k) ? 2 : 1)
    for (int rep = 0; rep < REP(0); ++rep) { if (IN(0)) phase0(A, lds, rep == 0); if (rep + 1 < REP(0)) grid.sync(); }
    SEAM(0);
    for (int rep = 0; rep < REP(1); ++rep) { if (IN(1)) { pg8::Gemm g{(const bf16_t*)(ws + WS_XN), (const bf16_t*)(ws + WS_WTIN), NTOK, INWP, D}; pg8::StaticOrder S; S.init(NTOK, INWP, gridDim.x, blockIdx.x);
        pg8::EpiU E{(bf16_t*)(ws + WS_U), INWP}; pg8::gemm_phase<pg8::EpiU, pg8::StaticOrder>((PG8_LAS unsigned char*)lds, g, S, E); } if (rep + 1 < REP(1)) grid.sync(); }
    SEAM(1);
    for (int rep = 0; rep < REP(2); ++rep) { if (IN(2)) {
        for (;;) { if (tid == 0) *taskL = atomicAdd((int*)(ws + WS_CTL) + (rep ? CW_Q2B : CW_Q2), 1); __syncthreads(); const int task = *taskL; __syncthreads();
            if (task >= 1408) break;
            if (task < 128) compress_task(A, task, lds); else if (task < 1152) gdn_chunk_task(A, task - 128, lds); else nsa_prep_task(A, task - 1152, lds); } } if (rep + 1 < REP(2)) grid.sync(); }
    SEAM(2);
    for (int rep = 0; rep < REP(3); ++rep) { if (IN(3)) {
        if (blockIdx.x < 64) { gdn_scan_block(A, blockIdx.x, lds); __syncthreads(); }
        for (;;) { if (tid == 0) *taskL = atomicAdd((int*)(ws + WS_CTL) + (rep ? CW_Q3B : CW_Q3), 1); __syncthreads(); const int unit = *taskL; __syncthreads();
            if (unit >= 512) break;
            nsa_unit(A, unit, lds); } } if (rep + 1 < REP(3)) grid.sync(); }
    SEAM(3);
    for (int rep = 0; rep < REP(4); ++rep) { if (IN(4)) phase_finalize(A); if (rep + 1 < REP(4)) grid.sync(); }
    SEAM(4);
    for (int rep = 0; rep < REP(5); ++rep) { if (IN(5)) { pg8::Gemm g{(const bf16_t*)(ws + WS_OCAT), (const bf16_t*)(ws + WS_WTOUT), NTOK, D, D}; pg8::StaticOrder S; S.init(NTOK, D, gridDim.x, blockIdx.x);
        pg8::EpiRes E{A.in[I_X], A.out, D}; pg8::gemm_phase<pg8::EpiRes, pg8::StaticOrder>((PG8_LAS unsigned char*)lds, g, S, E); } if (rep + 1 < REP(5)) grid.sync(); }
    SEAM(5);
    for (int rep = 0; rep < REP(6); ++rep) { if (IN(6)) phase_router(A, lds);
        if (rep + 1 < REP(6)) { grid.sync(); if (blockIdx.x == 0 && tid < 32) ((unsigned*)(ws + WS_CTL))[CW_CNT + tid] = 0u; grid.sync(); } }
    SEAM(6);
    for (int rep = 0; rep < REP(7); ++rep) { if (IN(7)) phase_gather(A, lds); if (rep + 1 < REP(7)) grid.sync(); }
    SEAM(7);
    for (int rep = 0; rep < REP(8); ++rep) { if (IN(8)) { const int* ctl = (const int*)(ws + WS_CTL); const int nM = ctl[CW_NT];
        pg8::Gemm g{(const bf16_t*)(ws + WS_XS), (const bf16_t*)(ws + WS_EXPGU), 0, 0, D}; pg8::MoeOrder S; S.init(nM, 8, gridDim.x, blockIdx.x, ctl + CW_TILEE);
        pg8::EpiSwiglu E{(bf16_t*)(ws + WS_HID), A.in[I_EBG], A.in[I_EBU]}; pg8::gemm_phase<pg8::EpiSwiglu, pg8::MoeOrder>((PG8_LAS unsigned char*)lds, g, S, E); } if (rep + 1 < REP(8)) grid.sync(); }
    SEAM(8);
    for (int rep = 0; rep < REP(9); ++rep) { if (IN(9)) { const int* ctl = (const int*)(ws + WS_CTL); const int nM = ctl[CW_NT];
        pg8::Gemm g{(const bf16_t*)(ws + WS_HID), (const bf16_t*)(ws + WS_EXPD), 0, 0, D}; pg8::MoeOrder S; S.init(nM, 4, gridDim.x, blockIdx.x, ctl + CW_TILEE);
        pg8::EpiDown E{(bf16_t*)(ws + WS_XS), A.in[I_EBD], (const float*)(ws + WS_ROWG)}; pg8::gemm_phase<pg8::EpiDown, pg8::MoeOrder>((PG8_LAS unsigned char*)lds, g, S, E); } if (rep + 1 < REP(9)) grid.sync(); }
    SEAM(9);
    if (IN(10)) phase_combine(A);
#undef IN
#undef SEAM
}

constexpr int NPHASE = 11;
#ifndef N_LAUNCHES
#define N_LAUNCHES 1
#endif
extern "C" void kernel_launch(void* const* d_in, const int* in_sizes, int n_in, void* d_out, int out_size, void* d_ws, size_t ws_size, hipStream_t stream) {
    static int grid = 0;
    if (grid == 0) {
        if (n_in != 32 || out_size != NTOK * D || ws_size < WS_END) { fprintf(stderr, "kernel_launch: unexpected shapes (n_in %d out %d ws %zu)\n", n_in, out_size, ws_size); grid = -1; return; }
        int dev = 0, cus = 0, per_cu = 0;
        hipGetDevice(&dev); hipDeviceGetAttribute(&cus, hipDeviceAttributeMultiprocessorCount, dev);
        hipFuncSetAttribute((const void*)mega, hipFuncAttributeMaxDynamicSharedMemorySize, LDS_BYTES);
        hipOccupancyMaxActiveBlocksPerMultiprocessor(&per_cu, (const void*)mega, 512, LDS_BYTES);
        if (per_cu < 1) { fprintf(stderr, "kernel_launch: occupancy query says %d blocks per CU\n", per_cu); per_cu = 1; }
        (void)hipGetLastError();
        grid = cus;
    }
    if (grid < 0) return;
    hipMemsetAsync((char*)d_ws + WS_CTL, 0, CTL_BYTES, stream);
    Args a{};
    for (int i = 0; i < 32; ++i) a.in[i] = (const float*)d_in[i];
    a.out = (float*)d_out; a.ws = (unsigned char*)d_ws;
    if (N_LAUNCHES == 1) { a.ph_lo = 0; a.ph_hi = NPHASE; void* args[] = {&a};
        hipError_t e = hipLaunchCooperativeKernel((const void*)mega, dim3(grid), dim3(512), args, LDS_BYTES, stream);
        if (e != hipSuccess) fprintf(stderr, "cooperative launch failed: %s (grid %d)\n", hipGetErrorString(e), grid); }
    else { for (int p = 0; p < NPHASE; ++p) { a.ph_lo = p; a.ph_hi = p + 1; void* args[] = {&a};
            hipError_t e = hipLaunchCooperativeKernel((const void*)mega, dim3(grid), dim3(512), args, LDS_BYTES, stream);
            if (e != hipSuccess) { fprintf(stderr, "launch %d failed: %s\n", p, hipGetErrorString(e)); break; } } }
}
```

```cpp
#include <hip/hip_runtime.h>
#include <hip/hip_cooperative_groups.h>
#include <cstdio>
#include <cstdint>
namespace cg = cooperative_groups;

#define DI __device__ __forceinline__
#define LAS __attribute__((address_space(3)))
typedef unsigned short bf16_t;
typedef short bf16x8 __attribute__((ext_vector_type(8)));
typedef float f32x4 __attribute__((ext_vector_type(4)));
typedef float f32x16 __attribute__((ext_vector_type(16)));
typedef unsigned u32x4 __attribute__((ext_vector_type(4)));
typedef unsigned u32x2 __attribute__((ext_vector_type(2)));
typedef float f32x2_t __attribute__((ext_vector_type(2)));
typedef __bf16 bf16x2_t __attribute__((ext_vector_type(2)));

constexpr int NB = 2, T = 8192, D = 1024, NTOK = NB * T, INWP = 3584;
constexpr int C_Q = 0, C_KC = 512, C_VC = 640, C_KS = 768, C_VS = 896, C_KW = 1024, C_VW = 1152, C_GATE = 1280,
              C_GQ = 1304, C_GK = 1816, C_GV = 2328, C_GZ = 2840, C_GA = 3352, C_GB = 3356, INW = 3360;
constexpr float EPS = 1e-6f, LOG2E = 1.4426950408889634f;
constexpr int NEXP = 32, MAXROWS = 65536 + NEXP * 256, MAXTILES = MAXROWS / 256;

constexpr size_t MiB = 1u << 20;
constexpr size_t WS_CTL = 0, CTL_BYTES = 64 * 1024;
constexpr size_t WS_WTIN = 1 * MiB, WS_WTOUT = 8 * MiB, WS_WTC1K = 10 * MiB, WS_WTC1V = 11 * MiB;
constexpr size_t WS_MISC = 12 * MiB;
constexpr size_t WS_WTC2K = WS_MISC, WS_WTC2V = WS_MISC + 32 * 1024, WS_RSTD2 = WS_MISC + 64 * 1024, WS_TOKE = WS_MISC + 128 * 1024,
                 WS_TOKG = WS_MISC + 384 * 1024, WS_TOKPOS = WS_MISC + 640 * 1024, WS_DEST = WS_MISC + 896 * 1024,
                 WS_ROWG = WS_MISC + 1152 * 1024, WS_GL = WS_MISC + 1536 * 1024, WS_PB1P = WS_MISC + 1600 * 1024  , WS_GATES = 14 * MiB;
constexpr size_t WS_EXPGU = 16 * MiB, WS_EXPD = 144 * MiB;
constexpr size_t WS_XN = 208 * MiB, WS_ONSA = 208 * MiB, WS_U = 240 * MiB, WS_QN = 352 * MiB, WS_KSN = 368 * MiB, WS_VST = 372 * MiB,
                 WS_KWN = 376 * MiB, WS_VWT = 380 * MiB, WS_KC = 384 * MiB, WS_VCT = 384 * MiB + 512 * 1024;
constexpr size_t WS_WP = 388 * MiB, WS_QGP = 404 * MiB, WS_KDTP = 420 * MiB, WS_QKP = 436 * MiB, WS_UP = 444 * MiB, WS_OG = 460 * MiB, WS_OCAT = 476 * MiB;
constexpr size_t WS_XS = 208 * MiB, WS_HID = 352 * MiB, WS_END = 508 * MiB;
constexpr int CW_Q2 = 0, CW_Q3 = 64, CW_Q2B = 32, CW_Q3B = 96, CW_CNT = 2048  , CW_PB1 = 4096  , CW_NT = 1024, CW_TILEE = 1088  , CW_PSTART = 1536, CW_BAR = 12288;

constexpr int LDS_BYTES = 147456, LDS_MISC = 140 * 1024;

DI unsigned pk2(float lo, float hi) { f32x2_t v = {lo, hi}; bf16x2_t b = __builtin_convertvector(v, bf16x2_t); return __builtin_bit_cast(unsigned, b); }
DI float bflo(unsigned w) { return __uint_as_float(w << 16); }
DI float bfhi(unsigned w) { return __uint_as_float(w & 0xffff0000u); }
DI float bf2f(bf16_t v) { return __uint_as_float((unsigned)v << 16); }
DI bf16_t f2bf(float f) { return (bf16_t)(pk2(f, 0.f) & 0xffffu); }
DI bf16x8 pack8(float a0, float a1, float a2, float a3, float a4, float a5, float a6, float a7) {
    u32x4 w; w.x = pk2(a0, a1); w.y = pk2(a2, a3); w.z = pk2(a4, a5); w.w = pk2(a6, a7); return __builtin_bit_cast(bf16x8, w); }
DI float wave_sum(float v) {
#pragma unroll
    for (int o = 1; o < 64; o <<= 1) v += __shfl_xor(v, o);
    return v; }
DI float sigm(float x) { return __builtin_amdgcn_rcpf(1.f + __builtin_amdgcn_exp2f(-x * LOG2E)); }
DI int otid() { int t = threadIdx.x; asm volatile("" : "+v"(t)); return t; }
DI int crow(int r, int hi) { return (r & 3) + 8 * (r >> 2) + 4 * hi; }
DI int perm16(int p) { return 8 * ((p & 7) >> 2) + 4 * (p >> 3) + (p & 3); }
DI int perm16inv(int k) { return 8 * ((k >> 2) & 1) + 4 * (k >> 3) + (k & 3); }
#define MFMA32(a, b, c) __builtin_amdgcn_mfma_f32_32x32x16_bf16((a), (b), (c), 0, 0, 0)
#define MFMA16(a, b, c) __builtin_amdgcn_mfma_f32_16x16x32_bf16((a), (b), (c), 0, 0, 0)

namespace pg8 {
#define PG8_LAS __attribute__((address_space(3)))
constexpr int BM = 256, BK = 64, HALF = 128, HTB = HALF * BK * 2, STAGE_BYTES = 8 * HTB, NXCD = 8, WGM = 8;
__host__ __device__ __forceinline__ int lds_byte(int r, int c) { const int st = (r >> 4) * 2 + (c >> 5), rr = r & 15, cc = c & 31, ob = rr * 64 + cc * 2; return st * 1024 + (ob ^ (((ob >> 9) & 1) << 5)); }
__host__ __device__ __forceinline__ void stage_rc(int b, int& R, int& C) { const int st = b / 1024, sb = b % 1024, swz = sb ^ (((sb >> 9) & 1) << 5); R = (st >> 1) * 16 + swz / 64; C = (st & 1) * 32 + (swz % 64) / 2; }
__host__ __device__ __forceinline__ int perm32(int rho) { const int n = rho >> 4, i = rho & 15; return 8 * (i >> 2) + 4 * n + (i & 3); }
struct Unit { int pm, pn; };
struct Gemm { const bf16_t* A; const bf16_t* Bt; int M, N, K; };
struct StaticOrder {
    int nM, nN, nwg, G, c;
    __device__ void init(int M, int N, int G_, int c_) { nM = M / BM; nN = N / BM; nwg = nM * nN; G = G_; c = c_; }
    __device__ bool next(int i, Unit& u) const {
        const long L = (long)i * G + c; if (L >= nwg) return false;
        int wgid = (int)L; { const int q = nwg / NXCD, r = nwg % NXCD, xcd = wgid % NXCD, off = wgid / NXCD; wgid = (xcd < r ? xcd * (q + 1) : r * (q + 1) + (xcd - r) * q) + off; }
        const int nig = WGM * nN, gid = wgid / nig, fm = gid * WGM, gsz = (nM - fm) < WGM ? (nM - fm) : WGM;
        u.pm = fm + ((wgid % nig) % gsz); u.pn = (wgid % nig) / gsz; return true;
    }
};
struct MoeOrder {
    StaticOrder S; const int* tile_e;
    __device__ void init(int nM_, int nN_, int G_, int c_, const int* te) { S.nM = nM_; S.nN = nN_; S.nwg = nM_ * nN_; S.G = G_; S.c = c_; tile_e = te; }
    __device__ bool next(int i, Unit& u) const { if (!S.next(i, u)) return false; u.pn = tile_e[u.pm] * S.nN + u.pn; return true; }
};

template <class Epi, class Sched>
__device__ __forceinline__ void gemm_phase(PG8_LAS unsigned char* lds, const Gemm g, const Sched& S, const Epi& E) {
    const int tid = otid(), wid = __builtin_amdgcn_readfirstlane(tid >> 6), lane = tid & 63, wr = wid >> 2, wc = wid & 3, fr = lane & 15, fq = lane >> 4;
    const int K = g.K, nt = K / BK;
    unsigned voffA[2], voffB[2];
#pragma unroll
    for (int i = 0; i < 2; ++i) { int R, C; stage_rc(tid * 16 + i * 8192, R, C); const int Rb = Epi::PERM ? ((R & ~31) + perm32(R & 31)) : R;
        voffA[i] = (unsigned)(R * K + C) * 2u; voffB[i] = (unsigned)(Rb * K + C) * 2u; }
    const size_t kstep = (size_t)(BK * 2);
    const size_t hstep = (size_t)HALF * K * 2;
    const size_t tstep = 2 * hstep;
    const unsigned ldsw = (unsigned)wid * 1024u;
    const int aoff = lds_byte(wr * 64 + fr, fq * 8), boff = lds_byte(wc * 32 + fr, fq * 8);
#define PG8_SA(b, h) (((b) * 2 + (h)) * HTB)
#define PG8_SB(b, h) ((4 + (b) * 2 + (h)) * HTB)
#define PG8_STAGE(bufoff, gbase, voff) do { _Pragma("unroll") for (int _i = 0; _i < 2; ++_i) \
        __builtin_amdgcn_global_load_lds((const unsigned*)((const char*)(gbase) + (voff)[_i]), (PG8_LAS unsigned*)(lds + (bufoff) + ldsw + _i * 8192), 16, 0, 0); } while (0)
#define PG8_LDA(dst, b, h) do { _Pragma("unroll") for (int m = 0; m < 4; ++m) _Pragma("unroll") for (int k = 0; k < 2; ++k) dst[m][k] = *(const PG8_LAS bf16x8*)(lds + PG8_SA(b, h) + aoff + m * 2048 + k * 1024); } while (0)
#define PG8_LDB(dst, b, h) do { _Pragma("unroll") for (int n = 0; n < 2; ++n) _Pragma("unroll") for (int k = 0; k < 2; ++k) dst[n][k] = *(const PG8_LAS bf16x8*)(lds + PG8_SB(b, h) + boff + n * 2048 + k * 1024); } while (0)
#define PG8_MMA(ai, bj, At, Bt) do { __builtin_amdgcn_s_setprio(1); _Pragma("unroll") for (int m = 0; m < 4; ++m) _Pragma("unroll") for (int n = 0; n < 2; ++n) _Pragma("unroll") for (int k = 0; k < 2; ++k) \
        acc[ai][bj][m][n] = __builtin_amdgcn_mfma_f32_16x16x32_bf16(Bt[n][k], At[m][k], acc[ai][bj][m][n], 0, 0, 0); __builtin_amdgcn_s_setprio(0); } while (0)
#define PG8_WAIT_V(n) asm volatile("s_waitcnt vmcnt(" #n ")" ::: "memory")
#define PG8_WAIT_L(n) asm volatile("s_waitcnt lgkmcnt(" #n ")" ::: "memory")
#define PG8_BAR __builtin_amdgcn_s_barrier()
#define PG8_SCHED __builtin_amdgcn_sched_barrier(0)
    Unit cur, nxt; int ui = 0;
    if (!S.next(0, cur)) return;
    f32x4 acc[2][2][4][2];
#pragma unroll
    for (int a = 0; a < 2; ++a)
#pragma unroll
        for (int b = 0; b < 2; ++b)
#pragma unroll
            for (int m = 0; m < 4; ++m)
#pragma unroll
                for (int n = 0; n < 2; ++n) acc[a][b][m][n] = (f32x4){0.f, 0.f, 0.f, 0.f};
    bf16x8 At[4][2], B0[2][2], B1[2][2];
    const char* cA = (const char*)g.A + (size_t)cur.pm * tstep; const char* cB = (const char*)g.Bt + (size_t)cur.pn * tstep;
    PG8_STAGE(PG8_SB(0, 0), cB, voffB); PG8_STAGE(PG8_SB(0, 1), cB + hstep, voffB); PG8_STAGE(PG8_SA(0, 0), cA, voffA); PG8_STAGE(PG8_SA(0, 1), cA + hstep, voffA);
    if (wr == 1) PG8_BAR;
    PG8_WAIT_V(2); PG8_BAR;
    PG8_STAGE(PG8_SB(1, 0), cB + kstep, voffB); PG8_STAGE(PG8_SA(1, 0), cA + kstep, voffA); PG8_STAGE(PG8_SB(1, 1), cB + hstep + kstep, voffB);
    PG8_WAIT_V(6); PG8_BAR;
    for (;;) {
        const bool has_next = S.next(ui + 1, nxt);
        const char* nA = has_next ? (const char*)g.A + (size_t)nxt.pm * tstep : cA; const char* nB = has_next ? (const char*)g.Bt + (size_t)nxt.pn * tstep : cB;
        for (int t = 0; t < nt; t += 2) {
            const bool last = (t == nt - 2);
            const char* a1 = cA + (size_t)(t + 1) * kstep;
            const char* a2 = last ? nA : cA + (size_t)(t + 2) * kstep; const char* b2 = last ? nB : cB + (size_t)(t + 2) * kstep;
            const char* a3 = a2 + kstep; const char* b3 = b2 + kstep;
            PG8_LDB(B0, 0, 0); PG8_LDB(B1, 0, 1); PG8_SCHED; PG8_LDA(At, 0, 0); PG8_STAGE(PG8_SA(1, 1), a1 + hstep, voffA);
            PG8_WAIT_V(8); PG8_WAIT_L(0); PG8_BAR; PG8_MMA(0, 0, At, B0); PG8_MMA(0, 1, At, B1); PG8_BAR; PG8_SCHED;
            PG8_LDA(At, 0, 1); PG8_STAGE(PG8_SB(0, 0), b2, voffB); PG8_STAGE(PG8_SB(0, 1), b2 + hstep, voffB); PG8_STAGE(PG8_SA(0, 0), a2, voffA);
            PG8_WAIT_V(8); PG8_WAIT_L(0); PG8_BAR; PG8_MMA(1, 0, At, B0); PG8_MMA(1, 1, At, B1); PG8_BAR; PG8_SCHED;
            PG8_LDB(B0, 1, 0); PG8_LDB(B1, 1, 1); PG8_SCHED; PG8_LDA(At, 1, 0); PG8_STAGE(PG8_SA(0, 1), a2 + hstep, voffA);
            PG8_WAIT_V(8); PG8_WAIT_L(0); PG8_BAR; PG8_MMA(0, 0, At, B0); PG8_MMA(0, 1, At, B1); PG8_BAR; PG8_SCHED;
            PG8_LDA(At, 1, 1); PG8_STAGE(PG8_SB(1, 0), b3, voffB); PG8_STAGE(PG8_SB(1, 1), b3 + hstep, voffB); PG8_STAGE(PG8_SA(1, 0), a3, voffA);
            PG8_WAIT_V(8); PG8_WAIT_L(0); PG8_BAR; PG8_MMA(1, 0, At, B0); PG8_MMA(1, 1, At, B1); PG8_BAR; PG8_SCHED;
        }
        if (wr == 0) PG8_BAR;
        E(acc, cur, wr, wc, fr, fq);
        if (!has_next) break;
#pragma unroll
        for (int a = 0; a < 2; ++a)
#pragma unroll
            for (int b = 0; b < 2; ++b)
#pragma unroll
                for (int m = 0; m < 4; ++m)
#pragma unroll
                    for (int n = 0; n < 2; ++n) acc[a][b][m][n] = (f32x4){0.f, 0.f, 0.f, 0.f};
        cur = nxt; cA = nA; cB = nB; ++ui;
        if (wr == 1) PG8_BAR;
    }
    PG8_WAIT_V(0);
    PG8_BAR;
#undef PG8_SA
#undef PG8_SB
#undef PG8_STAGE
#undef PG8_LDA
#undef PG8_LDB
#undef PG8_MMA
#undef PG8_WAIT_V
#undef PG8_WAIT_L
#undef PG8_BAR
#undef PG8_SCHED
}

struct EpiU {
    static constexpr bool PERM = true;
    bf16_t* O; int ldc;
    __device__ __forceinline__ void operator()(const f32x4 (&acc)[2][2][4][2], const Unit& u, int wr, int wc, int fr, int fq) const {
        const int row0 = u.pm * BM + wr * 64 + fr, col0 = u.pn * BM + wc * 32 + 8 * fq;
#pragma unroll
        for (int ai = 0; ai < 2; ++ai)
#pragma unroll
            for (int m = 0; m < 4; ++m) { bf16_t* rowp = O + (size_t)(row0 + ai * HALF + m * 16) * ldc + col0;
#pragma unroll
                for (int bj = 0; bj < 2; ++bj) { const f32x4 v0 = acc[ai][bj][m][0], v1 = acc[ai][bj][m][1];
                    u32x4 w; w.x = pk2(v0[0], v0[1]); w.y = pk2(v0[2], v0[3]); w.z = pk2(v1[0], v1[1]); w.w = pk2(v1[2], v1[3]);
                    *(u32x4*)(rowp + bj * HALF) = w; } }
    }
};
struct EpiRes {
    static constexpr bool PERM = false;
    const float* base; float* out; int ldc;
    __device__ __forceinline__ void operator()(const f32x4 (&acc)[2][2][4][2], const Unit& u, int wr, int wc, int fr, int fq) const {
        const int col0 = u.pn * BM + wc * 32 + 4 * fq;
#pragma unroll
        for (int ai = 0; ai < 2; ++ai)
#pragma unroll
            for (int m = 0; m < 4; ++m) { const size_t off = (size_t)(u.pm * BM + ai * HALF + wr * 64 + m * 16 + fr) * ldc + col0;
#pragma unroll
                for (int bj = 0; bj < 2; ++bj)
#pragma unroll
                    for (int n = 0; n < 2; ++n) { const f32x4 bs = *(const f32x4*)(base + off + bj * HALF + n * 16); *(f32x4*)(out + off + bj * HALF + n * 16) = bs + acc[ai][bj][m][n]; } }
    }
};
struct EpiSwiglu {
    static constexpr bool PERM = true;
    bf16_t* H; const float* bg; const float* bu;
    __device__ __forceinline__ void operator()(const f32x4 (&acc)[2][2][4][2], const Unit& u, int wr, int wc, int fr, int fq) const {
        const int e = u.pn >> 3, pnl = u.pn & 7, hc0 = pnl * 128 + wc * 32 + 8 * fq, row0 = u.pm * BM + wr * 64 + fr;
        float gb[8], ub[8];
#pragma unroll
        for (int i = 0; i < 8; ++i) { gb[i] = bg[e * 1024 + hc0 + i]; ub[i] = bu[e * 1024 + hc0 + i]; }
#pragma unroll
        for (int ai = 0; ai < 2; ++ai)
#pragma unroll
            for (int m = 0; m < 4; ++m) {
                float o[8];
#pragma unroll
                for (int n = 0; n < 2; ++n)
#pragma unroll
                    for (int i = 0; i < 4; ++i) {
                        const float gg = fminf(acc[ai][0][m][n][i] + gb[4 * n + i], 7.0f);
                        const float uu = fminf(fmaxf(acc[ai][1][m][n][i] + ub[4 * n + i], -7.0f), 7.0f);
                        o[4 * n + i] = (uu + 1.0f) * gg * sigm(gg * 1.702f); }
                u32x4 w; w.x = pk2(o[0], o[1]); w.y = pk2(o[2], o[3]); w.z = pk2(o[4], o[5]); w.w = pk2(o[6], o[7]);
                *(u32x4*)(H + (size_t)(row0 + ai * HALF + m * 16) * 1024 + hc0) = w; }
    }
};
struct EpiDown {
    static constexpr bool PERM = true;
    bf16_t* Y; const float* bd; const float* rowg;
    __device__ __forceinline__ void operator()(const f32x4 (&acc)[2][2][4][2], const Unit& u, int wr, int wc, int fr, int fq) const {
        const int e = u.pn >> 2, pnl = u.pn & 3, col0 = pnl * BM + wc * 32 + 8 * fq, row0 = u.pm * BM + wr * 64 + fr;
        float bv[2][8];
#pragma unroll
        for (int bj = 0; bj < 2; ++bj)
#pragma unroll
            for (int i = 0; i < 8; ++i) bv[bj][i] = bd[e * 1024 + col0 + bj * HALF + i];
#pragma unroll
        for (int ai = 0; ai < 2; ++ai)
#pragma unroll
            for (int m = 0; m < 4; ++m) { const int row = row0 + ai * HALF + m * 16; const float sc = rowg[row];
#pragma unroll
                for (int bj = 0; bj < 2; ++bj) { const f32x4 v0 = acc[ai][bj][m][0], v1 = acc[ai][bj][m][1];
                    u32x4 w; w.x = pk2((v0[0] + bv[bj][0]) * sc, (v0[1] + bv[bj][1]) * sc); w.y = pk2((v0[2] + bv[bj][2]) * sc, (v0[3] + bv[bj][3]) * sc);
                    w.z = pk2((v1[0] + bv[bj][4]) * sc, (v1[1] + bv[bj][5]) * sc); w.w = pk2((v1[2] + bv[bj][6]) * sc, (v1[3] + bv[bj][7]) * sc);
                    *(u32x4*)(Y + (size_t)row * 1024 + col0 + bj * HALF) = w; } }
    }
};
}

struct Args { const float* in[32]; float* out; unsigned char* ws; int ph_lo, ph_hi; };
enum { I_X = 0, I_ANG, I_WIN, I_QG, I_KCG, I_KSG, I_KWG, I_CKPOS, I_CKW1, I_CKB1, I_CKW2, I_CKB2, I_CVPOS, I_CVW1, I_CVB1, I_CVW2, I_CVB2,
       I_NSAOG, I_CONVW, I_ALOG, I_DTB, I_GDNOG, I_WOUT, I_FFNG, I_RW, I_RB, I_EWG, I_EBG, I_EWU, I_EBU, I_EWD, I_EBD };

DI void p0_transpose_item(const float* W, int K, int N, bf16_t* WT, long row_off, float* scr, int item, int lane) {
    const int nblk = N / 32, kb = item / nblk, nb = item % nblk, k0 = 64 * kb, n0 = 32 * nb;
#pragma unroll 8
    for (int i = 0; i < 32; ++i) { const int kk = 2 * i + (lane >> 5); scr[kk * 33 + (lane & 31)] = W[(size_t)(k0 + kk) * N + n0 + (lane & 31)]; }
    __builtin_amdgcn_s_waitcnt(0xC07F); asm volatile("" ::: "memory");
    const int c = lane & 7;
#pragma unroll
    for (int j = 0; j < 4; ++j) { const int n = (lane >> 3) + 8 * j; const float* s = scr + (8 * c) * 33 + n;
        u32x4 o; o.x = pk2(s[0 * 33], s[1 * 33]); o.y = pk2(s[2 * 33], s[3 * 33]); o.z = pk2(s[4 * 33], s[5 * 33]); o.w = pk2(s[6 * 33], s[7 * 33]);
        *(u32x4*)(WT + (size_t)(row_off + n0 + n) * K + k0 + 8 * c) = o; }
    __builtin_amdgcn_s_waitcnt(0xC07F); asm volatile("" ::: "memory");
}

DI void p0_transpose_item64(const float* W, int K, int N, bf16_t* WT, long row_off, float* scr, int kb, int nb, int lane) {
    const int k0 = 64 * kb, n0 = 64 * nb, c4 = (lane & 15) * 4, kr = lane >> 4;
    f32x4 v[16];
#pragma unroll
    for (int i = 0; i < 16; ++i) v[i] = *(const f32x4*)(W + (size_t)(k0 + 4 * i + kr) * N + n0 + c4);
#pragma unroll
    for (int i = 0; i < 16; ++i) { float* d = scr + (4 * i + kr) * 65 + c4; d[0] = v[i][0]; d[1] = v[i][1]; d[2] = v[i][2]; d[3] = v[i][3]; }
    __builtin_amdgcn_s_waitcnt(0xC07F); asm volatile("" ::: "memory");
    const int nn = lane >> 3, cc = lane & 7;
#pragma unroll
    for (int it = 0; it < 8; ++it) { const int n = 8 * it + nn; const float* s = scr + (8 * cc) * 65 + n;
        u32x4 o; o.x = pk2(s[0 * 65], s[1 * 65]); o.y = pk2(s[2 * 65], s[3 * 65]); o.z = pk2(s[4 * 65], s[5 * 65]); o.w = pk2(s[6 * 65], s[7 * 65]);
        *(u32x4*)(WT + (size_t)(row_off + n0 + n) * K + k0 + 8 * cc) = o; }
    __builtin_amdgcn_s_waitcnt(0xC07F); asm volatile("" ::: "memory");
}

DI void phase0(const Args& A, unsigned char* lds, bool first) {
    const int tid = otid(), lane = tid & 63, wave = tid >> 6, G = gridDim.x;
    const int gw = blockIdx.x * 8 + wave, NGW = G * 8;
    float* scr = (float*)(lds + wave * 17408);
    unsigned char* ws = A.ws;
    constexpr int I_IN = 16 * 105, I_OUT = 16 * 32, I_C1 = 32 * 8, I_C2 = 4 * 2, I_EX = 16 * 32;
    constexpr int NIT = I_IN + I_OUT + 2 * I_C1 + 2 * I_C2;
    for (int it = gw; it < NIT; it += NGW) {
        int r = it;
        if (r < I_IN) { p0_transpose_item(A.in[I_WIN], 1024, INW, (bf16_t*)(ws + WS_WTIN), 0, scr, r, lane); continue; } r -= I_IN;
        if (r < I_OUT) { p0_transpose_item(A.in[I_WOUT], 1024, 1024, (bf16_t*)(ws + WS_WTOUT), 0, scr, r, lane); continue; } r -= I_OUT;
        if (r < I_C1) { p0_transpose_item(A.in[I_CKW1], 2048, 256, (bf16_t*)(ws + WS_WTC1K), 0, scr, r, lane); continue; } r -= I_C1;
        if (r < I_C1) { p0_transpose_item(A.in[I_CVW1], 2048, 256, (bf16_t*)(ws + WS_WTC1V), 0, scr, r, lane); continue; } r -= I_C1;
        if (r < I_C2) { p0_transpose_item(A.in[I_CKW2], 256, 64, (bf16_t*)(ws + WS_WTC2K), 0, scr, r, lane); continue; } r -= I_C2;
        if (r < I_C2) { p0_transpose_item(A.in[I_CVW2], 256, 64, (bf16_t*)(ws + WS_WTC2V), 0, scr, r, lane); continue; }
    }
    for (int it = gw; it < 96 * 256; it += NGW) { const int mat = it >> 8, item = it & 255, kb = item >> 4, nb = item & 15, e = mat / 3, which = mat % 3;
        if (which == 2) p0_transpose_item64(A.in[I_EWD] + (size_t)e * 1048576, 1024, 1024, (bf16_t*)(ws + WS_EXPD), (long)e * 1024, scr, kb, nb, lane);
        else { const int n0 = 64 * nb; const long dest0 = (long)e * 2048 + (n0 >> 7) * 256 + (n0 & 127) + (which ? 128 : 0);
            p0_transpose_item64(A.in[which ? I_EWU : I_EWG] + (size_t)e * 1048576, 1024, 1024, (bf16_t*)(ws + WS_EXPGU), dest0 - n0, scr, kb, nb, lane); }
    }
    { const float* gain = A.in[I_ANG]; f32x4 gv[4];
#pragma unroll
      for (int j = 0; j < 4; ++j) gv[j] = *(const f32x4*)(gain + 4 * lane + 256 * j);
      for (int m = gw; m < NTOK; m += NGW) { const f32x4* xr = (const f32x4*)(A.in[I_X] + (size_t)m * D) + lane; f32x4 v[4]; float s = 0.f;
#pragma unroll
        for (int j = 0; j < 4; ++j) { v[j] = xr[64 * j]; s += v[j].x * v[j].x + v[j].y * v[j].y + v[j].z * v[j].z + v[j].w * v[j].w; }
        const float rs = rsqrtf(wave_sum(s) * (1.f / D) + EPS);
        u32x2* o = (u32x2*)((bf16_t*)(ws + WS_XN) + (size_t)m * D) + lane;
#pragma unroll
        for (int j = 0; j < 4; ++j) { u32x2 w; w.x = pk2(v[j].x * rs * gv[j].x, v[j].y * rs * gv[j].y); w.y = pk2(v[j].z * rs * gv[j].z, v[j].w * rs * gv[j].w); o[64 * j] = w; } } }
    { u32x4* p = (u32x4*)((bf16_t*)(ws + WS_WTIN) + (size_t)INW * 1024); const int n16 = (INWP - INW) * 1024 * 2 / 16;
      for (int i = blockIdx.x * 512 + tid; i < n16; i += G * 512) p[i] = (u32x4){0u, 0u, 0u, 0u}; }
    if (first && tid < 256) { for (int task = blockIdx.x; task < 256; task += G) { const int kv = task >> 7, seg = task & 127, j = tid;
        const float* pos = A.in[kv ? I_CVPOS : I_CKPOS] + seg * 16; const float* w1 = A.in[kv ? I_CVW1 : I_CKW1] + (size_t)seg * 16 * 256 + j; float wv[16];
#pragma unroll
        for (int k = 0; k < 16; ++k) wv[k] = w1[k * 256];
        float s = 0.f;
#pragma unroll
        for (int k = 0; k < 16; ++k) s += pos[k] * wv[k];
        ((float*)(ws + WS_PB1P))[seg * 512 + kv * 256 + j] = s; } }
}

DI void nsa_prep_task(const Args& A, int task, unsigned char* lds) {
    const int tid = otid(), lane = tid & 63, wave = tid >> 6;
    const int b = task >> 7, n = task & 127;
    unsigned char* ws = A.ws; const bf16_t* U = (const bf16_t*)(ws + WS_U);
    bf16_t* vsL = (bf16_t*)lds;
    for (int ti = 0; ti < 8; ++ti) {
        const int tl = wave * 8 + ti, t = n * 64 + tl; const size_t tok = (size_t)b * T + t; const bf16_t* ur = U + tok * INWP;
        { const u32x4 w = *(const u32x4*)(ur + C_Q + 8 * lane); float f[8] = {bflo(w.x), bfhi(w.x), bflo(w.y), bfhi(w.y), bflo(w.z), bfhi(w.z), bflo(w.w), bfhi(w.w)};
          float s = 0.f;
#pragma unroll
          for (int i = 0; i < 8; ++i) s += f[i] * f[i];
          s += __shfl_xor(s, 1); s += __shfl_xor(s, 2); s += __shfl_xor(s, 4);
          const float rs = rsqrtf(s * (1.f / 64.f) + EPS) * (0.125f * LOG2E); const float* gq = A.in[I_QG] + (8 * lane & 63);
          u32x4 o; o.x = pk2(f[0] * rs * gq[0], f[1] * rs * gq[1]); o.y = pk2(f[2] * rs * gq[2], f[3] * rs * gq[3]); o.z = pk2(f[4] * rs * gq[4], f[5] * rs * gq[5]); o.w = pk2(f[6] * rs * gq[6], f[7] * rs * gq[7]);
          *(u32x4*)((bf16_t*)(ws + WS_QN) + tok * 512 + 8 * lane) = o; }
        if (lane < 32) { const int sel = lane >> 4, l16 = lane & 15, g = l16 >> 3, d0 = (l16 & 7) * 8;
          const u32x4 w = *(const u32x4*)(ur + (sel ? C_KW : C_KS) + 8 * l16); float f[8] = {bflo(w.x), bfhi(w.x), bflo(w.y), bfhi(w.y), bflo(w.z), bfhi(w.z), bflo(w.w), bfhi(w.w)};
          float s = 0.f;
#pragma unroll
          for (int i = 0; i < 8; ++i) s += f[i] * f[i];
          s += __shfl_xor(s, 1); s += __shfl_xor(s, 2); s += __shfl_xor(s, 4);
          const float rs = rsqrtf(s * (1.f / 64.f) + EPS); const float* gk = A.in[sel ? I_KWG : I_KSG] + d0;
          u32x4 o; o.x = pk2(f[0] * rs * gk[0], f[1] * rs * gk[1]); o.y = pk2(f[2] * rs * gk[2], f[3] * rs * gk[3]); o.z = pk2(f[4] * rs * gk[4], f[5] * rs * gk[5]); o.w = pk2(f[6] * rs * gk[6], f[7] * rs * gk[7]);
          *(u32x4*)((bf16_t*)(ws + (sel ? WS_KWN : WS_KSN)) + ((size_t)(b * 2 + g) * T + t) * 64 + d0) = o; }
        else { const int l32 = lane - 32, sel = l32 >> 4, l16 = l32 & 15, g = l16 >> 3, d0 = (l16 & 7) * 8;
          const u32x4 w = *(const u32x4*)(ur + (sel ? C_VW : C_VS) + 8 * l16);
          const int pos = (tl & ~15) + perm16inv(tl & 15); bf16_t* dst = vsL + ((sel * 2 + g) * 64 + d0) * 64 + pos;
          dst[0 * 64] = (bf16_t)(w.x & 0xffff); dst[1 * 64] = (bf16_t)(w.x >> 16); dst[2 * 64] = (bf16_t)(w.y & 0xffff); dst[3 * 64] = (bf16_t)(w.y >> 16);
          dst[4 * 64] = (bf16_t)(w.z & 0xffff); dst[5 * 64] = (bf16_t)(w.z >> 16); dst[6 * 64] = (bf16_t)(w.w & 0xffff); dst[7 * 64] = (bf16_t)(w.w >> 16); }
        if (lane < 24) ((float*)(ws + WS_GATES))[tok * 24 + lane] = sigm(bf2f(ur[C_GATE + lane]));
    }
    __syncthreads();
    for (int c = tid; c < 2048; c += 512) { const int sel = c >> 10, g = (c >> 9) & 1, rem = c & 511;
        const u32x4 v = *(const u32x4*)(vsL + ((sel * 2 + g) * 64) * 64 + rem * 8);
        *(u32x4*)((bf16_t*)(ws + (sel ? WS_VWT : WS_VST)) + ((size_t)(b * 2 + g) * 128 + n) * 4096 + rem * 8) = v; }
    __syncthreads();
}

DI void compress_task(const Args& A, int task, unsigned char* lds) {
    const int tid = otid(), lane = tid & 63, wave = __builtin_amdgcn_readfirstlane(tid >> 6), r32 = lane & 31, hh = lane >> 5;
    const int kv = task >> 6, b = (task >> 5) & 1, g = (task >> 4) & 1, ct = task & 15, c0 = 32 * ct;
    unsigned char* ws = A.ws; const bf16_t* U = (const bf16_t*)(ws + WS_U);
    bf16_t* hidL = (bf16_t*)lds;
    float* outL = (float*)(lds + 16896);
    const int colbase = (kv ? C_VC : C_KC) + g * 64;
    const bf16_t* W1T = (const bf16_t*)(ws + (kv ? WS_WTC1V : WS_WTC1K));
    const bf16_t* W2T = (const bf16_t*)(ws + (kv ? WS_WTC2V : WS_WTC2K));
    {   int c = c0 + r32; if (c > 510) c = 510;
        const bf16_t* arow = U + ((size_t)b * T + 16 * c) * INWP + colbase + 8 * hh;
        const bf16_t* brow = W1T + (size_t)(32 * wave + r32) * 2048 + 8 * hh;
        f32x16 acc; for (int i = 0; i < 16; ++i) acc[i] = 0.f;
#pragma unroll 4
        for (int l = 0; l < 32; ++l) {
#pragma unroll
            for (int s = 0; s < 4; ++s) { const bf16x8 af = *(const bf16x8*)(arow + (size_t)l * INWP + 16 * s); const bf16x8 bf = *(const bf16x8*)(brow + l * 64 + 16 * s); acc = MFMA32(af, bf, acc); } }
        const int j = 32 * wave + r32; float pb = A.in[kv ? I_CVB1 : I_CKB1][j];
#pragma unroll
        for (int sg = 0; sg < 128; ++sg) pb += ((const float*)(ws + WS_PB1P))[sg * 512 + kv * 256 + j];
#pragma unroll
        for (int r = 0; r < 16; ++r) { const float x = acc[r] + pb; const float y = x * sigm(1.5957691216057308f * (x + 0.044715f * x * x * x)); hidL[crow(r, hh) * 264 + j] = f2bf(y); }
    }
    __syncthreads();
    if (wave < 2) { f32x16 acc; for (int i = 0; i < 16; ++i) acc[i] = 0.f;
#pragma unroll
        for (int s = 0; s < 16; ++s) { const bf16x8 af = *(const bf16x8*)(hidL + r32 * 264 + 16 * s + 8 * hh); const bf16x8 bf = *(const bf16x8*)(W2T + (size_t)(32 * wave + r32) * 256 + 16 * s + 8 * hh); acc = MFMA32(af, bf, acc); }
        const int d = 32 * wave + r32; const float b2 = A.in[kv ? I_CVB2 : I_CKB2][d];
#pragma unroll
        for (int r = 0; r < 16; ++r) outL[crow(r, hh) * 65 + d] = acc[r] + b2; }
    __syncthreads();
    if (kv == 0) { if (tid < 256) { const int cl = tid >> 3, sub = tid & 7; float f[8]; float s = 0.f;
#pragma unroll
            for (int i = 0; i < 8; ++i) { f[i] = outL[cl * 65 + 8 * sub + i]; s += f[i] * f[i]; }
            s += __shfl_xor(s, 1); s += __shfl_xor(s, 2); s += __shfl_xor(s, 4);
            const float rs = (c0 + cl > 510) ? 0.f : rsqrtf(s * (1.f / 64.f) + EPS); const float* gk = A.in[I_KCG] + 8 * sub;
            u32x4 o; o.x = pk2(f[0] * rs * gk[0], f[1] * rs * gk[1]); o.y = pk2(f[2] * rs * gk[2], f[3] * rs * gk[3]); o.z = pk2(f[4] * rs * gk[4], f[5] * rs * gk[5]); o.w = pk2(f[6] * rs * gk[6], f[7] * rs * gk[7]);
            *(u32x4*)((bf16_t*)(ws + WS_KC) + ((size_t)(b * 2 + g) * 512 + c0 + cl) * 64 + 8 * sub) = o; } }
    else { const int d = tid >> 3, part = tid & 7, p0 = 4 * part, gi = p0 >> 4, cl0 = 16 * gi + perm16(p0 & 15); float f[4];
#pragma unroll
        for (int i = 0; i < 4; ++i) f[i] = (c0 + cl0 + i > 510) ? 0.f : outL[(cl0 + i) * 65 + d];
        u32x2 o; o.x = pk2(f[0], f[1]); o.y = pk2(f[2], f[3]);
        *(u32x2*)((bf16_t*)(ws + WS_VCT) + ((size_t)(b * 2 + g) * 64 + d) * 512 + c0 + p0) = o; }
    __syncthreads();
}

DI void gdn_chunk_task(const Args& A, int task, unsigned char* lds) {
    const int tid = otid(), lane = tid & 63, wave = __builtin_amdgcn_readfirstlane(tid >> 6), r32 = lane & 31, hh = lane >> 5;
    const int b = task >> 9, h = (task >> 7) & 3, ch = task & 127, t0 = ch * 64; const size_t tok0 = (size_t)b * T + t0;
    unsigned char* ws = A.ws; const bf16_t* U = (const bf16_t*)(ws + WS_U);
    float* qL = (float*)lds; float* kL = qL + 64 * 132; float* vL = kL + 64 * 132; float* Lm = vL + 64 * 132; float* Qm = Lm + 64 * 68;
    float* gcL = Qm + 64 * 68; float* betaL = gcL + 64; float* egL = betaL + 64; float* kdsL = egL + 64;
    { const int c = tid & 127, part = tid >> 7;
#pragma unroll
      for (int s = 0; s < 3; ++s) { const int col = (s == 0 ? C_GQ : s == 1 ? C_GK : C_GV) + h * 128 + c; const float* cw = A.in[I_CONVW] + s * 512 + h * 128 + c;
        const float w0 = cw[0], w1 = cw[1536], w2 = cw[3072], w3 = cw[4608]; float* dst = (s == 0 ? qL : s == 1 ? kL : vL);
        const int tl0 = 16 * part; float x3, x2, x1;
        { const int tg = t0 + tl0; x3 = (tg - 3 >= 0) ? bf2f(U[(tok0 + tl0 - 3) * INWP + col]) : 0.f; x2 = (tg - 2 >= 0) ? bf2f(U[(tok0 + tl0 - 2) * INWP + col]) : 0.f; x1 = (tg - 1 >= 0) ? bf2f(U[(tok0 + tl0 - 1) * INWP + col]) : 0.f; }
#pragma unroll 4
        for (int i = 0; i < 16; ++i) { const float xt = bf2f(U[(tok0 + tl0 + i) * INWP + col]); const float y = w0 * x3 + w1 * x2 + w2 * x1 + w3 * xt;
            dst[(tl0 + i) * 132 + c] = y * sigm(y); x3 = x2; x2 = x1; x1 = xt; } } }
    if (tid < 64) { const int tl = tid; const float a = bf2f(U[(tok0 + tl) * INWP + C_GA + h]), bb = bf2f(U[(tok0 + tl) * INWP + C_GB + h]);
        const float x = a + A.in[I_DTB][h]; const float sp = (x > 20.f) ? x : log1pf(__expf(x)); float gt = -__expf(A.in[I_ALOG][h]) * sp;
#pragma unroll
        for (int o = 1; o < 64; o <<= 1) { const float v = __shfl_up(gt, o); if (lane >= o) gt += v; }
        const float g63 = __shfl(gt, 63);
        gcL[tl] = gt; betaL[tl] = sigm(bb); egL[tl] = __expf(gt); kdsL[tl] = __expf(g63 - gt);
        if (tl == 63) ((float*)(ws + WS_GL))[task] = __expf(gt); }
    __syncthreads();
    { const int tl = tid >> 3, sub = tid & 7; float sq = 0.f, sk = 0.f;
#pragma unroll
      for (int i = 0; i < 16; ++i) { const float a = qL[tl * 132 + sub * 16 + i], c = kL[tl * 132 + sub * 16 + i]; sq += a * a; sk += c * c; }
      sq += __shfl_xor(sq, 1); sq += __shfl_xor(sq, 2); sq += __shfl_xor(sq, 4); sk += __shfl_xor(sk, 1); sk += __shfl_xor(sk, 2); sk += __shfl_xor(sk, 4);
      const float rq = rsqrtf(sq + EPS) * 0.08838834764831845f, rk = rsqrtf(sk + EPS);
#pragma unroll
      for (int i = 0; i < 16; ++i) { qL[tl * 132 + sub * 16 + i] *= rq; kL[tl * 132 + sub * 16 + i] *= rk; } }
    __syncthreads();
    { const int mat = wave >> 2, mi = (wave >> 1) & 1, ni = wave & 1; const float* X = mat ? qL : kL;
      f32x16 acc; for (int i = 0; i < 16; ++i) acc[i] = 0.f;
#pragma unroll
      for (int s = 0; s < 8; ++s) { const f32x4 a0 = *(const f32x4*)(X + (32 * mi + r32) * 132 + 16 * s + 8 * hh), a1 = *(const f32x4*)(X + (32 * mi + r32) * 132 + 16 * s + 8 * hh + 4);
          const f32x4 b0 = *(const f32x4*)(kL + (32 * ni + r32) * 132 + 16 * s + 8 * hh), b1 = *(const f32x4*)(kL + (32 * ni + r32) * 132 + 16 * s + 8 * hh + 4);
          acc = MFMA32(pack8(a0[0], a0[1], a0[2], a0[3], a1[0], a1[1], a1[2], a1[3]), pack8(b0[0], b0[1], b0[2], b0[3], b1[0], b1[1], b1[2], b1[3]), acc); }
      const int sc = 32 * ni + r32; const float gs = gcL[sc];
#pragma unroll
      for (int r = 0; r < 16; ++r) { const int c = 32 * mi + crow(r, hh); const float dec = __expf(gcL[c] - gs);
          if (mat == 0) Lm[c * 68 + sc] = (c > sc) ? betaL[c] * acc[r] * dec : 0.f; else Qm[c * 68 + sc] = (c >= sc) ? acc[r] * dec : 0.f; } }
    __syncthreads();
    {   bf16_t* QGp = (bf16_t*)(ws + WS_QGP) + (size_t)task * 8192; bf16_t* KDTp = (bf16_t*)(ws + WS_KDTP) + (size_t)task * 8192; bf16_t* QKp = (bf16_t*)(ws + WS_QKP) + (size_t)task * 4096;
        for (int id = tid; id < 1024; id += 512) { const int c = id >> 4, chn = id & 15, ks = chn >> 2, q = chn & 3; const float e = egL[c];
            const f32x4 a = *(const f32x4*)(qL + c * 132 + 32 * ks + 4 * q), bq = *(const f32x4*)(qL + c * 132 + 32 * ks + 16 + 4 * q);
            *(bf16x8*)(QGp + id * 8) = pack8(a[0] * e, a[1] * e, a[2] * e, a[3] * e, bq[0] * e, bq[1] * e, bq[2] * e, bq[3] * e); }
        for (int id = tid; id < 1024; id += 512) { const int d = id >> 3, chn = id & 7, ks = chn >> 2, q = chn & 3; float f[8];
#pragma unroll
            for (int j = 0; j < 8; ++j) { const int s = 32 * ks + 16 * (j >> 2) + 4 * q + (j & 3); f[j] = kL[s * 132 + d] * kdsL[s]; }
            *(bf16x8*)(KDTp + id * 8) = pack8(f[0], f[1], f[2], f[3], f[4], f[5], f[6], f[7]); }
        { const int id = tid; const int c = id >> 3, chn = id & 7, ks = chn >> 2, q = chn & 3;
            const f32x4 a = *(const f32x4*)(Qm + c * 68 + 32 * ks + 4 * q), bq = *(const f32x4*)(Qm + c * 68 + 32 * ks + 16 + 4 * q);
            *(bf16x8*)(QKp + id * 8) = pack8(a[0], a[1], a[2], a[3], bq[0], bq[1], bq[2], bq[3]); } }
    __syncthreads();
    if (tid < 256) { const bool isW = tid >= 128; float* col = (isW ? kL : vL) + (tid & 127);
#pragma unroll 1
        for (int bi = 0; bi < 4; ++bi) {
            float r[16];
#pragma unroll
            for (int ii = 0; ii < 16; ++ii) { const int i = 16 * bi + ii; float v = col[i * 132] * betaL[i]; if (isW) v *= egL[i]; r[ii] = v; }
#pragma unroll 1
            for (int j = 0; j < 16 * bi; j += 4) {
                const float x0 = col[j * 132], x1 = col[(j + 1) * 132], x2 = col[(j + 2) * 132], x3 = col[(j + 3) * 132];
#pragma unroll
                for (int ii = 0; ii < 16; ++ii) { const f32x4 l4 = *(const f32x4*)(Lm + (16 * bi + ii) * 68 + j); r[ii] -= (l4[0] * x0 + l4[1] * x1) + (l4[2] * x2 + l4[3] * x3); } }
#pragma unroll
            for (int ii = 1; ii < 16; ++ii) {
#pragma unroll
                for (int j4 = 0; j4 < (ii + 3) / 4; ++j4) { const f32x4 l4 = *(const f32x4*)(Lm + (16 * bi + ii) * 68 + 16 * bi + 4 * j4);
#pragma unroll
                    for (int jj = 0; jj < 4; ++jj) if (4 * j4 + jj < ii) r[ii] -= l4[jj] * r[4 * j4 + jj]; } }
#pragma unroll
            for (int ii = 0; ii < 16; ++ii) col[(16 * bi + ii) * 132] = r[ii];
        } }
    __syncthreads();
    { bf16_t* Wp = (bf16_t*)(ws + WS_WP) + (size_t)task * 8192; bf16_t* Up = (bf16_t*)(ws + WS_UP) + (size_t)task * 8192;
      for (int id = tid; id < 1024; id += 512) { const int c = id >> 4, chn = id & 15, ks = chn >> 2, q = chn & 3;
          const f32x4 a = *(const f32x4*)(kL + c * 132 + 32 * ks + 4 * q), bq = *(const f32x4*)(kL + c * 132 + 32 * ks + 16 + 4 * q);
          *(bf16x8*)(Wp + id * 8) = pack8(a[0], a[1], a[2], a[3], bq[0], bq[1], bq[2], bq[3]); }
      for (int id = tid; id < 2048; id += 512) { const int ln = id & 63, mt = (id >> 6) & 3, es = id >> 8, q = ln >> 4, e = ln & 15; const int c = 16 * mt + 4 * q, col = 16 * es + e;
          u32x2 o; o.x = pk2(vL[c * 132 + col], vL[(c + 1) * 132 + col]); o.y = pk2(vL[(c + 2) * 132 + col], vL[(c + 3) * 132 + col]);
          *(u32x2*)(Up + id * 4) = o; } }
    __syncthreads();
}

constexpr int SC_W = 0, SC_QG = 17408, SC_KD = 34816, SC_QK = 53248, SC_UP = 62464, SC_BUF = 64512;
DI void gdn_scan_block(const Args& A, int sidx, unsigned char* lds) {
    const int tid = otid(), lane = tid & 63, wave = __builtin_amdgcn_readfirstlane(tid >> 6);
    const int es = sidx & 7, bh = sidx >> 3, b = bh >> 2, h = bh & 3, r16 = lane & 15, q = lane >> 4;
    unsigned char* ws = A.ws;
    const bf16_t* WP = (const bf16_t*)(ws + WS_WP) + (size_t)bh * 128 * 8192; const bf16_t* QGP = (const bf16_t*)(ws + WS_QGP) + (size_t)bh * 128 * 8192;
    const bf16_t* KDTP = (const bf16_t*)(ws + WS_KDTP) + (size_t)bh * 128 * 8192; const bf16_t* QKP = (const bf16_t*)(ws + WS_QKP) + (size_t)bh * 128 * 4096;
    const bf16_t* UP = (const bf16_t*)(ws + WS_UP) + (size_t)bh * 128 * 8192 + es * 1024;
    if (wave != 0) {
        const int lt = tid - 64; u32x4 R[9]; const u32x4 z4 = (u32x4){0u, 0u, 0u, 0u};
        const bf16_t* sp[9]; int dof[9], stp[9];
#pragma unroll
        for (int j = 0; j < 9; ++j) { const int c = lt + 448 * j;
            if (c < 1024) { sp[j] = WP + c * 8; dof[j] = SC_W + (c >> 4) * 272 + (c & 15) * 16; stp[j] = 8192; }
            else if (c < 2048) { const int cc = c - 1024; sp[j] = QGP + cc * 8; dof[j] = SC_QG + (cc >> 4) * 272 + (cc & 15) * 16; stp[j] = 8192; }
            else if (c < 3072) { const int cc = c - 2048; sp[j] = KDTP + cc * 8; dof[j] = SC_KD + (cc >> 3) * 144 + (cc & 7) * 16; stp[j] = 8192; }
            else if (c < 3584) { const int cc = c - 3072; sp[j] = QKP + cc * 8; dof[j] = SC_QK + (cc >> 3) * 144 + (cc & 7) * 16; stp[j] = 4096; }
            else if (c < 3712) { const int cc = c - 3584; sp[j] = UP + cc * 8; dof[j] = SC_UP + cc * 16; stp[j] = 8192; }
            else { sp[j] = nullptr; dof[j] = 0; stp[j] = 0; } }
#define SC_LOAD(i_) do { _Pragma("unroll") for (int j = 0; j < 9; ++j) R[j] = sp[j] ? *(const u32x4*)(sp[j] + (size_t)(i_) * stp[j]) : z4; } while (0)
#define SC_WRITE(bufi_) do { _Pragma("unroll") for (int j = 0; j < 9; ++j) if (sp[j]) *(u32x4*)(lds + (bufi_) * SC_BUF + dof[j]) = R[j]; } while (0)
        SC_LOAD(0); SC_WRITE(0); SC_LOAD(1);
        __syncthreads();
        for (int i = 0; i < 128; ++i) {
            if (i + 1 < 128) SC_WRITE((i + 1) & 1);
            if (i + 2 < 128) SC_LOAD(i + 2);
            __syncthreads(); }
#undef SC_LOAD
#undef SC_WRITE
        return;
    }
    const float* GL = (const float*)(ws + WS_GL) + bh * 128;
    bf16_t* OG = (bf16_t*)(ws + WS_OG);
    f32x4 S[8];
#pragma unroll
    for (int m = 0; m < 8; ++m) S[m] = (f32x4){0.f, 0.f, 0.f, 0.f};
    __syncthreads();
    float gl = GL[0];
    for (int i = 0; i < 128; ++i) {
        const unsigned char* bufp = lds + (i & 1) * SC_BUF;
        const unsigned char* wp = bufp + SC_W + r16 * 272 + 16 * q; const unsigned char* qgp = bufp + SC_QG + r16 * 272 + 16 * q;
        const unsigned char* kdp = bufp + SC_KD + r16 * 144 + 16 * q; const unsigned char* qkp = bufp + SC_QK + r16 * 144 + 16 * q;
        const unsigned char* up = bufp + SC_UP + lane * 8;
        const float gln = GL[(i + 1) & 127];
        bf16x8 Sb[4];
#pragma unroll
        for (int ks = 0; ks < 4; ++ks) Sb[ks] = pack8(S[2 * ks][0], S[2 * ks][1], S[2 * ks][2], S[2 * ks][3], S[2 * ks + 1][0], S[2 * ks + 1][1], S[2 * ks + 1][2], S[2 * ks + 1][3]);
        f32x4 vn[4];
#pragma unroll
        for (int mt = 0; mt < 4; ++mt) { f32x4 acc = (f32x4){0.f, 0.f, 0.f, 0.f};
#pragma unroll
            for (int ks = 0; ks < 4; ++ks) acc = MFMA16(*(const bf16x8*)(wp + mt * 16 * 272 + ks * 64), Sb[ks], acc);
            const u32x2 uw = *(const u32x2*)(up + mt * 512);
            vn[mt] = (f32x4){bflo(uw.x) - acc[0], bfhi(uw.x) - acc[1], bflo(uw.y) - acc[2], bfhi(uw.y) - acc[3]}; }
        bf16x8 Vb[2];
#pragma unroll
        for (int k2 = 0; k2 < 2; ++k2) Vb[k2] = pack8(vn[2 * k2][0], vn[2 * k2][1], vn[2 * k2][2], vn[2 * k2][3], vn[2 * k2 + 1][0], vn[2 * k2 + 1][1], vn[2 * k2 + 1][2], vn[2 * k2 + 1][3]);
        f32x4 Sn[8];
#pragma unroll
        for (int m = 0; m < 8; ++m) { f32x4 acc = S[m] * gl;
#pragma unroll
            for (int k2 = 0; k2 < 2; ++k2) acc = MFMA16(*(const bf16x8*)(kdp + m * 16 * 144 + k2 * 64), Vb[k2], acc);
            Sn[m] = acc; }
#pragma unroll
        for (int mt = 0; mt < 4; ++mt) { f32x4 acc = (f32x4){0.f, 0.f, 0.f, 0.f};
#pragma unroll
            for (int ks = 0; ks < 4; ++ks) acc = MFMA16(*(const bf16x8*)(qgp + mt * 16 * 272 + ks * 64), Sb[ks], acc);
#pragma unroll
            for (int k2 = 0; k2 < 2; ++k2) acc = MFMA16(*(const bf16x8*)(qkp + mt * 16 * 144 + k2 * 64), Vb[k2], acc);
            bf16_t* op = OG + ((size_t)b * T + i * 64 + 16 * mt + 4 * q) * 512 + h * 128 + es * 16 + r16;
            op[0] = f2bf(acc[0]); op[512] = f2bf(acc[1]); op[1024] = f2bf(acc[2]); op[1536] = f2bf(acc[3]); }
#pragma unroll
        for (int m = 0; m < 8; ++m) S[m] = Sn[m];
        gl = gln;
        __syncthreads();
    }
}

DI void tile_load_k(bf16x8 (&kf)[4], const bf16_t* __restrict__ K, int r32, int hh) {
#pragma unroll
    for (int s = 0; s < 4; ++s) kf[s] = *(const bf16x8*)(K + r32 * 64 + 16 * s + 8 * hh); }
DI void tile_load_v(bf16x8 (&vf)[2][2], const bf16_t* __restrict__ VT, int vp, int r32, int hh) {
#pragma unroll
    for (int dt = 0; dt < 2; ++dt)
#pragma unroll
        for (int ks = 0; ks < 2; ++ks) vf[dt][ks] = *(const bf16x8*)(VT + (size_t)(32 * dt + r32) * vp + 16 * ks + 8 * hh); }
DI f32x16 tile_scores(const bf16x8 (&kf)[4], const bf16x8 (&qf)[4], float negM, int hi2, int lo2, float& l) {
    f32x16 st;
#pragma unroll
    for (int i = 0; i < 16; ++i) st[i] = negM;
#pragma unroll
    for (int s = 0; s < 4; ++s) st = MFMA32(kf[s], qf[s], st);
#pragma unroll
    for (int r = 0; r < 16; ++r) { const int cr = (r & 3) + 8 * (r >> 2); float pv = __builtin_amdgcn_exp2f(st[r]); pv = (cr <= hi2 && cr > lo2) ? pv : 0.f; st[r] = pv; l += pv; }
    return st; }
DI void tile_pv(const f32x16& p, const bf16x8 (&vf)[2][2], f32x16 (&o)[2]) {
    const bf16x8 pb0 = pack8(p[0], p[1], p[2], p[3], p[4], p[5], p[6], p[7]), pb1 = pack8(p[8], p[9], p[10], p[11], p[12], p[13], p[14], p[15]);
#pragma unroll
    for (int dt = 0; dt < 2; ++dt) { o[dt] = MFMA32(vf[dt][0], pb0, o[dt]); o[dt] = MFMA32(vf[dt][1], pb1, o[dt]); } }

DI void block_stream(const bf16_t* __restrict__ KB, const bf16_t* __restrict__ VB, int f0, int f1, const bf16x8 (&qf)[4], f32x16 (&o)[2], float& l, float negM, int hi, int lo, int r32, int hh) {
    if (f0 >= f1) return;
    bf16x8 ka[4], kb[4], va[2][2], vb[2][2];
#define BS_LOAD(kx, vx, f_) do { const int n_ = (f_) >> 1, hf_ = (f_) & 1; tile_load_k(kx, KB + ((size_t)n_ * 64 + 32 * hf_) * 64, r32, hh); tile_load_v(vx, VB + (size_t)n_ * 4096 + 32 * hf_, 64, r32, hh); } while (0)
#define BS_COMP(kx, vx, f_) do { const int k0_ = 32 * (f_) + 4 * hh; const f32x16 p_ = tile_scores(kx, qf, negM, hi - k0_, lo - k0_, l); tile_pv(p_, vx, o); } while (0)
    BS_LOAD(ka, va, f0);
#pragma unroll 1
    for (int f = f0; f < f1; f += 2) {
        const bool h1 = f + 1 < f1;
        if (h1) BS_LOAD(kb, vb, f + 1);
        BS_COMP(ka, va, f);
        if (h1) { if (f + 2 < f1) BS_LOAD(ka, va, f + 2); BS_COMP(kb, vb, f + 1); } }
#undef BS_LOAD
#undef BS_COMP
}

DI float maxabs64(const float* g, int lane) { float v = fabsf(g[lane]);
#pragma unroll
    for (int o = 1; o < 64; o <<= 1) v = fmaxf(v, __shfl_xor(v, o));
    return v; }

#define LOADQF(qf) do { _Pragma("unroll") for (int s_ = 0; s_ < 4; ++s_) qf[s_] = *(const bf16x8*)(QL + row * 72 + 16 * s_ + 8 * hh); } while (0)
DI void nsa_unit(const Args& A, int unit, unsigned char* lds) {
    const int tid = otid(), lane = tid & 63, wave = __builtin_amdgcn_readfirstlane(tid >> 6), r32 = lane & 31, hh = lane >> 5;
    const int ti = 127 - (unit >> 2), bg = unit & 3, b = bg >> 1, g = bg & 1;
    unsigned char* ws = A.ws;
    bf16_t* QL = (bf16_t*)lds;
    int* OL = (int*)(lds + 36864);
    int* LL = (int*)(lds + 36864 + 67584);
    unsigned* BM = (unsigned*)(lds + 36864 + 67584 + 1024);
    int* CNT = (int*)(lds + 36864 + 67584 + 2048);
    float* SCL = (float*)(lds + 36864 + 67584 + 2048 + 64);
    float* IMP = (float*)(lds + 108544);
    const int slot = r32 >> 2, hd = r32 & 3, tl = wave * 8 + slot, trow = ti * 64 + tl; const size_t tokg = (size_t)b * T + trow;
    const int row = wave * 32 + r32;
    bf16_t* PA = (bf16_t*)IMP + row * 64;
    const float mq = maxabs64(A.in[I_QG], lane) * 8.08f * LOG2E;
    for (int i = tid; i < 256 + 16; i += 512) BM[i] = 0u;
    { const bf16_t* qp = (const bf16_t*)(ws + WS_QN) + tokg * 512 + (g * 4 + hd) * 64 + 8 * hh;
#pragma unroll
      for (int s = 0; s < 4; ++s) *(bf16x8*)(QL + row * 72 + 16 * s + 8 * hh) = *(const bf16x8*)(qp + 16 * s); }
    const float* gp = (const float*)(ws + WS_GATES) + tokg * 24 + (g * 4 + hd) * 3;
    __syncthreads();
    {   const float negMc = -mq * maxabs64(A.in[I_KCG], lane);
        bf16x8 qf[4]; LOADQF(qf);
        const int cmax_row = (trow >= 31) ? ((trow - 31) >> 4) : -1; const int tmaxw = ti * 64 + wave * 8 + 7; const int ntc = (tmaxw >= 31) ? ((((tmaxw - 31) >> 4) >> 5) + 1) : 0;
        const bf16_t* Kc = (const bf16_t*)(ws + WS_KC) + (size_t)(b * 2 + g) * 512 * 64; const bf16_t* VcT = (const bf16_t*)(ws + WS_VCT) + (size_t)(b * 2 + g) * 64 * 512;
        float lc = 0.f;
        if (ntc > 0) { bf16x8 ka[4], kb[4]; tile_load_k(ka, Kc, r32, hh);
#pragma unroll 1
            for (int ct = 0; ct < ntc; ct += 2) { const bool h1 = ct + 1 < ntc;
                if (h1) tile_load_k(kb, Kc + (ct + 1) * 2048, r32, hh);
                tile_scores(ka, qf, negMc, cmax_row - 32 * ct - 4 * hh, -1000000, lc);
                if (h1) { if (ct + 2 < ntc) tile_load_k(ka, Kc + (ct + 2) * 2048, r32, hh); tile_scores(kb, qf, negMc, cmax_row - 32 * (ct + 1) - 4 * hh, -1000000, lc); } } }
        lc += __shfl_xor(lc, 32);
        const float inv = (lc > 0.f) ? 1.f / lc : 0.f;
        f32x16 oc[2]; for (int i = 0; i < 16; ++i) { oc[0][i] = 0.f; oc[1][i] = 0.f; }
        float carry = 0.f, ldummy = 0.f;
#define CM_POST(p, ct_) do { float recv[4], bq[4]; \
            _Pragma("unroll") for (int jq = 0; jq < 4; ++jq) recv[jq] = __shfl_xor(p[4 * jq + 3], 32); \
            _Pragma("unroll") for (int jq = 0; jq < 4; ++jq) { const float pred = hh ? recv[jq] : (jq ? recv[jq - 1] : carry); float s_ = ((p[4 * jq] + p[4 * jq + 1]) + (p[4 * jq + 2] + p[4 * jq + 3]) + pred) * inv; \
                s_ += __shfl_xor(s_, 1); s_ += __shfl_xor(s_, 2); bq[jq] = s_; } \
            carry = recv[3]; \
            IMP[tl * 128 + 8 * (ct_) + 2 * hd + hh] = (hd == 0) ? bq[0] : (hd == 1) ? bq[1] : (hd == 2) ? bq[2] : bq[3]; } while (0)
        if (ntc > 0) { bf16x8 ka[4], kb[4], va[2][2], vb[2][2]; tile_load_k(ka, Kc, r32, hh); tile_load_v(va, VcT, 512, r32, hh);
#pragma unroll 1
            for (int ct = 0; ct < ntc; ct += 2) { const bool h1 = ct + 1 < ntc;
                if (h1) { tile_load_k(kb, Kc + (ct + 1) * 2048, r32, hh); tile_load_v(vb, VcT + (ct + 1) * 32, 512, r32, hh); }
                { const f32x16 p = tile_scores(ka, qf, negMc, cmax_row - 32 * ct - 4 * hh, -1000000, ldummy); tile_pv(p, va, oc); CM_POST(p, ct); }
                if (h1) { if (ct + 2 < ntc) { tile_load_k(ka, Kc + (ct + 2) * 2048, r32, hh); tile_load_v(va, VcT + (ct + 2) * 32, 512, r32, hh); }
                    const f32x16 p = tile_scores(kb, qf, negMc, cmax_row - 32 * (ct + 1) - 4 * hh, -1000000, ldummy); tile_pv(p, vb, oc); CM_POST(p, ct + 1); } } }
#undef CM_POST
        for (int ct = ntc; ct < 16; ++ct) IMP[tl * 128 + 8 * ct + 2 * hd + hh] = 0.f;
        if (ti >= 3) {
            __builtin_amdgcn_s_waitcnt(0xC07F); asm volatile("" ::: "memory");
            unsigned key[16]; const int li = hd + 4 * hh;
#pragma unroll
            for (int i4 = 0; i4 < 4; ++i4) { const f32x4 v4 = *(const f32x4*)(IMP + tl * 128 + li * 16 + 4 * i4);
#pragma unroll
                for (int i = 0; i < 4; ++i) { const int n = li * 16 + 4 * i4 + i; key[4 * i4 + i] = (n >= 1 && n <= ti - 2) ? ((__float_as_uint(fmaxf(v4[i], 0.f)) & ~0xFFu) | (unsigned)(128 - n)) : 0u; } }
#pragma unroll 1
            for (int it = 0; it < 13; ++it) { unsigned m = key[0];
#pragma unroll
                for (int i = 1; i < 16; ++i) m = (key[i] > m) ? key[i] : m;
                { unsigned o_; o_ = __shfl_xor(m, 1); m = o_ > m ? o_ : m; o_ = __shfl_xor(m, 2); m = o_ > m ? o_ : m; o_ = __shfl_xor(m, 32); m = o_ > m ? o_ : m; }
#pragma unroll
                for (int i = 0; i < 16; ++i) key[i] = (key[i] == m) ? 0u : key[i];
                if (m != 0u && hd == 0 && hh == 0) { const int nsel = 128 - (int)(m & 0xFFu); atomicOr(&BM[nsel * 2 + (tl >> 5)], 1u << (tl & 31)); } }
        }
        __builtin_amdgcn_s_waitcnt(0xC07F); asm volatile("" ::: "memory");
        { const float sc = gp[0] * inv;
#pragma unroll
          for (int dt = 0; dt < 2; ++dt)
#pragma unroll
              for (int r4 = 0; r4 < 4; ++r4) { u32x2 o; o.x = pk2(oc[dt][4 * r4] * sc, oc[dt][4 * r4 + 1] * sc); o.y = pk2(oc[dt][4 * r4 + 2] * sc, oc[dt][4 * r4 + 3] * sc);
                  *(u32x2*)(PA + 32 * dt + 8 * r4 + 4 * hh) = o; } }
    }
    const float negMs = -mq * maxabs64(A.in[I_KSG], lane);
    const bf16_t* KS = (const bf16_t*)(ws + WS_KSN) + (size_t)(b * 2 + g) * T * 64; const bf16_t* VS = (const bf16_t*)(ws + WS_VST) + (size_t)(b * 2 + g) * 128 * 4096;
    { bf16x8 qf[4]; LOADQF(qf);
      f32x16 os[2]; float lsel = 0.f; for (int i = 0; i < 16; ++i) { os[0][i] = 0.f; os[1][i] = 0.f; }
      block_stream(KS, VS, (ti >= 1 ? 2 * ti - 2 : 0), 2 * ti + 2, qf, os, lsel, negMs, trow, -1, r32, hh);
      if (ti >= 2) block_stream(KS, VS, 0, 2, qf, os, lsel, negMs, trow, -1, r32, hh);
      lsel += __shfl_xor(lsel, 32);
      const float scl = 1048576.0f / lsel;
#pragma unroll
      for (int dt = 0; dt < 2; ++dt)
#pragma unroll
          for (int r = 0; r < 16; ++r) OL[row * 66 + 32 * dt + crow(r, hh)] = __float2int_rn(os[dt][r] * scl);
      if (hh == 0) { LL[row] = __float2int_rn(lsel * scl); SCL[row] = scl; } }
    { const bf16_t* KW = (const bf16_t*)(ws + WS_KWN) + (size_t)(b * 2 + g) * T * 64; const bf16_t* VW = (const bf16_t*)(ws + WS_VWT) + (size_t)(b * 2 + g) * 128 * 4096;
      const float negMw = -mq * maxabs64(A.in[I_KWG], lane);
      bf16x8 qf[4]; LOADQF(qf);
      f32x16 ow[2]; float lw = 0.f; for (int i = 0; i < 16; ++i) { ow[0][i] = 0.f; ow[1][i] = 0.f; }
      const int tw0 = ti * 64 + wave * 8; const int nlo = (tw0 - 511 > 0) ? ((tw0 - 511) >> 6) : 0;
      block_stream(KW, VW, 2 * nlo, 2 * ti + 2, qf, ow, lw, negMw, trow, trow - 512, r32, hh);
      lw += __shfl_xor(lw, 32); const float sc = gp[2] / lw;
#pragma unroll
      for (int dt = 0; dt < 2; ++dt)
#pragma unroll
          for (int r4 = 0; r4 < 4; ++r4) { bf16_t* pp = PA + 32 * dt + 8 * r4 + 4 * hh; const u32x2 pa = *(const u32x2*)pp;
              u32x2 o; o.x = pk2(bflo(pa.x) + ow[dt][4 * r4] * sc, bfhi(pa.x) + ow[dt][4 * r4 + 1] * sc); o.y = pk2(bflo(pa.y) + ow[dt][4 * r4 + 2] * sc, bfhi(pa.y) + ow[dt][4 * r4 + 3] * sc);
              *(u32x2*)pp = o; } }
    __syncthreads();
    if (ti >= 3) {
        unsigned long long m_cur = 0ull; int n_cur = 0;
        int n_a = 0, n_b = 0; unsigned long long m_a = 0ull, m_b = 0ull;
#define ADVANCE(n_it, m_it, ok) do { ok = true; while (m_cur == 0ull) { int k_ = 0; if (lane == 0) k_ = atomicAdd(CNT, 1); k_ = __builtin_amdgcn_readfirstlane(k_); \
                if (k_ >= ti - 2) { ok = false; break; } n_cur = ti - 2 - k_; \
                m_cur = ((unsigned long long)__builtin_amdgcn_readfirstlane(BM[n_cur * 2 + 1]) << 32) | (unsigned)__builtin_amdgcn_readfirstlane(BM[n_cur * 2]); } \
            if (ok) { n_it = n_cur; m_it = m_cur; for (int i_ = 0; i_ < 8; ++i_) m_cur &= m_cur - 1ull; } } while (0)
        bool have; ADVANCE(n_a, m_a, have);
        bf16x8 ka[2][4], kb[2][4];
        if (have) { tile_load_k(ka[0], KS + (size_t)n_a * 4096, r32, hh); tile_load_k(ka[1], KS + (size_t)n_a * 4096 + 2048, r32, hh); }
        while (have) {
            bool have_b; ADVANCE(n_b, m_b, have_b);
            if (have_b) { tile_load_k(kb[0], KS + (size_t)n_b * 4096, r32, hh); tile_load_k(kb[1], KS + (size_t)n_b * 4096 + 2048, r32, hh); }
            bf16x8 va[2][2][2];
            tile_load_v(va[0], VS + (size_t)n_a * 4096, 64, r32, hh); tile_load_v(va[1], VS + (size_t)n_a * 4096 + 32, 64, r32, hh);
            unsigned long long mm = m_a; for (int i = 0; i < slot; ++i) mm &= mm - 1ull;
            const bool active = mm != 0ull; const int tt = active ? (__ffsll((long long)mm) - 1) : (__ffsll((long long)m_a) - 1);
            const int grow = tt * 4 + hd;
            bf16x8 qg[4];
#pragma unroll
            for (int s = 0; s < 4; ++s) qg[s] = *(const bf16x8*)(QL + grow * 72 + 16 * s + 8 * hh);
            f32x16 oo[2]; for (int i = 0; i < 16; ++i) { oo[0][i] = 0.f; oo[1][i] = 0.f; }
            float lp = 0.f; const int hi2 = active ? 1000000 : -1000000;
#pragma unroll
            for (int kt = 0; kt < 2; ++kt) { const f32x16 p = tile_scores(ka[kt], qg, negMs, hi2, -1000000, lp); tile_pv(p, va[kt], oo); }
            if (active) { const float scl = SCL[grow];
#pragma unroll
                for (int dt = 0; dt < 2; ++dt)
#pragma unroll
                    for (int r = 0; r < 16; ++r) atomicAdd(&OL[grow * 66 + 32 * dt + crow(r, hh)], __float2int_rn(oo[dt][r] * scl));
                atomicAdd(&LL[grow], __float2int_rn(lp * scl)); }
#pragma unroll
            for (int kt = 0; kt < 2; ++kt)
#pragma unroll
                for (int s = 0; s < 4; ++s) ka[kt][s] = kb[kt][s];
            n_a = n_b; m_a = m_b; have = have_b;
        }
#undef ADVANCE
    }
    __syncthreads();
    { const float sc = gp[1] / (float)LL[row];
      bf16_t* op = (bf16_t*)(ws + WS_ONSA) + tokg * 512 + (g * 4 + hd) * 64;
#pragma unroll
      for (int dt = 0; dt < 2; ++dt)
#pragma unroll
          for (int r4 = 0; r4 < 4; ++r4) { float f[4];
              const u32x2 pa = *(const u32x2*)(PA + 32 * dt + 8 * r4 + 4 * hh); const float pf[4] = {bflo(pa.x), bfhi(pa.x), bflo(pa.y), bfhi(pa.y)};
#pragma unroll
              for (int i = 0; i < 4; ++i) { const int r = 4 * r4 + i; f[i] = pf[i] + (float)OL[row * 66 + 32 * dt + crow(r, hh)] * sc; }
              u32x2 o; o.x = pk2(f[0], f[1]); o.y = pk2(f[2], f[3]);
              *(u32x2*)(op + 32 * dt + 8 * r4 + 4 * hh) = o; } }
    __syncthreads();
}

DI void phase_finalize(const Args& A) {
    const int tid = otid(), lane = tid & 63, wave = tid >> 6; const int gw = blockIdx.x * 8 + wave, NGW = gridDim.x * 8;
    unsigned char* ws = A.ws;
    for (int tok = gw; tok < NTOK; tok += NGW) {
        bf16_t* oc = (bf16_t*)(ws + WS_OCAT) + (size_t)tok * 1024;
        { const u32x4 w = *(const u32x4*)((const bf16_t*)(ws + WS_ONSA) + (size_t)tok * 512 + 8 * lane);
          float f[8] = {bflo(w.x), bfhi(w.x), bflo(w.y), bfhi(w.y), bflo(w.z), bfhi(w.z), bflo(w.w), bfhi(w.w)}; float s = 0.f;
#pragma unroll
          for (int i = 0; i < 8; ++i) s += f[i] * f[i];
          const float rs = rsqrtf(wave_sum(s) * (1.f / 512.f) + EPS); const float* gn = A.in[I_NSAOG] + 8 * lane;
          u32x4 o; o.x = pk2(f[0] * rs * gn[0], f[1] * rs * gn[1]); o.y = pk2(f[2] * rs * gn[2], f[3] * rs * gn[3]); o.z = pk2(f[4] * rs * gn[4], f[5] * rs * gn[5]); o.w = pk2(f[6] * rs * gn[6], f[7] * rs * gn[7]);
          *(u32x4*)(oc + 8 * lane) = o; }
        { const u32x4 w = *(const u32x4*)((const bf16_t*)(ws + WS_OG) + (size_t)tok * 512 + 8 * lane);
          const u32x4 zw = *(const u32x4*)((const bf16_t*)(ws + WS_U) + (size_t)tok * INWP + C_GZ + 8 * lane);
          float f[8] = {bflo(w.x), bfhi(w.x), bflo(w.y), bfhi(w.y), bflo(w.z), bfhi(w.z), bflo(w.w), bfhi(w.w)};
          float z[8] = {bflo(zw.x), bfhi(zw.x), bflo(zw.y), bfhi(zw.y), bflo(zw.z), bfhi(zw.z), bflo(zw.w), bfhi(zw.w)}; float s = 0.f;
#pragma unroll
          for (int i = 0; i < 8; ++i) s += f[i] * f[i];
          s += __shfl_xor(s, 1); s += __shfl_xor(s, 2); s += __shfl_xor(s, 4); s += __shfl_xor(s, 8);
          const float rs = rsqrtf(s * (1.f / 128.f) + EPS); const float* gn = A.in[I_GDNOG] + (8 * lane & 127); float o8[8];
#pragma unroll
          for (int i = 0; i < 8; ++i) o8[i] = f[i] * rs * gn[i] * z[i] * sigm(z[i]);
          u32x4 o; o.x = pk2(o8[0], o8[1]); o.y = pk2(o8[2], o8[3]); o.z = pk2(o8[4], o8[5]); o.w = pk2(o8[6], o8[7]);
          *(u32x4*)(oc + 512 + 8 * lane) = o; }
    }
}

DI void phase_router(const Args& A, unsigned char* lds) {
    const int tid = otid(), lane = tid & 63, wave = __builtin_amdgcn_readfirstlane(tid >> 6);
    unsigned char* ws = A.ws; const float* x1 = A.out; const float* rw = A.in[I_RW]; const float* fg = A.in[I_FFNG];
    float* partL = (float*)lds;
    float* ssL = partL + 8 * 32 * 33;
    unsigned* cntL = (unsigned*)(ssL + 256); unsigned* baseL = cntL + 32;
    const int i32 = lane & 31, kh = lane >> 5;
    for (int task = blockIdx.x; task < NTOK / 32; task += gridDim.x) {
        const int tok = task * 32 + i32; const float* xr = x1 + (size_t)tok * D + 128 * wave;
        f32x16 acc; for (int i = 0; i < 16; ++i) acc[i] = 0.f; float ss = 0.f;
#pragma unroll 8
        for (int kb = 0; kb < 16; ++kb) { const int k0 = 8 * kb + 4 * kh; const f32x4 av = *(const f32x4*)(xr + k0); const f32x4 gv = *(const f32x4*)(fg + 128 * wave + k0);
            ss += av[0] * av[0] + av[1] * av[1] + av[2] * av[2] + av[3] * av[3];
#pragma unroll
            for (int s = 0; s < 4; ++s) acc = __builtin_amdgcn_mfma_f32_32x32x2f32(av[s], rw[(size_t)(128 * wave + k0 + s) * 32 + i32] * gv[s], acc, 0, 0, 0); }
        ss += __shfl_xor(ss, 32);
        if (kh == 0) ssL[wave * 32 + i32] = ss;
#pragma unroll
        for (int r = 0; r < 16; ++r) partL[(wave * 32 + crow(r, kh)) * 33 + i32] = acc[r];
        __syncthreads();
        if (wave == 0 && lane < 32) { float sst = 0.f;
#pragma unroll
            for (int w = 0; w < 8; ++w) sst += ssL[w * 32 + lane];
            const float rstd = rsqrtf(sst * (1.f / D) + EPS); ((float*)(ws + WS_RSTD2))[tok] = rstd;
            float v[4] = {-3.0e38f, -3.0e38f, -3.0e38f, -3.0e38f}; int id[4] = {0, 0, 0, 0}; const float* rb = A.in[I_RB];
            for (int e = 0; e < 32; ++e) { float lg = 0.f;
#pragma unroll
                for (int w = 0; w < 8; ++w) lg += partL[(w * 32 + lane) * 33 + e];
                const float x = lg * rstd + rb[e];
                if (x > v[3]) { if (x > v[0]) { v[3] = v[2]; id[3] = id[2]; v[2] = v[1]; id[2] = id[1]; v[1] = v[0]; id[1] = id[0]; v[0] = x; id[0] = e; }
                    else if (x > v[1]) { v[3] = v[2]; id[3] = id[2]; v[2] = v[1]; id[2] = id[1]; v[1] = x; id[1] = e; }
                    else if (x > v[2]) { v[3] = v[2]; id[3] = id[2]; v[2] = x; id[2] = e; }
                    else { v[3] = x; id[3] = e; } } }
            const float e0 = 1.f, e1 = __expf(v[1] - v[0]), e2 = __expf(v[2] - v[0]), e3 = __expf(v[3] - v[0]); const float inv = 1.f / (e0 + e1 + e2 + e3);
            const float gt[4] = {e0 * inv, e1 * inv, e2 * inv, e3 * inv};
            cntL[lane] = 0u; asm volatile("s_waitcnt lgkmcnt(0)" ::: "memory");
            unsigned lp[4];
#pragma unroll
            for (int k = 0; k < 4; ++k) lp[k] = atomicAdd(&cntL[id[k]], 1u);
            asm volatile("s_waitcnt lgkmcnt(0)" ::: "memory");
            { const unsigned c = cntL[lane]; baseL[lane] = c ? atomicAdd((unsigned*)(ws + WS_CTL) + CW_CNT + 64 * lane, c) : 0u; }
            asm volatile("s_waitcnt vmcnt(0) lgkmcnt(0)" ::: "memory");
#pragma unroll
            for (int k = 0; k < 4; ++k) { const int pos = (int)(baseL[id[k]] + lp[k]);
                ((int*)(ws + WS_TOKE))[tok * 4 + k] = id[k]; ((float*)(ws + WS_TOKG))[tok * 4 + k] = gt[k]; ((int*)(ws + WS_TOKPOS))[tok * 4 + k] = pos; } }
        __syncthreads();
    }
}

DI void phase_gather(const Args& A, unsigned char* lds) {
    const int tid = otid(), lane = tid & 63, wave = tid >> 6; const int gw = blockIdx.x * 8 + wave, NGW = gridDim.x * 8;
    unsigned char* ws = A.ws; int* psL = (int*)lds;
    if (tid == 0) { const unsigned* cnt = (const unsigned*)(ws + WS_CTL) + CW_CNT; int acc = 0;
        for (int e = 0; e < 32; ++e) { psL[e] = acc; acc += ((int)cnt[64 * e] + 255) & ~255; }
        psL[32] = acc;
        if (blockIdx.x == 0) { int* ctl = (int*)(ws + WS_CTL); ctl[CW_NT] = acc >> 8; int e = 0;
            for (int r = 0; r < (acc >> 8); ++r) { while (r * 256 >= psL[e + 1]) ++e; ctl[CW_TILEE + r] = e; } } }
    __syncthreads();
    const float* x1 = A.out; const float* fg = A.in[I_FFNG]; f32x4 gv[4];
#pragma unroll
    for (int j = 0; j < 4; ++j) gv[j] = *(const f32x4*)(fg + 4 * lane + 256 * j);
    for (int pr = gw; pr < NTOK * 4; pr += NGW) { const int tok = pr >> 2;
        const int e = ((const int*)(ws + WS_TOKE))[pr], pos = ((const int*)(ws + WS_TOKPOS))[pr]; const int dest = psL[e] + pos;
        if (lane == 0) { ((int*)(ws + WS_DEST))[pr] = dest; ((float*)(ws + WS_ROWG))[dest] = ((const float*)(ws + WS_TOKG))[pr]; }
        const float rs = ((const float*)(ws + WS_RSTD2))[tok]; const f32x4* xr = (const f32x4*)(x1 + (size_t)tok * D) + lane;
        u32x2* o = (u32x2*)((bf16_t*)(ws + WS_XS) + (size_t)dest * D) + lane;
#pragma unroll
        for (int j = 0; j < 4; ++j) { const f32x4 v = xr[64 * j]; u32x2 w; w.x = pk2(v.x * rs * gv[j].x, v.y * rs * gv[j].y); w.y = pk2(v.z * rs * gv[j].z, v.w * rs * gv[j].w); o[64 * j] = w; } }
}

DI void phase_combine(const Args& A) {
    const int tid = otid(), lane = tid & 63, wave = tid >> 6; const int gw = blockIdx.x * 8 + wave, NGW = gridDim.x * 8;
    unsigned char* ws = A.ws; const bf16_t* YS = (const bf16_t*)(ws + WS_XS);
    for (int tok = gw; tok < NTOK; tok += NGW) { f32x4* xr = (f32x4*)(A.out + (size_t)tok * D) + lane; f32x4 v[4];
#pragma unroll
        for (int j = 0; j < 4; ++j) v[j] = xr[64 * j];
#pragma unroll
        for (int k = 0; k < 4; ++k) { const int dest = ((const int*)(ws + WS_DEST))[tok * 4 + k]; const u32x2* yr = (const u32x2*)(YS + (size_t)dest * D) + lane;
#pragma unroll
            for (int j = 0; j < 4; ++j) { const u32x2 w = yr[64 * j]; v[j].x += bflo(w.x); v[j].y += bfhi(w.x); v[j].z += bflo(w.y); v[j].w += bfhi(w.y); } }
#pragma unroll
        for (int j = 0; j < 4; ++j) xr[64 * j] = v[j]; }
}


#define XB_TMO      128
#define XB_XCNT(j)  (256  + 64 * (j))
#define XB_XSUB(j)  (1280 + 64 * (j))
#define XB_XGEN(j)  (2304 + 64 * (j))
#define XB_TOP      3328
#define XB_TOPGEN   3392
#define XCD_BAR_WORDS 3456
#define XB_SPIN_CAP (1u << 22)
DI unsigned xb_ld(unsigned* p)              { return __hip_atomic_load(p, __ATOMIC_RELAXED, __HIP_MEMORY_SCOPE_AGENT); }
DI unsigned xb_add(unsigned* p, unsigned v) { return __hip_atomic_fetch_add(p, v, __ATOMIC_RELAXED, __HIP_MEMORY_SCOPE_AGENT); }
DI unsigned xb_xcc_id() { return (unsigned)__builtin_amdgcn_s_getreg((3 << 11) | 20) & 0xFu; }
#define XB_SPIN(cond, bar) do { unsigned _sp = 0; while (cond) { __builtin_amdgcn_s_sleep(1); \
    if ((++_sp & 255u) == 0u) { if (xb_ld(&(bar)[XB_TMO])) break; if (_sp > XB_SPIN_CAP) { atomicAdd(&(bar)[XB_TMO], 1u); break; } } } } while (0)
struct XcdBarrier { unsigned* bar; unsigned x; volatile LAS unsigned* st; };
DI XcdBarrier xcd_barrier_post(unsigned* bar, volatile LAS unsigned* st) {
    XcdBarrier b; b.bar = bar; b.x = xb_xcc_id(); b.st = st;
    if (threadIdx.x == 0) (void)xb_add(&bar[XB_XCNT(b.x)], 1u);
    return b; }
DI void xcd_barrier_complete(unsigned* bar, unsigned x, unsigned& nloc, unsigned& nx) {
    const unsigned G = gridDim.x * gridDim.y * gridDim.z;
    unsigned sum, cnt, mine, sp = 0u;
    for (;;) {
        sum = 0u; cnt = 0u; mine = 0u;
#pragma unroll
        for (unsigned j = 0; j < 16; ++j) { const unsigned c = xb_ld(&bar[XB_XCNT(j)]); sum += c; cnt += (c > 0u) ? 1u : 0u; mine = (j == x) ? c : mine; }
        if (sum == G) break;
        __builtin_amdgcn_s_sleep(1);
        if ((++sp & 255u) == 0u) { if (xb_ld(&bar[XB_TMO])) break; if (sp > XB_SPIN_CAP) { atomicAdd(&bar[XB_TMO], 1u); break; } }
    }
    nloc = mine > 0u ? mine : 1u; nx = cnt > 0u ? cnt : 1u; }
DI void xcd_barrier(const XcdBarrier& b) {
    asm volatile("s_waitcnt vmcnt(0)" ::: "memory");
    __syncthreads();
    if (threadIdx.x == 0) {
        unsigned* bar = b.bar;
        __builtin_amdgcn_s_waitcnt(0);
        unsigned nloc = b.st[0], nx = b.st[1];
        if (nloc == 0u) { xcd_barrier_complete(bar, b.x, nloc, nx); b.st[0] = nloc; b.st[1] = nx; }
        const unsigned old = xb_add(&bar[XB_XSUB(b.x)], 1u);
        const unsigned gen = old / nloc;
        if (old + 1u == (gen + 1u) * nloc) {
            __builtin_amdgcn_fence(__ATOMIC_RELEASE, "agent");
            asm volatile("s_waitcnt vmcnt(0)" ::: "memory");
            const unsigned og = xb_add(&bar[XB_TOP], 1u);
            const unsigned tg = og / nx;
            if (og + 1u == (tg + 1u) * nx) xb_add(&bar[XB_TOPGEN], 1u);
            else XB_SPIN(xb_ld(&bar[XB_TOPGEN]) == tg, bar);
            __builtin_amdgcn_fence(__ATOMIC_ACQUIRE, "agent");
            xb_add(&bar[XB_XGEN(b.x)], 1u);
            asm volatile("s_waitcnt vmcnt(0)" ::: "memory");
        } else {
            XB_SPIN(xb_ld(&bar[XB_XGEN(b.x)]) == gen, bar);
            __builtin_amdgcn_fence(__ATOMIC_ACQUIRE, "agent");
            asm volatile("s_waitcnt vmcnt(0)" ::: "memory");
        }
    }
    __syncthreads();
}

__global__ void __launch_bounds__(512, 2) mega(Args A) {
    extern __shared__ __attribute__((aligned(16))) unsigned char lds[];
    cg::grid_group grid = cg::this_grid();
    const int lo = A.ph_lo, hi = A.ph_hi, tid = threadIdx.x;
    unsigned char* ws = A.ws;
    int* taskL = (int*)(lds + LDS_MISC);
    if (tid < 2) ((volatile LAS unsigned*)(lds + LDS_MISC + 16))[tid] = 0u;
    __syncthreads();
    XcdBarrier xbar = xcd_barrier_post((unsigned*)(ws + WS_CTL) + CW_BAR, (volatile LAS unsigned*)(lds + LDS_MISC + 16));
#define IN(k) (lo <= (k) && (k) < hi)
#define SEAM(k) do { if (IN(k) && IN((k) + 1)) { if ((k) == 0) grid.sync(); else xcd_barrier(xbar); } } while (0)

#ifndef REPEAT_PH
#define REPEAT_PH -1
#endif
#define REP(k) (REPEAT_PH == (k) ? 2 : 1)
    for (int rep = 0; rep < REP(0); ++rep) { if (IN(0)) phase0(A, lds, rep == 0); if (rep + 1 < REP(0)) grid.sync(); }
    SEAM(0);
    for (int rep = 0; rep < REP(1); ++rep) { if (IN(1)) { pg8::Gemm g{(const bf16_t*)(ws + WS_XN), (const bf16_t*)(ws + WS_WTIN), NTOK, INWP, D}; pg8::StaticOrder S; S.init(NTOK, INWP, gridDim.x, blockIdx.x);
        pg8::EpiU E{(bf16_t*)(ws + WS_U), INWP}; pg8::gemm_phase<pg8::EpiU, pg8::StaticOrder>((PG8_LAS unsigned char*)lds, g, S, E); } if (rep + 1 < REP(1)) grid.sync(); }
    SEAM(1);
    for (int rep = 0; rep < REP(2); ++rep) { if (IN(2)) {
        for (;;) { if (tid == 0) *taskL = atomicAdd((int*)(ws + WS_CTL) + (rep ? CW_Q2B : CW_Q2), 1); __syncthreads(); const int task = *taskL; __syncthreads();
            if (task >= 1408) break;
            if (task < 128) compress_task(A, task, lds); else if (task < 1152) gdn_chunk_task(A, task - 128, lds); else nsa_prep_task(A, task - 1152, lds); } } if (rep + 1 < REP(2)) grid.sync(); }
    SEAM(2);
    for (int rep = 0; rep < REP(3); ++rep) { if (IN(3)) {
        if (blockIdx.x < 64) { gdn_scan_block(A, blockIdx.x, lds); __syncthreads(); }
        for (;;) { if (tid == 0) *taskL = atomicAdd((int*)(ws + WS_CTL) + (rep ? CW_Q3B : CW_Q3), 1); __syncthreads(); const int unit = *taskL; __syncthreads();
            if (unit >= 512) break;
            nsa_unit(A, unit, lds); } } if (rep + 1 < REP(3)) grid.sync(); }
    SEAM(3);
    for (int rep = 0; rep < REP(4); ++rep) { if (IN(4)) phase_finalize(A); if (rep + 1 < REP(4)) grid.sync(); }
    SEAM(4);
    for (int rep = 0; rep < REP(5); ++rep) { if (IN(5)) { pg8::Gemm g{(const bf16_t*)(ws + WS_OCAT), (const bf16_t*)(ws + WS_WTOUT), NTOK, D, D}; pg8::StaticOrder S; S.init(NTOK, D, gridDim.x, blockIdx.x);
        pg8::EpiRes E{A.in[I_X], A.out, D}; pg8::gemm_phase<pg8::EpiRes, pg8::StaticOrder>((PG8_LAS unsigned char*)lds, g, S, E); } if (rep + 1 < REP(5)) grid.sync(); }
    SEAM(5);
    for (int rep = 0; rep < REP(6); ++rep) { if (IN(6)) phase_router(A, lds);
        if (rep + 1 < REP(6)) { grid.sync(); if (blockIdx.x == 0 && tid < 32) ((unsigned*)(ws + WS_CTL))[CW_CNT + 64 * tid] = 0u; grid.sync(); } }
    SEAM(6);
    for (int rep = 0; rep < REP(7); ++rep) { if (IN(7)) phase_gather(A, lds); if (rep + 1 < REP(7)) grid.sync(); }
    SEAM(7);
    for (int rep = 0; rep < REP(8); ++rep) { if (IN(8)) { const int* ctl = (const int*)(ws + WS_CTL); const int nM = ctl[CW_NT];
        pg8::Gemm g{(const bf16_t*)(ws + WS_XS), (const bf16_t*)(ws + WS_EXPGU), 0, 0, D}; pg8::MoeOrder S; S.init(nM, 8, gridDim.x, blockIdx.x, ctl + CW_TILEE);
        pg8::EpiSwiglu E{(bf16_t*)(ws + WS_HID), A.in[I_EBG], A.in[I_EBU]}; pg8::gemm_phase<pg8::EpiSwiglu, pg8::MoeOrder>((PG8_LAS unsigned char*)lds, g, S, E); } if (rep + 1 < REP(8)) grid.sync(); }
    SEAM(8);
    for (int rep = 0; rep < REP(9); ++rep) { if (IN(9)) { const int* ctl = (const int*)(ws + WS_CTL); const int nM = ctl[CW_NT];
        pg8::Gemm g{(const bf16_t*)(ws + WS_HID), (const bf16_t*)(ws + WS_EXPD), 0, 0, D}; pg8::MoeOrder S; S.init(nM, 4, gridDim.x, blockIdx.x, ctl + CW_TILEE);
        pg8::EpiDown E{(bf16_t*)(ws + WS_XS), A.in[I_EBD], (const float*)(ws + WS_ROWG)}; pg8::gemm_phase<pg8::EpiDown, pg8::MoeOrder>((PG8_LAS unsigned char*)lds, g, S, E); } if (rep + 1 < REP(9)) grid.sync(); }
    SEAM(9);
    if (IN(10)) phase_combine(A);
#undef IN
#undef SEAM
}

constexpr int NPHASE = 11;
#ifndef N_LAUNCHES
#define N_LAUNCHES 1
#endif
extern "C" void kernel_launch(void* const* d_in, const int* in_sizes, int n_in, void* d_out, int out_size, void* d_ws, size_t ws_size, hipStream_t stream) {
    static int grid = 0;
    if (grid == 0) {
        if (n_in != 32 || out_size != NTOK * D || ws_size < WS_END) { fprintf(stderr, "kernel_launch: unexpected shapes (n_in %d out %d ws %zu)\n", n_in, out_size, ws_size); grid = -1; return; }
        int dev = 0, cus = 0, per_cu = 0;
        hipGetDevice(&dev); hipDeviceGetAttribute(&cus, hipDeviceAttributeMultiprocessorCount, dev);
        hipFuncSetAttribute((const void*)mega, hipFuncAttributeMaxDynamicSharedMemorySize, LDS_BYTES);
        hipOccupancyMaxActiveBlocksPerMultiprocessor(&per_cu, (const void*)mega, 512, LDS_BYTES);
        if (per_cu < 1) { fprintf(stderr, "kernel_launch: occupancy query says %d blocks per CU\n", per_cu); per_cu = 1; }
        (void)hipGetLastError();
        grid = cus;
    }
    if (grid < 0) return;
    hipMemsetAsync((char*)d_ws + WS_CTL, 0, CTL_BYTES, stream);
    Args a{};
    for (int i = 0; i < 32; ++i) a.in[i] = (const float*)d_in[i];
    a.out = (float*)d_out; a.ws = (unsigned char*)d_ws;
    if (N_LAUNCHES == 1) { a.ph_lo = 0; a.ph_hi = NPHASE; void* args[] = {&a};
        hipError_t e = hipLaunchCooperativeKernel((const void*)mega, dim3(grid), dim3(512), args, LDS_BYTES, stream);
        if (e != hipSuccess) fprintf(stderr, "cooperative launch failed: %s (grid %d)\n", hipGetErrorString(e), grid); }
    else { for (int p = 0; p < NPHASE; ++p) { a.ph_lo = p; a.ph_hi = p + 1; void* args[] = {&a};
            hipError_t e = hipLaunchCooperativeKernel((const void*)mega, dim3(grid), dim3(512), args, LDS_BYTES, stream);
            if (e != hipSuccess) { fprintf(stderr, "launch %d failed: %s\n", p, hipGetErrorString(e)); break; } } }
}
```

```cpp
#include <hip/hip_runtime.h>
#include <hip/hip_cooperative_groups.h>
#include <cstdio>
#include <cstdint>
namespace cg = cooperative_groups;

#define DI __device__ __forceinline__
#define LAS __attribute__((address_space(3)))
typedef unsigned short bf16_t;
typedef short bf16x8 __attribute__((ext_vector_type(8)));
typedef float f32x4 __attribute__((ext_vector_type(4)));
typedef float f32x16 __attribute__((ext_vector_type(16)));
typedef unsigned u32x4 __attribute__((ext_vector_type(4)));
typedef unsigned u32x2 __attribute__((ext_vector_type(2)));
typedef float f32x2_t __attribute__((ext_vector_type(2)));
typedef __bf16 bf16x2_t __attribute__((ext_vector_type(2)));

constexpr int NB = 2, T = 8192, D = 1024, NTOK = NB * T, INWP = 3584;
constexpr int C_Q = 0, C_KC = 512, C_VC = 640, C_KS = 768, C_VS = 896, C_KW = 1024, C_VW = 1152, C_GATE = 1280,
              C_GQ = 1304, C_GK = 1816, C_GV = 2328, C_GZ = 2840, C_GA = 3352, C_GB = 3356, INW = 3360;
constexpr float EPS = 1e-6f, LOG2E = 1.4426950408889634f;
constexpr int NEXP = 32, MAXROWS = 65536 + NEXP * 256, MAXTILES = MAXROWS / 256;

constexpr size_t MiB = 1u << 20;
constexpr size_t WS_CTL = 0, CTL_BYTES = 64 * 1024;
constexpr size_t WS_WTIN = 1 * MiB, WS_WTOUT = 8 * MiB, WS_WTC1K = 10 * MiB, WS_WTC1V = 11 * MiB;
constexpr size_t WS_MISC = 12 * MiB;
constexpr size_t WS_WTC2K = WS_MISC, WS_WTC2V = WS_MISC + 32 * 1024, WS_RSTD2 = WS_MISC + 64 * 1024, WS_TOKE = WS_MISC + 128 * 1024,
                 WS_TOKG = WS_MISC + 384 * 1024, WS_TOKPOS = WS_MISC + 640 * 1024, WS_DEST = WS_MISC + 896 * 1024,
                 WS_ROWG = WS_MISC + 1152 * 1024, WS_GL = WS_MISC + 1536 * 1024, WS_PB1P = WS_MISC + 1600 * 1024  , WS_GATES = 14 * MiB;
constexpr size_t WS_EXPGU = 16 * MiB, WS_EXPD = 144 * MiB;
constexpr size_t WS_XN = 208 * MiB, WS_ONSA = 208 * MiB, WS_U = 240 * MiB, WS_QN = 352 * MiB, WS_KSN = 368 * MiB, WS_VST = 372 * MiB,
                 WS_KWN = 376 * MiB, WS_VWT = 380 * MiB, WS_KC = 384 * MiB, WS_VCT = 384 * MiB + 512 * 1024;
constexpr size_t WS_WP = 388 * MiB, WS_QGP = 404 * MiB, WS_KDTP = 420 * MiB, WS_QKP = 436 * MiB, WS_UP = 444 * MiB, WS_OG = 460 * MiB, WS_OCAT = 476 * MiB;
constexpr size_t WS_XS = 208 * MiB, WS_HID = 352 * MiB, WS_END = 508 * MiB;
constexpr int CW_Q2 = 0, CW_Q3 = 64, CW_Q2B = 32, CW_Q3B = 96, CW_CNT = 2048  , CW_PB1 = 4096  , CW_NT = 1024, CW_TILEE = 1088  , CW_PSTART = 1536, CW_BAR = 12288;

constexpr int LDS_BYTES = 147456, LDS_MISC = 140 * 1024;

DI unsigned pk2(float lo, float hi) { f32x2_t v = {lo, hi}; bf16x2_t b = __builtin_convertvector(v, bf16x2_t); return __builtin_bit_cast(unsigned, b); }
DI float bflo(unsigned w) { return __uint_as_float(w << 16); }
DI float bfhi(unsigned w) { return __uint_as_float(w & 0xffff0000u); }
DI float bf2f(bf16_t v) { return __uint_as_float((unsigned)v << 16); }
DI bf16_t f2bf(float f) { return (bf16_t)(pk2(f, 0.f) & 0xffffu); }
DI bf16x8 pack8(float a0, float a1, float a2, float a3, float a4, float a5, float a6, float a7) {
    u32x4 w; w.x = pk2(a0, a1); w.y = pk2(a2, a3); w.z = pk2(a4, a5); w.w = pk2(a6, a7); return __builtin_bit_cast(bf16x8, w); }
DI float wave_sum(float v) {
#pragma unroll
    for (int o = 1; o < 64; o <<= 1) v += __shfl_xor(v, o);
    return v; }
DI float sigm(float x) { return __builtin_amdgcn_rcpf(1.f + __builtin_amdgcn_exp2f(-x * LOG2E)); }
DI int otid() { int t = threadIdx.x; asm volatile("" : "+v"(t)); return t; }
DI int crow(int r, int hi) { return (r & 3) + 8 * (r >> 2) + 4 * hi; }
DI int perm16(int p) { return 8 * ((p & 7) >> 2) + 4 * (p >> 3) + (p & 3); }
DI int perm16inv(int k) { return 8 * ((k >> 2) & 1) + 4 * (k >> 3) + (k & 3); }
#define MFMA32(a, b, c) __builtin_amdgcn_mfma_f32_32x32x16_bf16((a), (b), (c), 0, 0, 0)
#define MFMA16(a, b, c) __builtin_amdgcn_mfma_f32_16x16x32_bf16((a), (b), (c), 0, 0, 0)

namespace pg8 {
#define PG8_LAS __attribute__((address_space(3)))
constexpr int BM = 256, BK = 64, HALF = 128, HTB = HALF * BK * 2, STAGE_BYTES = 8 * HTB, NXCD = 8, WGM = 8;
__host__ __device__ __forceinline__ int lds_byte(int r, int c) { const int st = (r >> 4) * 2 + (c >> 5), rr = r & 15, cc = c & 31, ob = rr * 64 + cc * 2; return st * 1024 + (ob ^ (((ob >> 9) & 1) << 5)); }
__host__ __device__ __forceinline__ void stage_rc(int b, int& R, int& C) { const int st = b / 1024, sb = b % 1024, swz = sb ^ (((sb >> 9) & 1) << 5); R = (st >> 1) * 16 + swz / 64; C = (st & 1) * 32 + (swz % 64) / 2; }
__host__ __device__ __forceinline__ int perm32(int rho) { const int n = rho >> 4, i = rho & 15; return 8 * (i >> 2) + 4 * n + (i & 3); }
struct Unit { int pm, pn; };
struct Gemm { const bf16_t* A; const bf16_t* Bt; int M, N, K; };
struct StaticOrder {
    int nM, nN, nwg, G, c;
    __device__ void init(int M, int N, int G_, int c_) { nM = M / BM; nN = N / BM; nwg = nM * nN; G = G_; c = c_; }
    __device__ bool next(int i, Unit& u) const {
        const long L = (long)i * G + c; if (L >= nwg) return false;
        int wgid = (int)L; { const int q = nwg / NXCD, r = nwg % NXCD, xcd = wgid % NXCD, off = wgid / NXCD; wgid = (xcd < r ? xcd * (q + 1) : r * (q + 1) + (xcd - r) * q) + off; }
        const int nig = WGM * nN, gid = wgid / nig, fm = gid * WGM, gsz = (nM - fm) < WGM ? (nM - fm) : WGM;
        u.pm = fm + ((wgid % nig) % gsz); u.pn = (wgid % nig) / gsz; return true;
    }
};
struct MoeOrder {
    StaticOrder S; const int* tile_e;
    __device__ void init(int nM_, int nN_, int G_, int c_, const int* te) { S.nM = nM_; S.nN = nN_; S.nwg = nM_ * nN_; S.G = G_; S.c = c_; tile_e = te; }
    __device__ bool next(int i, Unit& u) const { if (!S.next(i, u)) return false; u.pn = tile_e[u.pm] * S.nN + u.pn; return true; }
};

template <class Epi, class Sched>
__device__ __forceinline__ void gemm_phase(PG8_LAS unsigned char* lds, const Gemm g, const Sched& S, const Epi& E) {
    const int tid = otid(), wid = __builtin_amdgcn_readfirstlane(tid >> 6), lane = tid & 63, wr = wid >> 2, wc = wid & 3, fr = lane & 15, fq = lane >> 4;
    const int K = g.K, nt = K / BK;
    unsigned voffA[2], voffB[2];
#pragma unroll
    for (int i = 0; i < 2; ++i) { int R, C; stage_rc(tid * 16 + i * 8192, R, C); const int Rb = Epi::PERM ? ((R & ~31) + perm32(R & 31)) : R;
        voffA[i] = (unsigned)(R * K + C) * 2u; voffB[i] = (unsigned)(Rb * K + C) * 2u; }
    const size_t kstep = (size_t)(BK * 2);
    const size_t hstep = (size_t)HALF * K * 2;
    const size_t tstep = 2 * hstep;
    const unsigned ldsw = (unsigned)wid * 1024u;
    const int aoff = lds_byte(wr * 64 + fr, fq * 8), boff = lds_byte(wc * 32 + fr, fq * 8);
#define PG8_SA(b, h) (((b) * 2 + (h)) * HTB)
#define PG8_SB(b, h) ((4 + (b) * 2 + (h)) * HTB)
#define PG8_STAGE(bufoff, gbase, voff) do { _Pragma("unroll") for (int _i = 0; _i < 2; ++_i) \
        __builtin_amdgcn_global_load_lds((const unsigned*)((const char*)(gbase) + (voff)[_i]), (PG8_LAS unsigned*)(lds + (bufoff) + ldsw + _i * 8192), 16, 0, 0); } while (0)
#define PG8_LDA(dst, b, h) do { _Pragma("unroll") for (int m = 0; m < 4; ++m) _Pragma("unroll") for (int k = 0; k < 2; ++k) dst[m][k] = *(const PG8_LAS bf16x8*)(lds + PG8_SA(b, h) + aoff + m * 2048 + k * 1024); } while (0)
#define PG8_LDB(dst, b, h) do { _Pragma("unroll") for (int n = 0; n < 2; ++n) _Pragma("unroll") for (int k = 0; k < 2; ++k) dst[n][k] = *(const PG8_LAS bf16x8*)(lds + PG8_SB(b, h) + boff + n * 2048 + k * 1024); } while (0)
#define PG8_MMA(ai, bj, At, Bt) do { __builtin_amdgcn_s_setprio(1); _Pragma("unroll") for (int m = 0; m < 4; ++m) _Pragma("unroll") for (int n = 0; n < 2; ++n) _Pragma("unroll") for (int k = 0; k < 2; ++k) \
        acc[ai][bj][m][n] = __builtin_amdgcn_mfma_f32_16x16x32_bf16(Bt[n][k], At[m][k], acc[ai][bj][m][n], 0, 0, 0); __builtin_amdgcn_s_setprio(0); } while (0)
#define PG8_WAIT_V(n) asm volatile("s_waitcnt vmcnt(" #n ")" ::: "memory")
#define PG8_WAIT_L(n) asm volatile("s_waitcnt lgkmcnt(" #n ")" ::: "memory")
#define PG8_BAR __builtin_amdgcn_s_barrier()
#define PG8_SCHED __builtin_amdgcn_sched_barrier(0)
    Unit cur, nxt; int ui = 0;
    if (!S.next(0, cur)) return;
    f32x4 acc[2][2][4][2];
#pragma unroll
    for (int a = 0; a < 2; ++a)
#pragma unroll
        for (int b = 0; b < 2; ++b)
#pragma unroll
            for (int m = 0; m < 4; ++m)
#pragma unroll
                for (int n = 0; n < 2; ++n) acc[a][b][m][n] = (f32x4){0.f, 0.f, 0.f, 0.f};
    bf16x8 At[4][2], B0[2][2], B1[2][2];
    const char* cA = (const char*)g.A + (size_t)cur.pm * tstep; const char* cB = (const char*)g.Bt + (size_t)cur.pn * tstep;
    PG8_STAGE(PG8_SB(0, 0), cB, voffB); PG8_STAGE(PG8_SB(0, 1), cB + hstep, voffB); PG8_STAGE(PG8_SA(0, 0), cA, voffA); PG8_STAGE(PG8_SA(0, 1), cA + hstep, voffA);
    if (wr == 1) PG8_BAR;
    PG8_WAIT_V(2); PG8_BAR;
    PG8_STAGE(PG8_SB(1, 0), cB + kstep, voffB); PG8_STAGE(PG8_SA(1, 0), cA + kstep, voffA); PG8_STAGE(PG8_SB(1, 1), cB + hstep + kstep, voffB);
    PG8_WAIT_V(6); PG8_BAR;
    for (;;) {
        const bool has_next = S.next(ui + 1, nxt);
        const char* nA = has_next ? (const char*)g.A + (size_t)nxt.pm * tstep : cA; const char* nB = has_next ? (const char*)g.Bt + (size_t)nxt.pn * tstep : cB;
        for (int t = 0; t < nt; t += 2) {
            const bool last = (t == nt - 2);
            const char* a1 = cA + (size_t)(t + 1) * kstep;
            const char* a2 = last ? nA : cA + (size_t)(t + 2) * kstep; const char* b2 = last ? nB : cB + (size_t)(t + 2) * kstep;
            const char* a3 = a2 + kstep; const char* b3 = b2 + kstep;
            PG8_LDB(B0, 0, 0); PG8_LDB(B1, 0, 1); PG8_SCHED; PG8_LDA(At, 0, 0); PG8_STAGE(PG8_SA(1, 1), a1 + hstep, voffA);
            PG8_WAIT_V(8); PG8_WAIT_L(0); PG8_BAR; PG8_MMA(0, 0, At, B0); PG8_MMA(0, 1, At, B1); PG8_BAR; PG8_SCHED;
            PG8_LDA(At, 0, 1); PG8_STAGE(PG8_SB(0, 0), b2, voffB); PG8_STAGE(PG8_SB(0, 1), b2 + hstep, voffB); PG8_STAGE(PG8_SA(0, 0), a2, voffA);
            PG8_WAIT_V(8); PG8_WAIT_L(0); PG8_BAR; PG8_MMA(1, 0, At, B0); PG8_MMA(1, 1, At, B1); PG8_BAR; PG8_SCHED;
            PG8_LDB(B0, 1, 0); PG8_LDB(B1, 1, 1); PG8_SCHED; PG8_LDA(At, 1, 0); PG8_STAGE(PG8_SA(0, 1), a2 + hstep, voffA);
            PG8_WAIT_V(8); PG8_WAIT_L(0); PG8_BAR; PG8_MMA(0, 0, At, B0); PG8_MMA(0, 1, At, B1); PG8_BAR; PG8_SCHED;
            PG8_LDA(At, 1, 1); PG8_STAGE(PG8_SB(1, 0), b3, voffB); PG8_STAGE(PG8_SB(1, 1), b3 + hstep, voffB); PG8_STAGE(PG8_SA(1, 0), a3, voffA);
            PG8_WAIT_V(8); PG8_WAIT_L(0); PG8_BAR; PG8_MMA(1, 0, At, B0); PG8_MMA(1, 1, At, B1); PG8_BAR; PG8_SCHED;
        }
        if (wr == 0) PG8_BAR;
        E(acc, cur, wr, wc, fr, fq);
        if (!has_next) break;
#pragma unroll
        for (int a = 0; a < 2; ++a)
#pragma unroll
            for (int b = 0; b < 2; ++b)
#pragma unroll
                for (int m = 0; m < 4; ++m)
#pragma unroll
                    for (int n = 0; n < 2; ++n) acc[a][b][m][n] = (f32x4){0.f, 0.f, 0.f, 0.f};
        cur = nxt; cA = nA; cB = nB; ++ui;
        if (wr == 1) PG8_BAR;
    }
    PG8_WAIT_V(0);
    PG8_BAR;
#undef PG8_SA
#undef PG8_SB
#undef PG8_STAGE
#undef PG8_LDA
#undef PG8_LDB
#undef PG8_MMA
#undef PG8_WAIT_V
#undef PG8_WAIT_L
#undef PG8_BAR
#undef PG8_SCHED
}

struct EpiU {
    static constexpr bool PERM = true;
    bf16_t* O; int ldc;
    __device__ __forceinline__ void operator()(const f32x4 (&acc)[2][2][4][2], const Unit& u, int wr, int wc, int fr, int fq) const {
        const int row0 = u.pm * BM + wr * 64 + fr, col0 = u.pn * BM + wc * 32 + 8 * fq;
#pragma unroll
        for (int ai = 0; ai < 2; ++ai)
#pragma unroll
            for (int m = 0; m < 4; ++m) { bf16_t* rowp = O + (size_t)(row0 + ai * HALF + m * 16) * ldc + col0;
#pragma unroll
                for (int bj = 0; bj < 2; ++bj) { const f32x4 v0 = acc[ai][bj][m][0], v1 = acc[ai][bj][m][1];
                    u32x4 w; w.x = pk2(v0[0], v0[1]); w.y = pk2(v0[2], v0[3]); w.z = pk2(v1[0], v1[1]); w.w = pk2(v1[2], v1[3]);
                    *(u32x4*)(rowp + bj * HALF) = w; } }
    }
};
struct EpiRes {
    static constexpr bool PERM = false;
    const float* base; float* out; int ldc;
    __device__ __forceinline__ void operator()(const f32x4 (&acc)[2][2][4][2], const Unit& u, int wr, int wc, int fr, int fq) const {
        const int col0 = u.pn * BM + wc * 32 + 4 * fq;
#pragma unroll
        for (int ai = 0; ai < 2; ++ai)
#pragma unroll
            for (int m = 0; m < 4; ++m) { const size_t off = (size_t)(u.pm * BM + ai * HALF + wr * 64 + m * 16 + fr) * ldc + col0;
#pragma unroll
                for (int bj = 0; bj < 2; ++bj)
#pragma unroll
                    for (int n = 0; n < 2; ++n) { const f32x4 bs = *(const f32x4*)(base + off + bj * HALF + n * 16); *(f32x4*)(out + off + bj * HALF + n * 16) = bs + acc[ai][bj][m][n]; } }
    }
};
struct EpiSwiglu {
    static constexpr bool PERM = true;
    bf16_t* H; const float* bg; const float* bu;
    __device__ __forceinline__ void operator()(const f32x4 (&acc)[2][2][4][2], const Unit& u, int wr, int wc, int fr, int fq) const {
        const int e = u.pn >> 3, pnl = u.pn & 7, hc0 = pnl * 128 + wc * 32 + 8 * fq, row0 = u.pm * BM + wr * 64 + fr;
        float gb[8], ub[8];
#pragma unroll
        for (int i = 0; i < 8; ++i) { gb[i] = bg[e * 1024 + hc0 + i]; ub[i] = bu[e * 1024 + hc0 + i]; }
#pragma unroll
        for (int ai = 0; ai < 2; ++ai)
#pragma unroll
            for (int m = 0; m < 4; ++m) {
                float o[8];
#pragma unroll
                for (int n = 0; n < 2; ++n)
#pragma unroll
                    for (int i = 0; i < 4; ++i) {
                        const float gg = fminf(acc[ai][0][m][n][i] + gb[4 * n + i], 7.0f);
                        const float uu = fminf(fmaxf(acc[ai][1][m][n][i] + ub[4 * n + i], -7.0f), 7.0f);
                        o[4 * n + i] = (uu + 1.0f) * gg * sigm(gg * 1.702f); }
                u32x4 w; w.x = pk2(o[0], o[1]); w.y = pk2(o[2], o[3]); w.z = pk2(o[4], o[5]); w.w = pk2(o[6], o[7]);
                *(u32x4*)(H + (size_t)(row0 + ai * HALF + m * 16) * 1024 + hc0) = w; }
    }
};
struct EpiDown {
    static constexpr bool PERM = true;
    bf16_t* Y; const float* bd; const float* rowg;
    __device__ __forceinline__ void operator()(const f32x4 (&acc)[2][2][4][2], const Unit& u, int wr, int wc, int fr, int fq) const {
        const int e = u.pn >> 2, pnl = u.pn & 3, col0 = pnl * BM + wc * 32 + 8 * fq, row0 = u.pm * BM + wr * 64 + fr;
        float bv[2][8];
#pragma unroll
        for (int bj = 0; bj < 2; ++bj)
#pragma unroll
            for (int i = 0; i < 8; ++i) bv[bj][i] = bd[e * 1024 + col0 + bj * HALF + i];
#pragma unroll
        for (int ai = 0; ai < 2; ++ai)
#pragma unroll
            for (int m = 0; m < 4; ++m) { const int row = row0 + ai * HALF + m * 16; const float sc = rowg[row];
#pragma unroll
                for (int bj = 0; bj < 2; ++bj) { const f32x4 v0 = acc[ai][bj][m][0], v1 = acc[ai][bj][m][1];
                    u32x4 w; w.x = pk2((v0[0] + bv[bj][0]) * sc, (v0[1] + bv[bj][1]) * sc); w.y = pk2((v0[2] + bv[bj][2]) * sc, (v0[3] + bv[bj][3]) * sc);
                    w.z = pk2((v1[0] + bv[bj][4]) * sc, (v1[1] + bv[bj][5]) * sc); w.w = pk2((v1[2] + bv[bj][6]) * sc, (v1[3] + bv[bj][7]) * sc);
                    *(u32x4*)(Y + (size_t)row * 1024 + col0 + bj * HALF) = w; } }
    }
};
}

struct Args { const float* in[32]; float* out; unsigned char* ws; int ph_lo, ph_hi; };
enum { I_X = 0, I_ANG, I_WIN, I_QG, I_KCG, I_KSG, I_KWG, I_CKPOS, I_CKW1, I_CKB1, I_CKW2, I_CKB2, I_CVPOS, I_CVW1, I_CVB1, I_CVW2, I_CVB2,
       I_NSAOG, I_CONVW, I_ALOG, I_DTB, I_GDNOG, I_WOUT, I_FFNG, I_RW, I_RB, I_EWG, I_EBG, I_EWU, I_EBU, I_EWD, I_EBD };

DI void p0_transpose_item(const float* W, int K, int N, bf16_t* WT, long row_off, float* scr, int item, int lane) {
    const int nblk = N / 32, kb = item / nblk, nb = item % nblk, k0 = 64 * kb, n0 = 32 * nb;
#pragma unroll 8
    for (int i = 0; i < 32; ++i) { const int kk = 2 * i + (lane >> 5); scr[kk * 33 + (lane & 31)] = W[(size_t)(k0 + kk) * N + n0 + (lane & 31)]; }
    __builtin_amdgcn_s_waitcnt(0xC07F); asm volatile("" ::: "memory");
    const int c = lane & 7;
#pragma unroll
    for (int j = 0; j < 4; ++j) { const int n = (lane >> 3) + 8 * j; const float* s = scr + (8 * c) * 33 + n;
        u32x4 o; o.x = pk2(s[0 * 33], s[1 * 33]); o.y = pk2(s[2 * 33], s[3 * 33]); o.z = pk2(s[4 * 33], s[5 * 33]); o.w = pk2(s[6 * 33], s[7 * 33]);
        *(u32x4*)(WT + (size_t)(row_off + n0 + n) * K + k0 + 8 * c) = o; }
    __builtin_amdgcn_s_waitcnt(0xC07F); asm volatile("" ::: "memory");
}

DI void p0_transpose_item64(const float* W, int K, int N, bf16_t* WT, long row_off, float* scr, int kb, int nb, int lane) {
    const int k0 = 64 * kb, n0 = 64 * nb, c4 = (lane & 15) * 4, kr = lane >> 4;
    f32x4 v[16];
#pragma unroll
    for (int i = 0; i < 16; ++i) v[i] = *(const f32x4*)(W + (size_t)(k0 + 4 * i + kr) * N + n0 + c4);
#pragma unroll
    for (int i = 0; i < 16; ++i) { float* d = scr + (4 * i + kr) * 65 + c4; d[0] = v[i][0]; d[1] = v[i][1]; d[2] = v[i][2]; d[3] = v[i][3]; }
    __builtin_amdgcn_s_waitcnt(0xC07F); asm volatile("" ::: "memory");
    const int nn = lane >> 3, cc = lane & 7;
#pragma unroll
    for (int it = 0; it < 8; ++it) { const int n = 8 * it + nn; const float* s = scr + (8 * cc) * 65 + n;
        u32x4 o; o.x = pk2(s[0 * 65], s[1 * 65]); o.y = pk2(s[2 * 65], s[3 * 65]); o.z = pk2(s[4 * 65], s[5 * 65]); o.w = pk2(s[6 * 65], s[7 * 65]);
        *(u32x4*)(WT + (size_t)(row_off + n0 + n) * K + k0 + 8 * cc) = o; }
    __builtin_amdgcn_s_waitcnt(0xC07F); asm volatile("" ::: "memory");
}

DI void phase0(const Args& A, unsigned char* lds, bool first) {
    const int tid = otid(), lane = tid & 63, wave = tid >> 6, G = gridDim.x;
    const int gw = blockIdx.x * 8 + wave, NGW = G * 8;
    float* scr = (float*)(lds + wave * 17408);
    unsigned char* ws = A.ws;
    constexpr int I_IN = 16 * 105, I_OUT = 16 * 32, I_C1 = 32 * 8, I_C2 = 4 * 2, I_EX = 16 * 32;
    constexpr int NIT = I_IN + I_OUT + 2 * I_C1 + 2 * I_C2;
    for (int it = gw; it < NIT; it += NGW) {
        int r = it;
        if (r < I_IN) { p0_transpose_item(A.in[I_WIN], 1024, INW, (bf16_t*)(ws + WS_WTIN), 0, scr, r, lane); continue; } r -= I_IN;
        if (r < I_OUT) { p0_transpose_item(A.in[I_WOUT], 1024, 1024, (bf16_t*)(ws + WS_WTOUT), 0, scr, r, lane); continue; } r -= I_OUT;
        if (r < I_C1) { p0_transpose_item(A.in[I_CKW1], 2048, 256, (bf16_t*)(ws + WS_WTC1K), 0, scr, r, lane); continue; } r -= I_C1;
        if (r < I_C1) { p0_transpose_item(A.in[I_CVW1], 2048, 256, (bf16_t*)(ws + WS_WTC1V), 0, scr, r, lane); continue; } r -= I_C1;
        if (r < I_C2) { p0_transpose_item(A.in[I_CKW2], 256, 64, (bf16_t*)(ws + WS_WTC2K), 0, scr, r, lane); continue; } r -= I_C2;
        if (r < I_C2) { p0_transpose_item(A.in[I_CVW2], 256, 64, (bf16_t*)(ws + WS_WTC2V), 0, scr, r, lane); continue; }
    }
    for (int it = gw; it < 96 * 256; it += NGW) { const int mat = it >> 8, item = it & 255, kb = item >> 4, nb = item & 15, e = mat / 3, which = mat % 3;
        if (which == 2) p0_transpose_item64(A.in[I_EWD] + (size_t)e * 1048576, 1024, 1024, (bf16_t*)(ws + WS_EXPD), (long)e * 1024, scr, kb, nb, lane);
        else { const int n0 = 64 * nb; const long dest0 = (long)e * 2048 + (n0 >> 7) * 256 + (n0 & 127) + (which ? 128 : 0);
            p0_transpose_item64(A.in[which ? I_EWU : I_EWG] + (size_t)e * 1048576, 1024, 1024, (bf16_t*)(ws + WS_EXPGU), dest0 - n0, scr, kb, nb, lane); }
    }
    { const float* gain = A.in[I_ANG]; f32x4 gv[4];
#pragma unroll
      for (int j = 0; j < 4; ++j) gv[j] = *(const f32x4*)(gain + 4 * lane + 256 * j);
      for (int m = gw; m < NTOK; m += NGW) { const f32x4* xr = (const f32x4*)(A.in[I_X] + (size_t)m * D) + lane; f32x4 v[4]; float s = 0.f;
#pragma unroll
        for (int j = 0; j < 4; ++j) { v[j] = xr[64 * j]; s += v[j].x * v[j].x + v[j].y * v[j].y + v[j].z * v[j].z + v[j].w * v[j].w; }
        const float rs = rsqrtf(wave_sum(s) * (1.f / D) + EPS);
        u32x2* o = (u32x2*)((bf16_t*)(ws + WS_XN) + (size_t)m * D) + lane;
#pragma unroll
        for (int j = 0; j < 4; ++j) { u32x2 w; w.x = pk2(v[j].x * rs * gv[j].x, v[j].y * rs * gv[j].y); w.y = pk2(v[j].z * rs * gv[j].z, v[j].w * rs * gv[j].w); o[64 * j] = w; } } }
    { u32x4* p = (u32x4*)((bf16_t*)(ws + WS_WTIN) + (size_t)INW * 1024); const int n16 = (INWP - INW) * 1024 * 2 / 16;
      for (int i = blockIdx.x * 512 + tid; i < n16; i += G * 512) p[i] = (u32x4){0u, 0u, 0u, 0u}; }
    if (first && tid < 256) { for (int task = blockIdx.x; task < 256; task += G) { const int kv = task >> 7, seg = task & 127, j = tid;
        const float* pos = A.in[kv ? I_CVPOS : I_CKPOS] + seg * 16; const float* w1 = A.in[kv ? I_CVW1 : I_CKW1] + (size_t)seg * 16 * 256 + j; float wv[16];
#pragma unroll
        for (int k = 0; k < 16; ++k) wv[k] = w1[k * 256];
        float s = 0.f;
#pragma unroll
        for (int k = 0; k < 16; ++k) s += pos[k] * wv[k];
        ((float*)(ws + WS_PB1P))[seg * 512 + kv * 256 + j] = s; } }
}

DI void nsa_prep_task(const Args& A, int task, unsigned char* lds) {
    const int tid = otid(), lane = tid & 63, wave = tid >> 6;
    const int b = task >> 7, n = task & 127;
    unsigned char* ws = A.ws; const bf16_t* U = (const bf16_t*)(ws + WS_U);
    bf16_t* vsL = (bf16_t*)lds;
    for (int ti = 0; ti < 8; ++ti) {
        const int tl = wave * 8 + ti, t = n * 64 + tl; const size_t tok = (size_t)b * T + t; const bf16_t* ur = U + tok * INWP;
        { const u32x4 w = *(const u32x4*)(ur + C_Q + 8 * lane); float f[8] = {bflo(w.x), bfhi(w.x), bflo(w.y), bfhi(w.y), bflo(w.z), bfhi(w.z), bflo(w.w), bfhi(w.w)};
          float s = 0.f;
#pragma unroll
          for (int i = 0; i < 8; ++i) s += f[i] * f[i];
          s += __shfl_xor(s, 1); s += __shfl_xor(s, 2); s += __shfl_xor(s, 4);
          const float rs = rsqrtf(s * (1.f / 64.f) + EPS) * (0.125f * LOG2E); const float* gq = A.in[I_QG] + (8 * lane & 63);
          u32x4 o; o.x = pk2(f[0] * rs * gq[0], f[1] * rs * gq[1]); o.y = pk2(f[2] * rs * gq[2], f[3] * rs * gq[3]); o.z = pk2(f[4] * rs * gq[4], f[5] * rs * gq[5]); o.w = pk2(f[6] * rs * gq[6], f[7] * rs * gq[7]);
          *(u32x4*)((bf16_t*)(ws + WS_QN) + tok * 512 + 8 * lane) = o; }
        if (lane < 32) { const int sel = lane >> 4, l16 = lane & 15, g = l16 >> 3, d0 = (l16 & 7) * 8;
          const u32x4 w = *(const u32x4*)(ur + (sel ? C_KW : C_KS) + 8 * l16); float f[8] = {bflo(w.x), bfhi(w.x), bflo(w.y), bfhi(w.y), bflo(w.z), bfhi(w.z), bflo(w.w), bfhi(w.w)};
          float s = 0.f;
#pragma unroll
          for (int i = 0; i < 8; ++i) s += f[i] * f[i];
          s += __shfl_xor(s, 1); s += __shfl_xor(s, 2); s += __shfl_xor(s, 4);
          const float rs = rsqrtf(s * (1.f / 64.f) + EPS); const float* gk = A.in[sel ? I_KWG : I_KSG] + d0;
          u32x4 o; o.x = pk2(f[0] * rs * gk[0], f[1] * rs * gk[1]); o.y = pk2(f[2] * rs * gk[2], f[3] * rs * gk[3]); o.z = pk2(f[4] * rs * gk[4], f[5] * rs * gk[5]); o.w = pk2(f[6] * rs * gk[6], f[7] * rs * gk[7]);
          { const int c = l16 & 7; *(u32x4*)((bf16_t*)(ws + (sel ? WS_KWN : WS_KSN)) + (size_t)(b * 2 + g) * T * 64 + ((size_t)((t >> 5) * 4 + (c >> 1)) * 64 + (c & 1) * 32 + (t & 31)) * 8) = o; } }
        else { const int l32 = lane - 32, sel = l32 >> 4, l16 = l32 & 15, g = l16 >> 3, d0 = (l16 & 7) * 8;
          const u32x4 w = *(const u32x4*)(ur + (sel ? C_VW : C_VS) + 8 * l16);
          const int pos = (tl & ~15) + perm16inv(tl & 15); bf16_t* dst = vsL + ((sel * 2 + g) * 64 + d0) * 64 + pos;
          dst[0 * 64] = (bf16_t)(w.x & 0xffff); dst[1 * 64] = (bf16_t)(w.x >> 16); dst[2 * 64] = (bf16_t)(w.y & 0xffff); dst[3 * 64] = (bf16_t)(w.y >> 16);
          dst[4 * 64] = (bf16_t)(w.z & 0xffff); dst[5 * 64] = (bf16_t)(w.z >> 16); dst[6 * 64] = (bf16_t)(w.w & 0xffff); dst[7 * 64] = (bf16_t)(w.w >> 16); }
        if (lane < 24) ((float*)(ws + WS_GATES))[tok * 24 + lane] = sigm(bf2f(ur[C_GATE + lane]));
    }
    __syncthreads();
    for (int c = tid; c < 2048; c += 512) { const int sel = c >> 10, g = (c >> 9) & 1, rem = c & 511;
        const int r32 = rem & 31, hh = (rem >> 5) & 1, ks = (rem >> 6) & 1, dt = (rem >> 7) & 1, tb = rem >> 8;
        const u32x4 v = *(const u32x4*)(vsL + ((sel * 2 + g) * 64 + 32 * dt + r32) * 64 + 32 * tb + 16 * ks + 8 * hh);
        *(u32x4*)((bf16_t*)(ws + (sel ? WS_VWT : WS_VST)) + ((size_t)(b * 2 + g) * 128 + n) * 4096 + rem * 8) = v; }
    __syncthreads();
}

DI void compress_task(const Args& A, int task, unsigned char* lds) {
    const int tid = otid(), lane = tid & 63, wave = __builtin_amdgcn_readfirstlane(tid >> 6), r32 = lane & 31, hh = lane >> 5;
    const int kv = task >> 6, b = (task >> 5) & 1, g = (task >> 4) & 1, ct = task & 15, c0 = 32 * ct;
    unsigned char* ws = A.ws; const bf16_t* U = (const bf16_t*)(ws + WS_U);
    bf16_t* hidL = (bf16_t*)lds;
    float* outL = (float*)(lds + 16896);
    const int colbase = (kv ? C_VC : C_KC) + g * 64;
    const bf16_t* W1T = (const bf16_t*)(ws + (kv ? WS_WTC1V : WS_WTC1K));
    const bf16_t* W2T = (const bf16_t*)(ws + (kv ? WS_WTC2V : WS_WTC2K));
    {   int c = c0 + r32; if (c > 510) c = 510;
        const bf16_t* arow = U + ((size_t)b * T + 16 * c) * INWP + colbase + 8 * hh;
        const bf16_t* brow = W1T + (size_t)(32 * wave + r32) * 2048 + 8 * hh;
        f32x16 acc; for (int i = 0; i < 16; ++i) acc[i] = 0.f;
#pragma unroll 4
        for (int l = 0; l < 32; ++l) {
#pragma unroll
            for (int s = 0; s < 4; ++s) { const bf16x8 af = *(const bf16x8*)(arow + (size_t)l * INWP + 16 * s); const bf16x8 bf = *(const bf16x8*)(brow + l * 64 + 16 * s); acc = MFMA32(af, bf, acc); } }
        const int j = 32 * wave + r32; float pb = A.in[kv ? I_CVB1 : I_CKB1][j];
#pragma unroll
        for (int sg = 0; sg < 128; ++sg) pb += ((const float*)(ws + WS_PB1P))[sg * 512 + kv * 256 + j];
#pragma unroll
        for (int r = 0; r < 16; ++r) { const float x = acc[r] + pb; const float y = x * sigm(1.5957691216057308f * (x + 0.044715f * x * x * x)); hidL[crow(r, hh) * 264 + j] = f2bf(y); }
    }
    __syncthreads();
    if (wave < 2) { f32x16 acc; for (int i = 0; i < 16; ++i) acc[i] = 0.f;
#pragma unroll
        for (int s = 0; s < 16; ++s) { const bf16x8 af = *(const bf16x8*)(hidL + r32 * 264 + 16 * s + 8 * hh); const bf16x8 bf = *(const bf16x8*)(W2T + (size_t)(32 * wave + r32) * 256 + 16 * s + 8 * hh); acc = MFMA32(af, bf, acc); }
        const int d = 32 * wave + r32; const float b2 = A.in[kv ? I_CVB2 : I_CKB2][d];
#pragma unroll
        for (int r = 0; r < 16; ++r) outL[crow(r, hh) * 65 + d] = acc[r] + b2; }
    __syncthreads();
    if (kv == 0) { if (tid < 256) { const int cl = tid >> 3, sub = tid & 7; float f[8]; float s = 0.f;
#pragma unroll
            for (int i = 0; i < 8; ++i) { f[i] = outL[cl * 65 + 8 * sub + i]; s += f[i] * f[i]; }
            s += __shfl_xor(s, 1); s += __shfl_xor(s, 2); s += __shfl_xor(s, 4);
            const float rs = (c0 + cl > 510) ? 0.f : rsqrtf(s * (1.f / 64.f) + EPS); const float* gk = A.in[I_KCG] + 8 * sub;
            u32x4 o; o.x = pk2(f[0] * rs * gk[0], f[1] * rs * gk[1]); o.y = pk2(f[2] * rs * gk[2], f[3] * rs * gk[3]); o.z = pk2(f[4] * rs * gk[4], f[5] * rs * gk[5]); o.w = pk2(f[6] * rs * gk[6], f[7] * rs * gk[7]);
            *(u32x4*)((bf16_t*)(ws + WS_KC) + (size_t)(b * 2 + g) * 512 * 64 + ((size_t)(ct * 4 + (sub >> 1)) * 64 + (sub & 1) * 32 + cl) * 8) = o; } }
    else { const int d = tid >> 3, part = tid & 7, p0 = 4 * part, gi = p0 >> 4, cl0 = 16 * gi + perm16(p0 & 15); float f[4];
#pragma unroll
        for (int i = 0; i < 4; ++i) f[i] = (c0 + cl0 + i > 510) ? 0.f : outL[(cl0 + i) * 65 + d];
        u32x2 o; o.x = pk2(f[0], f[1]); o.y = pk2(f[2], f[3]);
        *(u32x2*)((bf16_t*)(ws + WS_VCT) + (size_t)(b * 2 + g) * 64 * 512 + ((size_t)((ct * 2 + (d >> 5)) * 2 + (p0 >> 4)) * 64 + ((p0 >> 3) & 1) * 32 + (d & 31)) * 8 + (p0 & 7)) = o; }
    __syncthreads();
}

DI void gdn_chunk_task(const Args& A, int task, unsigned char* lds) {
    const int tid = otid(), lane = tid & 63, wave = __builtin_amdgcn_readfirstlane(tid >> 6), r32 = lane & 31, hh = lane >> 5;
    const int b = task >> 9, h = (task >> 7) & 3, ch = task & 127, t0 = ch * 64; const size_t tok0 = (size_t)b * T + t0;
    unsigned char* ws = A.ws; const bf16_t* U = (const bf16_t*)(ws + WS_U);
    float* qL = (float*)lds; float* kL = qL + 64 * 132; float* vL = kL + 64 * 132; float* Lm = vL + 64 * 132; float* Qm = Lm + 64 * 68;
    float* gcL = Qm + 64 * 68; float* betaL = gcL + 64; float* egL = betaL + 64; float* kdsL = egL + 64;
    { const int c = tid & 127, part = tid >> 7;
#pragma unroll
      for (int s = 0; s < 3; ++s) { const int col = (s == 0 ? C_GQ : s == 1 ? C_GK : C_GV) + h * 128 + c; const float* cw = A.in[I_CONVW] + s * 512 + h * 128 + c;
        const float w0 = cw[0], w1 = cw[1536], w2 = cw[3072], w3 = cw[4608]; float* dst = (s == 0 ? qL : s == 1 ? kL : vL);
        const int tl0 = 16 * part; float x3, x2, x1;
        { const int tg = t0 + tl0; x3 = (tg - 3 >= 0) ? bf2f(U[(tok0 + tl0 - 3) * INWP + col]) : 0.f; x2 = (tg - 2 >= 0) ? bf2f(U[(tok0 + tl0 - 2) * INWP + col]) : 0.f; x1 = (tg - 1 >= 0) ? bf2f(U[(tok0 + tl0 - 1) * INWP + col]) : 0.f; }
#pragma unroll 4
        for (int i = 0; i < 16; ++i) { const float xt = bf2f(U[(tok0 + tl0 + i) * INWP + col]); const float y = w0 * x3 + w1 * x2 + w2 * x1 + w3 * xt;
            dst[(tl0 + i) * 132 + c] = y * sigm(y); x3 = x2; x2 = x1; x1 = xt; } } }
    if (tid < 64) { const int tl = tid; const float a = bf2f(U[(tok0 + tl) * INWP + C_GA + h]), bb = bf2f(U[(tok0 + tl) * INWP + C_GB + h]);
        const float x = a + A.in[I_DTB][h]; const float sp = (x > 20.f) ? x : log1pf(__expf(x)); float gt = -__expf(A.in[I_ALOG][h]) * sp;
#pragma unroll
        for (int o = 1; o < 64; o <<= 1) { const float v = __shfl_up(gt, o); if (lane >= o) gt += v; }
        const float g63 = __shfl(gt, 63);
        gcL[tl] = gt; betaL[tl] = sigm(bb); egL[tl] = __expf(gt); kdsL[tl] = __expf(g63 - gt);
        if (tl == 63) ((float*)(ws + WS_GL))[task] = __expf(gt); }
    __syncthreads();
    { const int tl = tid >> 3, sub = tid & 7; float sq = 0.f, sk = 0.f;
#pragma unroll
      for (int i = 0; i < 16; ++i) { const float a = qL[tl * 132 + sub * 16 + i], c = kL[tl * 132 + sub * 16 + i]; sq += a * a; sk += c * c; }
      sq += __shfl_xor(sq, 1); sq += __shfl_xor(sq, 2); sq += __shfl_xor(sq, 4); sk += __shfl_xor(sk, 1); sk += __shfl_xor(sk, 2); sk += __shfl_xor(sk, 4);
      const float rq = rsqrtf(sq + EPS) * 0.08838834764831845f, rk = rsqrtf(sk + EPS);
#pragma unroll
      for (int i = 0; i < 16; ++i) { qL[tl * 132 + sub * 16 + i] *= rq; kL[tl * 132 + sub * 16 + i] *= rk; } }
    __syncthreads();
    { const int mat = wave >> 2, mi = (wave >> 1) & 1, ni = wave & 1; const float* X = mat ? qL : kL;
      f32x16 acc; for (int i = 0; i < 16; ++i) acc[i] = 0.f;
#pragma unroll
      for (int s = 0; s < 8; ++s) { const f32x4 a0 = *(const f32x4*)(X + (32 * mi + r32) * 132 + 16 * s + 8 * hh), a1 = *(const f32x4*)(X + (32 * mi + r32) * 132 + 16 * s + 8 * hh + 4);
          const f32x4 b0 = *(const f32x4*)(kL + (32 * ni + r32) * 132 + 16 * s + 8 * hh), b1 = *(const f32x4*)(kL + (32 * ni + r32) * 132 + 16 * s + 8 * hh + 4);
          acc = MFMA32(pack8(a0[0], a0[1], a0[2], a0[3], a1[0], a1[1], a1[2], a1[3]), pack8(b0[0], b0[1], b0[2], b0[3], b1[0], b1[1], b1[2], b1[3]), acc); }
      const int sc = 32 * ni + r32; const float gs = gcL[sc];
#pragma unroll
      for (int r = 0; r < 16; ++r) { const int c = 32 * mi + crow(r, hh); const float dec = __expf(gcL[c] - gs);
          if (mat == 0) Lm[c * 68 + sc] = (c > sc) ? betaL[c] * acc[r] * dec : 0.f; else Qm[c * 68 + sc] = (c >= sc) ? acc[r] * dec : 0.f; } }
    __syncthreads();
    {   bf16_t* QGp = (bf16_t*)(ws + WS_QGP) + (size_t)task * 8192; bf16_t* KDTp = (bf16_t*)(ws + WS_KDTP) + (size_t)task * 8192; bf16_t* QKp = (bf16_t*)(ws + WS_QKP) + (size_t)task * 4096;
        for (int id = tid; id < 1024; id += 512) { const int c = id >> 4, chn = id & 15, ks = chn >> 2, q = chn & 3; const float e = egL[c];
            const f32x4 a = *(const f32x4*)(qL + c * 132 + 32 * ks + 4 * q), bq = *(const f32x4*)(qL + c * 132 + 32 * ks + 16 + 4 * q);
            *(bf16x8*)(QGp + id * 8) = pack8(a[0] * e, a[1] * e, a[2] * e, a[3] * e, bq[0] * e, bq[1] * e, bq[2] * e, bq[3] * e); }
        for (int id = tid; id < 1024; id += 512) { const int d = id >> 3, chn = id & 7, ks = chn >> 2, q = chn & 3; float f[8];
#pragma unroll
            for (int j = 0; j < 8; ++j) { const int s = 32 * ks + 16 * (j >> 2) + 4 * q + (j & 3); f[j] = kL[s * 132 + d] * kdsL[s]; }
            *(bf16x8*)(KDTp + id * 8) = pack8(f[0], f[1], f[2], f[3], f[4], f[5], f[6], f[7]); }
        { const int id = tid; const int c = id >> 3, chn = id & 7, ks = chn >> 2, q = chn & 3;
            const f32x4 a = *(const f32x4*)(Qm + c * 68 + 32 * ks + 4 * q), bq = *(const f32x4*)(Qm + c * 68 + 32 * ks + 16 + 4 * q);
            *(bf16x8*)(QKp + id * 8) = pack8(a[0], a[1], a[2], a[3], bq[0], bq[1], bq[2], bq[3]); } }
    __syncthreads();
    if (tid < 256) { const bool isW = tid >= 128; float* col = (isW ? kL : vL) + (tid & 127);
#pragma unroll 1
        for (int bi = 0; bi < 4; ++bi) {
            float r[16];
#pragma unroll
            for (int ii = 0; ii < 16; ++ii) { const int i = 16 * bi + ii; float v = col[i * 132] * betaL[i]; if (isW) v *= egL[i]; r[ii] = v; }
#pragma unroll 1
            for (int j = 0; j < 16 * bi; j += 4) {
                const float x0 = col[j * 132], x1 = col[(j + 1) * 132], x2 = col[(j + 2) * 132], x3 = col[(j + 3) * 132];
#pragma unroll
                for (int ii = 0; ii < 16; ++ii) { const f32x4 l4 = *(const f32x4*)(Lm + (16 * bi + ii) * 68 + j); r[ii] -= (l4[0] * x0 + l4[1] * x1) + (l4[2] * x2 + l4[3] * x3); } }
#pragma unroll
            for (int ii = 1; ii < 16; ++ii) {
#pragma unroll
                for (int j4 = 0; j4 < (ii + 3) / 4; ++j4) { const f32x4 l4 = *(const f32x4*)(Lm + (16 * bi + ii) * 68 + 16 * bi + 4 * j4);
#pragma unroll
                    for (int jj = 0; jj < 4; ++jj) if (4 * j4 + jj < ii) r[ii] -= l4[jj] * r[4 * j4 + jj]; } }
#pragma unroll
            for (int ii = 0; ii < 16; ++ii) col[(16 * bi + ii) * 132] = r[ii];
        } }
    __syncthreads();
    { bf16_t* Wp = (bf16_t*)(ws + WS_WP) + (size_t)task * 8192; bf16_t* Up = (bf16_t*)(ws + WS_UP) + (size_t)task * 8192;
      for (int id = tid; id < 1024; id += 512) { const int c = id >> 4, chn = id & 15, ks = chn >> 2, q = chn & 3;
          const f32x4 a = *(const f32x4*)(kL + c * 132 + 32 * ks + 4 * q), bq = *(const f32x4*)(kL + c * 132 + 32 * ks + 16 + 4 * q);
          *(bf16x8*)(Wp + id * 8) = pack8(a[0], a[1], a[2], a[3], bq[0], bq[1], bq[2], bq[3]); }
      for (int id = tid; id < 2048; id += 512) { const int ln = id & 63, mt = (id >> 6) & 3, es = id >> 8, q = ln >> 4, e = ln & 15; const int c = 16 * mt + 4 * q, col = 16 * es + e;
          u32x2 o; o.x = pk2(vL[c * 132 + col], vL[(c + 1) * 132 + col]); o.y = pk2(vL[(c + 2) * 132 + col], vL[(c + 3) * 132 + col]);
          *(u32x2*)(Up + id * 4) = o; } }
    __syncthreads();
}

constexpr int SC_W = 0, SC_QG = 17408, SC_KD = 34816, SC_QK = 53248, SC_UP = 62464, SC_BUF = 64512, SC_OB = 2 * 64512  ;
#define SC_BAR() do { asm volatile("s_waitcnt lgkmcnt(0)" ::: "memory"); __builtin_amdgcn_s_barrier(); asm volatile("" ::: "memory"); } while (0)
DI void gdn_scan_block(const Args& A, int sidx, unsigned char* lds) {
    const int tid = otid(), lane = tid & 63, wave = __builtin_amdgcn_readfirstlane(tid >> 6);
    const int es = sidx & 7, bh = sidx >> 3, b = bh >> 2, h = bh & 3, r16 = lane & 15, q = lane >> 4;
    unsigned char* ws = A.ws;
    const bf16_t* WP = (const bf16_t*)(ws + WS_WP) + (size_t)bh * 128 * 8192; const bf16_t* QGP = (const bf16_t*)(ws + WS_QGP) + (size_t)bh * 128 * 8192;
    const bf16_t* KDTP = (const bf16_t*)(ws + WS_KDTP) + (size_t)bh * 128 * 8192; const bf16_t* QKP = (const bf16_t*)(ws + WS_QKP) + (size_t)bh * 128 * 4096;
    const bf16_t* UP = (const bf16_t*)(ws + WS_UP) + (size_t)bh * 128 * 8192 + es * 1024;
    if (wave != 0) {
        const int lt = tid - 64; u32x4 R0[9], R1[9], R2[9];
        const bf16_t* sp[9]; int dof[9], stp[9];
#pragma unroll
        for (int j = 0; j < 9; ++j) { const int c = lt + 448 * j;
            if (c < 1024) { sp[j] = WP + c * 8; dof[j] = SC_W + (c >> 4) * 272 + (c & 15) * 16; stp[j] = 8192; }
            else if (c < 2048) { const int cc = c - 1024; sp[j] = QGP + cc * 8; dof[j] = SC_QG + (cc >> 4) * 272 + (cc & 15) * 16; stp[j] = 8192; }
            else if (c < 3072) { const int cc = c - 2048; sp[j] = KDTP + cc * 8; dof[j] = SC_KD + (cc >> 3) * 144 + (cc & 7) * 16; stp[j] = 8192; }
            else if (c < 3584) { const int cc = c - 3072; sp[j] = QKP + cc * 8; dof[j] = SC_QK + (cc >> 3) * 144 + (cc & 7) * 16; stp[j] = 4096; }
            else if (c < 3712) { const int cc = c - 3584; sp[j] = UP + cc * 8; dof[j] = SC_UP + cc * 16; stp[j] = 8192; }
            else { sp[j] = WP; dof[j] = -1; stp[j] = 0; } }
#define SC_LOAD(R, i_) do { if ((i_) < 128) { _Pragma("unroll") for (int j = 0; j < 9; ++j) R[j] = *(const __attribute__((address_space(1))) u32x4*)(sp[j] + (size_t)(i_) * stp[j]); } } while (0)
#define SC_WRITE(R, bufi_) do { _Pragma("unroll") for (int j = 0; j < 9; ++j) if (dof[j] >= 0) *(u32x4*)(lds + (bufi_) * SC_BUF + dof[j]) = R[j]; } while (0)
        bf16_t* OGr = (bf16_t*)(ws + WS_OG) + ((size_t)b * T + lt) * 512 + h * 128 + es * 16;
        const int odump = SC_OB + (((lt >> 4) * 64 + ((lt >> 2) & 3) * 16) * 4 + (lt & 3)) * 2;
#define SC_OFLUSH(i_) do { if (wave == 1 && (i_) >= 0) { const unsigned char* ob = lds + odump + ((i_) & 1) * 2048; unsigned w_[8]; \
            _Pragma("unroll") for (int e2 = 0; e2 < 8; ++e2) w_[e2] = (unsigned)*(const bf16_t*)(ob + (2 * e2) * 8) | ((unsigned)*(const bf16_t*)(ob + (2 * e2 + 1) * 8) << 16); \
            u32x4* dst_ = (u32x4*)(OGr + (size_t)(i_) * 64 * 512); dst_[0] = (u32x4){w_[0], w_[1], w_[2], w_[3]}; dst_[1] = (u32x4){w_[4], w_[5], w_[6], w_[7]}; } } while (0)
        SC_LOAD(R0, 0); SC_LOAD(R1, 1); SC_LOAD(R2, 2); SC_WRITE(R0, 0); SC_LOAD(R0, 3);
        SC_BAR();
        for (int i = 0; i < 128; i += 3) {
            if (i + 1 < 128) SC_WRITE(R1, (i + 1) & 1);
            SC_LOAD(R1, i + 4); SC_OFLUSH(i - 1);
            SC_BAR();
            if (i + 1 < 128) { if (i + 2 < 128) SC_WRITE(R2, (i + 2) & 1);
                SC_LOAD(R2, i + 5); SC_OFLUSH(i);
                SC_BAR(); }
            if (i + 2 < 128) { if (i + 3 < 128) SC_WRITE(R0, (i + 3) & 1);
                SC_LOAD(R0, i + 6); SC_OFLUSH(i + 1);
                SC_BAR(); } }
        SC_OFLUSH(127);
#undef SC_LOAD
#undef SC_WRITE
#undef SC_OFLUSH
        return;
    }
    const float* GLp = (const float*)(ws + WS_GL) + bh * 128; const float glA = GLp[lane], glB = GLp[64 + lane];
    f32x4 S[8];
#pragma unroll
    for (int m = 0; m < 8; ++m) S[m] = (f32x4){0.f, 0.f, 0.f, 0.f};
    asm volatile("s_waitcnt vmcnt(0)" ::: "memory");
    SC_BAR();
    for (int i = 0; i < 128; ++i) {
        const unsigned char* bufp = lds + (i & 1) * SC_BUF;
        const unsigned char* wp = bufp + SC_W + r16 * 272 + 16 * q; const unsigned char* qgp = bufp + SC_QG + r16 * 272 + 16 * q;
        const unsigned char* kdp = bufp + SC_KD + r16 * 144 + 16 * q; const unsigned char* qkp = bufp + SC_QK + r16 * 144 + 16 * q;
        const unsigned char* up = bufp + SC_UP + lane * 8;
        const float gl = __builtin_bit_cast(float, __builtin_amdgcn_readlane(__builtin_bit_cast(int, (i < 64) ? glA : glB), i & 63));
        bf16x8 fa[16], fb[16];
#pragma unroll
        for (int mt = 0; mt < 4; ++mt)
#pragma unroll
            for (int ks = 0; ks < 4; ++ks) fa[mt * 4 + ks] = *(const bf16x8*)(wp + mt * 16 * 272 + ks * 64);
        u32x2 uw[4];
#pragma unroll
        for (int mt = 0; mt < 4; ++mt) uw[mt] = *(const u32x2*)(up + mt * 512);
#pragma unroll
        for (int m = 0; m < 8; ++m)
#pragma unroll
            for (int k2 = 0; k2 < 2; ++k2) fb[m * 2 + k2] = *(const bf16x8*)(kdp + m * 16 * 144 + k2 * 64);
        bf16x8 Sb[4];
#pragma unroll
        for (int ks = 0; ks < 4; ++ks) Sb[ks] = pack8(S[2 * ks][0], S[2 * ks][1], S[2 * ks][2], S[2 * ks][3], S[2 * ks + 1][0], S[2 * ks + 1][1], S[2 * ks + 1][2], S[2 * ks + 1][3]);
        f32x4 vn[4];
#pragma unroll
        for (int mt = 0; mt < 4; ++mt) vn[mt] = (f32x4){0.f, 0.f, 0.f, 0.f};
#pragma unroll
        for (int ks = 0; ks < 4; ++ks)
#pragma unroll
            for (int mt = 0; mt < 4; ++mt) vn[mt] = MFMA16(fa[mt * 4 + ks], Sb[ks], vn[mt]);
#pragma unroll
        for (int mt = 0; mt < 4; ++mt)
#pragma unroll
            for (int ks = 0; ks < 4; ++ks) fa[mt * 4 + ks] = *(const bf16x8*)(qgp + mt * 16 * 272 + ks * 64);
#pragma unroll
        for (int mt = 0; mt < 4; ++mt) vn[mt] = (f32x4){bflo(uw[mt].x) - vn[mt][0], bfhi(uw[mt].x) - vn[mt][1], bflo(uw[mt].y) - vn[mt][2], bfhi(uw[mt].y) - vn[mt][3]};
        bf16x8 Vb[2];
#pragma unroll
        for (int k2 = 0; k2 < 2; ++k2) Vb[k2] = pack8(vn[2 * k2][0], vn[2 * k2][1], vn[2 * k2][2], vn[2 * k2][3], vn[2 * k2 + 1][0], vn[2 * k2 + 1][1], vn[2 * k2 + 1][2], vn[2 * k2 + 1][3]);
#pragma unroll
        for (int m = 0; m < 8; ++m) S[m] = S[m] * gl;
#pragma unroll
        for (int k2 = 0; k2 < 2; ++k2)
#pragma unroll
            for (int m = 0; m < 8; ++m) S[m] = MFMA16(fb[m * 2 + k2], Vb[k2], S[m]);
#pragma unroll
        for (int mt = 0; mt < 4; ++mt)
#pragma unroll
            for (int k2 = 0; k2 < 2; ++k2) fb[mt * 2 + k2] = *(const bf16x8*)(qkp + mt * 16 * 144 + k2 * 64);
        f32x4 oa[4];
#pragma unroll
        for (int mt = 0; mt < 4; ++mt) oa[mt] = (f32x4){0.f, 0.f, 0.f, 0.f};
#pragma unroll
        for (int ks = 0; ks < 4; ++ks)
#pragma unroll
            for (int mt = 0; mt < 4; ++mt) oa[mt] = MFMA16(fa[mt * 4 + ks], Sb[ks], oa[mt]);
#pragma unroll
        for (int k2 = 0; k2 < 2; ++k2)
#pragma unroll
            for (int mt = 0; mt < 4; ++mt) oa[mt] = MFMA16(fb[mt * 2 + k2], Vb[k2], oa[mt]);
#pragma unroll
        for (int mt = 0; mt < 4; ++mt) { u32x2 o2; o2.x = pk2(oa[mt][0], oa[mt][1]); o2.y = pk2(oa[mt][2], oa[mt][3]); *(u32x2*)(lds + SC_OB + (i & 1) * 2048 + (mt * 64 + lane) * 8) = o2; }
        SC_BAR();
    }
}

DI void tile_load_k(bf16x8 (&kf)[4], const bf16_t* __restrict__ KT, int lane) {
#pragma unroll
    for (int s = 0; s < 4; ++s) kf[s] = *(const bf16x8*)(KT + s * 512 + lane * 8); }
DI void tile_load_v(bf16x8 (&vf)[2][2], const bf16_t* __restrict__ VT, int lane) {
#pragma unroll
    for (int dt = 0; dt < 2; ++dt)
#pragma unroll
        for (int ks = 0; ks < 2; ++ks) vf[dt][ks] = *(const bf16x8*)(VT + (dt * 2 + ks) * 512 + lane * 8); }
DI f32x16 tile_scores(const bf16x8 (&kf)[4], const bf16x8 (&qf)[4], float negM, int hi2, int lo2, float& l) {
    f32x16 st;
#pragma unroll
    for (int i = 0; i < 16; ++i) st[i] = negM;
#pragma unroll
    for (int s = 0; s < 4; ++s) st = MFMA32(kf[s], qf[s], st);
#pragma unroll
    for (int r = 0; r < 16; ++r) { const int cr = (r & 3) + 8 * (r >> 2); float pv = __builtin_amdgcn_exp2f(st[r]); pv = (cr <= hi2 && cr > lo2) ? pv : 0.f; st[r] = pv; l += pv; }
    return st; }
DI void tile_pv(const f32x16& p, const bf16x8 (&vf)[2][2], f32x16 (&o)[2]) {
    const bf16x8 pb0 = pack8(p[0], p[1], p[2], p[3], p[4], p[5], p[6], p[7]), pb1 = pack8(p[8], p[9], p[10], p[11], p[12], p[13], p[14], p[15]);
#pragma unroll
    for (int dt = 0; dt < 2; ++dt) { o[dt] = MFMA32(vf[dt][0], pb0, o[dt]); o[dt] = MFMA32(vf[dt][1], pb1, o[dt]); } }

DI void block_stream(const bf16_t* __restrict__ KB, const bf16_t* __restrict__ VB, int f0, int f1, const bf16x8 (&qf)[4], f32x16 (&o)[2], float& l, float negM, int hi, int lo, int r32, int hh) {
    if (f0 >= f1) return;
    const int lane_ = hh * 32 + r32;
    bf16x8 ka[4], kb[4], va[2][2], vb[2][2];
#define BS_LOAD(kx, vx, f_) do { tile_load_k(kx, KB + (size_t)(f_) * 2048, lane_); tile_load_v(vx, VB + (size_t)(f_) * 2048, lane_); } while (0)
#define BS_COMP(kx, vx, f_) do { const int k0_ = 32 * (f_) + 4 * hh; const f32x16 p_ = tile_scores(kx, qf, negM, hi - k0_, lo - k0_, l); tile_pv(p_, vx, o); } while (0)
    BS_LOAD(ka, va, f0);
#pragma unroll 1
    for (int f = f0; f < f1; f += 2) {
        const bool h1 = f + 1 < f1;
        if (h1) BS_LOAD(kb, vb, f + 1);
        BS_COMP(ka, va, f);
        if (h1) { if (f + 2 < f1) BS_LOAD(ka, va, f + 2); BS_COMP(kb, vb, f + 1); } }
#undef BS_LOAD
#undef BS_COMP
}

DI float maxabs64(const float* g, int lane) { float v = fabsf(g[lane]);
#pragma unroll
    for (int o = 1; o < 64; o <<= 1) v = fmaxf(v, __shfl_xor(v, o));
    return v; }

#define LOADQF(qf) do { _Pragma("unroll") for (int s_ = 0; s_ < 4; ++s_) qf[s_] = *(const bf16x8*)(QL + row * 72 + 16 * s_ + 8 * hh); } while (0)
DI void nsa_unit(const Args& A, int unit, unsigned char* lds) {
    const int tid = otid(), lane = tid & 63, wave = __builtin_amdgcn_readfirstlane(tid >> 6), r32 = lane & 31, hh = lane >> 5;
    const int ti = 127 - (unit >> 2), bg = unit & 3, b = bg >> 1, g = bg & 1;
    unsigned char* ws = A.ws;
    bf16_t* QL = (bf16_t*)lds;
    int* OL = (int*)(lds + 36864);
    int* LL = (int*)(lds + 36864 + 67584);
    unsigned* BM = (unsigned*)(lds + 36864 + 67584 + 1024);
    int* CNT = (int*)(lds + 36864 + 67584 + 2048);
    float* SCL = (float*)(lds + 36864 + 67584 + 2048 + 64);
    float* IMP = (float*)(lds + 108544);
    const int slot = r32 >> 2, hd = r32 & 3, tl = wave * 8 + slot, trow = ti * 64 + tl; const size_t tokg = (size_t)b * T + trow;
    const int row = wave * 32 + r32;
    bf16_t* PA = (bf16_t*)IMP + row * 64;
    const float mq = maxabs64(A.in[I_QG], lane) * 8.08f * LOG2E;
    for (int i = tid; i < 256 + 16; i += 512) BM[i] = 0u;
    { const bf16_t* qp = (const bf16_t*)(ws + WS_QN) + tokg * 512 + (g * 4 + hd) * 64 + 8 * hh;
#pragma unroll
      for (int s = 0; s < 4; ++s) *(bf16x8*)(QL + row * 72 + 16 * s + 8 * hh) = *(const bf16x8*)(qp + 16 * s); }
    const float* gp = (const float*)(ws + WS_GATES) + tokg * 24 + (g * 4 + hd) * 3;
    __syncthreads();
    {   const float negMc = -mq * maxabs64(A.in[I_KCG], lane);
        bf16x8 qf[4]; LOADQF(qf);
        const int cmax_row = (trow >= 31) ? ((trow - 31) >> 4) : -1; const int tmaxw = ti * 64 + wave * 8 + 7; const int ntc = (tmaxw >= 31) ? ((((tmaxw - 31) >> 4) >> 5) + 1) : 0;
        const bf16_t* Kc = (const bf16_t*)(ws + WS_KC) + (size_t)(b * 2 + g) * 512 * 64; const bf16_t* VcT = (const bf16_t*)(ws + WS_VCT) + (size_t)(b * 2 + g) * 64 * 512;
        float lc = 0.f;
        if (ntc > 0) { bf16x8 ka[4], kb[4]; tile_load_k(ka, Kc, lane);
#pragma unroll 1
            for (int ct = 0; ct < ntc; ct += 2) { const bool h1 = ct + 1 < ntc;
                if (h1) tile_load_k(kb, Kc + (ct + 1) * 2048, lane);
                tile_scores(ka, qf, negMc, cmax_row - 32 * ct - 4 * hh, -1000000, lc);
                if (h1) { if (ct + 2 < ntc) tile_load_k(ka, Kc + (ct + 2) * 2048, lane); tile_scores(kb, qf, negMc, cmax_row - 32 * (ct + 1) - 4 * hh, -1000000, lc); } } }
        lc += __shfl_xor(lc, 32);
        const float inv = (lc > 0.f) ? 1.f / lc : 0.f;
        f32x16 oc[2]; for (int i = 0; i < 16; ++i) { oc[0][i] = 0.f; oc[1][i] = 0.f; }
        float carry = 0.f, ldummy = 0.f;
#define CM_POST(p, ct_) do { float recv[4], bq[4]; \
            _Pragma("unroll") for (int jq = 0; jq < 4; ++jq) recv[jq] = __shfl_xor(p[4 * jq + 3], 32); \
            _Pragma("unroll") for (int jq = 0; jq < 4; ++jq) { const float pred = hh ? recv[jq] : (jq ? recv[jq - 1] : carry); float s_ = ((p[4 * jq] + p[4 * jq + 1]) + (p[4 * jq + 2] + p[4 * jq + 3]) + pred) * inv; \
                s_ += __shfl_xor(s_, 1); s_ += __shfl_xor(s_, 2); bq[jq] = s_; } \
            carry = recv[3]; \
            IMP[tl * 128 + 8 * (ct_) + 2 * hd + hh] = (hd == 0) ? bq[0] : (hd == 1) ? bq[1] : (hd == 2) ? bq[2] : bq[3]; } while (0)
        if (ntc > 0) { bf16x8 ka[4], kb[4], va[2][2], vb[2][2]; tile_load_k(ka, Kc, lane); tile_load_v(va, VcT, lane);
#pragma unroll 1
            for (int ct = 0; ct < ntc; ct += 2) { const bool h1 = ct + 1 < ntc;
                if (h1) { tile_load_k(kb, Kc + (ct + 1) * 2048, lane); tile_load_v(vb, VcT + (ct + 1) * 2048, lane); }
                { const f32x16 p = tile_scores(ka, qf, negMc, cmax_row - 32 * ct - 4 * hh, -1000000, ldummy); tile_pv(p, va, oc); CM_POST(p, ct); }
                if (h1) { if (ct + 2 < ntc) { tile_load_k(ka, Kc + (ct + 2) * 2048, lane); tile_load_v(va, VcT + (ct + 2) * 2048, lane); }
                    const f32x16 p = tile_scores(kb, qf, negMc, cmax_row - 32 * (ct + 1) - 4 * hh, -1000000, ldummy); tile_pv(p, vb, oc); CM_POST(p, ct + 1); } } }
#undef CM_POST
        for (int ct = ntc; ct < 16; ++ct) IMP[tl * 128 + 8 * ct + 2 * hd + hh] = 0.f;
        if (ti >= 3) {
            __builtin_amdgcn_s_waitcnt(0xC07F); asm volatile("" ::: "memory");
            unsigned key[16]; const int li = hd + 4 * hh;
#pragma unroll
            for (int i4 = 0; i4 < 4; ++i4) { const f32x4 v4 = *(const f32x4*)(IMP + tl * 128 + li * 16 + 4 * i4);
#pragma unroll
                for (int i = 0; i < 4; ++i) { const int n = li * 16 + 4 * i4 + i; key[4 * i4 + i] = (n >= 1 && n <= ti - 2) ? ((__float_as_uint(fmaxf(v4[i], 0.f)) & ~0xFFu) | (unsigned)(128 - n)) : 0u; } }
#pragma unroll 1
            for (int it = 0; it < 13; ++it) { unsigned m = key[0];
#pragma unroll
                for (int i = 1; i < 16; ++i) m = (key[i] > m) ? key[i] : m;
                { unsigned o_; o_ = __shfl_xor(m, 1); m = o_ > m ? o_ : m; o_ = __shfl_xor(m, 2); m = o_ > m ? o_ : m; o_ = __shfl_xor(m, 32); m = o_ > m ? o_ : m; }
#pragma unroll
                for (int i = 0; i < 16; ++i) key[i] = (key[i] == m) ? 0u : key[i];
                if (m != 0u && hd == 0 && hh == 0) { const int nsel = 128 - (int)(m & 0xFFu); atomicOr(&BM[nsel * 2 + (tl >> 5)], 1u << (tl & 31)); } }
        }
        __builtin_amdgcn_s_waitcnt(0xC07F); asm volatile("" ::: "memory");
        { const float sc = gp[0] * inv;
#pragma unroll
          for (int dt = 0; dt < 2; ++dt)
#pragma unroll
              for (int r4 = 0; r4 < 4; ++r4) { u32x2 o; o.x = pk2(oc[dt][4 * r4] * sc, oc[dt][4 * r4 + 1] * sc); o.y = pk2(oc[dt][4 * r4 + 2] * sc, oc[dt][4 * r4 + 3] * sc);
                  *(u32x2*)(PA + 32 * dt + 8 * r4 + 4 * hh) = o; } }
    }
    const float negMs = -mq * maxabs64(A.in[I_KSG], lane);
    const bf16_t* KS = (const bf16_t*)(ws + WS_KSN) + (size_t)(b * 2 + g) * T * 64; const bf16_t* VS = (const bf16_t*)(ws + WS_VST) + (size_t)(b * 2 + g) * 128 * 4096;
    { bf16x8 qf[4]; LOADQF(qf);
      f32x16 os[2]; float lsel = 0.f; for (int i = 0; i < 16; ++i) { os[0][i] = 0.f; os[1][i] = 0.f; }
      block_stream(KS, VS, (ti >= 1 ? 2 * ti - 2 : 0), 2 * ti + 2, qf, os, lsel, negMs, trow, -1, r32, hh);
      if (ti >= 2) block_stream(KS, VS, 0, 2, qf, os, lsel, negMs, trow, -1, r32, hh);
      lsel += __shfl_xor(lsel, 32);
      const float scl = 1048576.0f / lsel;
#pragma unroll
      for (int dt = 0; dt < 2; ++dt)
#pragma unroll
          for (int r = 0; r < 16; ++r) OL[row * 66 + 32 * dt + crow(r, hh)] = __float2int_rn(os[dt][r] * scl);
      if (hh == 0) { LL[row] = __float2int_rn(lsel * scl); SCL[row] = scl; } }
    { const bf16_t* KW = (const bf16_t*)(ws + WS_KWN) + (size_t)(b * 2 + g) * T * 64; const bf16_t* VW = (const bf16_t*)(ws + WS_VWT) + (size_t)(b * 2 + g) * 128 * 4096;
      const float negMw = -mq * maxabs64(A.in[I_KWG], lane);
      bf16x8 qf[4]; LOADQF(qf);
      f32x16 ow[2]; float lw = 0.f; for (int i = 0; i < 16; ++i) { ow[0][i] = 0.f; ow[1][i] = 0.f; }
      const int tw0 = ti * 64 + wave * 8; const int nlo = (tw0 - 511 > 0) ? ((tw0 - 511) >> 6) : 0;
      block_stream(KW, VW, 2 * nlo, 2 * ti + 2, qf, ow, lw, negMw, trow, trow - 512, r32, hh);
      lw += __shfl_xor(lw, 32); const float sc = gp[2] / lw;
#pragma unroll
      for (int dt = 0; dt < 2; ++dt)
#pragma unroll
          for (int r4 = 0; r4 < 4; ++r4) { bf16_t* pp = PA + 32 * dt + 8 * r4 + 4 * hh; const u32x2 pa = *(const u32x2*)pp;
              u32x2 o; o.x = pk2(bflo(pa.x) + ow[dt][4 * r4] * sc, bfhi(pa.x) + ow[dt][4 * r4 + 1] * sc); o.y = pk2(bflo(pa.y) + ow[dt][4 * r4 + 2] * sc, bfhi(pa.y) + ow[dt][4 * r4 + 3] * sc);
              *(u32x2*)pp = o; } }
    __syncthreads();
    if (ti >= 3) {
        unsigned long long m_cur = 0ull; int n_cur = 0;
        int n_a = 0, n_b = 0; unsigned long long m_a = 0ull, m_b = 0ull;
#define ADVANCE(n_it, m_it, ok) do { ok = true; while (m_cur == 0ull) { int k_ = 0; if (lane == 0) k_ = atomicAdd(CNT, 1); k_ = __builtin_amdgcn_readfirstlane(k_); \
                if (k_ >= ti - 2) { ok = false; break; } n_cur = ti - 2 - k_; \
                m_cur = ((unsigned long long)__builtin_amdgcn_readfirstlane(BM[n_cur * 2 + 1]) << 32) | (unsigned)__builtin_amdgcn_readfirstlane(BM[n_cur * 2]); } \
            if (ok) { n_it = n_cur; m_it = m_cur; for (int i_ = 0; i_ < 8; ++i_) m_cur &= m_cur - 1ull; } } while (0)
        bool have; ADVANCE(n_a, m_a, have);
        bf16x8 ka[2][4], kb[2][4];
        if (have) { tile_load_k(ka[0], KS + (size_t)n_a * 4096, lane); tile_load_k(ka[1], KS + (size_t)n_a * 4096 + 2048, lane); }
        while (have) {
            bool have_b; ADVANCE(n_b, m_b, have_b);
            if (have_b) { tile_load_k(kb[0], KS + (size_t)n_b * 4096, lane); tile_load_k(kb[1], KS + (size_t)n_b * 4096 + 2048, lane); }
            bf16x8 va[2][2][2];
            tile_load_v(va[0], VS + (size_t)n_a * 4096, lane); tile_load_v(va[1], VS + (size_t)n_a * 4096 + 2048, lane);
            unsigned long long mm = m_a; for (int i = 0; i < slot; ++i) mm &= mm - 1ull;
            const bool active = mm != 0ull; const int tt = active ? (__ffsll((long long)mm) - 1) : (__ffsll((long long)m_a) - 1);
            const int grow = tt * 4 + hd;
            bf16x8 qg[4];
#pragma unroll
            for (int s = 0; s < 4; ++s) qg[s] = *(const bf16x8*)(QL + grow * 72 + 16 * s + 8 * hh);
            f32x16 oo[2]; for (int i = 0; i < 16; ++i) { oo[0][i] = 0.f; oo[1][i] = 0.f; }
            float lp = 0.f; const int hi2 = active ? 1000000 : -1000000;
#pragma unroll
            for (int kt = 0; kt < 2; ++kt) { const f32x16 p = tile_scores(ka[kt], qg, negMs, hi2, -1000000, lp); tile_pv(p, va[kt], oo); }
            if (active) { const float scl = SCL[grow];
#pragma unroll
                for (int dt = 0; dt < 2; ++dt)
#pragma unroll
                    for (int r = 0; r < 16; ++r) atomicAdd(&OL[grow * 66 + 32 * dt + crow(r, hh)], __float2int_rn(oo[dt][r] * scl));
                atomicAdd(&LL[grow], __float2int_rn(lp * scl)); }
#pragma unroll
            for (int kt = 0; kt < 2; ++kt)
#pragma unroll
                for (int s = 0; s < 4; ++s) ka[kt][s] = kb[kt][s];
            n_a = n_b; m_a = m_b; have = have_b;
        }
#undef ADVANCE
    }
    __syncthreads();
    { const float sc = gp[1] / (float)LL[row];
      bf16_t* op = (bf16_t*)(ws + WS_ONSA) + tokg * 512 + (g * 4 + hd) * 64;
#pragma unroll
      for (int dt = 0; dt < 2; ++dt)
#pragma unroll
          for (int r4 = 0; r4 < 4; ++r4) { float f[4];
              const u32x2 pa = *(const u32x2*)(PA + 32 * dt + 8 * r4 + 4 * hh); const float pf[4] = {bflo(pa.x), bfhi(pa.x), bflo(pa.y), bfhi(pa.y)};
#pragma unroll
              for (int i = 0; i < 4; ++i) { const int r = 4 * r4 + i; f[i] = pf[i] + (float)OL[row * 66 + 32 * dt + crow(r, hh)] * sc; }
              u32x2 o; o.x = pk2(f[0], f[1]); o.y = pk2(f[2], f[3]);
              *(u32x2*)(op + 32 * dt + 8 * r4 + 4 * hh) = o; } }
    __syncthreads();
}

DI void phase_finalize(const Args& A) {
    const int tid = otid(), lane = tid & 63, wave = tid >> 6; const int gw = blockIdx.x * 8 + wave, NGW = gridDim.x * 8;
    unsigned char* ws = A.ws;
    for (int tok = gw; tok < NTOK; tok += NGW) {
        bf16_t* oc = (bf16_t*)(ws + WS_OCAT) + (size_t)tok * 1024;
        { const u32x4 w = *(const u32x4*)((const bf16_t*)(ws + WS_ONSA) + (size_t)tok * 512 + 8 * lane);
          float f[8] = {bflo(w.x), bfhi(w.x), bflo(w.y), bfhi(w.y), bflo(w.z), bfhi(w.z), bflo(w.w), bfhi(w.w)}; float s = 0.f;
#pragma unroll
          for (int i = 0; i < 8; ++i) s += f[i] * f[i];
          const float rs = rsqrtf(wave_sum(s) * (1.f / 512.f) + EPS); const float* gn = A.in[I_NSAOG] + 8 * lane;
          u32x4 o; o.x = pk2(f[0] * rs * gn[0], f[1] * rs * gn[1]); o.y = pk2(f[2] * rs * gn[2], f[3] * rs * gn[3]); o.z = pk2(f[4] * rs * gn[4], f[5] * rs * gn[5]); o.w = pk2(f[6] * rs * gn[6], f[7] * rs * gn[7]);
          *(u32x4*)(oc + 8 * lane) = o; }
        { const u32x4 w = *(const u32x4*)((const bf16_t*)(ws + WS_OG) + (size_t)tok * 512 + 8 * lane);
          const u32x4 zw = *(const u32x4*)((const bf16_t*)(ws + WS_U) + (size_t)tok * INWP + C_GZ + 8 * lane);
          float f[8] = {bflo(w.x), bfhi(w.x), bflo(w.y), bfhi(w.y), bflo(w.z), bfhi(w.z), bflo(w.w), bfhi(w.w)};
          float z[8] = {bflo(zw.x), bfhi(zw.x), bflo(zw.y), bfhi(zw.y), bflo(zw.z), bfhi(zw.z), bflo(zw.w), bfhi(zw.w)}; float s = 0.f;
#pragma unroll
          for (int i = 0; i < 8; ++i) s += f[i] * f[i];
          s += __shfl_xor(s, 1); s += __shfl_xor(s, 2); s += __shfl_xor(s, 4); s += __shfl_xor(s, 8);
          const float rs = rsqrtf(s * (1.f / 128.f) + EPS); const float* gn = A.in[I_GDNOG] + (8 * lane & 127); float o8[8];
#pragma unroll
          for (int i = 0; i < 8; ++i) o8[i] = f[i] * rs * gn[i] * z[i] * sigm(z[i]);
          u32x4 o; o.x = pk2(o8[0], o8[1]); o.y = pk2(o8[2], o8[3]); o.z = pk2(o8[4], o8[5]); o.w = pk2(o8[6], o8[7]);
          *(u32x4*)(oc + 512 + 8 * lane) = o; }
    }
}

DI void phase_router(const Args& A, unsigned char* lds) {
    const int tid = otid(), lane = tid & 63, wave = __builtin_amdgcn_readfirstlane(tid >> 6);
    unsigned char* ws = A.ws; const float* x1 = A.out; const float* rw = A.in[I_RW]; const float* fg = A.in[I_FFNG];
    float* partL = (float*)lds;
    float* ssL = partL + 8 * 32 * 33;
    unsigned* cntL = (unsigned*)(ssL + 256); unsigned* baseL = cntL + 32;
    const int i32 = lane & 31, kh = lane >> 5;
    for (int task = blockIdx.x; task < NTOK / 32; task += gridDim.x) {
        const int tok = task * 32 + i32; const float* xr = x1 + (size_t)tok * D + 128 * wave;
        f32x16 acc; for (int i = 0; i < 16; ++i) acc[i] = 0.f; float ss = 0.f;
#pragma unroll 8
        for (int kb = 0; kb < 16; ++kb) { const int k0 = 8 * kb + 4 * kh; const f32x4 av = *(const f32x4*)(xr + k0); const f32x4 gv = *(const f32x4*)(fg + 128 * wave + k0);
            ss += av[0] * av[0] + av[1] * av[1] + av[2] * av[2] + av[3] * av[3];
#pragma unroll
            for (int s = 0; s < 4; ++s) acc = __builtin_amdgcn_mfma_f32_32x32x2f32(av[s], rw[(size_t)(128 * wave + k0 + s) * 32 + i32] * gv[s], acc, 0, 0, 0); }
        ss += __shfl_xor(ss, 32);
        if (kh == 0) ssL[wave * 32 + i32] = ss;
#pragma unroll
        for (int r = 0; r < 16; ++r) partL[(wave * 32 + crow(r, kh)) * 33 + i32] = acc[r];
        __syncthreads();
        if (wave == 0 && lane < 32) { float sst = 0.f;
#pragma unroll
            for (int w = 0; w < 8; ++w) sst += ssL[w * 32 + lane];
            const float rstd = rsqrtf(sst * (1.f / D) + EPS); ((float*)(ws + WS_RSTD2))[tok] = rstd;
            float v[4] = {-3.0e38f, -3.0e38f, -3.0e38f, -3.0e38f}; int id[4] = {0, 0, 0, 0}; const float* rb = A.in[I_RB];
            for (int e = 0; e < 32; ++e) { float lg = 0.f;
#pragma unroll
                for (int w = 0; w < 8; ++w) lg += partL[(w * 32 + lane) * 33 + e];
                const float x = lg * rstd + rb[e];
                if (x > v[3]) { if (x > v[0]) { v[3] = v[2]; id[3] = id[2]; v[2] = v[1]; id[2] = id[1]; v[1] = v[0]; id[1] = id[0]; v[0] = x; id[0] = e; }
                    else if (x > v[1]) { v[3] = v[2]; id[3] = id[2]; v[2] = v[1]; id[2] = id[1]; v[1] = x; id[1] = e; }
                    else if (x > v[2]) { v[3] = v[2]; id[3] = id[2]; v[2] = x; id[2] = e; }
                    else { v[3] = x; id[3] = e; } } }
            const float e0 = 1.f, e1 = __expf(v[1] - v[0]), e2 = __expf(v[2] - v[0]), e3 = __expf(v[3] - v[0]); const float inv = 1.f / (e0 + e1 + e2 + e3);
            const float gt[4] = {e0 * inv, e1 * inv, e2 * inv, e3 * inv};
            cntL[lane] = 0u; asm volatile("s_waitcnt lgkmcnt(0)" ::: "memory");
            unsigned lp[4];
#pragma unroll
            for (int k = 0; k < 4; ++k) lp[k] = atomicAdd(&cntL[id[k]], 1u);
            asm volatile("s_waitcnt lgkmcnt(0)" ::: "memory");
            { const unsigned c = cntL[lane]; baseL[lane] = c ? atomicAdd((unsigned*)(ws + WS_CTL) + CW_CNT + 64 * lane, c) : 0u; }
            asm volatile("s_waitcnt vmcnt(0) lgkmcnt(0)" ::: "memory");
#pragma unroll
            for (int k = 0; k < 4; ++k) { const int pos = (int)(baseL[id[k]] + lp[k]);
                ((int*)(ws + WS_TOKE))[tok * 4 + k] = id[k]; ((float*)(ws + WS_TOKG))[tok * 4 + k] = gt[k]; ((int*)(ws + WS_TOKPOS))[tok * 4 + k] = pos; } }
        __syncthreads();
    }
}

DI void phase_gather(const Args& A, unsigned char* lds) {
    const int tid = otid(), lane = tid & 63, wave = tid >> 6; const int gw = blockIdx.x * 8 + wave, NGW = gridDim.x * 8;
    unsigned char* ws = A.ws; int* psL = (int*)lds;
    if (tid == 0) { const unsigned* cnt = (const unsigned*)(ws + WS_CTL) + CW_CNT; int acc = 0;
        for (int e = 0; e < 32; ++e) { psL[e] = acc; acc += ((int)cnt[64 * e] + 255) & ~255; }
        psL[32] = acc;
        if (blockIdx.x == 0) { int* ctl = (int*)(ws + WS_CTL); ctl[CW_NT] = acc >> 8; int e = 0;
            for (int r = 0; r < (acc >> 8); ++r) { while (r * 256 >= psL[e + 1]) ++e; ctl[CW_TILEE + r] = e; } } }
    __syncthreads();
    const float* x1 = A.out; const float* fg = A.in[I_FFNG]; f32x4 gv[4];
#pragma unroll
    for (int j = 0; j < 4; ++j) gv[j] = *(const f32x4*)(fg + 4 * lane + 256 * j);
    for (int pr = gw; pr < NTOK * 4; pr += NGW) { const int tok = pr >> 2;
        const int e = ((const int*)(ws + WS_TOKE))[pr], pos = ((const int*)(ws + WS_TOKPOS))[pr]; const int dest = psL[e] + pos;
        if (lane == 0) { ((int*)(ws + WS_DEST))[pr] = dest; ((float*)(ws + WS_ROWG))[dest] = ((const float*)(ws + WS_TOKG))[pr]; }
        const float rs = ((const float*)(ws + WS_RSTD2))[tok]; const f32x4* xr = (const f32x4*)(x1 + (size_t)tok * D) + lane;
        u32x2* o = (u32x2*)((bf16_t*)(ws + WS_XS) + (size_t)dest * D) + lane;
#pragma unroll
        for (int j = 0; j < 4; ++j) { const f32x4 v = xr[64 * j]; u32x2 w; w.x = pk2(v.x * rs * gv[j].x, v.y * rs * gv[j].y); w.y = pk2(v.z * rs * gv[j].z, v.w * rs * gv[j].w); o[64 * j] = w; } }
}

DI void phase_combine(const Args& A) {
    const int tid = otid(), lane = tid & 63, wave = tid >> 6; const int gw = blockIdx.x * 8 + wave, NGW = gridDim.x * 8;
    unsigned char* ws = A.ws; const bf16_t* YS = (const bf16_t*)(ws + WS_XS);
    for (int tok = gw; tok < NTOK; tok += NGW) { f32x4* xr = (f32x4*)(A.out + (size_t)tok * D) + lane; f32x4 v[4];
#pragma unroll
        for (int j = 0; j < 4; ++j) v[j] = xr[64 * j];
#pragma unroll
        for (int k = 0; k < 4; ++k) { const int dest = ((const int*)(ws + WS_DEST))[tok * 4 + k]; const u32x2* yr = (const u32x2*)(YS + (size_t)dest * D) + lane;
#pragma unroll
            for (int j = 0; j < 4; ++j) { const u32x2 w = yr[64 * j]; v[j].x += bflo(w.x); v[j].y += bfhi(w.x); v[j].z += bflo(w.y); v[j].w += bfhi(w.y); } }
#pragma unroll
        for (int j = 0; j < 4; ++j) xr[64 * j] = v[j]; }
}


#define XB_TMO      128
#define XB_XCNT(j)  (256  + 64 * (j))
#define XB_XSUB(j)  (1280 + 64 * (j))
#define XB_XGEN(j)  (2304 + 64 * (j))
#define XB_TOP      3328
#define XB_TOPGEN   3392
#define XCD_BAR_WORDS 3456
#define XB_SPIN_CAP (1u << 22)
DI unsigned xb_ld(unsigned* p)              { return __hip_atomic_load(p, __ATOMIC_RELAXED, __HIP_MEMORY_SCOPE_AGENT); }
DI unsigned xb_add(unsigned* p, unsigned v) { return __hip_atomic_fetch_add(p, v, __ATOMIC_RELAXED, __HIP_MEMORY_SCOPE_AGENT); }
DI unsigned xb_xcc_id() { return (unsigned)__builtin_amdgcn_s_getreg((3 << 11) | 20) & 0xFu; }
#define XB_SPIN(cond, bar) do { unsigned _sp = 0; while (cond) { __builtin_amdgcn_s_sleep(1); \
    if ((++_sp & 255u) == 0u) { if (xb_ld(&(bar)[XB_TMO])) break; if (_sp > XB_SPIN_CAP) { atomicAdd(&(bar)[XB_TMO], 1u); break; } } } } while (0)
struct XcdBarrier { unsigned* bar; unsigned x; volatile LAS unsigned* st; };
DI XcdBarrier xcd_barrier_post(unsigned* bar, volatile LAS unsigned* st) {
    XcdBarrier b; b.bar = bar; b.x = xb_xcc_id(); b.st = st;
    if (threadIdx.x == 0) (void)xb_add(&bar[XB_XCNT(b.x)], 1u);
    return b; }
DI void xcd_barrier_complete(unsigned* bar, unsigned x, unsigned& nloc, unsigned& nx) {
    const unsigned G = gridDim.x * gridDim.y * gridDim.z;
    unsigned sum, cnt, mine, sp = 0u;
    for (;;) {
        sum = 0u; cnt = 0u; mine = 0u;
#pragma unroll
        for (unsigned j = 0; j < 16; ++j) { const unsigned c = xb_ld(&bar[XB_XCNT(j)]); sum += c; cnt += (c > 0u) ? 1u : 0u; mine = (j == x) ? c : mine; }
        if (sum == G) break;
        __builtin_amdgcn_s_sleep(1);
        if ((++sp & 255u) == 0u) { if (xb_ld(&bar[XB_TMO])) break; if (sp > XB_SPIN_CAP) { atomicAdd(&bar[XB_TMO], 1u); break; } }
    }
    nloc = mine > 0u ? mine : 1u; nx = cnt > 0u ? cnt : 1u; }
DI void xcd_barrier(const XcdBarrier& b) {
    asm volatile("s_waitcnt vmcnt(0)" ::: "memory");
    __syncthreads();
    if (threadIdx.x == 0) {
        unsigned* bar = b.bar;
        __builtin_amdgcn_s_waitcnt(0);
        unsigned nloc = b.st[0], nx = b.st[1];
        if (nloc == 0u) { xcd_barrier_complete(bar, b.x, nloc, nx); b.st[0] = nloc; b.st[1] = nx; }
        const unsigned old = xb_add(&bar[XB_XSUB(b.x)], 1u);
        const unsigned gen = old / nloc;
        if (old + 1u == (gen + 1u) * nloc) {
            __builtin_amdgcn_fence(__ATOMIC_RELEASE, "agent");
            asm volatile("s_waitcnt vmcnt(0)" ::: "memory");
            const unsigned og = xb_add(&bar[XB_TOP], 1u);
            const unsigned tg = og / nx;
            if (og + 1u == (tg + 1u) * nx) xb_add(&bar[XB_TOPGEN], 1u);
            else XB_SPIN(xb_ld(&bar[XB_TOPGEN]) == tg, bar);
            __builtin_amdgcn_fence(__ATOMIC_ACQUIRE, "agent");
            xb_add(&bar[XB_XGEN(b.x)], 1u);
            asm volatile("s_waitcnt vmcnt(0)" ::: "memory");
        } else {
            XB_SPIN(xb_ld(&bar[XB_XGEN(b.x)]) == gen, bar);
            __builtin_amdgcn_fence(__ATOMIC_ACQUIRE, "agent");
            asm volatile("s_waitcnt vmcnt(0)" ::: "memory");
        }
    }
    __syncthreads();
}

__global__ void __launch_bounds__(512, 2) mega(Args A) {
    extern __shared__ __attribute__((aligned(16))) unsigned char lds[];
    cg::grid_group grid = cg::this_grid();
    const int lo = A.ph_lo, hi = A.ph_hi, tid = threadIdx.x;
    unsigned char* ws = A.ws;
    int* taskL = (int*)(lds + LDS_MISC);
    if (tid < 2) ((volatile LAS unsigned*)(lds + LDS_MISC + 16))[tid] = 0u;
    __syncthreads();
    XcdBarrier xbar = xcd_barrier_post((unsigned*)(ws + WS_CTL) + CW_BAR, (volatile LAS unsigned*)(lds + LDS_MISC + 16));
#define IN(k) (lo <= (k) && (k) < hi)
#define SEAM(k) do { if (IN(k) && IN((k) + 1)) { if ((k) == 0) grid.sync(); else xcd_barrier(xbar); } } while (0)

#ifndef REPEAT_PH
#define REPEAT_PH -1
#endif
#define REP(k) (REPEAT_PH == (k) ? 2 : 1)
    for (int rep = 0; rep < REP(0); ++rep) { if (IN(0)) phase0(A, lds, rep == 0); if (rep + 1 < REP(0)) grid.sync(); }
    SEAM(0);
    for (int rep = 0; rep < REP(1); ++rep) { if (IN(1)) { pg8::Gemm g{(const bf16_t*)(ws + WS_XN), (const bf16_t*)(ws + WS_WTIN), NTOK, INWP, D}; pg8::StaticOrder S; S.init(NTOK, INWP, gridDim.x, blockIdx.x);
        pg8::EpiU E{(bf16_t*)(ws + WS_U), INWP}; pg8::gemm_phase<pg8::EpiU, pg8::StaticOrder>((PG8_LAS unsigned char*)lds, g, S, E); } if (rep + 1 < REP(1)) grid.sync(); }
    SEAM(1);
    for (int rep = 0; rep < REP(2); ++rep) { if (IN(2)) {
        for (;;) { if (tid == 0) *taskL = atomicAdd((int*)(ws + WS_CTL) + (rep ? CW_Q2B : CW_Q2), 1); __syncthreads(); const int task = *taskL; __syncthreads();
            if (task >= 1408) break;
            if (task < 128) compress_task(A, task, lds); else if (task < 1152) gdn_chunk_task(A, task - 128, lds); else nsa_prep_task(A, task - 1152, lds); } } if (rep + 1 < REP(2)) grid.sync(); }
    SEAM(2);
    for (int rep = 0; rep < REP(3); ++rep) { if (IN(3)) {
        if (blockIdx.x < 64) { gdn_scan_block(A, blockIdx.x, lds); __syncthreads(); }
        { const int bg0 = (int)(xb_xcc_id() & 3u);
          for (int q = 0; q < 4; ++q) { const int bgq = (bg0 + q) & 3;
            for (;;) { if (tid == 0) *taskL = atomicAdd((int*)(ws + WS_CTL) + (rep ? CW_Q3B : CW_Q3) + bgq, 1); __syncthreads(); const int u = *taskL; __syncthreads();
                if (u >= 128) break;
                nsa_unit(A, u * 4 + bgq, lds); } } } } if (rep + 1 < REP(3)) grid.sync(); }
    SEAM(3);
    for (int rep = 0; rep < REP(4); ++rep) { if (IN(4)) phase_finalize(A); if (rep + 1 < REP(4)) grid.sync(); }
    SEAM(4);
    for (int rep = 0; rep < REP(5); ++rep) { if (IN(5)) { pg8::Gemm g{(const bf16_t*)(ws + WS_OCAT), (const bf16_t*)(ws + WS_WTOUT), NTOK, D, D}; pg8::StaticOrder S; S.init(NTOK, D, gridDim.x, blockIdx.x);
        pg8::EpiRes E{A.in[I_X], A.out, D}; pg8::gemm_phase<pg8::EpiRes, pg8::StaticOrder>((PG8_LAS unsigned char*)lds, g, S, E); } if (rep + 1 < REP(5)) grid.sync(); }
    SEAM(5);
    for (int rep = 0; rep < REP(6); ++rep) { if (IN(6)) phase_router(A, lds);
        if (rep + 1 < REP(6)) { grid.sync(); if (blockIdx.x == 0 && tid < 32) ((unsigned*)(ws + WS_CTL))[CW_CNT + 64 * tid] = 0u; grid.sync(); } }
    SEAM(6);
    for (int rep = 0; rep < REP(7); ++rep) { if (IN(7)) phase_gather(A, lds); if (rep + 1 < REP(7)) grid.sync(); }
    SEAM(7);
    for (int rep = 0; rep < REP(8); ++rep) { if (IN(8)) { const int* ctl = (const int*)(ws + WS_CTL); const int nM = ctl[CW_NT];
        pg8::Gemm g{(const bf16_t*)(ws + WS_XS), (const bf16_t*)(ws + WS_EXPGU), 0, 0, D}; pg8::MoeOrder S; S.init(nM, 8, gridDim.x, blockIdx.x, ctl + CW_TILEE);
        pg8::EpiSwiglu E{(bf16_t*)(ws + WS_HID), A.in[I_EBG], A.in[I_EBU]}; pg8::gemm_phase<pg8::EpiSwiglu, pg8::MoeOrder>((PG8_LAS unsigned char*)lds, g, S, E); } if (rep + 1 < REP(8)) grid.sync(); }
    SEAM(8);
    for (int rep = 0; rep < REP(9); ++rep) { if (IN(9)) { const int* ctl = (const int*)(ws + WS_CTL); const int nM = ctl[CW_NT];
        pg8::Gemm g{(const bf16_t*)(ws + WS_HID), (const bf16_t*)(ws + WS_EXPD), 0, 0, D}; pg8::MoeOrder S; S.init(nM, 4, gridDim.x, blockIdx.x, ctl + CW_TILEE);
        pg8::EpiDown E{(bf16_t*)(ws + WS_XS), A.in[I_EBD], (const float*)(ws + WS_ROWG)}; pg8::gemm_phase<pg8::EpiDown, pg8::MoeOrder>((PG8_LAS unsigned char*)lds, g, S, E); } if (rep + 1 < REP(9)) grid.sync(); }
    SEAM(9);
    if (IN(10)) phase_combine(A);
#undef IN
#undef SEAM
}

constexpr int NPHASE = 11;
#ifndef N_LAUNCHES
#define N_LAUNCHES 1
#endif
extern "C" void kernel_launch(void* const* d_in, const int* in_sizes, int n_in, void* d_out, int out_size, void* d_ws, size_t ws_size, hipStream_t stream) {
    static int grid = 0;
    if (grid == 0) {
        if (n_in != 32 || out_size != NTOK * D || ws_size < WS_END) { fprintf(stderr, "kernel_launch: unexpected shapes (n_in %d out %d ws %zu)\n", n_in, out_size, ws_size); grid = -1; return; }
        int dev = 0, cus = 0, per_cu = 0;
        hipGetDevice(&dev); hipDeviceGetAttribute(&cus, hipDeviceAttributeMultiprocessorCount, dev);
        hipFuncSetAttribute((const void*)mega, hipFuncAttributeMaxDynamicSharedMemorySize, LDS_BYTES);
        hipOccupancyMaxActiveBlocksPerMultiprocessor(&per_cu, (const void*)mega, 512, LDS_BYTES);
        if (per_cu < 1) { fprintf(stderr, "kernel_launch: occupancy query says %d blocks per CU\n", per_cu); per_cu = 1; }
        (void)hipGetLastError();
        grid = cus;
    }
    if (grid < 0) return;
    hipMemsetAsync((char*)d_ws + WS_CTL, 0, CTL_BYTES, stream);
    Args a{};
    for (int i = 0; i < 32; ++i) a.in[i] = (const float*)d_in[i];
    a.out = (float*)d_out; a.ws = (unsigned char*)d_ws;
    if (N_LAUNCHES == 1) { a.ph_lo = 0; a.ph_hi = NPHASE; void* args[] = {&a};
        hipError_t e = hipLaunchCooperativeKernel((const void*)mega, dim3(grid), dim3(512), args, LDS_BYTES, stream);
        if (e != hipSuccess) fprintf(stderr, "cooperative launch failed: %s (grid %d)\n", hipGetErrorString(e), grid); }
    else { for (int p = 0; p < NPHASE; ++p) { a.ph_lo = p; a.ph_hi = p + 1; void* args[] = {&a};
            hipError_t e = hipLaunchCooperativeKernel((const void*)mega, dim3(grid), dim3(512), args, LDS_BYTES, stream);
            if (e != hipSuccess) { fprintf(stderr, "launch %d failed: %s\n", p, hipGetErrorString(e)); break; } } }
}
```

```cpp
#include <hip/hip_runtime.h>
#include <hip/hip_cooperative_groups.h>
#include <cstdio>
#include <cstdint>
namespace cg = cooperative_groups;

#define DI __device__ __forceinline__
#define LAS __attribute__((address_space(3)))
typedef unsigned short bf16_t;
typedef short bf16x8 __attribute__((ext_vector_type(8)));
typedef float f32x4 __attribute__((ext_vector_type(4)));
typedef float f32x16 __attribute__((ext_vector_type(16)));
typedef unsigned u32x4 __attribute__((ext_vector_type(4)));
typedef unsigned u32x2 __attribute__((ext_vector_type(2)));
typedef float f32x2_t __attribute__((ext_vector_type(2)));
typedef __bf16 bf16x2_t __attribute__((ext_vector_type(2)));

constexpr int NB = 2, T = 8192, D = 1024, NTOK = NB * T, INWP = 3584;
constexpr int C_Q = 0, C_KC = 512, C_VC = 640, C_KS = 768, C_VS = 896, C_KW = 1024, C_VW = 1152, C_GATE = 1280,
              C_GQ = 1304, C_GK = 1816, C_GV = 2328, C_GZ = 2840, C_GA = 3352, C_GB = 3356, INW = 3360;
constexpr float EPS = 1e-6f, LOG2E = 1.4426950408889634f;
constexpr int NEXP = 32, MAXROWS = 65536 + NEXP * 256, MAXTILES = MAXROWS / 256;

constexpr size_t MiB = 1u << 20;
constexpr size_t WS_CTL = 0, CTL_BYTES = 64 * 1024;
constexpr size_t WS_WTIN = 1 * MiB, WS_WTOUT = 8 * MiB, WS_WTC1K = 10 * MiB, WS_WTC1V = 11 * MiB;
constexpr size_t WS_MISC = 12 * MiB;
constexpr size_t WS_WTC2K = WS_MISC, WS_WTC2V = WS_MISC + 32 * 1024, WS_RSTD2 = WS_MISC + 64 * 1024, WS_TOKE = WS_MISC + 128 * 1024,
                 WS_TOKG = WS_MISC + 384 * 1024, WS_TOKPOS = WS_MISC + 640 * 1024, WS_DEST = WS_MISC + 896 * 1024,
                 WS_ROWG = WS_MISC + 1152 * 1024, WS_GL = WS_MISC + 1536 * 1024, WS_PB1P = WS_MISC + 1600 * 1024  , WS_GATES = 14 * MiB;
constexpr size_t WS_EXPGU = 16 * MiB, WS_EXPD = 144 * MiB;
constexpr size_t WS_XN = 208 * MiB, WS_ONSA = 208 * MiB, WS_U = 240 * MiB, WS_QN = 352 * MiB, WS_KSN = 368 * MiB, WS_VST = 372 * MiB,
                 WS_KWN = 376 * MiB, WS_VWT = 380 * MiB, WS_KC = 384 * MiB, WS_VCT = 384 * MiB + 512 * 1024;
constexpr size_t WS_WP = 388 * MiB, WS_QGP = 404 * MiB, WS_KDTP = 420 * MiB, WS_QKP = 436 * MiB, WS_UP = 444 * MiB, WS_OG = 460 * MiB, WS_OCAT = 476 * MiB;
constexpr size_t WS_H2 = 208 * MiB  , WS_XS = 208 * MiB  , WS_HID = 352 * MiB, WS_END = 508 * MiB;
constexpr size_t WS_ROWTOK = 14 * MiB  ;
constexpr int CW_Q2 = 0, CW_Q3 = 64, CW_Q2B = 32, CW_Q3B = 96, CW_CNT = 2048  , CW_PB1 = 4096  , CW_NT = 1024, CW_TILEE = 1088  , CW_PSTART = 1536, CW_BAR = 12288;

constexpr int LDS_BYTES = 147456, LDS_MISC = 140 * 1024;

DI unsigned pk2(float lo, float hi) { f32x2_t v = {lo, hi}; bf16x2_t b = __builtin_convertvector(v, bf16x2_t); return __builtin_bit_cast(unsigned, b); }
DI float bflo(unsigned w) { return __uint_as_float(w << 16); }
DI float bfhi(unsigned w) { return __uint_as_float(w & 0xffff0000u); }
DI float bf2f(bf16_t v) { return __uint_as_float((unsigned)v << 16); }
DI bf16_t f2bf(float f) { return (bf16_t)(pk2(f, 0.f) & 0xffffu); }
DI bf16x8 pack8(float a0, float a1, float a2, float a3, float a4, float a5, float a6, float a7) {
    u32x4 w; w.x = pk2(a0, a1); w.y = pk2(a2, a3); w.z = pk2(a4, a5); w.w = pk2(a6, a7); return __builtin_bit_cast(bf16x8, w); }
DI float wave_sum(float v) {
#pragma unroll
    for (int o = 1; o < 64; o <<= 1) v += __shfl_xor(v, o);
    return v; }
DI float sigm(float x) { return __builtin_amdgcn_rcpf(1.f + __builtin_amdgcn_exp2f(-x * LOG2E)); }
DI int otid() { int t = threadIdx.x; asm volatile("" : "+v"(t)); return t; }
DI int crow(int r, int hi) { return (r & 3) + 8 * (r >> 2) + 4 * hi; }
DI int perm16(int p) { return 8 * ((p & 7) >> 2) + 4 * (p >> 3) + (p & 3); }
DI int perm16inv(int k) { return 8 * ((k >> 2) & 1) + 4 * (k >> 3) + (k & 3); }
#define MFMA32(a, b, c) __builtin_amdgcn_mfma_f32_32x32x16_bf16((a), (b), (c), 0, 0, 0)
#define MFMA16(a, b, c) __builtin_amdgcn_mfma_f32_16x16x32_bf16((a), (b), (c), 0, 0, 0)

namespace pg8 {
#define PG8_LAS __attribute__((address_space(3)))
constexpr int BM = 256, BK = 64, HALF = 128, HTB = HALF * BK * 2, STAGE_BYTES = 8 * HTB, NXCD = 8, WGM = 8;
__host__ __device__ __forceinline__ int lds_byte(int r, int c) { const int st = (r >> 4) * 2 + (c >> 5), rr = r & 15, cc = c & 31, ob = rr * 64 + cc * 2; return st * 1024 + (ob ^ (((ob >> 9) & 1) << 5)); }
__host__ __device__ __forceinline__ void stage_rc(int b, int& R, int& C) { const int st = b / 1024, sb = b % 1024, swz = sb ^ (((sb >> 9) & 1) << 5); R = (st >> 1) * 16 + swz / 64; C = (st & 1) * 32 + (swz % 64) / 2; }
__host__ __device__ __forceinline__ int perm32(int rho) { const int n = rho >> 4, i = rho & 15; return 8 * (i >> 2) + 4 * n + (i & 3); }
struct Unit { int pm, pn; };
struct Gemm { const bf16_t* A; const bf16_t* Bt; int M, N, K; };
struct StaticOrder {
    int nM, nN, nwg, G, c;
    __device__ void init(int M, int N, int G_, int c_) { nM = M / BM; nN = N / BM; nwg = nM * nN; G = G_; c = c_; }
    __device__ bool next(int i, Unit& u) const {
        const long L = (long)i * G + c; if (L >= nwg) return false;
        int wgid = (int)L; { const int q = nwg / NXCD, r = nwg % NXCD, xcd = wgid % NXCD, off = wgid / NXCD; wgid = (xcd < r ? xcd * (q + 1) : r * (q + 1) + (xcd - r) * q) + off; }
        const int nig = WGM * nN, gid = wgid / nig, fm = gid * WGM, gsz = (nM - fm) < WGM ? (nM - fm) : WGM;
        u.pm = fm + ((wgid % nig) % gsz); u.pn = (wgid % nig) / gsz; return true;
    }
};
struct MoeOrder {
    StaticOrder S; const int* tile_e;
    __device__ void init(int nM_, int nN_, int G_, int c_, const int* te) { S.nM = nM_; S.nN = nN_; S.nwg = nM_ * nN_; S.G = G_; S.c = c_; tile_e = te; }
    __device__ bool next(int i, Unit& u) const { if (!S.next(i, u)) return false; u.pn = tile_e[u.pm] * S.nN + u.pn; return true; }
};

template <class Epi, class Sched, bool GATHER = false>
__device__ __forceinline__ void gemm_phase(PG8_LAS unsigned char* lds, const Gemm g, const Sched& S, const Epi& E, const int* rowtok = nullptr) {
    const int tid = otid(), wid = __builtin_amdgcn_readfirstlane(tid >> 6), lane = tid & 63, wr = wid >> 2, wc = wid & 3, fr = lane & 15, fq = lane >> 4;
    const int K = g.K, nt = K / BK;
    unsigned voffA[2], voffB[2]; int CA0 = 0;
#pragma unroll
    for (int i = 0; i < 2; ++i) { int R, C; stage_rc(tid * 16 + i * 8192, R, C); const int Rb = Epi::PERM ? ((R & ~31) + perm32(R & 31)) : R; if (i == 0) { CA0 = C; }
        voffA[i] = (unsigned)(R * K + C) * 2u; voffB[i] = (unsigned)(Rb * K + C) * 2u; }
    unsigned tc0 = 0u, tc1 = 0u;
#define PG8_GTOK(t0_, t1_, pm_) do { int _R, _C; stage_rc(otid() * 16, _R, _C); const int* _rt = rowtok + (pm_) * BM + _R; t0_ = (unsigned)_rt[0] | ((unsigned)_rt[64] << 16); t1_ = (unsigned)_rt[HALF] | ((unsigned)_rt[HALF + 64] << 16); } while (0)
    const size_t kstep = (size_t)(BK * 2);
    const size_t hstep = (size_t)HALF * K * 2;
    const size_t tstep = 2 * hstep;
    const unsigned ldsw = (unsigned)wid * 1024u;
    const int aoff = lds_byte(wr * 64 + fr, fq * 8), boff = lds_byte(wc * 32 + fr, fq * 8);
#define PG8_SA(b, h) (((b) * 2 + (h)) * HTB)
#define PG8_SB(b, h) ((4 + (b) * 2 + (h)) * HTB)
#define PG8_STAGE(bufoff, gbase, voff) do { _Pragma("unroll") for (int _i = 0; _i < 2; ++_i) \
        __builtin_amdgcn_global_load_lds((const unsigned*)((const char*)(gbase) + (voff)[_i]), (PG8_LAS unsigned*)(lds + (bufoff) + ldsw + _i * 8192), 16, 0, 0); } while (0)
#define PG8_STAGE_A(bufoff, plainptr, kt, h, nx) do { if constexpr (GATHER) { const char* _b = (const char*)g.A + (size_t)(kt) * kstep; \
        unsigned _t = (h) ? tc1 : tc0; asm volatile("" : "+v"(_t));     \
        unsigned _v[2]; _v[0] = ((_t & 0xffffu) * (unsigned)K + (unsigned)CA0) * 2u; _v[1] = ((_t >> 16) * (unsigned)K + (unsigned)CA0) * 2u; \
        PG8_STAGE(bufoff, _b, _v); } \
        else PG8_STAGE(bufoff, plainptr, voffA); } while (0)
#define PG8_LDA(dst, b, h) do { _Pragma("unroll") for (int m = 0; m < 4; ++m) _Pragma("unroll") for (int k = 0; k < 2; ++k) dst[m][k] = *(const PG8_LAS bf16x8*)(lds + PG8_SA(b, h) + aoff + m * 2048 + k * 1024); } while (0)
#define PG8_LDB(dst, b, h) do { _Pragma("unroll") for (int n = 0; n < 2; ++n) _Pragma("unroll") for (int k = 0; k < 2; ++k) dst[n][k] = *(const PG8_LAS bf16x8*)(lds + PG8_SB(b, h) + boff + n * 2048 + k * 1024); } while (0)
#define PG8_MMA(ai, bj, At, Bt) do { __builtin_amdgcn_s_setprio(1); _Pragma("unroll") for (int m = 0; m < 4; ++m) _Pragma("unroll") for (int n = 0; n < 2; ++n) _Pragma("unroll") for (int k = 0; k < 2; ++k) \
        acc[ai][bj][m][n] = __builtin_amdgcn_mfma_f32_16x16x32_bf16(Bt[n][k], At[m][k], acc[ai][bj][m][n], 0, 0, 0); __builtin_amdgcn_s_setprio(0); } while (0)
#define PG8_WAIT_V(n) asm volatile("s_waitcnt vmcnt(" #n ")" ::: "memory")
#define PG8_WAIT_L(n) asm volatile("s_waitcnt lgkmcnt(" #n ")" ::: "memory")
#define PG8_BAR __builtin_amdgcn_s_barrier()
#define PG8_SCHED __builtin_amdgcn_sched_barrier(0)
    Unit cur, nxt; int ui = 0;
    if (!S.next(0, cur)) return;
    f32x4 acc[2][2][4][2];
#pragma unroll
    for (int a = 0; a < 2; ++a)
#pragma unroll
        for (int b = 0; b < 2; ++b)
#pragma unroll
            for (int m = 0; m < 4; ++m)
#pragma unroll
                for (int n = 0; n < 2; ++n) acc[a][b][m][n] = (f32x4){0.f, 0.f, 0.f, 0.f};
    bf16x8 At[4][2], B0[2][2], B1[2][2];
    const char* cA = (const char*)g.A + (size_t)cur.pm * tstep; const char* cB = (const char*)g.Bt + (size_t)cur.pn * tstep;
    if constexpr (GATHER) { PG8_GTOK(tc0, tc1, cur.pm); }
    PG8_STAGE(PG8_SB(0, 0), cB, voffB); PG8_STAGE(PG8_SB(0, 1), cB + hstep, voffB); PG8_STAGE_A(PG8_SA(0, 0), cA, 0, 0, false); PG8_STAGE_A(PG8_SA(0, 1), cA + hstep, 0, 1, false);
    if (wr == 1) PG8_BAR;
    PG8_WAIT_V(2); PG8_BAR;
    PG8_STAGE(PG8_SB(1, 0), cB + kstep, voffB); PG8_STAGE_A(PG8_SA(1, 0), cA + kstep, 1, 0, false); PG8_STAGE(PG8_SB(1, 1), cB + hstep + kstep, voffB);
    PG8_WAIT_V(6); PG8_BAR;
    for (;;) {
        const bool has_next = S.next(ui + 1, nxt);
        const char* nA = has_next ? (const char*)g.A + (size_t)nxt.pm * tstep : cA; const char* nB = has_next ? (const char*)g.Bt + (size_t)nxt.pn * tstep : cB;
        unsigned tn0 = 0u, tn1 = 0u;
        if constexpr (GATHER) { if (has_next) { PG8_GTOK(tn0, tn1, nxt.pm); } }
        for (int t = 0; t < nt; t += 2) {
            const bool last = (t == nt - 2);
            const char* a1 = cA + (size_t)(t + 1) * kstep;
            const char* a2 = last ? nA : cA + (size_t)(t + 2) * kstep; const char* b2 = last ? nB : cB + (size_t)(t + 2) * kstep;
            const char* a3 = a2 + kstep; const char* b3 = b2 + kstep;
            const int k2 = last ? 0 : t + 2, k3 = k2 + 1;
            PG8_LDB(B0, 0, 0); PG8_LDB(B1, 0, 1); PG8_SCHED; PG8_LDA(At, 0, 0); PG8_STAGE_A(PG8_SA(1, 1), a1 + hstep, t + 1, 1, false);
            if constexpr (GATHER) { if (last && has_next) { tc0 = tn0; tc1 = tn1; } }
            if (GATHER && t == 0) { PG8_WAIT_V(12); } else { PG8_WAIT_V(8); } PG8_WAIT_L(0); PG8_BAR; PG8_MMA(0, 0, At, B0); PG8_MMA(0, 1, At, B1); PG8_BAR; PG8_SCHED;
            PG8_LDA(At, 0, 1); PG8_STAGE(PG8_SB(0, 0), b2, voffB); PG8_STAGE(PG8_SB(0, 1), b2 + hstep, voffB); PG8_STAGE_A(PG8_SA(0, 0), a2, k2, 0, last);
            PG8_WAIT_V(8); PG8_WAIT_L(0); PG8_BAR; PG8_MMA(1, 0, At, B0); PG8_MMA(1, 1, At, B1); PG8_BAR; PG8_SCHED;
            PG8_LDB(B0, 1, 0); PG8_LDB(B1, 1, 1); PG8_SCHED; PG8_LDA(At, 1, 0); PG8_STAGE_A(PG8_SA(0, 1), a2 + hstep, k2, 1, last);
            PG8_WAIT_V(8); PG8_WAIT_L(0); PG8_BAR; PG8_MMA(0, 0, At, B0); PG8_MMA(0, 1, At, B1); PG8_BAR; PG8_SCHED;
            PG8_LDA(At, 1, 1); PG8_STAGE(PG8_SB(1, 0), b3, voffB); PG8_STAGE(PG8_SB(1, 1), b3 + hstep, voffB); PG8_STAGE_A(PG8_SA(1, 0), a3, k3, 0, last);
            PG8_WAIT_V(8); PG8_WAIT_L(0); PG8_BAR; PG8_MMA(1, 0, At, B0); PG8_MMA(1, 1, At, B1); PG8_BAR; PG8_SCHED;
        }
        if (wr == 0) PG8_BAR;
        E(acc, cur, wr, wc, fr, fq);
        if (!has_next) break;
#pragma unroll
        for (int a = 0; a < 2; ++a)
#pragma unroll
            for (int b = 0; b < 2; ++b)
#pragma unroll
                for (int m = 0; m < 4; ++m)
#pragma unroll
                    for (int n = 0; n < 2; ++n) acc[a][b][m][n] = (f32x4){0.f, 0.f, 0.f, 0.f};
        cur = nxt; cA = nA; cB = nB; ++ui;
        if (wr == 1) PG8_BAR;
    }
    PG8_WAIT_V(0);
    PG8_BAR;
#undef PG8_SA
#undef PG8_SB
#undef PG8_STAGE
#undef PG8_STAGE_A
#undef PG8_GTOK
#undef PG8_LDA
#undef PG8_LDB
#undef PG8_MMA
#undef PG8_WAIT_V
#undef PG8_WAIT_L
#undef PG8_BAR
#undef PG8_SCHED
}

struct EpiU {
    static constexpr bool PERM = true;
    bf16_t* O; int ldc;
    __device__ __forceinline__ void operator()(const f32x4 (&acc)[2][2][4][2], const Unit& u, int wr, int wc, int fr, int fq) const {
        const int row0 = u.pm * BM + wr * 64 + fr, col0 = u.pn * BM + wc * 32 + 8 * fq;
#pragma unroll
        for (int ai = 0; ai < 2; ++ai)
#pragma unroll
            for (int m = 0; m < 4; ++m) { bf16_t* rowp = O + (size_t)(row0 + ai * HALF + m * 16) * ldc + col0;
#pragma unroll
                for (int bj = 0; bj < 2; ++bj) { const f32x4 v0 = acc[ai][bj][m][0], v1 = acc[ai][bj][m][1];
                    u32x4 w; w.x = pk2(v0[0], v0[1]); w.y = pk2(v0[2], v0[3]); w.z = pk2(v1[0], v1[1]); w.w = pk2(v1[2], v1[3]);
                    *(u32x4*)(rowp + bj * HALF) = w; } }
    }
};
struct EpiRes {
    static constexpr bool PERM = false;
    const float* base; float* out; int ldc;
    __device__ __forceinline__ void operator()(const f32x4 (&acc)[2][2][4][2], const Unit& u, int wr, int wc, int fr, int fq) const {
        const int col0 = u.pn * BM + wc * 32 + 4 * fq;
#pragma unroll
        for (int ai = 0; ai < 2; ++ai)
#pragma unroll
            for (int m = 0; m < 4; ++m) { const size_t off = (size_t)(u.pm * BM + ai * HALF + wr * 64 + m * 16 + fr) * ldc + col0;
#pragma unroll
                for (int bj = 0; bj < 2; ++bj)
#pragma unroll
                    for (int n = 0; n < 2; ++n) { const f32x4 bs = *(const f32x4*)(base + off + bj * HALF + n * 16); *(f32x4*)(out + off + bj * HALF + n * 16) = bs + acc[ai][bj][m][n]; } }
    }
};
struct EpiSwiglu {
    static constexpr bool PERM = true;
    bf16_t* H; const float* bg; const float* bu;
    __device__ __forceinline__ void operator()(const f32x4 (&acc)[2][2][4][2], const Unit& u, int wr, int wc, int fr, int fq) const {
        const int e = u.pn >> 3, pnl = u.pn & 7, hc0 = pnl * 128 + wc * 32 + 8 * fq, row0 = u.pm * BM + wr * 64 + fr;
        float gb[8], ub[8];
#pragma unroll
        for (int i = 0; i < 8; ++i) { gb[i] = bg[e * 1024 + hc0 + i]; ub[i] = bu[e * 1024 + hc0 + i]; }
#pragma unroll
        for (int ai = 0; ai < 2; ++ai)
#pragma unroll
            for (int m = 0; m < 4; ++m) {
                float o[8];
#pragma unroll
                for (int n = 0; n < 2; ++n)
#pragma unroll
                    for (int i = 0; i < 4; ++i) {
                        const float gg = fminf(acc[ai][0][m][n][i] + gb[4 * n + i], 7.0f);
                        const float uu = fminf(fmaxf(acc[ai][1][m][n][i] + ub[4 * n + i], -7.0f), 7.0f);
                        o[4 * n + i] = (uu + 1.0f) * gg * sigm(gg * 1.702f); }
                u32x4 w; w.x = pk2(o[0], o[1]); w.y = pk2(o[2], o[3]); w.z = pk2(o[4], o[5]); w.w = pk2(o[6], o[7]);
                *(u32x4*)(H + (size_t)(row0 + ai * HALF + m * 16) * 1024 + hc0) = w; }
    }
};
struct EpiDown {
    static constexpr bool PERM = true;
    bf16_t* Y; const float* bd; const float* rowg;
    __device__ __forceinline__ void operator()(const f32x4 (&acc)[2][2][4][2], const Unit& u, int wr, int wc, int fr, int fq) const {
        const int e = u.pn >> 2, pnl = u.pn & 3, col0 = pnl * BM + wc * 32 + 8 * fq, row0 = u.pm * BM + wr * 64 + fr;
        float bv[2][8];
#pragma unroll
        for (int bj = 0; bj < 2; ++bj)
#pragma unroll
            for (int i = 0; i < 8; ++i) bv[bj][i] = bd[e * 1024 + col0 + bj * HALF + i];
#pragma unroll
        for (int ai = 0; ai < 2; ++ai)
#pragma unroll
            for (int m = 0; m < 4; ++m) { const int row = row0 + ai * HALF + m * 16; const float sc = rowg[row];
#pragma unroll
                for (int bj = 0; bj < 2; ++bj) { const f32x4 v0 = acc[ai][bj][m][0], v1 = acc[ai][bj][m][1];
                    u32x4 w; w.x = pk2((v0[0] + bv[bj][0]) * sc, (v0[1] + bv[bj][1]) * sc); w.y = pk2((v0[2] + bv[bj][2]) * sc, (v0[3] + bv[bj][3]) * sc);
                    w.z = pk2((v1[0] + bv[bj][4]) * sc, (v1[1] + bv[bj][5]) * sc); w.w = pk2((v1[2] + bv[bj][6]) * sc, (v1[3] + bv[bj][7]) * sc);
                    *(u32x4*)(Y + (size_t)row * 1024 + col0 + bj * HALF) = w; } }
    }
};
}

struct Args { const float* in[32]; float* out; unsigned char* ws; int ph_lo, ph_hi; };
enum { I_X = 0, I_ANG, I_WIN, I_QG, I_KCG, I_KSG, I_KWG, I_CKPOS, I_CKW1, I_CKB1, I_CKW2, I_CKB2, I_CVPOS, I_CVW1, I_CVB1, I_CVW2, I_CVB2,
       I_NSAOG, I_CONVW, I_ALOG, I_DTB, I_GDNOG, I_WOUT, I_FFNG, I_RW, I_RB, I_EWG, I_EBG, I_EWU, I_EBU, I_EWD, I_EBD };

DI void p0_transpose_item(const float* W, int K, int N, bf16_t* WT, long row_off, float* scr, int item, int lane) {
    const int nblk = N / 32, kb = item / nblk, nb = item % nblk, k0 = 64 * kb, n0 = 32 * nb;
#pragma unroll 8
    for (int i = 0; i < 32; ++i) { const int kk = 2 * i + (lane >> 5); scr[kk * 33 + (lane & 31)] = W[(size_t)(k0 + kk) * N + n0 + (lane & 31)]; }
    __builtin_amdgcn_s_waitcnt(0xC07F); asm volatile("" ::: "memory");
    const int c = lane & 7;
#pragma unroll
    for (int j = 0; j < 4; ++j) { const int n = (lane >> 3) + 8 * j; const float* s = scr + (8 * c) * 33 + n;
        u32x4 o; o.x = pk2(s[0 * 33], s[1 * 33]); o.y = pk2(s[2 * 33], s[3 * 33]); o.z = pk2(s[4 * 33], s[5 * 33]); o.w = pk2(s[6 * 33], s[7 * 33]);
        *(u32x4*)(WT + (size_t)(row_off + n0 + n) * K + k0 + 8 * c) = o; }
    __builtin_amdgcn_s_waitcnt(0xC07F); asm volatile("" ::: "memory");
}

DI void p0_transpose_item64(const float* W, int K, int N, bf16_t* WT, long row_off, float* scr, int kb, int nb, int lane) {
    const int k0 = 64 * kb, n0 = 64 * nb, c4 = (lane & 15) * 4, kr = lane >> 4;
    f32x4 v[16];
#pragma unroll
    for (int i = 0; i < 16; ++i) v[i] = *(const f32x4*)(W + (size_t)(k0 + 4 * i + kr) * N + n0 + c4);
#pragma unroll
    for (int i = 0; i < 16; ++i) { float* d = scr + (4 * i + kr) * 65 + c4; d[0] = v[i][0]; d[1] = v[i][1]; d[2] = v[i][2]; d[3] = v[i][3]; }
    __builtin_amdgcn_s_waitcnt(0xC07F); asm volatile("" ::: "memory");
    const int nn = lane >> 3, cc = lane & 7;
#pragma unroll
    for (int it = 0; it < 8; ++it) { const int n = 8 * it + nn; const float* s = scr + (8 * cc) * 65 + n;
        u32x4 o; o.x = pk2(s[0 * 65], s[1 * 65]); o.y = pk2(s[2 * 65], s[3 * 65]); o.z = pk2(s[4 * 65], s[5 * 65]); o.w = pk2(s[6 * 65], s[7 * 65]);
        *(u32x4*)(WT + (size_t)(row_off + n0 + n) * K + k0 + 8 * cc) = o; }
    __builtin_amdgcn_s_waitcnt(0xC07F); asm volatile("" ::: "memory");
}

DI void phase0(const Args& A, unsigned char* lds, bool first) {
    const int tid = otid(), lane = tid & 63, wave = tid >> 6, G = gridDim.x;
    const int gw = blockIdx.x * 8 + wave, NGW = G * 8;
    float* scr = (float*)(lds + wave * 17408);
    unsigned char* ws = A.ws;
    constexpr int I_IN = 16 * 105, I_OUT = 16 * 32, I_C1 = 32 * 8, I_C2 = 4 * 2, I_EX = 16 * 32;
    constexpr int NIT = I_IN + I_OUT + 2 * I_C2;
    for (int it = gw; it < NIT; it += NGW) {
        int r = it;
        if (r < I_IN) { p0_transpose_item(A.in[I_WIN], 1024, INW, (bf16_t*)(ws + WS_WTIN), 0, scr, r, lane); continue; } r -= I_IN;
        if (r < I_OUT) { p0_transpose_item(A.in[I_WOUT], 1024, 1024, (bf16_t*)(ws + WS_WTOUT), 0, scr, r, lane); continue; } r -= I_OUT;
        if (r < I_C2) { p0_transpose_item(A.in[I_CKW2], 256, 64, (bf16_t*)(ws + WS_WTC2K), 0, scr, r, lane); continue; } r -= I_C2;
        if (r < I_C2) { p0_transpose_item(A.in[I_CVW2], 256, 64, (bf16_t*)(ws + WS_WTC2V), 0, scr, r, lane); continue; }
    }
    for (int id = blockIdx.x * 512 + tid; id < 2 * 65536; id += G * 512) { const int kv = id >> 16, rem = id & 65535, ln = rem & 63, kk = (rem >> 6) & 127, jt = rem >> 13;
        const float* w = A.in[kv ? I_CVW1 : I_CKW1] + (size_t)(16 * kk + 8 * (ln >> 5)) * 256 + 32 * jt + (ln & 31);
        u32x4 o; o.x = pk2(w[0], w[256]); o.y = pk2(w[512], w[768]); o.z = pk2(w[1024], w[1280]); o.w = pk2(w[1536], w[1792]);
        *(u32x4*)((bf16_t*)(ws + (kv ? WS_WTC1V : WS_WTC1K)) + (size_t)rem * 8) = o; }
    for (int it = gw; it < 96 * 256; it += NGW) { const int mat = it >> 8, item = it & 255, kb = item >> 4, nb = item & 15, e = mat / 3, which = mat % 3;
        if (which == 2) p0_transpose_item64(A.in[I_EWD] + (size_t)e * 1048576, 1024, 1024, (bf16_t*)(ws + WS_EXPD), (long)e * 1024, scr, kb, nb, lane);
        else { const int n0 = 64 * nb; const long dest0 = (long)e * 2048 + (n0 >> 7) * 256 + (n0 & 127) + (which ? 128 : 0);
            p0_transpose_item64(A.in[which ? I_EWU : I_EWG] + (size_t)e * 1048576, 1024, 1024, (bf16_t*)(ws + WS_EXPGU), dest0 - n0, scr, kb, nb, lane); }
    }
    { const float* gain = A.in[I_ANG]; f32x4 gv[4];
#pragma unroll
      for (int j = 0; j < 4; ++j) gv[j] = *(const f32x4*)(gain + 4 * lane + 256 * j);
      for (int m = gw; m < NTOK; m += NGW) { const f32x4* xr = (const f32x4*)(A.in[I_X] + (size_t)m * D) + lane; f32x4 v[4]; float s = 0.f;
#pragma unroll
        for (int j = 0; j < 4; ++j) { v[j] = xr[64 * j]; s += v[j].x * v[j].x + v[j].y * v[j].y + v[j].z * v[j].z + v[j].w * v[j].w; }
        const float rs = rsqrtf(wave_sum(s) * (1.f / D) + EPS);
        u32x2* o = (u32x2*)((bf16_t*)(ws + WS_XN) + (size_t)m * D) + lane;
#pragma unroll
        for (int j = 0; j < 4; ++j) { u32x2 w; w.x = pk2(v[j].x * rs * gv[j].x, v[j].y * rs * gv[j].y); w.y = pk2(v[j].z * rs * gv[j].z, v[j].w * rs * gv[j].w); o[64 * j] = w; } } }
    { u32x4* p = (u32x4*)((bf16_t*)(ws + WS_WTIN) + (size_t)INW * 1024); const int n16 = (INWP - INW) * 1024 * 2 / 16;
      for (int i = blockIdx.x * 512 + tid; i < n16; i += G * 512) p[i] = (u32x4){0u, 0u, 0u, 0u}; }
    if (first && tid < 256) { for (int task = blockIdx.x; task < 256; task += G) { const int kv = task >> 7, seg = task & 127, j = tid;
        const float* pos = A.in[kv ? I_CVPOS : I_CKPOS] + seg * 16; const float* w1 = A.in[kv ? I_CVW1 : I_CKW1] + (size_t)seg * 16 * 256 + j; float wv[16];
#pragma unroll
        for (int k = 0; k < 16; ++k) wv[k] = w1[k * 256];
        float s = 0.f;
#pragma unroll
        for (int k = 0; k < 16; ++k) s += pos[k] * wv[k];
        ((float*)(ws + WS_PB1P))[seg * 512 + kv * 256 + j] = s; } }
}

DI void nsa_prep_task(const Args& A, int task, unsigned char* lds) {
    const int tid = otid(), lane = tid & 63, wave = tid >> 6;
    const int b = task >> 7, n = task & 127;
    unsigned char* ws = A.ws; const bf16_t* U = (const bf16_t*)(ws + WS_U);
    bf16_t* vsL = (bf16_t*)lds;
    for (int ti = 0; ti < 8; ++ti) {
        const int tl = wave * 8 + ti, t = n * 64 + tl; const size_t tok = (size_t)b * T + t; const bf16_t* ur = U + tok * INWP;
        { const u32x4 w = *(const u32x4*)(ur + C_Q + 8 * lane); float f[8] = {bflo(w.x), bfhi(w.x), bflo(w.y), bfhi(w.y), bflo(w.z), bfhi(w.z), bflo(w.w), bfhi(w.w)};
          float s = 0.f;
#pragma unroll
          for (int i = 0; i < 8; ++i) s += f[i] * f[i];
          s += __shfl_xor(s, 1); s += __shfl_xor(s, 2); s += __shfl_xor(s, 4);
          const float rs = rsqrtf(s * (1.f / 64.f) + EPS) * (0.125f * LOG2E); const float* gq = A.in[I_QG] + (8 * lane & 63);
          u32x4 o; o.x = pk2(f[0] * rs * gq[0], f[1] * rs * gq[1]); o.y = pk2(f[2] * rs * gq[2], f[3] * rs * gq[3]); o.z = pk2(f[4] * rs * gq[4], f[5] * rs * gq[5]); o.w = pk2(f[6] * rs * gq[6], f[7] * rs * gq[7]);
          *(u32x4*)((bf16_t*)(ws + WS_QN) + tok * 512 + 8 * lane) = o; }
        if (lane < 32) { const int sel = lane >> 4, l16 = lane & 15, g = l16 >> 3, d0 = (l16 & 7) * 8;
          const u32x4 w = *(const u32x4*)(ur + (sel ? C_KW : C_KS) + 8 * l16); float f[8] = {bflo(w.x), bfhi(w.x), bflo(w.y), bfhi(w.y), bflo(w.z), bfhi(w.z), bflo(w.w), bfhi(w.w)};
          float s = 0.f;
#pragma unroll
          for (int i = 0; i < 8; ++i) s += f[i] * f[i];
          s += __shfl_xor(s, 1); s += __shfl_xor(s, 2); s += __shfl_xor(s, 4);
          const float rs = rsqrtf(s * (1.f / 64.f) + EPS); const float* gk = A.in[sel ? I_KWG : I_KSG] + d0;
          u32x4 o; o.x = pk2(f[0] * rs * gk[0], f[1] * rs * gk[1]); o.y = pk2(f[2] * rs * gk[2], f[3] * rs * gk[3]); o.z = pk2(f[4] * rs * gk[4], f[5] * rs * gk[5]); o.w = pk2(f[6] * rs * gk[6], f[7] * rs * gk[7]);
          { const int c = l16 & 7; *(u32x4*)((bf16_t*)(ws + (sel ? WS_KWN : WS_KSN)) + (size_t)(b * 2 + g) * T * 64 + ((size_t)((t >> 5) * 4 + (c >> 1)) * 64 + (c & 1) * 32 + (t & 31)) * 8) = o; } }
        else { const int l32 = lane - 32, sel = l32 >> 4, l16 = l32 & 15, g = l16 >> 3, d0 = (l16 & 7) * 8;
          const u32x4 w = *(const u32x4*)(ur + (sel ? C_VW : C_VS) + 8 * l16);
          const int pos = (tl & ~15) + perm16inv(tl & 15); bf16_t* dst = vsL + ((sel * 2 + g) * 64 + d0) * 64 + pos;
          dst[0 * 64] = (bf16_t)(w.x & 0xffff); dst[1 * 64] = (bf16_t)(w.x >> 16); dst[2 * 64] = (bf16_t)(w.y & 0xffff); dst[3 * 64] = (bf16_t)(w.y >> 16);
          dst[4 * 64] = (bf16_t)(w.z & 0xffff); dst[5 * 64] = (bf16_t)(w.z >> 16); dst[6 * 64] = (bf16_t)(w.w & 0xffff); dst[7 * 64] = (bf16_t)(w.w >> 16); }
        if (lane < 24) ((float*)(ws + WS_GATES))[tok * 24 + lane] = sigm(bf2f(ur[C_GATE + lane]));
    }
    __syncthreads();
    for (int c = tid; c < 2048; c += 512) { const int sel = c >> 10, g = (c >> 9) & 1, rem = c & 511;
        const int r32 = rem & 31, hh = (rem >> 5) & 1, ks = (rem >> 6) & 1, dt = (rem >> 7) & 1, tb = rem >> 8;
        const u32x4 v = *(const u32x4*)(vsL + ((sel * 2 + g) * 64 + 32 * dt + r32) * 64 + 32 * tb + 16 * ks + 8 * hh);
        *(u32x4*)((bf16_t*)(ws + (sel ? WS_VWT : WS_VST)) + ((size_t)(b * 2 + g) * 128 + n) * 4096 + rem * 8) = v; }
    __syncthreads();
}

DI void compress_task(const Args& A, int task, unsigned char* lds) {
    const int tid = otid(), lane = tid & 63, wave = __builtin_amdgcn_readfirstlane(tid >> 6), r32 = lane & 31, hh = lane >> 5;
    const int kv = task >> 6, b = (task >> 5) & 1, g = (task >> 4) & 1, ct = task & 15, c0 = 32 * ct;
    unsigned char* ws = A.ws; const bf16_t* U = (const bf16_t*)(ws + WS_U);
    unsigned char* XU = lds;
    bf16_t* hidL = (bf16_t*)(lds + 67584);
    float* outL = (float*)(lds + 67584 + 16896);
    const int colbase = (kv ? C_VC : C_KC) + g * 64;
    const bf16_t* W1F = (const bf16_t*)(ws + (kv ? WS_WTC1V : WS_WTC1K)) + (size_t)wave * 128 * 512 + lane * 8;
    const bf16_t* W2T = (const bf16_t*)(ws + (kv ? WS_WTC2V : WS_WTC2K));
    {   u32x4 rv[9];
#pragma unroll
        for (int j = 0; j < 9; ++j) { const int id = tid + 512 * j, tk = id >> 3, ch = id & 7; rv[j] = (u32x4){0u, 0u, 0u, 0u};
            if (id < 528 * 8 && 16 * c0 + tk < T) rv[j] = *(const u32x4*)(U + ((size_t)b * T + 16 * c0 + tk) * INWP + colbase + ch * 8); }
#pragma unroll
        for (int j = 0; j < 9; ++j) { const int id = tid + 512 * j, tk = id >> 3, ch = id & 7; if (id < 528 * 8) *(u32x4*)(XU + tk * 128 + ((ch ^ ((tk >> 4) & 7)) * 16)) = rv[j]; } }
    __syncthreads();
    {   f32x16 acc; for (int i = 0; i < 16; ++i) acc[i] = 0.f;
#pragma unroll 8
        for (int kk = 0; kk < 128; ++kk) { const int l = kk >> 2, s = kk & 3, tk = 16 * r32 + l;
            const bf16x8 af = *(const bf16x8*)(XU + tk * 128 + (((2 * s + hh) ^ ((tk >> 4) & 7)) * 16));
            const bf16x8 bf = *(const bf16x8*)(W1F + (size_t)kk * 512);
            acc = MFMA32(af, bf, acc); }
        const int j = 32 * wave + r32; float pb = A.in[kv ? I_CVB1 : I_CKB1][j];
#pragma unroll
        for (int sg = 0; sg < 128; ++sg) pb += ((const float*)(ws + WS_PB1P))[sg * 512 + kv * 256 + j];
#pragma unroll
        for (int r = 0; r < 16; ++r) { const float x = acc[r] + pb; const float y = x * sigm(1.5957691216057308f * (x + 0.044715f * x * x * x)); hidL[crow(r, hh) * 264 + j] = f2bf(y); }
    }
    __syncthreads();
    if (wave < 2) { f32x16 acc; for (int i = 0; i < 16; ++i) acc[i] = 0.f;
#pragma unroll
        for (int s = 0; s < 16; ++s) { const bf16x8 af = *(const bf16x8*)(hidL + r32 * 264 + 16 * s + 8 * hh); const bf16x8 bf = *(const bf16x8*)(W2T + (size_t)(32 * wave + r32) * 256 + 16 * s + 8 * hh); acc = MFMA32(af, bf, acc); }
        const int d = 32 * wave + r32; const float b2 = A.in[kv ? I_CVB2 : I_CKB2][d];
#pragma unroll
        for (int r = 0; r < 16; ++r) outL[crow(r, hh) * 65 + d] = acc[r] + b2; }
    __syncthreads();
    if (kv == 0) { if (tid < 256) { const int cl = tid >> 3, sub = tid & 7; float f[8]; float s = 0.f;
#pragma unroll
            for (int i = 0; i < 8; ++i) { f[i] = outL[cl * 65 + 8 * sub + i]; s += f[i] * f[i]; }
            s += __shfl_xor(s, 1); s += __shfl_xor(s, 2); s += __shfl_xor(s, 4);
            const float rs = (c0 + cl > 510) ? 0.f : rsqrtf(s * (1.f / 64.f) + EPS); const float* gk = A.in[I_KCG] + 8 * sub;
            u32x4 o; o.x = pk2(f[0] * rs * gk[0], f[1] * rs * gk[1]); o.y = pk2(f[2] * rs * gk[2], f[3] * rs * gk[3]); o.z = pk2(f[4] * rs * gk[4], f[5] * rs * gk[5]); o.w = pk2(f[6] * rs * gk[6], f[7] * rs * gk[7]);
            *(u32x4*)((bf16_t*)(ws + WS_KC) + (size_t)(b * 2 + g) * 512 * 64 + ((size_t)(ct * 4 + (sub >> 1)) * 64 + (sub & 1) * 32 + cl) * 8) = o; } }
    else { const int d = tid >> 3, part = tid & 7, p0 = 4 * part, gi = p0 >> 4, cl0 = 16 * gi + perm16(p0 & 15); float f[4];
#pragma unroll
        for (int i = 0; i < 4; ++i) f[i] = (c0 + cl0 + i > 510) ? 0.f : outL[(cl0 + i) * 65 + d];
        u32x2 o; o.x = pk2(f[0], f[1]); o.y = pk2(f[2], f[3]);
        *(u32x2*)((bf16_t*)(ws + WS_VCT) + (size_t)(b * 2 + g) * 64 * 512 + ((size_t)((ct * 2 + (d >> 5)) * 2 + (p0 >> 4)) * 64 + ((p0 >> 3) & 1) * 32 + (d & 31)) * 8 + (p0 & 7)) = o; }
    __syncthreads();
}

DI void gdn_chunk_task(const Args& A, int task, unsigned char* lds) {
    const int tid = otid(), lane = tid & 63, wave = __builtin_amdgcn_readfirstlane(tid >> 6), r32 = lane & 31, hh = lane >> 5;
    const int b = task >> 9, h = (task >> 7) & 3, ch = task & 127, t0 = ch * 64; const size_t tok0 = (size_t)b * T + t0;
    unsigned char* ws = A.ws; const bf16_t* U = (const bf16_t*)(ws + WS_U);
    float* qL = (float*)lds; float* kL = qL + 64 * 132; float* vL = kL + 64 * 132; float* Lm = vL + 64 * 132; float* Qm = Lm + 64 * 68;
    float* gcL = Qm + 64 * 68; float* betaL = gcL + 64; float* egL = betaL + 64; float* kdsL = egL + 64;
    float ga = 0.f, gb = 0.f;
    if (tid < 64) { ga = bf2f(U[(tok0 + tid) * INWP + C_GA + h]); gb = bf2f(U[(tok0 + tid) * INWP + C_GB + h]); }
    {   u32x4 rv[7]; int rt[7], rc[7];
#pragma unroll
        for (int j = 0; j < 7; ++j) { const int id = tid + 512 * j; rt[j] = id / 48; rc[j] = id % 48; rv[j] = (u32x4){0u, 0u, 0u, 0u};
            if (id < 67 * 48 && t0 + rt[j] - 3 >= 0) { const int s = rc[j] >> 4, c8 = (rc[j] & 15) * 8; const int col = (s == 0 ? C_GQ : s == 1 ? C_GK : C_GV) + h * 128 + c8;
                rv[j] = *(const u32x4*)(U + (tok0 + rt[j] - 3) * INWP + col); } }
#pragma unroll
        for (int j = 0; j < 7; ++j) { const int id = tid + 512 * j; if (id < 67 * 48) { const int s = rc[j] >> 4, c8 = (rc[j] & 15) * 8; float* base = (s == 0 ? qL : s == 1 ? kL : vL);
                float* dst = (rt[j] >= 3) ? base + (rt[j] - 3) * 132 + c8 : Lm + (s * 3 + rt[j]) * 132 + c8;
                *(f32x4*)dst = (f32x4){bflo(rv[j].x), bfhi(rv[j].x), bflo(rv[j].y), bfhi(rv[j].y)}; *(f32x4*)(dst + 4) = (f32x4){bflo(rv[j].z), bfhi(rv[j].z), bflo(rv[j].w), bfhi(rv[j].w)}; } } }
    __syncthreads();
    if (tid < 384) { const int s = tid >> 7, c = tid & 127; float* col = (s == 0 ? qL : s == 1 ? kL : vL) + c; const float* halo = Lm + (s * 3) * 132 + c;
        const float* cw = A.in[I_CONVW] + s * 512 + h * 128 + c; const float w0 = cw[0], w1 = cw[1536], w2 = cw[3072], w3 = cw[4608];
        float x0 = col[63 * 132], x1 = col[62 * 132], x2 = col[61 * 132];
#pragma unroll 8
        for (int t = 63; t >= 0; --t) { const float x3 = (t >= 3) ? col[(t - 3) * 132] : halo[t * 132];
            const float y = w0 * x3 + w1 * x2 + w2 * x1 + w3 * x0; col[t * 132] = y * sigm(y); x0 = x1; x1 = x2; x2 = x3; } }
    if (tid < 64) { const int tl = tid;
        const float x = ga + A.in[I_DTB][h]; const float sp = (x > 20.f) ? x : log1pf(__expf(x)); float gt = -__expf(A.in[I_ALOG][h]) * sp;
#pragma unroll
        for (int o = 1; o < 64; o <<= 1) { const float v = __shfl_up(gt, o); if (lane >= o) gt += v; }
        const float g63 = __shfl(gt, 63);
        gcL[tl] = gt; betaL[tl] = sigm(gb); egL[tl] = __expf(gt); kdsL[tl] = __expf(g63 - gt);
        if (tl == 63) ((float*)(ws + WS_GL))[task] = __expf(gt); }
    __syncthreads();
    { const int tl = tid >> 3, sub = tid & 7; float sq = 0.f, sk = 0.f;
#pragma unroll
      for (int i = 0; i < 16; ++i) { const float a = qL[tl * 132 + sub * 16 + i], c = kL[tl * 132 + sub * 16 + i]; sq += a * a; sk += c * c; }
      sq += __shfl_xor(sq, 1); sq += __shfl_xor(sq, 2); sq += __shfl_xor(sq, 4); sk += __shfl_xor(sk, 1); sk += __shfl_xor(sk, 2); sk += __shfl_xor(sk, 4);
      const float rq = rsqrtf(sq + EPS) * 0.08838834764831845f, rk = rsqrtf(sk + EPS);
#pragma unroll
      for (int i = 0; i < 16; ++i) { qL[tl * 132 + sub * 16 + i] *= rq; kL[tl * 132 + sub * 16 + i] *= rk; } }
    __syncthreads();
    { const int mat = wave >> 2, mi = (wave >> 1) & 1, ni = wave & 1; const float* X = mat ? qL : kL;
      f32x16 acc; for (int i = 0; i < 16; ++i) acc[i] = 0.f;
#pragma unroll
      for (int s = 0; s < 8; ++s) { const f32x4 a0 = *(const f32x4*)(X + (32 * mi + r32) * 132 + 16 * s + 8 * hh), a1 = *(const f32x4*)(X + (32 * mi + r32) * 132 + 16 * s + 8 * hh + 4);
          const f32x4 b0 = *(const f32x4*)(kL + (32 * ni + r32) * 132 + 16 * s + 8 * hh), b1 = *(const f32x4*)(kL + (32 * ni + r32) * 132 + 16 * s + 8 * hh + 4);
          acc = MFMA32(pack8(a0[0], a0[1], a0[2], a0[3], a1[0], a1[1], a1[2], a1[3]), pack8(b0[0], b0[1], b0[2], b0[3], b1[0], b1[1], b1[2], b1[3]), acc); }
      const int sc = 32 * ni + r32; const float gs = gcL[sc];
#pragma unroll
      for (int r = 0; r < 16; ++r) { const int c = 32 * mi + crow(r, hh); const float dec = __expf(gcL[c] - gs);
          if (mat == 0) Lm[c * 68 + sc] = (c > sc) ? betaL[c] * acc[r] * dec : 0.f; else Qm[c * 68 + sc] = (c >= sc) ? acc[r] * dec : 0.f; } }
    __syncthreads();
    {   bf16_t* QGp = (bf16_t*)(ws + WS_QGP) + (size_t)task * 8192; bf16_t* KDTp = (bf16_t*)(ws + WS_KDTP) + (size_t)task * 8192; bf16_t* QKp = (bf16_t*)(ws + WS_QKP) + (size_t)task * 4096;
        for (int id = tid; id < 1024; id += 512) { const int c = id >> 4, chn = id & 15, ks = chn >> 2, q = chn & 3; const float e = egL[c];
            const f32x4 a = *(const f32x4*)(qL + c * 132 + 32 * ks + 4 * q), bq = *(const f32x4*)(qL + c * 132 + 32 * ks + 16 + 4 * q);
            *(bf16x8*)(QGp + id * 8) = pack8(a[0] * e, a[1] * e, a[2] * e, a[3] * e, bq[0] * e, bq[1] * e, bq[2] * e, bq[3] * e); }
        for (int id = tid; id < 1024; id += 512) { const int d = id >> 3, chn = id & 7, ks = chn >> 2, q = chn & 3; float f[8];
#pragma unroll
            for (int j = 0; j < 8; ++j) { const int s = 32 * ks + 16 * (j >> 2) + 4 * q + (j & 3); f[j] = kL[s * 132 + d] * kdsL[s]; }
            *(bf16x8*)(KDTp + id * 8) = pack8(f[0], f[1], f[2], f[3], f[4], f[5], f[6], f[7]); }
        { const int id = tid; const int c = id >> 3, chn = id & 7, ks = chn >> 2, q = chn & 3;
            const f32x4 a = *(const f32x4*)(Qm + c * 68 + 32 * ks + 4 * q), bq = *(const f32x4*)(Qm + c * 68 + 32 * ks + 16 + 4 * q);
            *(bf16x8*)(QKp + id * 8) = pack8(a[0], a[1], a[2], a[3], bq[0], bq[1], bq[2], bq[3]); } }
    __syncthreads();
    bf16_t* XT = (bf16_t*)qL;
    float* TK = Qm;
    {
        const int k = lane >> 4, c = lane & 15; float x[16];
#pragma unroll
        for (int i = 0; i < 16; ++i) x[i] = (i == c) ? 1.f : 0.f;
#pragma unroll
        for (int i = 1; i < 16; ++i) {
#pragma unroll
            for (int j4 = 0; j4 < (i + 3) / 4; ++j4) { const f32x4 l4 = *(const f32x4*)(Lm + (16 * k + i) * 68 + 16 * k + 4 * j4);
#pragma unroll
                for (int jj = 0; jj < 4; ++jj) if (4 * j4 + jj < i) x[i] -= l4[jj] * x[4 * j4 + jj]; } }
#pragma unroll
        for (int i = 0; i < 16; ++i) TK[(k * 16 + i) * 16 + c] = x[i];
        asm volatile("s_waitcnt lgkmcnt(0)" ::: "memory");
    }
    {   const int r16 = lane & 15, q4 = lane >> 4; const bf16x8 z8 = pack8(0.f, 0.f, 0.f, 0.f, 0.f, 0.f, 0.f, 0.f);
#pragma unroll 1
        for (int nt2 = 0; nt2 < 2; ++nt2) { const int nt = 2 * wave + nt2; const bool isW = nt >= 8; const float* srcc = (isW ? kL : vL) + ((16 * nt + r16) & 127);
            bf16_t* xcol = XT + (16 * nt + r16) * 64;
#pragma unroll
            for (int bi = 0; bi < 4; ++bi) {
                f32x4 acc = (f32x4){0.f, 0.f, 0.f, 0.f};
#pragma unroll
                for (int ks = 0; ks * 32 < 16 * bi; ++ks) { const int k0 = 32 * ks + 8 * q4; const bool ok = k0 < 16 * bi;
                    const f32x4 l0 = *(const f32x4*)(Lm + (16 * bi + r16) * 68 + k0), l1 = *(const f32x4*)(Lm + (16 * bi + r16) * 68 + k0 + 4);
                    const bf16x8 af = ok ? pack8(l0[0], l0[1], l0[2], l0[3], l1[0], l1[1], l1[2], l1[3]) : z8;
                    const bf16x8 xb = *(const bf16x8*)(xcol + k0); const bf16x8 bf = ok ? xb : z8;
                    acc = MFMA16(af, bf, acc); }
                float d[4];
#pragma unroll
                for (int r = 0; r < 4; ++r) { const int i = 16 * bi + 4 * q4 + r; float v = srcc[i * 132] * betaL[i]; if (isW) v *= egL[i]; d[r] = v - acc[r]; }
                const f32x4 t4 = *(const f32x4*)(TK + (bi * 16 + r16) * 16 + 4 * q4);
                const bf16x8 ta = pack8(t4[0], t4[1], t4[2], t4[3], 0.f, 0.f, 0.f, 0.f), db = pack8(d[0], d[1], d[2], d[3], 0.f, 0.f, 0.f, 0.f);
                const f32x4 xr = MFMA16(ta, db, ((f32x4){0.f, 0.f, 0.f, 0.f}));
                u32x2 o; o.x = pk2(xr[0], xr[1]); o.y = pk2(xr[2], xr[3]);
                *(u32x2*)(xcol + 16 * bi + 4 * q4) = o;
                asm volatile("s_waitcnt lgkmcnt(0)" ::: "memory"); } } }
    __syncthreads();
    { bf16_t* Wp = (bf16_t*)(ws + WS_WP) + (size_t)task * 8192; bf16_t* Up = (bf16_t*)(ws + WS_UP) + (size_t)task * 8192;
      for (int id = tid; id < 1024; id += 512) { const int c = id >> 4, chn = id & 15, ks = chn >> 2, q = chn & 3; unsigned short f[8];
#pragma unroll
          for (int j = 0; j < 8; ++j) { const int d = 32 * ks + 16 * (j >> 2) + 4 * q + (j & 3); f[j] = XT[(128 + d) * 64 + c]; }
          u32x4 o; o.x = f[0] | ((unsigned)f[1] << 16); o.y = f[2] | ((unsigned)f[3] << 16); o.z = f[4] | ((unsigned)f[5] << 16); o.w = f[6] | ((unsigned)f[7] << 16);
          *(u32x4*)(Wp + id * 8) = o; }
      for (int id = tid; id < 2048; id += 512) { const int ln = id & 63, mt = (id >> 6) & 3, es = id >> 8, q = ln >> 4, e = ln & 15; const int c = 16 * mt + 4 * q, col = 16 * es + e;
          *(u32x2*)(Up + id * 4) = *(const u32x2*)(XT + col * 64 + c); } }
    __syncthreads();
}

constexpr int SC_W = 0, SC_QG = 17408, SC_KD = 34816, SC_QK = 53248, SC_UP = 62464, SC_BUF = 64512, SC_OB = 2 * 64512  ;
#define SC_BAR() do { asm volatile("s_waitcnt lgkmcnt(0)" ::: "memory"); __builtin_amdgcn_s_barrier(); asm volatile("" ::: "memory"); } while (0)
DI void gdn_scan_block(const Args& A, int sidx, unsigned char* lds) {
    const int tid = otid(), lane = tid & 63, wave = __builtin_amdgcn_readfirstlane(tid >> 6);
    const int es = sidx & 7, bh = sidx >> 3, b = bh >> 2, h = bh & 3, r16 = lane & 15, q = lane >> 4;
    unsigned char* ws = A.ws;
    const bf16_t* WP = (const bf16_t*)(ws + WS_WP) + (size_t)bh * 128 * 8192; const bf16_t* QGP = (const bf16_t*)(ws + WS_QGP) + (size_t)bh * 128 * 8192;
    const bf16_t* KDTP = (const bf16_t*)(ws + WS_KDTP) + (size_t)bh * 128 * 8192; const bf16_t* QKP = (const bf16_t*)(ws + WS_QKP) + (size_t)bh * 128 * 4096;
    const bf16_t* UP = (const bf16_t*)(ws + WS_UP) + (size_t)bh * 128 * 8192 + es * 1024;
    if (wave != 0) {
        const int lt = tid - 64; u32x4 R0[9], R1[9], R2[9];
        const bf16_t* sp[9]; int dof[9], stp[9];
#pragma unroll
        for (int j = 0; j < 9; ++j) { const int c = lt + 448 * j;
            if (c < 1024) { sp[j] = WP + c * 8; dof[j] = SC_W + (c >> 4) * 272 + (c & 15) * 16; stp[j] = 8192; }
            else if (c < 2048) { const int cc = c - 1024; sp[j] = QGP + cc * 8; dof[j] = SC_QG + (cc >> 4) * 272 + (cc & 15) * 16; stp[j] = 8192; }
            else if (c < 3072) { const int cc = c - 2048; sp[j] = KDTP + cc * 8; dof[j] = SC_KD + (cc >> 3) * 144 + (cc & 7) * 16; stp[j] = 8192; }
            else if (c < 3584) { const int cc = c - 3072; sp[j] = QKP + cc * 8; dof[j] = SC_QK + (cc >> 3) * 144 + (cc & 7) * 16; stp[j] = 4096; }
            else if (c < 3712) { const int cc = c - 3584; sp[j] = UP + cc * 8; dof[j] = SC_UP + cc * 16; stp[j] = 8192; }
            else { sp[j] = WP; dof[j] = -1; stp[j] = 0; } }
#define SC_LOAD(R, i_) do { if ((i_) < 128) { _Pragma("unroll") for (int j = 0; j < 9; ++j) R[j] = *(const __attribute__((address_space(1))) u32x4*)(sp[j] + (size_t)(i_) * stp[j]); } } while (0)
#define SC_WRITE(R, bufi_) do { _Pragma("unroll") for (int j = 0; j < 9; ++j) if (dof[j] >= 0) *(u32x4*)(lds + (bufi_) * SC_BUF + dof[j]) = R[j]; } while (0)
        bf16_t* OGr = (bf16_t*)(ws + WS_OG) + ((size_t)b * T + lt) * 512 + h * 128 + es * 16;
        const int odump = SC_OB + (((lt >> 4) * 64 + ((lt >> 2) & 3) * 16) * 4 + (lt & 3)) * 2;
#define SC_OFLUSH(i_) do { if (wave == 1 && (i_) >= 0) { const unsigned char* ob = lds + odump + ((i_) & 1) * 2048; unsigned w_[8]; \
            _Pragma("unroll") for (int e2 = 0; e2 < 8; ++e2) w_[e2] = (unsigned)*(const bf16_t*)(ob + (2 * e2) * 8) | ((unsigned)*(const bf16_t*)(ob + (2 * e2 + 1) * 8) << 16); \
            u32x4* dst_ = (u32x4*)(OGr + (size_t)(i_) * 64 * 512); dst_[0] = (u32x4){w_[0], w_[1], w_[2], w_[3]}; dst_[1] = (u32x4){w_[4], w_[5], w_[6], w_[7]}; } } while (0)
        SC_LOAD(R0, 0); SC_LOAD(R1, 1); SC_LOAD(R2, 2); SC_WRITE(R0, 0); SC_LOAD(R0, 3);
        SC_BAR();
        for (int i = 0; i < 128; i += 3) {
            if (i + 1 < 128) SC_WRITE(R1, (i + 1) & 1);
            SC_LOAD(R1, i + 4); SC_OFLUSH(i - 1);
            SC_BAR();
            if (i + 1 < 128) { if (i + 2 < 128) SC_WRITE(R2, (i + 2) & 1);
                SC_LOAD(R2, i + 5); SC_OFLUSH(i);
                SC_BAR(); }
            if (i + 2 < 128) { if (i + 3 < 128) SC_WRITE(R0, (i + 3) & 1);
                SC_LOAD(R0, i + 6); SC_OFLUSH(i + 1);
                SC_BAR(); } }
        SC_OFLUSH(127);
#undef SC_LOAD
#undef SC_WRITE
#undef SC_OFLUSH
        return;
    }
    const float* GLp = (const float*)(ws + WS_GL) + bh * 128; const float glA = GLp[lane], glB = GLp[64 + lane];
    f32x4 S[8];
#pragma unroll
    for (int m = 0; m < 8; ++m) S[m] = (f32x4){0.f, 0.f, 0.f, 0.f};
    asm volatile("s_waitcnt vmcnt(0)" ::: "memory");
    SC_BAR();
    for (int i = 0; i < 128; ++i) {
        const unsigned char* bufp = lds + (i & 1) * SC_BUF;
        const unsigned char* wp = bufp + SC_W + r16 * 272 + 16 * q; const unsigned char* qgp = bufp + SC_QG + r16 * 272 + 16 * q;
        const unsigned char* kdp = bufp + SC_KD + r16 * 144 + 16 * q; const unsigned char* qkp = bufp + SC_QK + r16 * 144 + 16 * q;
        const unsigned char* up = bufp + SC_UP + lane * 8;
        const float gl = __builtin_bit_cast(float, __builtin_amdgcn_readlane(__builtin_bit_cast(int, (i < 64) ? glA : glB), i & 63));
        bf16x8 fa[16], fb[16];
#pragma unroll
        for (int mt = 0; mt < 4; ++mt)
#pragma unroll
            for (int ks = 0; ks < 4; ++ks) fa[mt * 4 + ks] = *(const bf16x8*)(wp + mt * 16 * 272 + ks * 64);
        u32x2 uw[4];
#pragma unroll
        for (int mt = 0; mt < 4; ++mt) uw[mt] = *(const u32x2*)(up + mt * 512);
#pragma unroll
        for (int m = 0; m < 8; ++m)
#pragma unroll
            for (int k2 = 0; k2 < 2; ++k2) fb[m * 2 + k2] = *(const bf16x8*)(kdp + m * 16 * 144 + k2 * 64);
        bf16x8 Sb[4];
#pragma unroll
        for (int ks = 0; ks < 4; ++ks) Sb[ks] = pack8(S[2 * ks][0], S[2 * ks][1], S[2 * ks][2], S[2 * ks][3], S[2 * ks + 1][0], S[2 * ks + 1][1], S[2 * ks + 1][2], S[2 * ks + 1][3]);
        f32x4 vn[4];
#pragma unroll
        for (int mt = 0; mt < 4; ++mt) vn[mt] = (f32x4){0.f, 0.f, 0.f, 0.f};
#pragma unroll
        for (int ks = 0; ks < 4; ++ks)
#pragma unroll
            for (int mt = 0; mt < 4; ++mt) vn[mt] = MFMA16(fa[mt * 4 + ks], Sb[ks], vn[mt]);
#pragma unroll
        for (int mt = 0; mt < 4; ++mt)
#pragma unroll
            for (int ks = 0; ks < 4; ++ks) fa[mt * 4 + ks] = *(const bf16x8*)(qgp + mt * 16 * 272 + ks * 64);
#pragma unroll
        for (int mt = 0; mt < 4; ++mt) vn[mt] = (f32x4){bflo(uw[mt].x) - vn[mt][0], bfhi(uw[mt].x) - vn[mt][1], bflo(uw[mt].y) - vn[mt][2], bfhi(uw[mt].y) - vn[mt][3]};
        bf16x8 Vb[2];
#pragma unroll
        for (int k2 = 0; k2 < 2; ++k2) Vb[k2] = pack8(vn[2 * k2][0], vn[2 * k2][1], vn[2 * k2][2], vn[2 * k2][3], vn[2 * k2 + 1][0], vn[2 * k2 + 1][1], vn[2 * k2 + 1][2], vn[2 * k2 + 1][3]);
#pragma unroll
        for (int m = 0; m < 8; ++m) S[m] = S[m] * gl;
#pragma unroll
        for (int k2 = 0; k2 < 2; ++k2)
#pragma unroll
            for (int m = 0; m < 8; ++m) S[m] = MFMA16(fb[m * 2 + k2], Vb[k2], S[m]);
#pragma unroll
        for (int mt = 0; mt < 4; ++mt)
#pragma unroll
            for (int k2 = 0; k2 < 2; ++k2) fb[mt * 2 + k2] = *(const bf16x8*)(qkp + mt * 16 * 144 + k2 * 64);
        f32x4 oa[4];
#pragma unroll
        for (int mt = 0; mt < 4; ++mt) oa[mt] = (f32x4){0.f, 0.f, 0.f, 0.f};
#pragma unroll
        for (int ks = 0; ks < 4; ++ks)
#pragma unroll
            for (int mt = 0; mt < 4; ++mt) oa[mt] = MFMA16(fa[mt * 4 + ks], Sb[ks], oa[mt]);
#pragma unroll
        for (int k2 = 0; k2 < 2; ++k2)
#pragma unroll
            for (int mt = 0; mt < 4; ++mt) oa[mt] = MFMA16(fb[mt * 2 + k2], Vb[k2], oa[mt]);
#pragma unroll
        for (int mt = 0; mt < 4; ++mt) { u32x2 o2; o2.x = pk2(oa[mt][0], oa[mt][1]); o2.y = pk2(oa[mt][2], oa[mt][3]); *(u32x2*)(lds + SC_OB + (i & 1) * 2048 + (mt * 64 + lane) * 8) = o2; }
        SC_BAR();
    }
}

DI void tile_load_k(bf16x8 (&kf)[4], const bf16_t* __restrict__ KT, int lane) {
#pragma unroll
    for (int s = 0; s < 4; ++s) kf[s] = *(const bf16x8*)(KT + s * 512 + lane * 8); }
DI void tile_load_v(bf16x8 (&vf)[2][2], const bf16_t* __restrict__ VT, int lane) {
#pragma unroll
    for (int dt = 0; dt < 2; ++dt)
#pragma unroll
        for (int ks = 0; ks < 2; ++ks) vf[dt][ks] = *(const bf16x8*)(VT + (dt * 2 + ks) * 512 + lane * 8); }
DI f32x16 tile_scores(const bf16x8 (&kf)[4], const bf16x8 (&qf)[4], float negM, int hi2, int lo2, float& l) {
    f32x16 st;
#pragma unroll
    for (int i = 0; i < 16; ++i) st[i] = negM;
#pragma unroll
    for (int s = 0; s < 4; ++s) st = MFMA32(kf[s], qf[s], st);
#pragma unroll
    for (int r = 0; r < 16; ++r) { const int cr = (r & 3) + 8 * (r >> 2); float pv = __builtin_amdgcn_exp2f(st[r]); pv = (cr <= hi2 && cr > lo2) ? pv : 0.f; st[r] = pv; l += pv; }
    return st; }
DI void tile_pv(const f32x16& p, const bf16x8 (&vf)[2][2], f32x16 (&o)[2]) {
    const bf16x8 pb0 = pack8(p[0], p[1], p[2], p[3], p[4], p[5], p[6], p[7]), pb1 = pack8(p[8], p[9], p[10], p[11], p[12], p[13], p[14], p[15]);
#pragma unroll
    for (int dt = 0; dt < 2; ++dt) { o[dt] = MFMA32(vf[dt][0], pb0, o[dt]); o[dt] = MFMA32(vf[dt][1], pb1, o[dt]); } }

DI void block_stream(const bf16_t* __restrict__ KB, const bf16_t* __restrict__ VB, int f0, int f1, const bf16x8 (&qf)[4], f32x16 (&o)[2], float& l, float negM, int hi, int lo, int r32, int hh) {
    if (f0 >= f1) return;
    const int lane_ = hh * 32 + r32;
    bf16x8 ka[4], kb[4], va[2][2], vb[2][2];
#define BS_LOAD(kx, vx, f_) do { tile_load_k(kx, KB + (size_t)(f_) * 2048, lane_); tile_load_v(vx, VB + (size_t)(f_) * 2048, lane_); } while (0)
#define BS_COMP(kx, vx, f_) do { const int k0_ = 32 * (f_) + 4 * hh; const f32x16 p_ = tile_scores(kx, qf, negM, hi - k0_, lo - k0_, l); tile_pv(p_, vx, o); } while (0)
    BS_LOAD(ka, va, f0);
#pragma unroll 1
    for (int f = f0; f < f1; f += 2) {
        const bool h1 = f + 1 < f1;
        if (h1) BS_LOAD(kb, vb, f + 1);
        BS_COMP(ka, va, f);
        if (h1) { if (f + 2 < f1) BS_LOAD(ka, va, f + 2); BS_COMP(kb, vb, f + 1); } }
#undef BS_LOAD
#undef BS_COMP
}

DI float maxabs64(const float* g, int lane) { float v = fabsf(g[lane]);
#pragma unroll
    for (int o = 1; o < 64; o <<= 1) v = fmaxf(v, __shfl_xor(v, o));
    return v; }

#define LOADQF(qf) do { _Pragma("unroll") for (int s_ = 0; s_ < 4; ++s_) qf[s_] = *(const bf16x8*)(QL + row * 72 + 16 * s_ + 8 * hh); } while (0)
DI void nsa_unit(const Args& A, int unit, unsigned char* lds) {
    const int tid = otid(), lane = tid & 63, wave = __builtin_amdgcn_readfirstlane(tid >> 6), r32 = lane & 31, hh = lane >> 5;
    const int ti = 127 - (unit >> 2), bg = unit & 3, b = bg >> 1, g = bg & 1;
    unsigned char* ws = A.ws;
    bf16_t* QL = (bf16_t*)lds;
    int* OL = (int*)(lds + 36864);
    int* LL = (int*)(lds + 36864 + 67584);
    unsigned* BM = (unsigned*)(lds + 36864 + 67584 + 1024);
    int* CNT = (int*)(lds + 36864 + 67584 + 2048);
    float* SCL = (float*)(lds + 36864 + 67584 + 2048 + 64);
    float* IMP = (float*)(lds + 108544);
    const int slot = r32 >> 2, hd = r32 & 3, tl = wave * 8 + slot, trow = ti * 64 + tl; const size_t tokg = (size_t)b * T + trow;
    const int row = wave * 32 + r32;
    bf16_t* PA = (bf16_t*)IMP + row * 64;
    const float mq = maxabs64(A.in[I_QG], lane) * 8.08f * LOG2E;
    for (int i = tid; i < 256 + 16; i += 512) BM[i] = 0u;
    { const bf16_t* qp = (const bf16_t*)(ws + WS_QN) + tokg * 512 + (g * 4 + hd) * 64 + 8 * hh;
#pragma unroll
      for (int s = 0; s < 4; ++s) *(bf16x8*)(QL + row * 72 + 16 * s + 8 * hh) = *(const bf16x8*)(qp + 16 * s); }
    const float* gp = (const float*)(ws + WS_GATES) + tokg * 24 + (g * 4 + hd) * 3;
    __syncthreads();
    {   const float negMc = -mq * maxabs64(A.in[I_KCG], lane);
        bf16x8 qf[4]; LOADQF(qf);
        const int cmax_row = (trow >= 31) ? ((trow - 31) >> 4) : -1; const int tmaxw = ti * 64 + wave * 8 + 7; const int ntc = (tmaxw >= 31) ? ((((tmaxw - 31) >> 4) >> 5) + 1) : 0;
        const bf16_t* Kc = (const bf16_t*)(ws + WS_KC) + (size_t)(b * 2 + g) * 512 * 64; const bf16_t* VcT = (const bf16_t*)(ws + WS_VCT) + (size_t)(b * 2 + g) * 64 * 512;
        float lc = 0.f;
        if (ntc > 0) { bf16x8 ka[4], kb[4]; tile_load_k(ka, Kc, lane);
#pragma unroll 1
            for (int ct = 0; ct < ntc; ct += 2) { const bool h1 = ct + 1 < ntc;
                if (h1) tile_load_k(kb, Kc + (ct + 1) * 2048, lane);
                tile_scores(ka, qf, negMc, cmax_row - 32 * ct - 4 * hh, -1000000, lc);
                if (h1) { if (ct + 2 < ntc) tile_load_k(ka, Kc + (ct + 2) * 2048, lane); tile_scores(kb, qf, negMc, cmax_row - 32 * (ct + 1) - 4 * hh, -1000000, lc); } } }
        lc += __shfl_xor(lc, 32);
        const float inv = (lc > 0.f) ? 1.f / lc : 0.f;
        f32x16 oc[2]; for (int i = 0; i < 16; ++i) { oc[0][i] = 0.f; oc[1][i] = 0.f; }
        float carry = 0.f, ldummy = 0.f;
#define CM_POST(p, ct_) do { float recv[4], bq[4]; \
            _Pragma("unroll") for (int jq = 0; jq < 4; ++jq) recv[jq] = __shfl_xor(p[4 * jq + 3], 32); \
            _Pragma("unroll") for (int jq = 0; jq < 4; ++jq) { const float pred = hh ? recv[jq] : (jq ? recv[jq - 1] : carry); float s_ = ((p[4 * jq] + p[4 * jq + 1]) + (p[4 * jq + 2] + p[4 * jq + 3]) + pred) * inv; \
                s_ += __shfl_xor(s_, 1); s_ += __shfl_xor(s_, 2); bq[jq] = s_; } \
            carry = recv[3]; \
            IMP[tl * 128 + 8 * (ct_) + 2 * hd + hh] = (hd == 0) ? bq[0] : (hd == 1) ? bq[1] : (hd == 2) ? bq[2] : bq[3]; } while (0)
        if (ntc > 0) { bf16x8 ka[4], kb[4], va[2][2], vb[2][2]; tile_load_k(ka, Kc, lane); tile_load_v(va, VcT, lane);
#pragma unroll 1
            for (int ct = 0; ct < ntc; ct += 2) { const bool h1 = ct + 1 < ntc;
                if (h1) { tile_load_k(kb, Kc + (ct + 1) * 2048, lane); tile_load_v(vb, VcT + (ct + 1) * 2048, lane); }
                { const f32x16 p = tile_scores(ka, qf, negMc, cmax_row - 32 * ct - 4 * hh, -1000000, ldummy); tile_pv(p, va, oc); CM_POST(p, ct); }
                if (h1) { if (ct + 2 < ntc) { tile_load_k(ka, Kc + (ct + 2) * 2048, lane); tile_load_v(va, VcT + (ct + 2) * 2048, lane); }
                    const f32x16 p = tile_scores(kb, qf, negMc, cmax_row - 32 * (ct + 1) - 4 * hh, -1000000, ldummy); tile_pv(p, vb, oc); CM_POST(p, ct + 1); } } }
#undef CM_POST
        for (int ct = ntc; ct < 16; ++ct) IMP[tl * 128 + 8 * ct + 2 * hd + hh] = 0.f;
        if (ti >= 3) {
            __builtin_amdgcn_s_waitcnt(0xC07F); asm volatile("" ::: "memory");
            unsigned key[16]; const int li = hd + 4 * hh;
#pragma unroll
            for (int i4 = 0; i4 < 4; ++i4) { const f32x4 v4 = *(const f32x4*)(IMP + tl * 128 + li * 16 + 4 * i4);
#pragma unroll
                for (int i = 0; i < 4; ++i) { const int n = li * 16 + 4 * i4 + i; key[4 * i4 + i] = (n >= 1 && n <= ti - 2) ? ((__float_as_uint(fmaxf(v4[i], 0.f)) & ~0xFFu) | (unsigned)(128 - n)) : 0u; } }
#pragma unroll 1
            for (int it = 0; it < 13; ++it) { unsigned m = key[0];
#pragma unroll
                for (int i = 1; i < 16; ++i) m = (key[i] > m) ? key[i] : m;
                { unsigned o_; o_ = __shfl_xor(m, 1); m = o_ > m ? o_ : m; o_ = __shfl_xor(m, 2); m = o_ > m ? o_ : m; o_ = __shfl_xor(m, 32); m = o_ > m ? o_ : m; }
#pragma unroll
                for (int i = 0; i < 16; ++i) key[i] = (key[i] == m) ? 0u : key[i];
                if (m != 0u && hd == 0 && hh == 0) { const int nsel = 128 - (int)(m & 0xFFu); atomicOr(&BM[nsel * 2 + (tl >> 5)], 1u << (tl & 31)); } }
        }
        __builtin_amdgcn_s_waitcnt(0xC07F); asm volatile("" ::: "memory");
        { const float sc = gp[0] * inv;
#pragma unroll
          for (int dt = 0; dt < 2; ++dt)
#pragma unroll
              for (int r4 = 0; r4 < 4; ++r4) { u32x2 o; o.x = pk2(oc[dt][4 * r4] * sc, oc[dt][4 * r4 + 1] * sc); o.y = pk2(oc[dt][4 * r4 + 2] * sc, oc[dt][4 * r4 + 3] * sc);
                  *(u32x2*)(PA + 32 * dt + 8 * r4 + 4 * hh) = o; } }
    }
    const float negMs = -mq * maxabs64(A.in[I_KSG], lane);
    const bf16_t* KS = (const bf16_t*)(ws + WS_KSN) + (size_t)(b * 2 + g) * T * 64; const bf16_t* VS = (const bf16_t*)(ws + WS_VST) + (size_t)(b * 2 + g) * 128 * 4096;
    { bf16x8 qf[4]; LOADQF(qf);
      f32x16 os[2]; float lsel = 0.f; for (int i = 0; i < 16; ++i) { os[0][i] = 0.f; os[1][i] = 0.f; }
      block_stream(KS, VS, (ti >= 1 ? 2 * ti - 2 : 0), 2 * ti + 2, qf, os, lsel, negMs, trow, -1, r32, hh);
      if (ti >= 2) block_stream(KS, VS, 0, 2, qf, os, lsel, negMs, trow, -1, r32, hh);
      lsel += __shfl_xor(lsel, 32);
      const float scl = 1048576.0f / lsel;
#pragma unroll
      for (int dt = 0; dt < 2; ++dt)
#pragma unroll
          for (int r = 0; r < 16; ++r) OL[row * 66 + 32 * dt + crow(r, hh)] = __float2int_rn(os[dt][r] * scl);
      if (hh == 0) { LL[row] = __float2int_rn(lsel * scl); SCL[row] = scl; } }
    { const bf16_t* KW = (const bf16_t*)(ws + WS_KWN) + (size_t)(b * 2 + g) * T * 64; const bf16_t* VW = (const bf16_t*)(ws + WS_VWT) + (size_t)(b * 2 + g) * 128 * 4096;
      const float negMw = -mq * maxabs64(A.in[I_KWG], lane);
      bf16x8 qf[4]; LOADQF(qf);
      f32x16 ow[2]; float lw = 0.f; for (int i = 0; i < 16; ++i) { ow[0][i] = 0.f; ow[1][i] = 0.f; }
      const int tw0 = ti * 64 + wave * 8; const int nlo = (tw0 - 511 > 0) ? ((tw0 - 511) >> 6) : 0;
      block_stream(KW, VW, 2 * nlo, 2 * ti + 2, qf, ow, lw, negMw, trow, trow - 512, r32, hh);
      lw += __shfl_xor(lw, 32); const float sc = gp[2] / lw;
#pragma unroll
      for (int dt = 0; dt < 2; ++dt)
#pragma unroll
          for (int r4 = 0; r4 < 4; ++r4) { bf16_t* pp = PA + 32 * dt + 8 * r4 + 4 * hh; const u32x2 pa = *(const u32x2*)pp;
              u32x2 o; o.x = pk2(bflo(pa.x) + ow[dt][4 * r4] * sc, bfhi(pa.x) + ow[dt][4 * r4 + 1] * sc); o.y = pk2(bflo(pa.y) + ow[dt][4 * r4 + 2] * sc, bfhi(pa.y) + ow[dt][4 * r4 + 3] * sc);
              *(u32x2*)pp = o; } }
    __syncthreads();
    if (ti >= 3) {
        unsigned long long m_cur = 0ull; int n_cur = 0;
        int n_a = 0, n_b = 0; unsigned long long m_a = 0ull, m_b = 0ull;
#define ADVANCE(n_it, m_it, ok) do { ok = true; while (m_cur == 0ull) { int k_ = 0; if (lane == 0) k_ = atomicAdd(CNT, 1); k_ = __builtin_amdgcn_readfirstlane(k_); \
                if (k_ >= ti - 2) { ok = false; break; } n_cur = ti - 2 - k_; \
                m_cur = ((unsigned long long)__builtin_amdgcn_readfirstlane(BM[n_cur * 2 + 1]) << 32) | (unsigned)__builtin_amdgcn_readfirstlane(BM[n_cur * 2]); } \
            if (ok) { n_it = n_cur; m_it = m_cur; for (int i_ = 0; i_ < 8; ++i_) m_cur &= m_cur - 1ull; } } while (0)
        bool have; ADVANCE(n_a, m_a, have);
        bf16x8 ka[2][4], kb[2][4];
        if (have) { tile_load_k(ka[0], KS + (size_t)n_a * 4096, lane); tile_load_k(ka[1], KS + (size_t)n_a * 4096 + 2048, lane); }
        while (have) {
            bool have_b; ADVANCE(n_b, m_b, have_b);
            if (have_b) { tile_load_k(kb[0], KS + (size_t)n_b * 4096, lane); tile_load_k(kb[1], KS + (size_t)n_b * 4096 + 2048, lane); }
            bf16x8 va[2][2][2];
            tile_load_v(va[0], VS + (size_t)n_a * 4096, lane); tile_load_v(va[1], VS + (size_t)n_a * 4096 + 2048, lane);
            unsigned long long mm = m_a; for (int i = 0; i < slot; ++i) mm &= mm - 1ull;
            const bool active = mm != 0ull; const int tt = active ? (__ffsll((long long)mm) - 1) : (__ffsll((long long)m_a) - 1);
            const int grow = tt * 4 + hd;
            bf16x8 qg[4];
#pragma unroll
            for (int s = 0; s < 4; ++s) qg[s] = *(const bf16x8*)(QL + grow * 72 + 16 * s + 8 * hh);
            f32x16 oo[2]; for (int i = 0; i < 16; ++i) { oo[0][i] = 0.f; oo[1][i] = 0.f; }
            float lp = 0.f; const int hi2 = active ? 1000000 : -1000000;
#pragma unroll
            for (int kt = 0; kt < 2; ++kt) { const f32x16 p = tile_scores(ka[kt], qg, negMs, hi2, -1000000, lp); tile_pv(p, va[kt], oo); }
            if (active) { const float scl = SCL[grow];
#pragma unroll
                for (int dt = 0; dt < 2; ++dt)
#pragma unroll
                    for (int r = 0; r < 16; ++r) atomicAdd(&OL[grow * 66 + 32 * dt + crow(r, hh)], __float2int_rn(oo[dt][r] * scl));
                atomicAdd(&LL[grow], __float2int_rn(lp * scl)); }
#pragma unroll
            for (int kt = 0; kt < 2; ++kt)
#pragma unroll
                for (int s = 0; s < 4; ++s) ka[kt][s] = kb[kt][s];
            n_a = n_b; m_a = m_b; have = have_b;
        }
#undef ADVANCE
    }
    __syncthreads();
    { const float sc = gp[1] / (float)LL[row];
      bf16_t* op = (bf16_t*)(ws + WS_ONSA) + tokg * 512 + (g * 4 + hd) * 64;
#pragma unroll
      for (int dt = 0; dt < 2; ++dt)
#pragma unroll
          for (int r4 = 0; r4 < 4; ++r4) { float f[4];
              const u32x2 pa = *(const u32x2*)(PA + 32 * dt + 8 * r4 + 4 * hh); const float pf[4] = {bflo(pa.x), bfhi(pa.x), bflo(pa.y), bfhi(pa.y)};
#pragma unroll
              for (int i = 0; i < 4; ++i) { const int r = 4 * r4 + i; f[i] = pf[i] + (float)OL[row * 66 + 32 * dt + crow(r, hh)] * sc; }
              u32x2 o; o.x = pk2(f[0], f[1]); o.y = pk2(f[2], f[3]);
              *(u32x2*)(op + 32 * dt + 8 * r4 + 4 * hh) = o; } }
    __syncthreads();
}

DI void phase_finalize(const Args& A) {
    const int tid = otid(), lane = tid & 63, wave = tid >> 6; const int gw = blockIdx.x * 8 + wave, NGW = gridDim.x * 8;
    unsigned char* ws = A.ws;
    for (int tok = gw; tok < NTOK; tok += NGW) {
        bf16_t* oc = (bf16_t*)(ws + WS_OCAT) + (size_t)tok * 1024;
        { const u32x4 w = *(const u32x4*)((const bf16_t*)(ws + WS_ONSA) + (size_t)tok * 512 + 8 * lane);
          float f[8] = {bflo(w.x), bfhi(w.x), bflo(w.y), bfhi(w.y), bflo(w.z), bfhi(w.z), bflo(w.w), bfhi(w.w)}; float s = 0.f;
#pragma unroll
          for (int i = 0; i < 8; ++i) s += f[i] * f[i];
          const float rs = rsqrtf(wave_sum(s) * (1.f / 512.f) + EPS); const float* gn = A.in[I_NSAOG] + 8 * lane;
          u32x4 o; o.x = pk2(f[0] * rs * gn[0], f[1] * rs * gn[1]); o.y = pk2(f[2] * rs * gn[2], f[3] * rs * gn[3]); o.z = pk2(f[4] * rs * gn[4], f[5] * rs * gn[5]); o.w = pk2(f[6] * rs * gn[6], f[7] * rs * gn[7]);
          *(u32x4*)(oc + 8 * lane) = o; }
        { const u32x4 w = *(const u32x4*)((const bf16_t*)(ws + WS_OG) + (size_t)tok * 512 + 8 * lane);
          const u32x4 zw = *(const u32x4*)((const bf16_t*)(ws + WS_U) + (size_t)tok * INWP + C_GZ + 8 * lane);
          float f[8] = {bflo(w.x), bfhi(w.x), bflo(w.y), bfhi(w.y), bflo(w.z), bfhi(w.z), bflo(w.w), bfhi(w.w)};
          float z[8] = {bflo(zw.x), bfhi(zw.x), bflo(zw.y), bfhi(zw.y), bflo(zw.z), bfhi(zw.z), bflo(zw.w), bfhi(zw.w)}; float s = 0.f;
#pragma unroll
          for (int i = 0; i < 8; ++i) s += f[i] * f[i];
          s += __shfl_xor(s, 1); s += __shfl_xor(s, 2); s += __shfl_xor(s, 4); s += __shfl_xor(s, 8);
          const float rs = rsqrtf(s * (1.f / 128.f) + EPS); const float* gn = A.in[I_GDNOG] + (8 * lane & 127); float o8[8];
#pragma unroll
          for (int i = 0; i < 8; ++i) o8[i] = f[i] * rs * gn[i] * z[i] * sigm(z[i]);
          u32x4 o; o.x = pk2(o8[0], o8[1]); o.y = pk2(o8[2], o8[3]); o.z = pk2(o8[4], o8[5]); o.w = pk2(o8[6], o8[7]);
          *(u32x4*)(oc + 512 + 8 * lane) = o; }
    }
}

DI void phase_router(const Args& A, unsigned char* lds) {
    const int tid = otid(), lane = tid & 63, wave = __builtin_amdgcn_readfirstlane(tid >> 6);
    unsigned char* ws = A.ws; const float* x1 = A.out; const float* rw = A.in[I_RW]; const float* fg = A.in[I_FFNG];
    float* partL = (float*)lds;
    float* ssL = partL + 8 * 32 * 33;
    unsigned* cntL = (unsigned*)(ssL + 256); unsigned* baseL = cntL + 32;
    const int i32 = lane & 31, kh = lane >> 5;
    for (int task = blockIdx.x; task < NTOK / 32; task += gridDim.x) {
        const int tok = task * 32 + i32; const float* xr = x1 + (size_t)tok * D + 128 * wave;
        f32x16 acc; for (int i = 0; i < 16; ++i) acc[i] = 0.f; float ss = 0.f;
#pragma unroll 8
        for (int kb = 0; kb < 16; ++kb) { const int k0 = 8 * kb + 4 * kh; const f32x4 av = *(const f32x4*)(xr + k0); const f32x4 gv = *(const f32x4*)(fg + 128 * wave + k0);
            ss += av[0] * av[0] + av[1] * av[1] + av[2] * av[2] + av[3] * av[3];
#pragma unroll
            for (int s = 0; s < 4; ++s) acc = __builtin_amdgcn_mfma_f32_32x32x2f32(av[s], rw[(size_t)(128 * wave + k0 + s) * 32 + i32] * gv[s], acc, 0, 0, 0); }
        ss += __shfl_xor(ss, 32);
        if (kh == 0) ssL[wave * 32 + i32] = ss;
#pragma unroll
        for (int r = 0; r < 16; ++r) partL[(wave * 32 + crow(r, kh)) * 33 + i32] = acc[r];
        __syncthreads();
        if (wave == 0 && lane < 32) { float sst = 0.f;
#pragma unroll
            for (int w = 0; w < 8; ++w) sst += ssL[w * 32 + lane];
            const float rstd = rsqrtf(sst * (1.f / D) + EPS); ssL[256 + 64 + lane] = rstd;
            float v[4] = {-3.0e38f, -3.0e38f, -3.0e38f, -3.0e38f}; int id[4] = {0, 0, 0, 0}; const float* rb = A.in[I_RB];
            for (int e = 0; e < 32; ++e) { float lg = 0.f;
#pragma unroll
                for (int w = 0; w < 8; ++w) lg += partL[(w * 32 + lane) * 33 + e];
                const float x = lg * rstd + rb[e];
                if (x > v[3]) { if (x > v[0]) { v[3] = v[2]; id[3] = id[2]; v[2] = v[1]; id[2] = id[1]; v[1] = v[0]; id[1] = id[0]; v[0] = x; id[0] = e; }
                    else if (x > v[1]) { v[3] = v[2]; id[3] = id[2]; v[2] = v[1]; id[2] = id[1]; v[1] = x; id[1] = e; }
                    else if (x > v[2]) { v[3] = v[2]; id[3] = id[2]; v[2] = x; id[2] = e; }
                    else { v[3] = x; id[3] = e; } } }
            const float e0 = 1.f, e1 = __expf(v[1] - v[0]), e2 = __expf(v[2] - v[0]), e3 = __expf(v[3] - v[0]); const float inv = 1.f / (e0 + e1 + e2 + e3);
            const float gt[4] = {e0 * inv, e1 * inv, e2 * inv, e3 * inv};
            cntL[lane] = 0u; asm volatile("s_waitcnt lgkmcnt(0)" ::: "memory");
            unsigned lp[4];
#pragma unroll
            for (int k = 0; k < 4; ++k) lp[k] = atomicAdd(&cntL[id[k]], 1u);
            asm volatile("s_waitcnt lgkmcnt(0)" ::: "memory");
            { const unsigned c = cntL[lane]; baseL[lane] = c ? atomicAdd((unsigned*)(ws + WS_CTL) + CW_CNT + 64 * lane, c) : 0u; }
            asm volatile("s_waitcnt vmcnt(0) lgkmcnt(0)" ::: "memory");
#pragma unroll
            for (int k = 0; k < 4; ++k) { const int pos = (int)(baseL[id[k]] + lp[k]);
                ((int*)(ws + WS_TOKE))[tok * 4 + k] = id[k]; ((float*)(ws + WS_TOKG))[tok * 4 + k] = gt[k]; ((int*)(ws + WS_TOKPOS))[tok * 4 + k] = pos; } }
        __syncthreads();
#pragma unroll
        for (int t4 = 0; t4 < 4; ++t4) { const int tk = task * 32 + 4 * wave + t4; const float rs = ((const volatile float*)ssL)[256 + 64 + 4 * wave + t4];
            const f32x4* xr4 = (const f32x4*)(x1 + (size_t)tk * D) + lane; u32x2* o = (u32x2*)((bf16_t*)(ws + WS_H2) + (size_t)tk * D) + lane;
#pragma unroll
            for (int j = 0; j < 4; ++j) { const f32x4 v = xr4[64 * j]; const f32x4 gv = *(const f32x4*)(fg + 4 * lane + 256 * j);
                u32x2 w; w.x = pk2(v.x * rs * gv.x, v.y * rs * gv.y); w.y = pk2(v.z * rs * gv.z, v.w * rs * gv.w); o[64 * j] = w; } }
        __syncthreads();
    }
}

DI void phase_gather(const Args& A, unsigned char* lds) {
    const int tid = otid(); const int gt = blockIdx.x * 512 + tid, NGT = gridDim.x * 512;
    unsigned char* ws = A.ws; int* psL = (int*)lds;
    if (tid == 0) { const unsigned* cnt = (const unsigned*)(ws + WS_CTL) + CW_CNT; int acc = 0;
        for (int e = 0; e < 32; ++e) { psL[e] = acc; psL[40 + e] = (int)cnt[64 * e]; acc += ((int)cnt[64 * e] + 255) & ~255; }
        psL[32] = acc;
        if (blockIdx.x == 0) { int* ctl = (int*)(ws + WS_CTL); ctl[CW_NT] = acc >> 8; int e = 0;
            for (int r = 0; r < (acc >> 8); ++r) { while (r * 256 >= psL[e + 1]) ++e; ctl[CW_TILEE + r] = e; } } }
    __syncthreads();
    int* rowtok = (int*)(ws + WS_ROWTOK);
    for (int pr = gt; pr < NTOK * 4; pr += NGT) { const int e = ((const int*)(ws + WS_TOKE))[pr], pos = ((const int*)(ws + WS_TOKPOS))[pr]; const int dest = psL[e] + pos;
        ((int*)(ws + WS_DEST))[pr] = dest; ((float*)(ws + WS_ROWG))[dest] = ((const float*)(ws + WS_TOKG))[pr]; rowtok[dest] = pr >> 2; }
    for (int r = gt; r < psL[32]; r += NGT) { int e = 0; while (r >= psL[e + 1]) ++e; if (r >= psL[e] + psL[40 + e]) { rowtok[r] = 0; ((float*)(ws + WS_ROWG))[r] = 0.f; } }
}

DI void phase_combine(const Args& A) {
    const int tid = otid(), lane = tid & 63, wave = tid >> 6; const int gw = blockIdx.x * 8 + wave, NGW = gridDim.x * 8;
    unsigned char* ws = A.ws; const bf16_t* YS = (const bf16_t*)(ws + WS_XS);
    for (int tok = gw; tok < NTOK; tok += NGW) { f32x4* xr = (f32x4*)(A.out + (size_t)tok * D) + lane; f32x4 v[4];
#pragma unroll
        for (int j = 0; j < 4; ++j) v[j] = xr[64 * j];
#pragma unroll
        for (int k = 0; k < 4; ++k) { const int dest = ((const int*)(ws + WS_DEST))[tok * 4 + k]; const u32x2* yr = (const u32x2*)(YS + (size_t)dest * D) + lane;
#pragma unroll
            for (int j = 0; j < 4; ++j) { const u32x2 w = yr[64 * j]; v[j].x += bflo(w.x); v[j].y += bfhi(w.x); v[j].z += bflo(w.y); v[j].w += bfhi(w.y); } }
#pragma unroll
        for (int j = 0; j < 4; ++j) xr[64 * j] = v[j]; }
}


#define XB_TMO      128
#define XB_XCNT(j)  (256  + 64 * (j))
#define XB_XSUB(j)  (1280 + 64 * (j))
#define XB_XGEN(j)  (2304 + 64 * (j))
#define XB_TOP      3328
#define XB_TOPGEN   3392
#define XCD_BAR_WORDS 3456
#define XB_SPIN_CAP (1u << 22)
DI unsigned xb_ld(unsigned* p)              { return __hip_atomic_load(p, __ATOMIC_RELAXED, __HIP_MEMORY_SCOPE_AGENT); }
DI unsigned xb_add(unsigned* p, unsigned v) { return __hip_atomic_fetch_add(p, v, __ATOMIC_RELAXED, __HIP_MEMORY_SCOPE_AGENT); }
DI unsigned xb_xcc_id() { return (unsigned)__builtin_amdgcn_s_getreg((3 << 11) | 20) & 0xFu; }
#define XB_SPIN(cond, bar) do { unsigned _sp = 0; while (cond) { __builtin_amdgcn_s_sleep(1); \
    if ((++_sp & 255u) == 0u) { if (xb_ld(&(bar)[XB_TMO])) break; if (_sp > XB_SPIN_CAP) { atomicAdd(&(bar)[XB_TMO], 1u); break; } } } } while (0)
struct XcdBarrier { unsigned* bar; unsigned x; volatile LAS unsigned* st; };
DI XcdBarrier xcd_barrier_post(unsigned* bar, volatile LAS unsigned* st) {
    XcdBarrier b; b.bar = bar; b.x = xb_xcc_id(); b.st = st;
    if (threadIdx.x == 0) (void)xb_add(&bar[XB_XCNT(b.x)], 1u);
    return b; }
DI void xcd_barrier_complete(unsigned* bar, unsigned x, unsigned& nloc, unsigned& nx) {
    const unsigned G = gridDim.x * gridDim.y * gridDim.z;
    unsigned sum, cnt, mine, sp = 0u;
    for (;;) {
        sum = 0u; cnt = 0u; mine = 0u;
#pragma unroll
        for (unsigned j = 0; j < 16; ++j) { const unsigned c = xb_ld(&bar[XB_XCNT(j)]); sum += c; cnt += (c > 0u) ? 1u : 0u; mine = (j == x) ? c : mine; }
        if (sum == G) break;
        __builtin_amdgcn_s_sleep(1);
        if ((++sp & 255u) == 0u) { if (xb_ld(&bar[XB_TMO])) break; if (sp > XB_SPIN_CAP) { atomicAdd(&bar[XB_TMO], 1u); break; } }
    }
    nloc = mine > 0u ? mine : 1u; nx = cnt > 0u ? cnt : 1u; }
DI void xcd_barrier(const XcdBarrier& b) {
    asm volatile("s_waitcnt vmcnt(0)" ::: "memory");
    __syncthreads();
    if (threadIdx.x == 0) {
        unsigned* bar = b.bar;
        __builtin_amdgcn_s_waitcnt(0);
        unsigned nloc = b.st[0], nx = b.st[1];
        if (nloc == 0u) { xcd_barrier_complete(bar, b.x, nloc, nx); b.st[0] = nloc; b.st[1] = nx; }
        const unsigned old = xb_add(&bar[XB_XSUB(b.x)], 1u);
        const unsigned gen = old / nloc;
        if (old + 1u == (gen + 1u) * nloc) {
            __builtin_amdgcn_fence(__ATOMIC_RELEASE, "agent");
            asm volatile("s_waitcnt vmcnt(0)" ::: "memory");
            const unsigned og = xb_add(&bar[XB_TOP], 1u);
            const unsigned tg = og / nx;
            if (og + 1u == (tg + 1u) * nx) xb_add(&bar[XB_TOPGEN], 1u);
            else XB_SPIN(xb_ld(&bar[XB_TOPGEN]) == tg, bar);
            __builtin_amdgcn_fence(__ATOMIC_ACQUIRE, "agent");
            xb_add(&bar[XB_XGEN(b.x)], 1u);
            asm volatile("s_waitcnt vmcnt(0)" ::: "memory");
        } else {
            XB_SPIN(xb_ld(&bar[XB_XGEN(b.x)]) == gen, bar);
            __builtin_amdgcn_fence(__ATOMIC_ACQUIRE, "agent");
            asm volatile("s_waitcnt vmcnt(0)" ::: "memory");
        }
    }
    __syncthreads();
}

__global__ void __launch_bounds__(512, 2) mega(Args A) {
    extern __shared__ __attribute__((aligned(16))) unsigned char lds[];
    cg::grid_group grid = cg::this_grid();
    const int lo = A.ph_lo, hi = A.ph_hi, tid = threadIdx.x;
    unsigned char* ws = A.ws;
    int* taskL = (int*)(lds + LDS_MISC);
    if (tid < 2) ((volatile LAS unsigned*)(lds + LDS_MISC + 16))[tid] = 0u;
    __syncthreads();
    XcdBarrier xbar = xcd_barrier_post((unsigned*)(ws + WS_CTL) + CW_BAR, (volatile LAS unsigned*)(lds + LDS_MISC + 16));
#define IN(k) (lo <= (k) && (k) < hi)
#define SEAM(k) do { if (IN(k) && IN((k) + 1)) { if ((k) == 0) grid.sync(); else xcd_barrier(xbar); } } while (0)

#ifndef REPEAT_PH
#define REPEAT_PH -1
#endif
#define REP(k) (REPEAT_PH == (k) ? 2 : 1)
    for (int rep = 0; rep < REP(0); ++rep) { if (IN(0)) phase0(A, lds, rep == 0); if (rep + 1 < REP(0)) grid.sync(); }
    SEAM(0);
    for (int rep = 0; rep < REP(1); ++rep) { if (IN(1)) { pg8::Gemm g{(const bf16_t*)(ws + WS_XN), (const bf16_t*)(ws + WS_WTIN), NTOK, INWP, D}; pg8::StaticOrder S; S.init(NTOK, INWP, gridDim.x, blockIdx.x);
        pg8::EpiU E{(bf16_t*)(ws + WS_U), INWP}; pg8::gemm_phase<pg8::EpiU, pg8::StaticOrder>((PG8_LAS unsigned char*)lds, g, S, E); } if (rep + 1 < REP(1)) grid.sync(); }
    SEAM(1);
    for (int rep = 0; rep < REP(2); ++rep) { if (IN(2)) {
        for (;;) { if (tid == 0) *taskL = atomicAdd((int*)(ws + WS_CTL) + (rep ? CW_Q2B : CW_Q2), 1); __syncthreads(); const int task = *taskL; __syncthreads();
            if (task >= 1408) break;
            if (task < 128) compress_task(A, task, lds); else if (task < 1152) gdn_chunk_task(A, task - 128, lds); else nsa_prep_task(A, task - 1152, lds); } } if (rep + 1 < REP(2)) grid.sync(); }
    SEAM(2);
    for (int rep = 0; rep < REP(3); ++rep) { if (IN(3)) {
        if (blockIdx.x < 64) { gdn_scan_block(A, blockIdx.x, lds); __syncthreads(); }
        { const int bg0 = (int)(xb_xcc_id() & 3u);
          for (int q = 0; q < 4; ++q) { const int bgq = (bg0 + q) & 3;
            for (;;) { if (tid == 0) *taskL = atomicAdd((int*)(ws + WS_CTL) + (rep ? CW_Q3B : CW_Q3) + bgq, 1); __syncthreads(); const int u = *taskL; __syncthreads();
                if (u >= 128) break;
                nsa_unit(A, u * 4 + bgq, lds); } } } } if (rep + 1 < REP(3)) grid.sync(); }
    SEAM(3);
    for (int rep = 0; rep < REP(4); ++rep) { if (IN(4)) phase_finalize(A); if (rep + 1 < REP(4)) grid.sync(); }
    SEAM(4);
    for (int rep = 0; rep < REP(5); ++rep) { if (IN(5)) { pg8::Gemm g{(const bf16_t*)(ws + WS_OCAT), (const bf16_t*)(ws + WS_WTOUT), NTOK, D, D}; pg8::StaticOrder S; S.init(NTOK, D, gridDim.x, blockIdx.x);
        pg8::EpiRes E{A.in[I_X], A.out, D}; pg8::gemm_phase<pg8::EpiRes, pg8::StaticOrder>((PG8_LAS unsigned char*)lds, g, S, E); } if (rep + 1 < REP(5)) grid.sync(); }
    SEAM(5);
    for (int rep = 0; rep < REP(6); ++rep) { if (IN(6)) phase_router(A, lds);
        if (rep + 1 < REP(6)) { grid.sync(); if (blockIdx.x == 0 && tid < 32) ((unsigned*)(ws + WS_CTL))[CW_CNT + 64 * tid] = 0u; grid.sync(); } }
    SEAM(6);
    for (int rep = 0; rep < REP(7); ++rep) { if (IN(7)) phase_gather(A, lds); if (rep + 1 < REP(7)) grid.sync(); }
    SEAM(7);
    for (int rep = 0; rep < REP(8); ++rep) { if (IN(8)) { const int* ctl = (const int*)(ws + WS_CTL); const int nM = ctl[CW_NT];
        pg8::Gemm g{(const bf16_t*)(ws + WS_H2), (const bf16_t*)(ws + WS_EXPGU), 0, 0, D}; pg8::MoeOrder S; S.init(nM, 8, gridDim.x, blockIdx.x, ctl + CW_TILEE);
        pg8::EpiSwiglu E{(bf16_t*)(ws + WS_HID), A.in[I_EBG], A.in[I_EBU]}; pg8::gemm_phase<pg8::EpiSwiglu, pg8::MoeOrder, true>((PG8_LAS unsigned char*)lds, g, S, E, (const int*)(ws + WS_ROWTOK)); } if (rep + 1 < REP(8)) grid.sync(); }
    SEAM(8);
    for (int rep = 0; rep < REP(9); ++rep) { if (IN(9)) { const int* ctl = (const int*)(ws + WS_CTL); const int nM = ctl[CW_NT];
        pg8::Gemm g{(const bf16_t*)(ws + WS_HID), (const bf16_t*)(ws + WS_EXPD), 0, 0, D}; pg8::MoeOrder S; S.init(nM, 4, gridDim.x, blockIdx.x, ctl + CW_TILEE);
        pg8::EpiDown E{(bf16_t*)(ws + WS_XS), A.in[I_EBD], (const float*)(ws + WS_ROWG)}; pg8::gemm_phase<pg8::EpiDown, pg8::MoeOrder>((PG8_LAS unsigned char*)lds, g, S, E); } if (rep + 1 < REP(9)) grid.sync(); }
    SEAM(9);
    if (IN(10)) phase_combine(A);
#undef IN
#undef SEAM
}

constexpr int NPHASE = 11;
#ifndef N_LAUNCHES
#define N_LAUNCHES 1
#endif
extern "C" void kernel_launch(void* const* d_in, const int* in_sizes, int n_in, void* d_out, int out_size, void* d_ws, size_t ws_size, hipStream_t stream) {
    static int grid = 0;
    if (grid == 0) {
        if (n_in != 32 || out_size != NTOK * D || ws_size < WS_END) { fprintf(stderr, "kernel_launch: unexpected shapes (n_in %d out %d ws %zu)\n", n_in, out_size, ws_size); grid = -1; return; }
        int dev = 0, cus = 0, per_cu = 0;
        hipGetDevice(&dev); hipDeviceGetAttribute(&cus, hipDeviceAttributeMultiprocessorCount, dev);
        hipFuncSetAttribute((const void*)mega, hipFuncAttributeMaxDynamicSharedMemorySize, LDS_BYTES);
        hipOccupancyMaxActiveBlocksPerMultiprocessor(&per_cu, (const void*)mega, 512, LDS_BYTES);
        if (per_cu < 1) { fprintf(stderr, "kernel_launch: occupancy query says %d blocks per CU\n", per_cu); per_cu = 1; }
        (void)hipGetLastError();
        grid = cus;
    }
    if (grid < 0) return;
    hipMemsetAsync((char*)d_ws + WS_CTL, 0, CTL_BYTES, stream);
    Args a{};
    for (int i = 0; i < 32; ++i) a.in[i] = (const float*)d_in[i];
    a.out = (float*)d_out; a.ws = (unsigned char*)d_ws;
    if (N_LAUNCHES == 1) { a.ph_lo = 0; a.ph_hi = NPHASE; void* args[] = {&a};
        hipError_t e = hipLaunchCooperativeKernel((const void*)mega, dim3(grid), dim3(512), args, LDS_BYTES, stream);
        if (e != hipSuccess) fprintf(stderr, "cooperative launch failed: %s (grid %d)\n", hipGetErrorString(e), grid); }
    else { for (int p = 0; p < NPHASE; ++p) { a.ph_lo = p; a.ph_hi = p + 1; void* args[] = {&a};
            hipError_t e = hipLaunchCooperativeKernel((const void*)mega, dim3(grid), dim3(512), args, LDS_BYTES, stream);
            if (e != hipSuccess) { fprintf(stderr, "launch %d failed: %s\n", p, hipGetErrorString(e)); break; } } }
}
```

```cpp
#include <hip/hip_runtime.h>
#include <hip/hip_cooperative_groups.h>
#include <cstdio>
#include <cstdint>
namespace cg = cooperative_groups;

#define DI __device__ __forceinline__
#define LAS __attribute__((address_space(3)))
typedef unsigned short bf16_t;
typedef short bf16x8 __attribute__((ext_vector_type(8)));
typedef float f32x4 __attribute__((ext_vector_type(4)));
typedef float f32x16 __attribute__((ext_vector_type(16)));
typedef unsigned u32x4 __attribute__((ext_vector_type(4)));
typedef unsigned u32x2 __attribute__((ext_vector_type(2)));
typedef float f32x2_t __attribute__((ext_vector_type(2)));
typedef __bf16 bf16x2_t __attribute__((ext_vector_type(2)));

constexpr int NB = 2, T = 8192, D = 1024, NTOK = NB * T, INWP = 3584;
constexpr int C_Q = 0, C_KC = 512, C_VC = 640, C_KS = 768, C_VS = 896, C_KW = 1024, C_VW = 1152, C_GATE = 1280,
              C_GQ = 1304, C_GK = 1816, C_GV = 2328, C_GZ = 2840, C_GA = 3352, C_GB = 3356, INW = 3360;
constexpr float EPS = 1e-6f, LOG2E = 1.4426950408889634f;
constexpr int NEXP = 32, MAXROWS = 65536 + NEXP * 256, MAXTILES = MAXROWS / 256;

constexpr size_t MiB = 1u << 20;
constexpr size_t WS_CTL = 0, CTL_BYTES = 64 * 1024;
constexpr size_t WS_WTIN = 1 * MiB, WS_WTOUT = 8 * MiB, WS_WTC1K = 10 * MiB, WS_WTC1V = 11 * MiB;
constexpr size_t WS_MISC = 12 * MiB;
constexpr size_t WS_WTC2K = WS_MISC, WS_WTC2V = WS_MISC + 32 * 1024, WS_RSTD2 = WS_MISC + 64 * 1024, WS_TOKE = WS_MISC + 128 * 1024,
                 WS_TOKG = WS_MISC + 384 * 1024, WS_TOKPOS = WS_MISC + 640 * 1024, WS_DEST = WS_MISC + 896 * 1024,
                 WS_ROWG = WS_MISC + 1152 * 1024, WS_GL = WS_MISC + 1536 * 1024, WS_PB1P = WS_MISC + 1600 * 1024  , WS_GATES = 14 * MiB;
constexpr size_t WS_EXPGU = 16 * MiB, WS_EXPD = 144 * MiB;
constexpr size_t WS_XN = 208 * MiB, WS_ONSA = 208 * MiB, WS_U = 240 * MiB, WS_QN = 352 * MiB, WS_KSN = 368 * MiB, WS_VST = 372 * MiB,
                 WS_KWN = 376 * MiB, WS_VWT = 380 * MiB, WS_KC = 384 * MiB, WS_VCT = 384 * MiB + 512 * 1024;
constexpr size_t WS_WP = 388 * MiB, WS_QGP = 404 * MiB, WS_KDTP = 420 * MiB, WS_QKP = 436 * MiB, WS_UP = 444 * MiB, WS_OG = 460 * MiB, WS_OCAT = 476 * MiB;
constexpr size_t WS_H2 = 208 * MiB  , WS_XS = 208 * MiB  , WS_HID = 352 * MiB, WS_END = 508 * MiB;
constexpr size_t WS_ROWTOK = 14 * MiB  ;
constexpr int CW_Q2 = 0, CW_Q3 = 64, CW_Q2B = 32, CW_Q3B = 96, CW_CNT = 2048  , CW_PB1 = 4096  , CW_NT = 1024, CW_TILEE = 1088  , CW_PSTART = 1536, CW_BAR = 12288;

constexpr int LDS_BYTES = 147456, LDS_MISC = 140 * 1024;

DI unsigned pk2(float lo, float hi) { f32x2_t v = {lo, hi}; bf16x2_t b = __builtin_convertvector(v, bf16x2_t); return __builtin_bit_cast(unsigned, b); }
DI float bflo(unsigned w) { return __uint_as_float(w << 16); }
DI float bfhi(unsigned w) { return __uint_as_float(w & 0xffff0000u); }
DI float bf2f(bf16_t v) { return __uint_as_float((unsigned)v << 16); }
DI bf16_t f2bf(float f) { return (bf16_t)(pk2(f, 0.f) & 0xffffu); }
DI bf16x8 pack8(float a0, float a1, float a2, float a3, float a4, float a5, float a6, float a7) {
    u32x4 w; w.x = pk2(a0, a1); w.y = pk2(a2, a3); w.z = pk2(a4, a5); w.w = pk2(a6, a7); return __builtin_bit_cast(bf16x8, w); }
DI float wave_sum(float v) {
#pragma unroll
    for (int o = 1; o < 64; o <<= 1) v += __shfl_xor(v, o);
    return v; }
DI float sigm(float x) { return __builtin_amdgcn_rcpf(1.f + __builtin_amdgcn_exp2f(-x * LOG2E)); }
DI int otid() { int t = threadIdx.x; asm volatile("" : "+v"(t)); return t; }
DI int crow(int r, int hi) { return (r & 3) + 8 * (r >> 2) + 4 * hi; }
DI int perm16(int p) { return 8 * ((p & 7) >> 2) + 4 * (p >> 3) + (p & 3); }
DI int perm16inv(int k) { return 8 * ((k >> 2) & 1) + 4 * (k >> 3) + (k & 3); }
#define MFMA32(a, b, c) __builtin_amdgcn_mfma_f32_32x32x16_bf16((a), (b), (c), 0, 0, 0)
#define MFMA16(a, b, c) __builtin_amdgcn_mfma_f32_16x16x32_bf16((a), (b), (c), 0, 0, 0)

namespace pg8 {
#define PG8_LAS __attribute__((address_space(3)))
constexpr int BM = 256, BK = 64, HALF = 128, HTB = HALF * BK * 2, STAGE_BYTES = 8 * HTB, NXCD = 8, WGM = 8;
__host__ __device__ __forceinline__ int lds_byte(int r, int c) { const int st = (r >> 4) * 2 + (c >> 5), rr = r & 15, cc = c & 31, ob = rr * 64 + cc * 2; return st * 1024 + (ob ^ (((ob >> 9) & 1) << 5)); }
__host__ __device__ __forceinline__ void stage_rc(int b, int& R, int& C) { const int st = b / 1024, sb = b % 1024, swz = sb ^ (((sb >> 9) & 1) << 5); R = (st >> 1) * 16 + swz / 64; C = (st & 1) * 32 + (swz % 64) / 2; }
__host__ __device__ __forceinline__ int perm32(int rho) { const int n = rho >> 4, i = rho & 15; return 8 * (i >> 2) + 4 * n + (i & 3); }
struct Unit { int pm, pn; };
struct Gemm { const bf16_t* A; const bf16_t* Bt; int M, N, K; };
struct StaticOrder {
    int nM, nN, nwg, G, c;
    __device__ void init(int M, int N, int G_, int c_) { nM = M / BM; nN = N / BM; nwg = nM * nN; G = G_; c = c_; }
    __device__ bool next(int i, Unit& u) const {
        const long L = (long)i * G + c; if (L >= nwg) return false;
        int wgid = (int)L; { const int q = nwg / NXCD, r = nwg % NXCD, xcd = wgid % NXCD, off = wgid / NXCD; wgid = (xcd < r ? xcd * (q + 1) : r * (q + 1) + (xcd - r) * q) + off; }
        const int nig = WGM * nN, gid = wgid / nig, fm = gid * WGM, gsz = (nM - fm) < WGM ? (nM - fm) : WGM;
        u.pm = fm + ((wgid % nig) % gsz); u.pn = (wgid % nig) / gsz; return true;
    }
};
struct MoeOrder {
    StaticOrder S; const int* tile_e;
    __device__ void init(int nM_, int nN_, int G_, int c_, const int* te) { S.nM = nM_; S.nN = nN_; S.nwg = nM_ * nN_; S.G = G_; S.c = c_; tile_e = te; }
    __device__ bool next(int i, Unit& u) const { if (!S.next(i, u)) return false; u.pn = tile_e[u.pm] * S.nN + u.pn; return true; }
};

template <class Epi, class Sched, bool GATHER = false>
__device__ __forceinline__ void gemm_phase(PG8_LAS unsigned char* lds, const Gemm g, const Sched& S, const Epi& E, const int* rowtok = nullptr) {
    const int tid = otid(), wid = __builtin_amdgcn_readfirstlane(tid >> 6), lane = tid & 63, wr = wid >> 2, wc = wid & 3, fr = lane & 15, fq = lane >> 4;
    const int K = g.K, nt = K / BK;
    unsigned voffA[2], voffB[2]; int CA0 = 0;
#pragma unroll
    for (int i = 0; i < 2; ++i) { int R, C; stage_rc(tid * 16 + i * 8192, R, C); const int Rb = Epi::PERM ? ((R & ~31) + perm32(R & 31)) : R; if (i == 0) { CA0 = C; }
        voffA[i] = (unsigned)(R * K + C) * 2u; voffB[i] = (unsigned)(Rb * K + C) * 2u; }
    unsigned tc0 = 0u, tc1 = 0u;
#define PG8_GTOK(t0_, t1_, pm_) do { int _R, _C; stage_rc(otid() * 16, _R, _C); const int* _rt = rowtok + (pm_) * BM + _R; t0_ = (unsigned)_rt[0] | ((unsigned)_rt[64] << 16); t1_ = (unsigned)_rt[HALF] | ((unsigned)_rt[HALF + 64] << 16); } while (0)
    const size_t kstep = (size_t)(BK * 2);
    const size_t hstep = (size_t)HALF * K * 2;
    const size_t tstep = 2 * hstep;
    const unsigned ldsw = (unsigned)wid * 1024u;
    const int aoff = lds_byte(wr * 64 + fr, fq * 8), boff = lds_byte(wc * 32 + fr, fq * 8);
#define PG8_SA(b, h) (((b) * 2 + (h)) * HTB)
#define PG8_SB(b, h) ((4 + (b) * 2 + (h)) * HTB)
#define PG8_STAGE(bufoff, gbase, voff) do { _Pragma("unroll") for (int _i = 0; _i < 2; ++_i) \
        __builtin_amdgcn_global_load_lds((const unsigned*)((const char*)(gbase) + (voff)[_i]), (PG8_LAS unsigned*)(lds + (bufoff) + ldsw + _i * 8192), 16, 0, 0); } while (0)
#define PG8_STAGE_A(bufoff, plainptr, kt, h, nx) do { if constexpr (GATHER) { const char* _b = (const char*)g.A + (size_t)(kt) * kstep; \
        unsigned _t = (h) ? tc1 : tc0; asm volatile("" : "+v"(_t));     \
        unsigned _v[2]; _v[0] = ((_t & 0xffffu) * (unsigned)K + (unsigned)CA0) * 2u; _v[1] = ((_t >> 16) * (unsigned)K + (unsigned)CA0) * 2u; \
        PG8_STAGE(bufoff, _b, _v); } \
        else PG8_STAGE(bufoff, plainptr, voffA); } while (0)
#define PG8_LDA(dst, b, h) do { _Pragma("unroll") for (int m = 0; m < 4; ++m) _Pragma("unroll") for (int k = 0; k < 2; ++k) dst[m][k] = *(const PG8_LAS bf16x8*)(lds + PG8_SA(b, h) + aoff + m * 2048 + k * 1024); } while (0)
#define PG8_LDB(dst, b, h) do { _Pragma("unroll") for (int n = 0; n < 2; ++n) _Pragma("unroll") for (int k = 0; k < 2; ++k) dst[n][k] = *(const PG8_LAS bf16x8*)(lds + PG8_SB(b, h) + boff + n * 2048 + k * 1024); } while (0)
#define PG8_MMA(ai, bj, At, Bt) do { __builtin_amdgcn_s_setprio(1); _Pragma("unroll") for (int m = 0; m < 4; ++m) _Pragma("unroll") for (int n = 0; n < 2; ++n) _Pragma("unroll") for (int k = 0; k < 2; ++k) \
        acc[ai][bj][m][n] = __builtin_amdgcn_mfma_f32_16x16x32_bf16(Bt[n][k], At[m][k], acc[ai][bj][m][n], 0, 0, 0); __builtin_amdgcn_s_setprio(0); } while (0)
#define PG8_WAIT_V(n) asm volatile("s_waitcnt vmcnt(" #n ")" ::: "memory")
#define PG8_WAIT_L(n) asm volatile("s_waitcnt lgkmcnt(" #n ")" ::: "memory")
#define PG8_BAR __builtin_amdgcn_s_barrier()
#define PG8_SCHED __builtin_amdgcn_sched_barrier(0)
    Unit cur, nxt; int ui = 0;
    if (!S.next(0, cur)) return;
    f32x4 acc[2][2][4][2];
#pragma unroll
    for (int a = 0; a < 2; ++a)
#pragma unroll
        for (int b = 0; b < 2; ++b)
#pragma unroll
            for (int m = 0; m < 4; ++m)
#pragma unroll
                for (int n = 0; n < 2; ++n) acc[a][b][m][n] = (f32x4){0.f, 0.f, 0.f, 0.f};
    bf16x8 At[4][2], B0[2][2], B1[2][2];
    const char* cA = (const char*)g.A + (size_t)cur.pm * tstep; const char* cB = (const char*)g.Bt + (size_t)cur.pn * tstep;
    if constexpr (GATHER) { PG8_GTOK(tc0, tc1, cur.pm); }
    PG8_STAGE(PG8_SB(0, 0), cB, voffB); PG8_STAGE(PG8_SB(0, 1), cB + hstep, voffB); PG8_STAGE_A(PG8_SA(0, 0), cA, 0, 0, false); PG8_STAGE_A(PG8_SA(0, 1), cA + hstep, 0, 1, false);
    if (wr == 1) PG8_BAR;
    PG8_WAIT_V(2); PG8_BAR;
    PG8_STAGE(PG8_SB(1, 0), cB + kstep, voffB); PG8_STAGE_A(PG8_SA(1, 0), cA + kstep, 1, 0, false); PG8_STAGE(PG8_SB(1, 1), cB + hstep + kstep, voffB);
    PG8_WAIT_V(6); PG8_BAR;
    for (;;) {
        const bool has_next = S.next(ui + 1, nxt);
        const char* nA = has_next ? (const char*)g.A + (size_t)nxt.pm * tstep : cA; const char* nB = has_next ? (const char*)g.Bt + (size_t)nxt.pn * tstep : cB;
        unsigned tn0 = 0u, tn1 = 0u;
        if constexpr (GATHER) { if (has_next) { PG8_GTOK(tn0, tn1, nxt.pm); } }
        for (int t = 0; t < nt; t += 2) {
            const bool last = (t == nt - 2);
            const char* a1 = cA + (size_t)(t + 1) * kstep;
            const char* a2 = last ? nA : cA + (size_t)(t + 2) * kstep; const char* b2 = last ? nB : cB + (size_t)(t + 2) * kstep;
            const char* a3 = a2 + kstep; const char* b3 = b2 + kstep;
            const int k2 = last ? 0 : t + 2, k3 = k2 + 1;
            PG8_LDB(B0, 0, 0); PG8_LDB(B1, 0, 1); PG8_SCHED; PG8_LDA(At, 0, 0); PG8_STAGE_A(PG8_SA(1, 1), a1 + hstep, t + 1, 1, false);
            if constexpr (GATHER) { if (last && has_next) { tc0 = tn0; tc1 = tn1; } }
            if (GATHER && t == 0) { PG8_WAIT_V(12); } else { PG8_WAIT_V(8); } PG8_WAIT_L(0); PG8_BAR; PG8_MMA(0, 0, At, B0); PG8_MMA(0, 1, At, B1); PG8_BAR; PG8_SCHED;
            PG8_LDA(At, 0, 1); PG8_STAGE(PG8_SB(0, 0), b2, voffB); PG8_STAGE(PG8_SB(0, 1), b2 + hstep, voffB); PG8_STAGE_A(PG8_SA(0, 0), a2, k2, 0, last);
            PG8_WAIT_V(8); PG8_WAIT_L(0); PG8_BAR; PG8_MMA(1, 0, At, B0); PG8_MMA(1, 1, At, B1); PG8_BAR; PG8_SCHED;
            PG8_LDB(B0, 1, 0); PG8_LDB(B1, 1, 1); PG8_SCHED; PG8_LDA(At, 1, 0); PG8_STAGE_A(PG8_SA(0, 1), a2 + hstep, k2, 1, last);
            PG8_WAIT_V(8); PG8_WAIT_L(0); PG8_BAR; PG8_MMA(0, 0, At, B0); PG8_MMA(0, 1, At, B1); PG8_BAR; PG8_SCHED;
            PG8_LDA(At, 1, 1); PG8_STAGE(PG8_SB(1, 0), b3, voffB); PG8_STAGE(PG8_SB(1, 1), b3 + hstep, voffB); PG8_STAGE_A(PG8_SA(1, 0), a3, k3, 0, last);
            PG8_WAIT_V(8); PG8_WAIT_L(0); PG8_BAR; PG8_MMA(1, 0, At, B0); PG8_MMA(1, 1, At, B1); PG8_BAR; PG8_SCHED;
        }
        if (wr == 0) PG8_BAR;
        E(acc, cur, wr, wc, fr, fq);
        if (!has_next) break;
#pragma unroll
        for (int a = 0; a < 2; ++a)
#pragma unroll
            for (int b = 0; b < 2; ++b)
#pragma unroll
                for (int m = 0; m < 4; ++m)
#pragma unroll
                    for (int n = 0; n < 2; ++n) acc[a][b][m][n] = (f32x4){0.f, 0.f, 0.f, 0.f};
        cur = nxt; cA = nA; cB = nB; ++ui;
        if (wr == 1) PG8_BAR;
    }
    PG8_WAIT_V(0);
    PG8_BAR;
#undef PG8_SA
#undef PG8_SB
#undef PG8_STAGE
#undef PG8_STAGE_A
#undef PG8_GTOK
#undef PG8_LDA
#undef PG8_LDB
#undef PG8_MMA
#undef PG8_WAIT_V
#undef PG8_WAIT_L
#undef PG8_BAR
#undef PG8_SCHED
}

struct EpiU {
    static constexpr bool PERM = true;
    bf16_t* O; int ldc;
    __device__ __forceinline__ void operator()(const f32x4 (&acc)[2][2][4][2], const Unit& u, int wr, int wc, int fr, int fq) const {
        const int row0 = u.pm * BM + wr * 64 + fr, col0 = u.pn * BM + wc * 32 + 8 * fq;
#pragma unroll
        for (int ai = 0; ai < 2; ++ai)
#pragma unroll
            for (int m = 0; m < 4; ++m) { bf16_t* rowp = O + (size_t)(row0 + ai * HALF + m * 16) * ldc + col0;
#pragma unroll
                for (int bj = 0; bj < 2; ++bj) { const f32x4 v0 = acc[ai][bj][m][0], v1 = acc[ai][bj][m][1];
                    u32x4 w; w.x = pk2(v0[0], v0[1]); w.y = pk2(v0[2], v0[3]); w.z = pk2(v1[0], v1[1]); w.w = pk2(v1[2], v1[3]);
                    *(u32x4*)(rowp + bj * HALF) = w; } }
    }
};
struct EpiRes {
    static constexpr bool PERM = false;
    const float* base; float* out; int ldc;
    __device__ __forceinline__ void operator()(const f32x4 (&acc)[2][2][4][2], const Unit& u, int wr, int wc, int fr, int fq) const {
        const int col0 = u.pn * BM + wc * 32 + 4 * fq;
#pragma unroll
        for (int ai = 0; ai < 2; ++ai)
#pragma unroll
            for (int m = 0; m < 4; ++m) { const size_t off = (size_t)(u.pm * BM + ai * HALF + wr * 64 + m * 16 + fr) * ldc + col0;
#pragma unroll
                for (int bj = 0; bj < 2; ++bj)
#pragma unroll
                    for (int n = 0; n < 2; ++n) { const f32x4 bs = *(const f32x4*)(base + off + bj * HALF + n * 16); *(f32x4*)(out + off + bj * HALF + n * 16) = bs + acc[ai][bj][m][n]; } }
    }
};
struct EpiSwiglu {
    static constexpr bool PERM = true;
    bf16_t* H; const float* bg; const float* bu;
    __device__ __forceinline__ void operator()(const f32x4 (&acc)[2][2][4][2], const Unit& u, int wr, int wc, int fr, int fq) const {
        const int e = u.pn >> 3, pnl = u.pn & 7, hc0 = pnl * 128 + wc * 32 + 8 * fq, row0 = u.pm * BM + wr * 64 + fr;
        float gb[8], ub[8];
#pragma unroll
        for (int i = 0; i < 8; ++i) { gb[i] = bg[e * 1024 + hc0 + i]; ub[i] = bu[e * 1024 + hc0 + i]; }
#pragma unroll
        for (int ai = 0; ai < 2; ++ai)
#pragma unroll
            for (int m = 0; m < 4; ++m) {
                float o[8];
#pragma unroll
                for (int n = 0; n < 2; ++n)
#pragma unroll
                    for (int i = 0; i < 4; ++i) {
                        const float gg = fminf(acc[ai][0][m][n][i] + gb[4 * n + i], 7.0f);
                        const float uu = fminf(fmaxf(acc[ai][1][m][n][i] + ub[4 * n + i], -7.0f), 7.0f);
                        o[4 * n + i] = (uu + 1.0f) * gg * sigm(gg * 1.702f); }
                u32x4 w; w.x = pk2(o[0], o[1]); w.y = pk2(o[2], o[3]); w.z = pk2(o[4], o[5]); w.w = pk2(o[6], o[7]);
                *(u32x4*)(H + (size_t)(row0 + ai * HALF + m * 16) * 1024 + hc0) = w; }
    }
};
struct EpiDown {
    static constexpr bool PERM = true;
    bf16_t* Y; const float* bd; const float* rowg;
    __device__ __forceinline__ void operator()(const f32x4 (&acc)[2][2][4][2], const Unit& u, int wr, int wc, int fr, int fq) const {
        const int e = u.pn >> 2, pnl = u.pn & 3, col0 = pnl * BM + wc * 32 + 8 * fq, row0 = u.pm * BM + wr * 64 + fr;
        float bv[2][8];
#pragma unroll
        for (int bj = 0; bj < 2; ++bj)
#pragma unroll
            for (int i = 0; i < 8; ++i) bv[bj][i] = bd[e * 1024 + col0 + bj * HALF + i];
#pragma unroll
        for (int ai = 0; ai < 2; ++ai)
#pragma unroll
            for (int m = 0; m < 4; ++m) { const int row = row0 + ai * HALF + m * 16; const float sc = rowg[row];
#pragma unroll
                for (int bj = 0; bj < 2; ++bj) { const f32x4 v0 = acc[ai][bj][m][0], v1 = acc[ai][bj][m][1];
                    u32x4 w; w.x = pk2((v0[0] + bv[bj][0]) * sc, (v0[1] + bv[bj][1]) * sc); w.y = pk2((v0[2] + bv[bj][2]) * sc, (v0[3] + bv[bj][3]) * sc);
                    w.z = pk2((v1[0] + bv[bj][4]) * sc, (v1[1] + bv[bj][5]) * sc); w.w = pk2((v1[2] + bv[bj][6]) * sc, (v1[3] + bv[bj][7]) * sc);
                    *(u32x4*)(Y + (size_t)row * 1024 + col0 + bj * HALF) = w; } }
    }
};
}

struct Args { const float* in[32]; float* out; unsigned char* ws; int ph_lo, ph_hi; };
enum { I_X = 0, I_ANG, I_WIN, I_QG, I_KCG, I_KSG, I_KWG, I_CKPOS, I_CKW1, I_CKB1, I_CKW2, I_CKB2, I_CVPOS, I_CVW1, I_CVB1, I_CVW2, I_CVB2,
       I_NSAOG, I_CONVW, I_ALOG, I_DTB, I_GDNOG, I_WOUT, I_FFNG, I_RW, I_RB, I_EWG, I_EBG, I_EWU, I_EBU, I_EWD, I_EBD };

DI void p0_transpose_item(const float* W, int K, int N, bf16_t* WT, long row_off, float* scr, int item, int lane) {
    const int nblk = N / 32, kb = item / nblk, nb = item % nblk, k0 = 64 * kb, n0 = 32 * nb;
#pragma unroll 8
    for (int i = 0; i < 32; ++i) { const int kk = 2 * i + (lane >> 5); scr[kk * 33 + (lane & 31)] = W[(size_t)(k0 + kk) * N + n0 + (lane & 31)]; }
    __builtin_amdgcn_s_waitcnt(0xC07F); asm volatile("" ::: "memory");
    const int c = lane & 7;
#pragma unroll
    for (int j = 0; j < 4; ++j) { const int n = (lane >> 3) + 8 * j; const float* s = scr + (8 * c) * 33 + n;
        u32x4 o; o.x = pk2(s[0 * 33], s[1 * 33]); o.y = pk2(s[2 * 33], s[3 * 33]); o.z = pk2(s[4 * 33], s[5 * 33]); o.w = pk2(s[6 * 33], s[7 * 33]);
        *(u32x4*)(WT + (size_t)(row_off + n0 + n) * K + k0 + 8 * c) = o; }
    __builtin_amdgcn_s_waitcnt(0xC07F); asm volatile("" ::: "memory");
}

DI void p0_transpose_item64(const float* W, int K, int N, bf16_t* WT, long row_off, float* scr, int kb, int nb, int lane) {
    const int k0 = 64 * kb, n0 = 64 * nb, c4 = (lane & 15) * 4, kr = lane >> 4;
    f32x4 v[16];
#pragma unroll
    for (int i = 0; i < 16; ++i) v[i] = *(const f32x4*)(W + (size_t)(k0 + 4 * i + kr) * N + n0 + c4);
#pragma unroll
    for (int i = 0; i < 16; ++i) { float* d = scr + (4 * i + kr) * 65 + c4; d[0] = v[i][0]; d[1] = v[i][1]; d[2] = v[i][2]; d[3] = v[i][3]; }
    __builtin_amdgcn_s_waitcnt(0xC07F); asm volatile("" ::: "memory");
    const int nn = lane >> 3, cc = lane & 7;
#pragma unroll
    for (int it = 0; it < 8; ++it) { const int n = 8 * it + nn; const float* s = scr + (8 * cc) * 65 + n;
        u32x4 o; o.x = pk2(s[0 * 65], s[1 * 65]); o.y = pk2(s[2 * 65], s[3 * 65]); o.z = pk2(s[4 * 65], s[5 * 65]); o.w = pk2(s[6 * 65], s[7 * 65]);
        *(u32x4*)(WT + (size_t)(row_off + n0 + n) * K + k0 + 8 * cc) = o; }
    __builtin_amdgcn_s_waitcnt(0xC07F); asm volatile("" ::: "memory");
}

DI void phase0(const Args& A, unsigned char* lds, bool first) {
    const int tid = otid(), lane = tid & 63, wave = tid >> 6, G = gridDim.x;
    const int gw = blockIdx.x * 8 + wave, NGW = G * 8;
    float* scr = (float*)(lds + wave * 17408);
    unsigned char* ws = A.ws;
    constexpr int I_IN = 16 * 105, I_OUT = 16 * 32, I_C1 = 32 * 8, I_C2 = 4 * 2, I_EX = 16 * 32;
    constexpr int NIT = I_IN + I_OUT + 2 * I_C2;
    for (int it = gw; it < NIT; it += NGW) {
        int r = it;
        if (r < I_IN) { p0_transpose_item(A.in[I_WIN], 1024, INW, (bf16_t*)(ws + WS_WTIN), 0, scr, r, lane); continue; } r -= I_IN;
        if (r < I_OUT) { p0_transpose_item(A.in[I_WOUT], 1024, 1024, (bf16_t*)(ws + WS_WTOUT), 0, scr, r, lane); continue; } r -= I_OUT;
        if (r < I_C2) { p0_transpose_item(A.in[I_CKW2], 256, 64, (bf16_t*)(ws + WS_WTC2K), 0, scr, r, lane); continue; } r -= I_C2;
        if (r < I_C2) { p0_transpose_item(A.in[I_CVW2], 256, 64, (bf16_t*)(ws + WS_WTC2V), 0, scr, r, lane); continue; }
    }
    for (int id = blockIdx.x * 512 + tid; id < 2 * 65536; id += G * 512) { const int kv = id >> 16, rem = id & 65535, ln = rem & 63, kk = (rem >> 6) & 127, jt = rem >> 13;
        const float* w = A.in[kv ? I_CVW1 : I_CKW1] + (size_t)(16 * kk + 8 * (ln >> 5)) * 256 + 32 * jt + (ln & 31);
        u32x4 o; o.x = pk2(w[0], w[256]); o.y = pk2(w[512], w[768]); o.z = pk2(w[1024], w[1280]); o.w = pk2(w[1536], w[1792]);
        *(u32x4*)((bf16_t*)(ws + (kv ? WS_WTC1V : WS_WTC1K)) + (size_t)rem * 8) = o; }
    { const float* gain = A.in[I_ANG]; f32x4 gv[4];
#pragma unroll
      for (int j = 0; j < 4; ++j) gv[j] = *(const f32x4*)(gain + 4 * lane + 256 * j);
      for (int m = gw; m < NTOK; m += NGW) { const f32x4* xr = (const f32x4*)(A.in[I_X] + (size_t)m * D) + lane; f32x4 v[4]; float s = 0.f;
#pragma unroll
        for (int j = 0; j < 4; ++j) { v[j] = xr[64 * j]; s += v[j].x * v[j].x + v[j].y * v[j].y + v[j].z * v[j].z + v[j].w * v[j].w; }
        const float rs = rsqrtf(wave_sum(s) * (1.f / D) + EPS);
        u32x2* o = (u32x2*)((bf16_t*)(ws + WS_XN) + (size_t)m * D) + lane;
#pragma unroll
        for (int j = 0; j < 4; ++j) { u32x2 w; w.x = pk2(v[j].x * rs * gv[j].x, v[j].y * rs * gv[j].y); w.y = pk2(v[j].z * rs * gv[j].z, v[j].w * rs * gv[j].w); o[64 * j] = w; } } }
    { u32x4* p = (u32x4*)((bf16_t*)(ws + WS_WTIN) + (size_t)INW * 1024); const int n16 = (INWP - INW) * 1024 * 2 / 16;
      for (int i = blockIdx.x * 512 + tid; i < n16; i += G * 512) p[i] = (u32x4){0u, 0u, 0u, 0u}; }
    if (first && tid < 256) { for (int task = blockIdx.x; task < 256; task += G) { const int kv = task >> 7, seg = task & 127, j = tid;
        const float* pos = A.in[kv ? I_CVPOS : I_CKPOS] + seg * 16; const float* w1 = A.in[kv ? I_CVW1 : I_CKW1] + (size_t)seg * 16 * 256 + j; float wv[16];
#pragma unroll
        for (int k = 0; k < 16; ++k) wv[k] = w1[k * 256];
        float s = 0.f;
#pragma unroll
        for (int k = 0; k < 16; ++k) s += pos[k] * wv[k];
        ((float*)(ws + WS_PB1P))[seg * 512 + kv * 256 + j] = s; } }
}

DI void nsa_prep_task(const Args& A, int task, unsigned char* lds) {
    const int tid = otid(), lane = tid & 63, wave = tid >> 6;
    const int b = task >> 7, n = task & 127;
    unsigned char* ws = A.ws; const bf16_t* U = (const bf16_t*)(ws + WS_U);
    bf16_t* vsL = (bf16_t*)lds;
    for (int ti = 0; ti < 8; ++ti) {
        const int tl = wave * 8 + ti, t = n * 64 + tl; const size_t tok = (size_t)b * T + t; const bf16_t* ur = U + tok * INWP;
        { const u32x4 w = *(const u32x4*)(ur + C_Q + 8 * lane); float f[8] = {bflo(w.x), bfhi(w.x), bflo(w.y), bfhi(w.y), bflo(w.z), bfhi(w.z), bflo(w.w), bfhi(w.w)};
          float s = 0.f;
#pragma unroll
          for (int i = 0; i < 8; ++i) s += f[i] * f[i];
          s += __shfl_xor(s, 1); s += __shfl_xor(s, 2); s += __shfl_xor(s, 4);
          const float rs = rsqrtf(s * (1.f / 64.f) + EPS) * (0.125f * LOG2E); const float* gq = A.in[I_QG] + (8 * lane & 63);
          u32x4 o; o.x = pk2(f[0] * rs * gq[0], f[1] * rs * gq[1]); o.y = pk2(f[2] * rs * gq[2], f[3] * rs * gq[3]); o.z = pk2(f[4] * rs * gq[4], f[5] * rs * gq[5]); o.w = pk2(f[6] * rs * gq[6], f[7] * rs * gq[7]);
          *(u32x4*)((bf16_t*)(ws + WS_QN) + tok * 512 + 8 * lane) = o; }
        if (lane < 32) { const int sel = lane >> 4, l16 = lane & 15, g = l16 >> 3, d0 = (l16 & 7) * 8;
          const u32x4 w = *(const u32x4*)(ur + (sel ? C_KW : C_KS) + 8 * l16); float f[8] = {bflo(w.x), bfhi(w.x), bflo(w.y), bfhi(w.y), bflo(w.z), bfhi(w.z), bflo(w.w), bfhi(w.w)};
          float s = 0.f;
#pragma unroll
          for (int i = 0; i < 8; ++i) s += f[i] * f[i];
          s += __shfl_xor(s, 1); s += __shfl_xor(s, 2); s += __shfl_xor(s, 4);
          const float rs = rsqrtf(s * (1.f / 64.f) + EPS); const float* gk = A.in[sel ? I_KWG : I_KSG] + d0;
          u32x4 o; o.x = pk2(f[0] * rs * gk[0], f[1] * rs * gk[1]); o.y = pk2(f[2] * rs * gk[2], f[3] * rs * gk[3]); o.z = pk2(f[4] * rs * gk[4], f[5] * rs * gk[5]); o.w = pk2(f[6] * rs * gk[6], f[7] * rs * gk[7]);
          { const int c = l16 & 7; *(u32x4*)((bf16_t*)(ws + (sel ? WS_KWN : WS_KSN)) + (size_t)(b * 2 + g) * T * 64 + ((size_t)((t >> 5) * 4 + (c >> 1)) * 64 + (c & 1) * 32 + (t & 31)) * 8) = o; } }
        else { const int l32 = lane - 32, sel = l32 >> 4, l16 = l32 & 15, g = l16 >> 3, d0 = (l16 & 7) * 8;
          const u32x4 w = *(const u32x4*)(ur + (sel ? C_VW : C_VS) + 8 * l16);
          const int pos = (tl & ~15) + perm16inv(tl & 15); bf16_t* dst = vsL + ((sel * 2 + g) * 64 + d0) * 64 + pos;
          dst[0 * 64] = (bf16_t)(w.x & 0xffff); dst[1 * 64] = (bf16_t)(w.x >> 16); dst[2 * 64] = (bf16_t)(w.y & 0xffff); dst[3 * 64] = (bf16_t)(w.y >> 16);
          dst[4 * 64] = (bf16_t)(w.z & 0xffff); dst[5 * 64] = (bf16_t)(w.z >> 16); dst[6 * 64] = (bf16_t)(w.w & 0xffff); dst[7 * 64] = (bf16_t)(w.w >> 16); }
        if (lane < 24) ((float*)(ws + WS_GATES))[tok * 24 + lane] = sigm(bf2f(ur[C_GATE + lane]));
    }
    __syncthreads();
    for (int c = tid; c < 2048; c += 512) { const int sel = c >> 10, g = (c >> 9) & 1, rem = c & 511;
        const int r32 = rem & 31, hh = (rem >> 5) & 1, ks = (rem >> 6) & 1, dt = (rem >> 7) & 1, tb = rem >> 8;
        const u32x4 v = *(const u32x4*)(vsL + ((sel * 2 + g) * 64 + 32 * dt + r32) * 64 + 32 * tb + 16 * ks + 8 * hh);
        *(u32x4*)((bf16_t*)(ws + (sel ? WS_VWT : WS_VST)) + ((size_t)(b * 2 + g) * 128 + n) * 4096 + rem * 8) = v; }
    __syncthreads();
}

DI void compress_task(const Args& A, int task, unsigned char* lds) {
    const int tid = otid(), lane = tid & 63, wave = __builtin_amdgcn_readfirstlane(tid >> 6), r32 = lane & 31, hh = lane >> 5;
    const int kv = task >> 6, b = (task >> 5) & 1, g = (task >> 4) & 1, ct = task & 15, c0 = 32 * ct;
    unsigned char* ws = A.ws; const bf16_t* U = (const bf16_t*)(ws + WS_U);
    unsigned char* XU = lds;
    bf16_t* hidL = (bf16_t*)(lds + 67584);
    float* outL = (float*)(lds + 67584 + 16896);
    const int colbase = (kv ? C_VC : C_KC) + g * 64;
    const bf16_t* W1F = (const bf16_t*)(ws + (kv ? WS_WTC1V : WS_WTC1K)) + (size_t)wave * 128 * 512 + lane * 8;
    const bf16_t* W2T = (const bf16_t*)(ws + (kv ? WS_WTC2V : WS_WTC2K));
    {   u32x4 rv[9];
#pragma unroll
        for (int j = 0; j < 9; ++j) { const int id = tid + 512 * j, tk = id >> 3, ch = id & 7; rv[j] = (u32x4){0u, 0u, 0u, 0u};
            if (id < 528 * 8 && 16 * c0 + tk < T) rv[j] = *(const u32x4*)(U + ((size_t)b * T + 16 * c0 + tk) * INWP + colbase + ch * 8); }
#pragma unroll
        for (int j = 0; j < 9; ++j) { const int id = tid + 512 * j, tk = id >> 3, ch = id & 7; if (id < 528 * 8) *(u32x4*)(XU + tk * 128 + ((ch ^ ((tk >> 4) & 7)) * 16)) = rv[j]; } }
    __syncthreads();
    {   f32x16 acc; for (int i = 0; i < 16; ++i) acc[i] = 0.f;
#pragma unroll 8
        for (int kk = 0; kk < 128; ++kk) { const int l = kk >> 2, s = kk & 3, tk = 16 * r32 + l;
            const bf16x8 af = *(const bf16x8*)(XU + tk * 128 + (((2 * s + hh) ^ ((tk >> 4) & 7)) * 16));
            const bf16x8 bf = *(const bf16x8*)(W1F + (size_t)kk * 512);
            acc = MFMA32(af, bf, acc); }
        const int j = 32 * wave + r32; float pb = A.in[kv ? I_CVB1 : I_CKB1][j];
#pragma unroll
        for (int sg = 0; sg < 128; ++sg) pb += ((const float*)(ws + WS_PB1P))[sg * 512 + kv * 256 + j];
#pragma unroll
        for (int r = 0; r < 16; ++r) { const float x = acc[r] + pb; const float y = x * sigm(1.5957691216057308f * (x + 0.044715f * x * x * x)); hidL[crow(r, hh) * 264 + j] = f2bf(y); }
    }
    __syncthreads();
    if (wave < 2) { f32x16 acc; for (int i = 0; i < 16; ++i) acc[i] = 0.f;
#pragma unroll
        for (int s = 0; s < 16; ++s) { const bf16x8 af = *(const bf16x8*)(hidL + r32 * 264 + 16 * s + 8 * hh); const bf16x8 bf = *(const bf16x8*)(W2T + (size_t)(32 * wave + r32) * 256 + 16 * s + 8 * hh); acc = MFMA32(af, bf, acc); }
        const int d = 32 * wave + r32; const float b2 = A.in[kv ? I_CVB2 : I_CKB2][d];
#pragma unroll
        for (int r = 0; r < 16; ++r) outL[crow(r, hh) * 65 + d] = acc[r] + b2; }
    __syncthreads();
    if (kv == 0) { if (tid < 256) { const int cl = tid >> 3, sub = tid & 7; float f[8]; float s = 0.f;
#pragma unroll
            for (int i = 0; i < 8; ++i) { f[i] = outL[cl * 65 + 8 * sub + i]; s += f[i] * f[i]; }
            s += __shfl_xor(s, 1); s += __shfl_xor(s, 2); s += __shfl_xor(s, 4);
            const float rs = (c0 + cl > 510) ? 0.f : rsqrtf(s * (1.f / 64.f) + EPS); const float* gk = A.in[I_KCG] + 8 * sub;
            u32x4 o; o.x = pk2(f[0] * rs * gk[0], f[1] * rs * gk[1]); o.y = pk2(f[2] * rs * gk[2], f[3] * rs * gk[3]); o.z = pk2(f[4] * rs * gk[4], f[5] * rs * gk[5]); o.w = pk2(f[6] * rs * gk[6], f[7] * rs * gk[7]);
            *(u32x4*)((bf16_t*)(ws + WS_KC) + (size_t)(b * 2 + g) * 512 * 64 + ((size_t)(ct * 4 + (sub >> 1)) * 64 + (sub & 1) * 32 + cl) * 8) = o; } }
    else { const int d = tid >> 3, part = tid & 7, p0 = 4 * part, gi = p0 >> 4, cl0 = 16 * gi + perm16(p0 & 15); float f[4];
#pragma unroll
        for (int i = 0; i < 4; ++i) f[i] = (c0 + cl0 + i > 510) ? 0.f : outL[(cl0 + i) * 65 + d];
        u32x2 o; o.x = pk2(f[0], f[1]); o.y = pk2(f[2], f[3]);
        *(u32x2*)((bf16_t*)(ws + WS_VCT) + (size_t)(b * 2 + g) * 64 * 512 + ((size_t)((ct * 2 + (d >> 5)) * 2 + (p0 >> 4)) * 64 + ((p0 >> 3) & 1) * 32 + (d & 31)) * 8 + (p0 & 7)) = o; }
    __syncthreads();
}

DI void gdn_chunk_task(const Args& A, int task, unsigned char* lds) {
    const int tid = otid(), lane = tid & 63, wave = __builtin_amdgcn_readfirstlane(tid >> 6), r32 = lane & 31, hh = lane >> 5;
    const int b = task >> 9, h = (task >> 7) & 3, ch = task & 127, t0 = ch * 64; const size_t tok0 = (size_t)b * T + t0;
    unsigned char* ws = A.ws; const bf16_t* U = (const bf16_t*)(ws + WS_U);
    float* qL = (float*)lds; float* kL = qL + 64 * 132; float* vL = kL + 64 * 132; float* Lm = vL + 64 * 132; float* Qm = Lm + 64 * 68;
    float* gcL = Qm + 64 * 68; float* betaL = gcL + 64; float* egL = betaL + 64; float* kdsL = egL + 64;
    float ga = 0.f, gb = 0.f;
    if (tid < 64) { ga = bf2f(U[(tok0 + tid) * INWP + C_GA + h]); gb = bf2f(U[(tok0 + tid) * INWP + C_GB + h]); }
    {   u32x4 rv[7]; int rt[7], rc[7];
#pragma unroll
        for (int j = 0; j < 7; ++j) { const int id = tid + 512 * j; rt[j] = id / 48; rc[j] = id % 48; rv[j] = (u32x4){0u, 0u, 0u, 0u};
            if (id < 67 * 48 && t0 + rt[j] - 3 >= 0) { const int s = rc[j] >> 4, c8 = (rc[j] & 15) * 8; const int col = (s == 0 ? C_GQ : s == 1 ? C_GK : C_GV) + h * 128 + c8;
                rv[j] = *(const u32x4*)(U + (tok0 + rt[j] - 3) * INWP + col); } }
#pragma unroll
        for (int j = 0; j < 7; ++j) { const int id = tid + 512 * j; if (id < 67 * 48) { const int s = rc[j] >> 4, c8 = (rc[j] & 15) * 8; float* base = (s == 0 ? qL : s == 1 ? kL : vL);
                float* dst = (rt[j] >= 3) ? base + (rt[j] - 3) * 132 + c8 : Lm + (s * 3 + rt[j]) * 132 + c8;
                *(f32x4*)dst = (f32x4){bflo(rv[j].x), bfhi(rv[j].x), bflo(rv[j].y), bfhi(rv[j].y)}; *(f32x4*)(dst + 4) = (f32x4){bflo(rv[j].z), bfhi(rv[j].z), bflo(rv[j].w), bfhi(rv[j].w)}; } } }
    __syncthreads();
    if (tid < 384) { const int s = tid >> 7, c = tid & 127; float* col = (s == 0 ? qL : s == 1 ? kL : vL) + c; const float* halo = Lm + (s * 3) * 132 + c;
        const float* cw = A.in[I_CONVW] + s * 512 + h * 128 + c; const float w0 = cw[0], w1 = cw[1536], w2 = cw[3072], w3 = cw[4608];
        float x0 = col[63 * 132], x1 = col[62 * 132], x2 = col[61 * 132];
#pragma unroll 8
        for (int t = 63; t >= 0; --t) { const float x3 = (t >= 3) ? col[(t - 3) * 132] : halo[t * 132];
            const float y = w0 * x3 + w1 * x2 + w2 * x1 + w3 * x0; col[t * 132] = y * sigm(y); x0 = x1; x1 = x2; x2 = x3; } }
    if (tid < 64) { const int tl = tid;
        const float x = ga + A.in[I_DTB][h]; const float sp = (x > 20.f) ? x : log1pf(__expf(x)); float gt = -__expf(A.in[I_ALOG][h]) * sp;
#pragma unroll
        for (int o = 1; o < 64; o <<= 1) { const float v = __shfl_up(gt, o); if (lane >= o) gt += v; }
        const float g63 = __shfl(gt, 63);
        gcL[tl] = gt; betaL[tl] = sigm(gb); egL[tl] = __expf(gt); kdsL[tl] = __expf(g63 - gt);
        if (tl == 63) ((float*)(ws + WS_GL))[task] = __expf(gt); }
    __syncthreads();
    { const int tl = tid >> 3, sub = tid & 7; float sq = 0.f, sk = 0.f;
#pragma unroll
      for (int i = 0; i < 16; ++i) { const float a = qL[tl * 132 + sub * 16 + i], c = kL[tl * 132 + sub * 16 + i]; sq += a * a; sk += c * c; }
      sq += __shfl_xor(sq, 1); sq += __shfl_xor(sq, 2); sq += __shfl_xor(sq, 4); sk += __shfl_xor(sk, 1); sk += __shfl_xor(sk, 2); sk += __shfl_xor(sk, 4);
      const float rq = rsqrtf(sq + EPS) * 0.08838834764831845f, rk = rsqrtf(sk + EPS);
#pragma unroll
      for (int i = 0; i < 16; ++i) { qL[tl * 132 + sub * 16 + i] *= rq; kL[tl * 132 + sub * 16 + i] *= rk; } }
    __syncthreads();
    { const int mat = wave >> 2, mi = (wave >> 1) & 1, ni = wave & 1; const float* X = mat ? qL : kL;
      f32x16 acc; for (int i = 0; i < 16; ++i) acc[i] = 0.f;
#pragma unroll
      for (int s = 0; s < 8; ++s) { const f32x4 a0 = *(const f32x4*)(X + (32 * mi + r32) * 132 + 16 * s + 8 * hh), a1 = *(const f32x4*)(X + (32 * mi + r32) * 132 + 16 * s + 8 * hh + 4);
          const f32x4 b0 = *(const f32x4*)(kL + (32 * ni + r32) * 132 + 16 * s + 8 * hh), b1 = *(const f32x4*)(kL + (32 * ni + r32) * 132 + 16 * s + 8 * hh + 4);
          acc = MFMA32(pack8(a0[0], a0[1], a0[2], a0[3], a1[0], a1[1], a1[2], a1[3]), pack8(b0[0], b0[1], b0[2], b0[3], b1[0], b1[1], b1[2], b1[3]), acc); }
      const int sc = 32 * ni + r32; const float gs = gcL[sc];
#pragma unroll
      for (int r = 0; r < 16; ++r) { const int c = 32 * mi + crow(r, hh); const float dec = __expf(gcL[c] - gs);
          if (mat == 0) Lm[c * 68 + sc] = (c > sc) ? betaL[c] * acc[r] * dec : 0.f; else Qm[c * 68 + sc] = (c >= sc) ? acc[r] * dec : 0.f; } }
    __syncthreads();
    {   bf16_t* QGp = (bf16_t*)(ws + WS_QGP) + (size_t)task * 8192; bf16_t* KDTp = (bf16_t*)(ws + WS_KDTP) + (size_t)task * 8192; bf16_t* QKp = (bf16_t*)(ws + WS_QKP) + (size_t)task * 4096;
        for (int id = tid; id < 1024; id += 512) { const int c = id >> 4, chn = id & 15, ks = chn >> 2, q = chn & 3; const float e = egL[c];
            const f32x4 a = *(const f32x4*)(qL + c * 132 + 32 * ks + 4 * q), bq = *(const f32x4*)(qL + c * 132 + 32 * ks + 16 + 4 * q);
            *(bf16x8*)(QGp + id * 8) = pack8(a[0] * e, a[1] * e, a[2] * e, a[3] * e, bq[0] * e, bq[1] * e, bq[2] * e, bq[3] * e); }
        for (int id = tid; id < 1024; id += 512) { const int d = id >> 3, chn = id & 7, ks = chn >> 2, q = chn & 3; float f[8];
#pragma unroll
            for (int j = 0; j < 8; ++j) { const int s = 32 * ks + 16 * (j >> 2) + 4 * q + (j & 3); f[j] = kL[s * 132 + d] * kdsL[s]; }
            *(bf16x8*)(KDTp + id * 8) = pack8(f[0], f[1], f[2], f[3], f[4], f[5], f[6], f[7]); }
        { const int id = tid; const int c = id >> 3, chn = id & 7, ks = chn >> 2, q = chn & 3;
            const f32x4 a = *(const f32x4*)(Qm + c * 68 + 32 * ks + 4 * q), bq = *(const f32x4*)(Qm + c * 68 + 32 * ks + 16 + 4 * q);
            *(bf16x8*)(QKp + id * 8) = pack8(a[0], a[1], a[2], a[3], bq[0], bq[1], bq[2], bq[3]); } }
    __syncthreads();
    bf16_t* XT = (bf16_t*)qL;
    float* TK = Qm;
    {
        const int k = lane >> 4, c = lane & 15; float x[16];
#pragma unroll
        for (int i = 0; i < 16; ++i) x[i] = (i == c) ? 1.f : 0.f;
#pragma unroll
        for (int i = 1; i < 16; ++i) {
#pragma unroll
            for (int j4 = 0; j4 < (i + 3) / 4; ++j4) { const f32x4 l4 = *(const f32x4*)(Lm + (16 * k + i) * 68 + 16 * k + 4 * j4);
#pragma unroll
                for (int jj = 0; jj < 4; ++jj) if (4 * j4 + jj < i) x[i] -= l4[jj] * x[4 * j4 + jj]; } }
#pragma unroll
        for (int i = 0; i < 16; ++i) TK[(k * 16 + i) * 16 + c] = x[i];
        asm volatile("s_waitcnt lgkmcnt(0)" ::: "memory");
    }
    {   const int r16 = lane & 15, q4 = lane >> 4; const bf16x8 z8 = pack8(0.f, 0.f, 0.f, 0.f, 0.f, 0.f, 0.f, 0.f);
#pragma unroll 1
        for (int nt2 = 0; nt2 < 2; ++nt2) { const int nt = 2 * wave + nt2; const bool isW = nt >= 8; const float* srcc = (isW ? kL : vL) + ((16 * nt + r16) & 127);
            bf16_t* xcol = XT + (16 * nt + r16) * 64;
#pragma unroll
            for (int bi = 0; bi < 4; ++bi) {
                f32x4 acc = (f32x4){0.f, 0.f, 0.f, 0.f};
#pragma unroll
                for (int ks = 0; ks * 32 < 16 * bi; ++ks) { const int k0 = 32 * ks + 8 * q4; const bool ok = k0 < 16 * bi;
                    const f32x4 l0 = *(const f32x4*)(Lm + (16 * bi + r16) * 68 + k0), l1 = *(const f32x4*)(Lm + (16 * bi + r16) * 68 + k0 + 4);
                    const bf16x8 af = ok ? pack8(l0[0], l0[1], l0[2], l0[3], l1[0], l1[1], l1[2], l1[3]) : z8;
                    const bf16x8 xb = *(const bf16x8*)(xcol + k0); const bf16x8 bf = ok ? xb : z8;
                    acc = MFMA16(af, bf, acc); }
                float d[4];
#pragma unroll
                for (int r = 0; r < 4; ++r) { const int i = 16 * bi + 4 * q4 + r; float v = srcc[i * 132] * betaL[i]; if (isW) v *= egL[i]; d[r] = v - acc[r]; }
                const f32x4 t4 = *(const f32x4*)(TK + (bi * 16 + r16) * 16 + 4 * q4);
                const bf16x8 ta = pack8(t4[0], t4[1], t4[2], t4[3], 0.f, 0.f, 0.f, 0.f), db = pack8(d[0], d[1], d[2], d[3], 0.f, 0.f, 0.f, 0.f);
                const f32x4 xr = MFMA16(ta, db, ((f32x4){0.f, 0.f, 0.f, 0.f}));
                u32x2 o; o.x = pk2(xr[0], xr[1]); o.y = pk2(xr[2], xr[3]);
                *(u32x2*)(xcol + 16 * bi + 4 * q4) = o;
                asm volatile("s_waitcnt lgkmcnt(0)" ::: "memory"); } } }
    __syncthreads();
    { bf16_t* Wp = (bf16_t*)(ws + WS_WP) + (size_t)task * 8192; bf16_t* Up = (bf16_t*)(ws + WS_UP) + (size_t)task * 8192;
      for (int id = tid; id < 1024; id += 512) { const int c = id >> 4, chn = id & 15, ks = chn >> 2, q = chn & 3; unsigned short f[8];
#pragma unroll
          for (int j = 0; j < 8; ++j) { const int d = 32 * ks + 16 * (j >> 2) + 4 * q + (j & 3); f[j] = XT[(128 + d) * 64 + c]; }
          u32x4 o; o.x = f[0] | ((unsigned)f[1] << 16); o.y = f[2] | ((unsigned)f[3] << 16); o.z = f[4] | ((unsigned)f[5] << 16); o.w = f[6] | ((unsigned)f[7] << 16);
          *(u32x4*)(Wp + id * 8) = o; }
      for (int id = tid; id < 2048; id += 512) { const int ln = id & 63, mt = (id >> 6) & 3, es = id >> 8, q = ln >> 4, e = ln & 15; const int c = 16 * mt + 4 * q, col = 16 * es + e;
          *(u32x2*)(Up + id * 4) = *(const u32x2*)(XT + col * 64 + c); } }
    __syncthreads();
}

constexpr int SC_W = 0, SC_QG = 17408, SC_KD = 34816, SC_QK = 53248, SC_UP = 62464, SC_BUF = 64512, SC_OB = 2 * 64512  ,
              SC_SB = SC_OB + 4096  , SC_VB = SC_SB + 8192  ;
#define SC_BAR() do { asm volatile("s_waitcnt lgkmcnt(0)" ::: "memory"); __builtin_amdgcn_s_barrier(); asm volatile("" ::: "memory"); } while (0)
DI void gdn_scan_block(const Args& A, int sidx, unsigned char* lds) {
    const int tid = otid(), lane = tid & 63, wave = __builtin_amdgcn_readfirstlane(tid >> 6);
    const int bh = sidx & 7, es = sidx >> 3, b = bh >> 2, h = bh & 3, r16 = lane & 15, q = lane >> 4;
    unsigned char* ws = A.ws;
    const bf16_t* WP = (const bf16_t*)(ws + WS_WP) + (size_t)bh * 128 * 8192; const bf16_t* QGP = (const bf16_t*)(ws + WS_QGP) + (size_t)bh * 128 * 8192;
    const bf16_t* KDTP = (const bf16_t*)(ws + WS_KDTP) + (size_t)bh * 128 * 8192; const bf16_t* QKP = (const bf16_t*)(ws + WS_QKP) + (size_t)bh * 128 * 4096;
    const bf16_t* UP = (const bf16_t*)(ws + WS_UP) + (size_t)bh * 128 * 8192 + es * 1024;
    u32x4 R0[8], R1[8], R2[8];
    const int dW = (tid >> 4) * 272 + (tid & 15) * 16, dK = (tid >> 3) * 144 + (tid & 7) * 16; const bool upok = tid < 128;
#define SC_SRC(j, i_) ((j) < 2 ? WP + (size_t)(i_) * 8192 + (tid + 512 * (j)) * 8 : (j) < 4 ? QGP + (size_t)(i_) * 8192 + (tid + 512 * ((j) - 2)) * 8 : (j) < 6 ? KDTP + (size_t)(i_) * 8192 + (tid + 512 * ((j) - 4)) * 8 : \
                       (j) < 7 ? QKP + (size_t)(i_) * 4096 + tid * 8 : UP + (size_t)(i_) * 8192 + (upok ? tid : 0) * 8)
#define SC_DST(j) ((j) < 2 ? SC_W + dW + 32 * (j) * 272 : (j) < 4 ? SC_QG + dW + 32 * ((j) - 2) * 272 : (j) < 6 ? SC_KD + dK + 64 * ((j) - 4) * 144 : (j) < 7 ? SC_QK + dK : SC_UP + tid * 16)
#define SC_LOAD(R, i_) do { const int il_ = ((i_) < 128) ? (i_) : 127;     \
        _Pragma("unroll") for (int j = 0; j < 8; ++j) R[j] = *(const __attribute__((address_space(1))) u32x4*)(SC_SRC(j, il_)); } while (0)
#define SC_WRITE(R, bufi_) do { _Pragma("unroll") for (int j = 0; j < 8; ++j) if (j < 7 || upok) *(u32x4*)(lds + (bufi_) * SC_BUF + SC_DST(j)) = R[j]; } while (0)
    bf16_t* OGr = (bf16_t*)(ws + WS_OG) + ((size_t)b * T + lane) * 512 + h * 128 + es * 16;
    const int odump = SC_OB + (((lane >> 4) * 64 + ((lane >> 2) & 3) * 16) * 4 + (lane & 3)) * 2;
#define SC_OFLUSH(i_) do { if (wave == 4 && (i_) >= 0) { const unsigned char* ob = lds + odump + ((i_) & 1) * 2048; unsigned w_[8]; \
        _Pragma("unroll") for (int e2 = 0; e2 < 8; ++e2) w_[e2] = (unsigned)*(const bf16_t*)(ob + (2 * e2) * 8) | ((unsigned)*(const bf16_t*)(ob + (2 * e2 + 1) * 8) << 16); \
        u32x4* dst_ = (u32x4*)(OGr + (size_t)(i_) * 64 * 512); dst_[0] = (u32x4){w_[0], w_[1], w_[2], w_[3]}; dst_[1] = (u32x4){w_[4], w_[5], w_[6], w_[7]}; } } while (0)
    const int w = wave;
    const float* GLp = (const float*)(ws + WS_GL) + bh * 128; const float glA = GLp[lane], glB = GLp[64 + lane];
    f32x4 S0 = (f32x4){0.f, 0.f, 0.f, 0.f}, S1 = S0;
    if (wave < 4) *(u32x4*)(lds + SC_SB + (w * 64 + lane) * 16) = (u32x4){0u, 0u, 0u, 0u};
#define SC_COMPUTE_A(i_) \
        const unsigned char* bufp = lds + ((i_) & 1) * SC_BUF; \
        const unsigned char* wp = bufp + SC_W + (16 * w + r16) * 272 + 16 * q; const unsigned char* qgp = bufp + SC_QG + (16 * w + r16) * 272 + 16 * q; \
        const unsigned char* kdp = bufp + SC_KD + (32 * w + r16) * 144 + 16 * q; const unsigned char* qkp = bufp + SC_QK + (16 * w + r16) * 144 + 16 * q; \
        const float gl = __builtin_bit_cast(float, __builtin_amdgcn_readlane(__builtin_bit_cast(int, ((i_) < 64) ? glA : glB), (i_) & 63)); \
        bf16x8 Sb[4], fw[4], fk[4], fq[4], fqk[2]; \
        _Pragma("unroll") for (int ks = 0; ks < 4; ++ks) Sb[ks] = *(const bf16x8*)(lds + SC_SB + ((i_) & 1) * 4096 + (ks * 64 + lane) * 16); \
        _Pragma("unroll") for (int ks = 0; ks < 4; ++ks) fw[ks] = *(const bf16x8*)(wp + ks * 64); \
        const u32x2 uw = *(const u32x2*)(bufp + SC_UP + (w * 64 + lane) * 8); \
        _Pragma("unroll") for (int t2 = 0; t2 < 2; ++t2) _Pragma("unroll") for (int k2 = 0; k2 < 2; ++k2) fk[t2 * 2 + k2] = *(const bf16x8*)(kdp + t2 * 16 * 144 + k2 * 64); \
        f32x4 t1 = (f32x4){0.f, 0.f, 0.f, 0.f}; \
        _Pragma("unroll") for (int ks = 0; ks < 4; ++ks) t1 = MFMA16(fw[ks], Sb[ks], t1); \
        const f32x4 vn = (f32x4){bflo(uw.x) - t1[0], bfhi(uw.x) - t1[1], bflo(uw.y) - t1[2], bfhi(uw.y) - t1[3]}; \
        { u32x2 o2; o2.x = pk2(vn[0], vn[1]); o2.y = pk2(vn[2], vn[3]); *(u32x2*)(lds + SC_VB + ((w >> 1) * 64 + lane) * 16 + (w & 1) * 8) = o2; } \

#define SC_COMPUTE_B(i_) \
        bf16x8 Vb[2]; \
        _Pragma("unroll") for (int k2 = 0; k2 < 2; ++k2) Vb[k2] = *(const bf16x8*)(lds + SC_VB + (k2 * 64 + lane) * 16); \
        S0 = S0 * gl; S1 = S1 * gl; \
        _Pragma("unroll") for (int k2 = 0; k2 < 2; ++k2) { S0 = MFMA16(fk[k2], Vb[k2], S0); S1 = MFMA16(fk[2 + k2], Vb[k2], S1); } \
        _Pragma("unroll") for (int ks = 0; ks < 4; ++ks) fq[ks] = *(const bf16x8*)(qgp + ks * 64); \
        _Pragma("unroll") for (int k2 = 0; k2 < 2; ++k2) fqk[k2] = *(const bf16x8*)(qkp + k2 * 64); \
        *(bf16x8*)(lds + SC_SB + (((i_) + 1) & 1) * 4096 + (w * 64 + lane) * 16) = pack8(S0[0], S0[1], S0[2], S0[3], S1[0], S1[1], S1[2], S1[3]); \
        bf16x8 So[4]; \
        _Pragma("unroll") for (int ks = 0; ks < 4; ++ks) So[ks] = *(const bf16x8*)(lds + SC_SB + ((i_) & 1) * 4096 + (ks * 64 + lane) * 16); \
        f32x4 oa = (f32x4){0.f, 0.f, 0.f, 0.f}; \
        _Pragma("unroll") for (int ks = 0; ks < 4; ++ks) oa = MFMA16(fq[ks], So[ks], oa); \
        _Pragma("unroll") for (int k2 = 0; k2 < 2; ++k2) oa = MFMA16(fqk[k2], Vb[k2], oa); \
        { u32x2 o2; o2.x = pk2(oa[0], oa[1]); o2.y = pk2(oa[2], oa[3]); *(u32x2*)(lds + SC_OB + ((i_) & 1) * 2048 + (w * 64 + lane) * 8) = o2; }
#define SC_STEP(RN, i_) do { const int i__ = (i_); \
        SC_WRITE(RN, (i__ + 1) & 1);       \
        SC_LOAD(RN, i__ + 4); SC_OFLUSH(i__ - 1); \
        if (wave < 4) { SC_COMPUTE_A(i__) SC_BAR(); SC_COMPUTE_B(i__) SC_BAR(); } else { SC_BAR(); SC_BAR(); } } while (0)
    SC_LOAD(R0, 0); SC_LOAD(R1, 1); SC_LOAD(R2, 2); SC_WRITE(R0, 0); SC_LOAD(R0, 3);
    asm volatile("" ::: "memory");
    SC_BAR();
    for (int i = 0; i < 126; i += 3) { SC_STEP(R1, i); SC_STEP(R2, i + 1); SC_STEP(R0, i + 2); }
    SC_STEP(R1, 126); SC_STEP(R2, 127);
    SC_OFLUSH(127);
#undef SC_LOAD
#undef SC_WRITE
#undef SC_OFLUSH
#undef SC_SRC
#undef SC_DST
#undef SC_COMPUTE_A
#undef SC_COMPUTE_B
#undef SC_STEP
}

DI void tile_load_k(bf16x8 (&kf)[4], const bf16_t* __restrict__ KT, int lane) {
#pragma unroll
    for (int s = 0; s < 4; ++s) kf[s] = *(const bf16x8*)(KT + s * 512 + lane * 8); }
DI void tile_load_v(bf16x8 (&vf)[2][2], const bf16_t* __restrict__ VT, int lane) {
#pragma unroll
    for (int dt = 0; dt < 2; ++dt)
#pragma unroll
        for (int ks = 0; ks < 2; ++ks) vf[dt][ks] = *(const bf16x8*)(VT + (dt * 2 + ks) * 512 + lane * 8); }
DI f32x16 tile_scores(const bf16x8 (&kf)[4], const bf16x8 (&qf)[4], float negM, int hi2, int lo2, float& l) {
    f32x16 st;
#pragma unroll
    for (int i = 0; i < 16; ++i) st[i] = negM;
#pragma unroll
    for (int s = 0; s < 4; ++s) st = MFMA32(kf[s], qf[s], st);
#pragma unroll
    for (int r = 0; r < 16; ++r) { const int cr = (r & 3) + 8 * (r >> 2); float pv = __builtin_amdgcn_exp2f(st[r]); pv = (cr <= hi2 && cr > lo2) ? pv : 0.f; st[r] = pv; l += pv; }
    return st; }
DI void tile_pv(const f32x16& p, const bf16x8 (&vf)[2][2], f32x16 (&o)[2]) {
    const bf16x8 pb0 = pack8(p[0], p[1], p[2], p[3], p[4], p[5], p[6], p[7]), pb1 = pack8(p[8], p[9], p[10], p[11], p[12], p[13], p[14], p[15]);
#pragma unroll
    for (int dt = 0; dt < 2; ++dt) { o[dt] = MFMA32(vf[dt][0], pb0, o[dt]); o[dt] = MFMA32(vf[dt][1], pb1, o[dt]); } }

DI void block_stream(const bf16_t* __restrict__ KB, const bf16_t* __restrict__ VB, int f0, int f1, const bf16x8 (&qf)[4], f32x16 (&o)[2], float& l, float negM, int hi, int lo, int r32, int hh) {
    if (f0 >= f1) return;
    const int lane_ = hh * 32 + r32;
    bf16x8 ka[4], kb[4], va[2][2], vb[2][2];
#define BS_LOAD(kx, vx, f_) do { tile_load_k(kx, KB + (size_t)(f_) * 2048, lane_); tile_load_v(vx, VB + (size_t)(f_) * 2048, lane_); } while (0)
#define BS_COMP(kx, vx, f_) do { const int k0_ = 32 * (f_) + 4 * hh; const f32x16 p_ = tile_scores(kx, qf, negM, hi - k0_, lo - k0_, l); tile_pv(p_, vx, o); } while (0)
    BS_LOAD(ka, va, f0);
#pragma unroll 1
    for (int f = f0; f < f1; f += 2) {
        const bool h1 = f + 1 < f1;
        if (h1) BS_LOAD(kb, vb, f + 1);
        BS_COMP(ka, va, f);
        if (h1) { if (f + 2 < f1) BS_LOAD(ka, va, f + 2); BS_COMP(kb, vb, f + 1); } }
#undef BS_LOAD
#undef BS_COMP
}

DI float maxabs64(const float* g, int lane) { float v = fabsf(g[lane]);
#pragma unroll
    for (int o = 1; o < 64; o <<= 1) v = fmaxf(v, __shfl_xor(v, o));
    return v; }

#define LOADQF(qf) do { _Pragma("unroll") for (int s_ = 0; s_ < 4; ++s_) qf[s_] = *(const bf16x8*)(QL + row * 72 + 16 * s_ + 8 * hh); } while (0)
DI void nsa_unit(const Args& A, int unit, unsigned char* lds) {
    const int tid = otid(), lane = tid & 63, wave = __builtin_amdgcn_readfirstlane(tid >> 6), r32 = lane & 31, hh = lane >> 5;
    const int ti = 127 - (unit >> 2), bg = unit & 3, b = bg >> 1, g = bg & 1;
    unsigned char* ws = A.ws;
    bf16_t* QL = (bf16_t*)lds;
    int* OL = (int*)(lds + 36864);
    int* LL = (int*)(lds + 36864 + 67584);
    unsigned* BM = (unsigned*)(lds + 36864 + 67584 + 1024);
    int* CNT = (int*)(lds + 36864 + 67584 + 2048);
    float* SCL = (float*)(lds + 36864 + 67584 + 2048 + 64);
    float* IMP = (float*)(lds + 108544);
    const int slot = r32 >> 2, hd = r32 & 3, tl = wave * 8 + slot, trow = ti * 64 + tl; const size_t tokg = (size_t)b * T + trow;
    const int row = wave * 32 + r32;
    bf16_t* PA = (bf16_t*)IMP + row * 64;
    const float mq = maxabs64(A.in[I_QG], lane) * 8.08f * LOG2E;
    for (int i = tid; i < 256 + 16; i += 512) BM[i] = 0u;
    { const bf16_t* qp = (const bf16_t*)(ws + WS_QN) + tokg * 512 + (g * 4 + hd) * 64 + 8 * hh;
#pragma unroll
      for (int s = 0; s < 4; ++s) *(bf16x8*)(QL + row * 72 + 16 * s + 8 * hh) = *(const bf16x8*)(qp + 16 * s); }
    const float* gp = (const float*)(ws + WS_GATES) + tokg * 24 + (g * 4 + hd) * 3;
    __syncthreads();
    {   const float negMc = -mq * maxabs64(A.in[I_KCG], lane);
        bf16x8 qf[4]; LOADQF(qf);
        const int cmax_row = (trow >= 31) ? ((trow - 31) >> 4) : -1; const int tmaxw = ti * 64 + wave * 8 + 7; const int ntc = (tmaxw >= 31) ? ((((tmaxw - 31) >> 4) >> 5) + 1) : 0;
        const bf16_t* Kc = (const bf16_t*)(ws + WS_KC) + (size_t)(b * 2 + g) * 512 * 64; const bf16_t* VcT = (const bf16_t*)(ws + WS_VCT) + (size_t)(b * 2 + g) * 64 * 512;
        float lc = 0.f;
        if (ntc > 0) { bf16x8 ka[4], kb[4]; tile_load_k(ka, Kc, lane);
#pragma unroll 1
            for (int ct = 0; ct < ntc; ct += 2) { const bool h1 = ct + 1 < ntc;
                if (h1) tile_load_k(kb, Kc + (ct + 1) * 2048, lane);
                tile_scores(ka, qf, negMc, cmax_row - 32 * ct - 4 * hh, -1000000, lc);
                if (h1) { if (ct + 2 < ntc) tile_load_k(ka, Kc + (ct + 2) * 2048, lane); tile_scores(kb, qf, negMc, cmax_row - 32 * (ct + 1) - 4 * hh, -1000000, lc); } } }
        lc += __shfl_xor(lc, 32);
        const float inv = (lc > 0.f) ? 1.f / lc : 0.f;
        f32x16 oc[2]; for (int i = 0; i < 16; ++i) { oc[0][i] = 0.f; oc[1][i] = 0.f; }
        float carry = 0.f, ldummy = 0.f;
#define CM_POST(p, ct_) do { float recv[4], bq[4]; \
            _Pragma("unroll") for (int jq = 0; jq < 4; ++jq) recv[jq] = __shfl_xor(p[4 * jq + 3], 32); \
            _Pragma("unroll") for (int jq = 0; jq < 4; ++jq) { const float pred = hh ? recv[jq] : (jq ? recv[jq - 1] : carry); float s_ = ((p[4 * jq] + p[4 * jq + 1]) + (p[4 * jq + 2] + p[4 * jq + 3]) + pred) * inv; \
                s_ += __shfl_xor(s_, 1); s_ += __shfl_xor(s_, 2); bq[jq] = s_; } \
            carry = recv[3]; \
            IMP[tl * 128 + 8 * (ct_) + 2 * hd + hh] = (hd == 0) ? bq[0] : (hd == 1) ? bq[1] : (hd == 2) ? bq[2] : bq[3]; } while (0)
        if (ntc > 0) { bf16x8 ka[4], kb[4], va[2][2], vb[2][2]; tile_load_k(ka, Kc, lane); tile_load_v(va, VcT, lane);
#pragma unroll 1
            for (int ct = 0; ct < ntc; ct += 2) { const bool h1 = ct + 1 < ntc;
                if (h1) { tile_load_k(kb, Kc + (ct + 1) * 2048, lane); tile_load_v(vb, VcT + (ct + 1) * 2048, lane); }
                { const f32x16 p = tile_scores(ka, qf, negMc, cmax_row - 32 * ct - 4 * hh, -1000000, ldummy); tile_pv(p, va, oc); CM_POST(p, ct); }
                if (h1) { if (ct + 2 < ntc) { tile_load_k(ka, Kc + (ct + 2) * 2048, lane); tile_load_v(va, VcT + (ct + 2) * 2048, lane); }
                    const f32x16 p = tile_scores(kb, qf, negMc, cmax_row - 32 * (ct + 1) - 4 * hh, -1000000, ldummy); tile_pv(p, vb, oc); CM_POST(p, ct + 1); } } }
#undef CM_POST
        for (int ct = ntc; ct < 16; ++ct) IMP[tl * 128 + 8 * ct + 2 * hd + hh] = 0.f;
        if (ti >= 3) {
            __builtin_amdgcn_s_waitcnt(0xC07F); asm volatile("" ::: "memory");
            unsigned key[16]; const int li = hd + 4 * hh;
#pragma unroll
            for (int i4 = 0; i4 < 4; ++i4) { const f32x4 v4 = *(const f32x4*)(IMP + tl * 128 + li * 16 + 4 * i4);
#pragma unroll
                for (int i = 0; i < 4; ++i) { const int n = li * 16 + 4 * i4 + i; key[4 * i4 + i] = (n >= 1 && n <= ti - 2) ? ((__float_as_uint(fmaxf(v4[i], 0.f)) & ~0xFFu) | (unsigned)(128 - n)) : 0u; } }
#pragma unroll 1
            for (int it = 0; it < 13; ++it) { unsigned m = key[0];
#pragma unroll
                for (int i = 1; i < 16; ++i) m = (key[i] > m) ? key[i] : m;
                { unsigned o_; o_ = __shfl_xor(m, 1); m = o_ > m ? o_ : m; o_ = __shfl_xor(m, 2); m = o_ > m ? o_ : m; o_ = __shfl_xor(m, 32); m = o_ > m ? o_ : m; }
#pragma unroll
                for (int i = 0; i < 16; ++i) key[i] = (key[i] == m) ? 0u : key[i];
                if (m != 0u && hd == 0 && hh == 0) { const int nsel = 128 - (int)(m & 0xFFu); atomicOr(&BM[nsel * 2 + (tl >> 5)], 1u << (tl & 31)); } }
        }
        __builtin_amdgcn_s_waitcnt(0xC07F); asm volatile("" ::: "memory");
        { const float sc = gp[0] * inv;
#pragma unroll
          for (int dt = 0; dt < 2; ++dt)
#pragma unroll
              for (int r4 = 0; r4 < 4; ++r4) { u32x2 o; o.x = pk2(oc[dt][4 * r4] * sc, oc[dt][4 * r4 + 1] * sc); o.y = pk2(oc[dt][4 * r4 + 2] * sc, oc[dt][4 * r4 + 3] * sc);
                  *(u32x2*)(PA + 32 * dt + 8 * r4 + 4 * hh) = o; } }
    }
    const float negMs = -mq * maxabs64(A.in[I_KSG], lane);
    const bf16_t* KS = (const bf16_t*)(ws + WS_KSN) + (size_t)(b * 2 + g) * T * 64; const bf16_t* VS = (const bf16_t*)(ws + WS_VST) + (size_t)(b * 2 + g) * 128 * 4096;
    { bf16x8 qf[4]; LOADQF(qf);
      f32x16 os[2]; float lsel = 0.f; for (int i = 0; i < 16; ++i) { os[0][i] = 0.f; os[1][i] = 0.f; }
      block_stream(KS, VS, (ti >= 1 ? 2 * ti - 2 : 0), 2 * ti + 2, qf, os, lsel, negMs, trow, -1, r32, hh);
      if (ti >= 2) block_stream(KS, VS, 0, 2, qf, os, lsel, negMs, trow, -1, r32, hh);
      lsel += __shfl_xor(lsel, 32);
      const float scl = 1048576.0f / lsel;
#pragma unroll
      for (int dt = 0; dt < 2; ++dt)
#pragma unroll
          for (int r = 0; r < 16; ++r) OL[row * 66 + 32 * dt + crow(r, hh)] = __float2int_rn(os[dt][r] * scl);
      if (hh == 0) { LL[row] = __float2int_rn(lsel * scl); SCL[row] = scl; } }
    { const bf16_t* KW = (const bf16_t*)(ws + WS_KWN) + (size_t)(b * 2 + g) * T * 64; const bf16_t* VW = (const bf16_t*)(ws + WS_VWT) + (size_t)(b * 2 + g) * 128 * 4096;
      const float negMw = -mq * maxabs64(A.in[I_KWG], lane);
      bf16x8 qf[4]; LOADQF(qf);
      f32x16 ow[2]; float lw = 0.f; for (int i = 0; i < 16; ++i) { ow[0][i] = 0.f; ow[1][i] = 0.f; }
      const int tw0 = ti * 64 + wave * 8; const int nlo = (tw0 - 511 > 0) ? ((tw0 - 511) >> 6) : 0;
      block_stream(KW, VW, 2 * nlo, 2 * ti + 2, qf, ow, lw, negMw, trow, trow - 512, r32, hh);
      lw += __shfl_xor(lw, 32); const float sc = gp[2] / lw;
#pragma unroll
      for (int dt = 0; dt < 2; ++dt)
#pragma unroll
          for (int r4 = 0; r4 < 4; ++r4) { bf16_t* pp = PA + 32 * dt + 8 * r4 + 4 * hh; const u32x2 pa = *(const u32x2*)pp;
              u32x2 o; o.x = pk2(bflo(pa.x) + ow[dt][4 * r4] * sc, bfhi(pa.x) + ow[dt][4 * r4 + 1] * sc); o.y = pk2(bflo(pa.y) + ow[dt][4 * r4 + 2] * sc, bfhi(pa.y) + ow[dt][4 * r4 + 3] * sc);
              *(u32x2*)pp = o; } }
    __syncthreads();
    if (ti >= 3) {
        unsigned long long m_cur = 0ull; int n_cur = 0;
        int n_a = 0, n_b = 0; unsigned long long m_a = 0ull, m_b = 0ull;
#define ADVANCE(n_it, m_it, ok) do { ok = true; while (m_cur == 0ull) { int k_ = 0; if (lane == 0) k_ = atomicAdd(CNT, 1); k_ = __builtin_amdgcn_readfirstlane(k_); \
                if (k_ >= ti - 2) { ok = false; break; } n_cur = ti - 2 - k_; \
                m_cur = ((unsigned long long)__builtin_amdgcn_readfirstlane(BM[n_cur * 2 + 1]) << 32) | (unsigned)__builtin_amdgcn_readfirstlane(BM[n_cur * 2]); } \
            if (ok) { n_it = n_cur; m_it = m_cur; for (int i_ = 0; i_ < 8; ++i_) m_cur &= m_cur - 1ull; } } while (0)
        bool have; ADVANCE(n_a, m_a, have);
        bf16x8 ka[2][4], kb[2][4];
        if (have) { tile_load_k(ka[0], KS + (size_t)n_a * 4096, lane); tile_load_k(ka[1], KS + (size_t)n_a * 4096 + 2048, lane); }
        while (have) {
            bool have_b; ADVANCE(n_b, m_b, have_b);
            if (have_b) { tile_load_k(kb[0], KS + (size_t)n_b * 4096, lane); tile_load_k(kb[1], KS + (size_t)n_b * 4096 + 2048, lane); }
            bf16x8 va[2][2][2];
            tile_load_v(va[0], VS + (size_t)n_a * 4096, lane); tile_load_v(va[1], VS + (size_t)n_a * 4096 + 2048, lane);
            unsigned long long mm = m_a; for (int i = 0; i < slot; ++i) mm &= mm - 1ull;
            const bool active = mm != 0ull; const int tt = active ? (__ffsll((long long)mm) - 1) : (__ffsll((long long)m_a) - 1);
            const int grow = tt * 4 + hd;
            bf16x8 qg[4];
#pragma unroll
            for (int s = 0; s < 4; ++s) qg[s] = *(const bf16x8*)(QL + grow * 72 + 16 * s + 8 * hh);
            f32x16 oo[2]; for (int i = 0; i < 16; ++i) { oo[0][i] = 0.f; oo[1][i] = 0.f; }
            float lp = 0.f; const int hi2 = active ? 1000000 : -1000000;
#pragma unroll
            for (int kt = 0; kt < 2; ++kt) { const f32x16 p = tile_scores(ka[kt], qg, negMs, hi2, -1000000, lp); tile_pv(p, va[kt], oo); }
            if (active) { const float scl = SCL[grow];
#pragma unroll
                for (int dt = 0; dt < 2; ++dt)
#pragma unroll
                    for (int r = 0; r < 16; ++r) atomicAdd(&OL[grow * 66 + 32 * dt + crow(r, hh)], __float2int_rn(oo[dt][r] * scl));
                atomicAdd(&LL[grow], __float2int_rn(lp * scl)); }
#pragma unroll
            for (int kt = 0; kt < 2; ++kt)
#pragma unroll
                for (int s = 0; s < 4; ++s) ka[kt][s] = kb[kt][s];
            n_a = n_b; m_a = m_b; have = have_b;
        }
#undef ADVANCE
    }
    __syncthreads();
    { const float sc = gp[1] / (float)LL[row];
      bf16_t* op = (bf16_t*)(ws + WS_ONSA) + tokg * 512 + (g * 4 + hd) * 64;
#pragma unroll
      for (int dt = 0; dt < 2; ++dt)
#pragma unroll
          for (int r4 = 0; r4 < 4; ++r4) { float f[4];
              const u32x2 pa = *(const u32x2*)(PA + 32 * dt + 8 * r4 + 4 * hh); const float pf[4] = {bflo(pa.x), bfhi(pa.x), bflo(pa.y), bfhi(pa.y)};
#pragma unroll
              for (int i = 0; i < 4; ++i) { const int r = 4 * r4 + i; f[i] = pf[i] + (float)OL[row * 66 + 32 * dt + crow(r, hh)] * sc; }
              u32x2 o; o.x = pk2(f[0], f[1]); o.y = pk2(f[2], f[3]);
              *(u32x2*)(op + 32 * dt + 8 * r4 + 4 * hh) = o; } }
    __syncthreads();
}

DI void phase_finalize(const Args& A) {
    const int tid = otid(), lane = tid & 63, wave = tid >> 6; const int gw = blockIdx.x * 8 + wave, NGW = gridDim.x * 8;
    unsigned char* ws = A.ws;
    for (int tok = gw; tok < NTOK; tok += NGW) {
        bf16_t* oc = (bf16_t*)(ws + WS_OCAT) + (size_t)tok * 1024;
        { const u32x4 w = *(const u32x4*)((const bf16_t*)(ws + WS_ONSA) + (size_t)tok * 512 + 8 * lane);
          float f[8] = {bflo(w.x), bfhi(w.x), bflo(w.y), bfhi(w.y), bflo(w.z), bfhi(w.z), bflo(w.w), bfhi(w.w)}; float s = 0.f;
#pragma unroll
          for (int i = 0; i < 8; ++i) s += f[i] * f[i];
          const float rs = rsqrtf(wave_sum(s) * (1.f / 512.f) + EPS); const float* gn = A.in[I_NSAOG] + 8 * lane;
          u32x4 o; o.x = pk2(f[0] * rs * gn[0], f[1] * rs * gn[1]); o.y = pk2(f[2] * rs * gn[2], f[3] * rs * gn[3]); o.z = pk2(f[4] * rs * gn[4], f[5] * rs * gn[5]); o.w = pk2(f[6] * rs * gn[6], f[7] * rs * gn[7]);
          *(u32x4*)(oc + 8 * lane) = o; }
        { const u32x4 w = *(const u32x4*)((const bf16_t*)(ws + WS_OG) + (size_t)tok * 512 + 8 * lane);
          const u32x4 zw = *(const u32x4*)((const bf16_t*)(ws + WS_U) + (size_t)tok * INWP + C_GZ + 8 * lane);
          float f[8] = {bflo(w.x), bfhi(w.x), bflo(w.y), bfhi(w.y), bflo(w.z), bfhi(w.z), bflo(w.w), bfhi(w.w)};
          float z[8] = {bflo(zw.x), bfhi(zw.x), bflo(zw.y), bfhi(zw.y), bflo(zw.z), bfhi(zw.z), bflo(zw.w), bfhi(zw.w)}; float s = 0.f;
#pragma unroll
          for (int i = 0; i < 8; ++i) s += f[i] * f[i];
          s += __shfl_xor(s, 1); s += __shfl_xor(s, 2); s += __shfl_xor(s, 4); s += __shfl_xor(s, 8);
          const float rs = rsqrtf(s * (1.f / 128.f) + EPS); const float* gn = A.in[I_GDNOG] + (8 * lane & 127); float o8[8];
#pragma unroll
          for (int i = 0; i < 8; ++i) o8[i] = f[i] * rs * gn[i] * z[i] * sigm(z[i]);
          u32x4 o; o.x = pk2(o8[0], o8[1]); o.y = pk2(o8[2], o8[3]); o.z = pk2(o8[4], o8[5]); o.w = pk2(o8[6], o8[7]);
          *(u32x4*)(oc + 512 + 8 * lane) = o; }
    }
}

DI void phase_router(const Args& A, unsigned char* lds) {
    const int tid = otid(), lane = tid & 63, wave = __builtin_amdgcn_readfirstlane(tid >> 6);
    unsigned char* ws = A.ws; const float* x1 = A.out; const float* rw = A.in[I_RW]; const float* fg = A.in[I_FFNG];
    float* partL = (float*)lds;
    float* ssL = partL + 8 * 32 * 33;
    unsigned* cntL = (unsigned*)(ssL + 256); unsigned* baseL = cntL + 32;
    const int i32 = lane & 31, kh = lane >> 5;
    for (int task = blockIdx.x; task < NTOK / 32; task += gridDim.x) {
        const int tok = task * 32 + i32; const float* xr = x1 + (size_t)tok * D + 128 * wave;
        f32x16 acc; for (int i = 0; i < 16; ++i) acc[i] = 0.f; float ss = 0.f;
#pragma unroll 8
        for (int kb = 0; kb < 16; ++kb) { const int k0 = 8 * kb + 4 * kh; const f32x4 av = *(const f32x4*)(xr + k0); const f32x4 gv = *(const f32x4*)(fg + 128 * wave + k0);
            ss += av[0] * av[0] + av[1] * av[1] + av[2] * av[2] + av[3] * av[3];
#pragma unroll
            for (int s = 0; s < 4; ++s) acc = __builtin_amdgcn_mfma_f32_32x32x2f32(av[s], rw[(size_t)(128 * wave + k0 + s) * 32 + i32] * gv[s], acc, 0, 0, 0); }
        ss += __shfl_xor(ss, 32);
        if (kh == 0) ssL[wave * 32 + i32] = ss;
#pragma unroll
        for (int r = 0; r < 16; ++r) partL[(wave * 32 + crow(r, kh)) * 33 + i32] = acc[r];
        __syncthreads();
        if (wave == 0 && lane < 32) { float sst = 0.f;
#pragma unroll
            for (int w = 0; w < 8; ++w) sst += ssL[w * 32 + lane];
            const float rstd = rsqrtf(sst * (1.f / D) + EPS); ssL[256 + 64 + lane] = rstd;
            float v[4] = {-3.0e38f, -3.0e38f, -3.0e38f, -3.0e38f}; int id[4] = {0, 0, 0, 0}; const float* rb = A.in[I_RB];
            for (int e = 0; e < 32; ++e) { float lg = 0.f;
#pragma unroll
                for (int w = 0; w < 8; ++w) lg += partL[(w * 32 + lane) * 33 + e];
                const float x = lg * rstd + rb[e];
                if (x > v[3]) { if (x > v[0]) { v[3] = v[2]; id[3] = id[2]; v[2] = v[1]; id[2] = id[1]; v[1] = v[0]; id[1] = id[0]; v[0] = x; id[0] = e; }
                    else if (x > v[1]) { v[3] = v[2]; id[3] = id[2]; v[2] = v[1]; id[2] = id[1]; v[1] = x; id[1] = e; }
                    else if (x > v[2]) { v[3] = v[2]; id[3] = id[2]; v[2] = x; id[2] = e; }
                    else { v[3] = x; id[3] = e; } } }
            const float e0 = 1.f, e1 = __expf(v[1] - v[0]), e2 = __expf(v[2] - v[0]), e3 = __expf(v[3] - v[0]); const float inv = 1.f / (e0 + e1 + e2 + e3);
            const float gt[4] = {e0 * inv, e1 * inv, e2 * inv, e3 * inv};
            cntL[lane] = 0u; asm volatile("s_waitcnt lgkmcnt(0)" ::: "memory");
            unsigned lp[4];
#pragma unroll
            for (int k = 0; k < 4; ++k) lp[k] = atomicAdd(&cntL[id[k]], 1u);
            asm volatile("s_waitcnt lgkmcnt(0)" ::: "memory");
            { const unsigned c = cntL[lane]; baseL[lane] = c ? atomicAdd((unsigned*)(ws + WS_CTL) + CW_CNT + 64 * lane, c) : 0u; }
            asm volatile("s_waitcnt vmcnt(0) lgkmcnt(0)" ::: "memory");
#pragma unroll
            for (int k = 0; k < 4; ++k) { const int pos = (int)(baseL[id[k]] + lp[k]);
                ((int*)(ws + WS_TOKE))[tok * 4 + k] = id[k]; ((float*)(ws + WS_TOKG))[tok * 4 + k] = gt[k]; ((int*)(ws + WS_TOKPOS))[tok * 4 + k] = pos; } }
        __syncthreads();
#pragma unroll
        for (int t4 = 0; t4 < 4; ++t4) { const int tk = task * 32 + 4 * wave + t4; const float rs = ((const volatile float*)ssL)[256 + 64 + 4 * wave + t4];
            const f32x4* xr4 = (const f32x4*)(x1 + (size_t)tk * D) + lane; u32x2* o = (u32x2*)((bf16_t*)(ws + WS_H2) + (size_t)tk * D) + lane;
#pragma unroll
            for (int j = 0; j < 4; ++j) { const f32x4 v = xr4[64 * j]; const f32x4 gv = *(const f32x4*)(fg + 4 * lane + 256 * j);
                u32x2 w; w.x = pk2(v.x * rs * gv.x, v.y * rs * gv.y); w.y = pk2(v.z * rs * gv.z, v.w * rs * gv.w); o[64 * j] = w; } }
        __syncthreads();
    }
}

DI void phase_gather(const Args& A, unsigned char* lds) {
    const int tid = otid(); const int gt = blockIdx.x * 512 + tid, NGT = gridDim.x * 512;
    unsigned char* ws = A.ws; int* psL = (int*)lds;
    if (tid == 0) { const unsigned* cnt = (const unsigned*)(ws + WS_CTL) + CW_CNT; int acc = 0;
        for (int e = 0; e < 32; ++e) { psL[e] = acc; psL[40 + e] = (int)cnt[64 * e]; acc += ((int)cnt[64 * e] + 255) & ~255; }
        psL[32] = acc;
        if (blockIdx.x == 0) { int* ctl = (int*)(ws + WS_CTL); ctl[CW_NT] = acc >> 8; int e = 0;
            for (int r = 0; r < (acc >> 8); ++r) { while (r * 256 >= psL[e + 1]) ++e; ctl[CW_TILEE + r] = e; } } }
    __syncthreads();
    int* rowtok = (int*)(ws + WS_ROWTOK);
    for (int pr = gt; pr < NTOK * 4; pr += NGT) { const int e = ((const int*)(ws + WS_TOKE))[pr], pos = ((const int*)(ws + WS_TOKPOS))[pr]; const int dest = psL[e] + pos;
        ((int*)(ws + WS_DEST))[pr] = dest; ((float*)(ws + WS_ROWG))[dest] = ((const float*)(ws + WS_TOKG))[pr]; rowtok[dest] = pr >> 2; }
    for (int r = gt; r < psL[32]; r += NGT) { int e = 0; while (r >= psL[e + 1]) ++e; if (r >= psL[e] + psL[40 + e]) { rowtok[r] = 0; ((float*)(ws + WS_ROWG))[r] = 0.f; } }
}

DI void phase_combine(const Args& A) {
    const int tid = otid(), lane = tid & 63, wave = tid >> 6; const int gw = blockIdx.x * 8 + wave, NGW = gridDim.x * 8;
    unsigned char* ws = A.ws; const bf16_t* YS = (const bf16_t*)(ws + WS_XS);
    for (int tok = gw; tok < NTOK; tok += NGW) { f32x4* xr = (f32x4*)(A.out + (size_t)tok * D) + lane; f32x4 v[4];
#pragma unroll
        for (int j = 0; j < 4; ++j) v[j] = xr[64 * j];
#pragma unroll
        for (int k = 0; k < 4; ++k) { const int dest = ((const int*)(ws + WS_DEST))[tok * 4 + k]; const u32x2* yr = (const u32x2*)(YS + (size_t)dest * D) + lane;
#pragma unroll
            for (int j = 0; j < 4; ++j) { const u32x2 w = yr[64 * j]; v[j].x += bflo(w.x); v[j].y += bfhi(w.x); v[j].z += bflo(w.y); v[j].w += bfhi(w.y); } }
#pragma unroll
        for (int j = 0; j < 4; ++j) xr[64 * j] = v[j]; }
}


DI void expert_conv_task(const Args& A, int task, unsigned char* lds) {
    const int tid = otid(), lane = tid & 63, wave = tid >> 6; unsigned char* ws = A.ws;
    float* scr = (float*)(lds + wave * 17408);
    const int it = task * 8 + wave; const int mat = it >> 8, item = it & 255, kb = item >> 4, nb = item & 15, e = mat / 3, which = mat % 3;
    if (which == 2) p0_transpose_item64(A.in[I_EWD] + (size_t)e * 1048576, 1024, 1024, (bf16_t*)(ws + WS_EXPD), (long)e * 1024, scr, kb, nb, lane);
    else { const int n0 = 64 * nb; const long dest0 = (long)e * 2048 + (n0 >> 7) * 256 + (n0 & 127) + (which ? 128 : 0);
        p0_transpose_item64(A.in[which ? I_EWU : I_EWG] + (size_t)e * 1048576, 1024, 1024, (bf16_t*)(ws + WS_EXPGU), dest0 - n0, scr, kb, nb, lane); }
}

#define XB_TMO      128
#define XB_XCNT(j)  (256  + 64 * (j))
#define XB_XSUB(j)  (1280 + 64 * (j))
#define XB_XGEN(j)  (2304 + 64 * (j))
#define XB_TOP      3328
#define XB_TOPGEN   3392
#define XCD_BAR_WORDS 3456
#define XB_SPIN_CAP (1u << 22)
DI unsigned xb_ld(unsigned* p)              { return __hip_atomic_load(p, __ATOMIC_RELAXED, __HIP_MEMORY_SCOPE_AGENT); }
DI unsigned xb_add(unsigned* p, unsigned v) { return __hip_atomic_fetch_add(p, v, __ATOMIC_RELAXED, __HIP_MEMORY_SCOPE_AGENT); }
DI unsigned xb_xcc_id() { return (unsigned)__builtin_amdgcn_s_getreg((3 << 11) | 20) & 0xFu; }
#define XB_SPIN(cond, bar) do { unsigned _sp = 0; while (cond) { __builtin_amdgcn_s_sleep(1); \
    if ((++_sp & 255u) == 0u) { if (xb_ld(&(bar)[XB_TMO])) break; if (_sp > XB_SPIN_CAP) { atomicAdd(&(bar)[XB_TMO], 1u); break; } } } } while (0)
struct XcdBarrier { unsigned* bar; unsigned x; volatile LAS unsigned* st; };
DI XcdBarrier xcd_barrier_post(unsigned* bar, volatile LAS unsigned* st) {
    XcdBarrier b; b.bar = bar; b.x = xb_xcc_id(); b.st = st;
    if (threadIdx.x == 0) (void)xb_add(&bar[XB_XCNT(b.x)], 1u);
    return b; }
DI void xcd_barrier_complete(unsigned* bar, unsigned x, unsigned& nloc, unsigned& nx) {
    const unsigned G = gridDim.x * gridDim.y * gridDim.z;
    unsigned sum, cnt, mine, sp = 0u;
    for (;;) {
        sum = 0u; cnt = 0u; mine = 0u;
#pragma unroll
        for (unsigned j = 0; j < 16; ++j) { const unsigned c = xb_ld(&bar[XB_XCNT(j)]); sum += c; cnt += (c > 0u) ? 1u : 0u; mine = (j == x) ? c : mine; }
        if (sum == G) break;
        __builtin_amdgcn_s_sleep(1);
        if ((++sp & 255u) == 0u) { if (xb_ld(&bar[XB_TMO])) break; if (sp > XB_SPIN_CAP) { atomicAdd(&bar[XB_TMO], 1u); break; } }
    }
    nloc = mine > 0u ? mine : 1u; nx = cnt > 0u ? cnt : 1u; }
DI void xcd_barrier(const XcdBarrier& b) {
    asm volatile("s_waitcnt vmcnt(0)" ::: "memory");
    __syncthreads();
    if (threadIdx.x == 0) {
        unsigned* bar = b.bar;
        __builtin_amdgcn_s_waitcnt(0);
        unsigned nloc = b.st[0], nx = b.st[1];
        if (nloc == 0u) { xcd_barrier_complete(bar, b.x, nloc, nx); b.st[0] = nloc; b.st[1] = nx; }
        const unsigned old = xb_add(&bar[XB_XSUB(b.x)], 1u);
        const unsigned gen = old / nloc;
        if (old + 1u == (gen + 1u) * nloc) {
            __builtin_amdgcn_fence(__ATOMIC_RELEASE, "agent");
            asm volatile("s_waitcnt vmcnt(0)" ::: "memory");
            const unsigned og = xb_add(&bar[XB_TOP], 1u);
            const unsigned tg = og / nx;
            if (og + 1u == (tg + 1u) * nx) xb_add(&bar[XB_TOPGEN], 1u);
            else XB_SPIN(xb_ld(&bar[XB_TOPGEN]) == tg, bar);
            __builtin_amdgcn_fence(__ATOMIC_ACQUIRE, "agent");
            xb_add(&bar[XB_XGEN(b.x)], 1u);
            asm volatile("s_waitcnt vmcnt(0)" ::: "memory");
        } else {
            XB_SPIN(xb_ld(&bar[XB_XGEN(b.x)]) == gen, bar);
            __builtin_amdgcn_fence(__ATOMIC_ACQUIRE, "agent");
            asm volatile("s_waitcnt vmcnt(0)" ::: "memory");
        }
    }
    __syncthreads();
}

__global__ void __launch_bounds__(512, 2) mega(Args A) {
    extern __shared__ __attribute__((aligned(16))) unsigned char lds[];
    cg::grid_group grid = cg::this_grid();
    const int lo = A.ph_lo, hi = A.ph_hi, tid = threadIdx.x;
    unsigned char* ws = A.ws;
    int* taskL = (int*)(lds + LDS_MISC);
    if (tid < 2) ((volatile LAS unsigned*)(lds + LDS_MISC + 16))[tid] = 0u;
    __syncthreads();
    XcdBarrier xbar = xcd_barrier_post((unsigned*)(ws + WS_CTL) + CW_BAR, (volatile LAS unsigned*)(lds + LDS_MISC + 16));
#define IN(k) (lo <= (k) && (k) < hi)
#define SEAM(k) do { if (IN(k) && IN((k) + 1)) { if ((k) == 0) grid.sync(); else xcd_barrier(xbar); } } while (0)

#ifndef REPEAT_PH
#define REPEAT_PH -1
#endif
#define REP(k) (REPEAT_PH == (k) ? 2 : 1)
    for (int rep = 0; rep < REP(0); ++rep) { if (IN(0)) phase0(A, lds, rep == 0); if (rep + 1 < REP(0)) grid.sync(); }
    SEAM(0);
    for (int rep = 0; rep < REP(1); ++rep) { if (IN(1)) { pg8::Gemm g{(const bf16_t*)(ws + WS_XN), (const bf16_t*)(ws + WS_WTIN), NTOK, INWP, D}; pg8::StaticOrder S; S.init(NTOK, INWP, gridDim.x, blockIdx.x);
        pg8::EpiU E{(bf16_t*)(ws + WS_U), INWP}; pg8::gemm_phase<pg8::EpiU, pg8::StaticOrder>((PG8_LAS unsigned char*)lds, g, S, E); } if (rep + 1 < REP(1)) grid.sync(); }
    SEAM(1);
    for (int rep = 0; rep < REP(2); ++rep) { if (IN(2)) {
        for (;;) { if (tid == 0) *taskL = atomicAdd((int*)(ws + WS_CTL) + (rep ? CW_Q2B : CW_Q2), 1); __syncthreads(); const int task = *taskL; __syncthreads();
            if (task >= 1408) break;
            if (task < 128) compress_task(A, task, lds); else if (task < 1152) gdn_chunk_task(A, task - 128, lds); else nsa_prep_task(A, task - 1152, lds); } } if (rep + 1 < REP(2)) grid.sync(); }
    SEAM(2);
    for (int rep = 0; rep < REP(3); ++rep) { if (IN(3)) {
        if (blockIdx.x < 64) { gdn_scan_block(A, blockIdx.x, lds); __syncthreads(); }
        { const int bg0 = (int)(xb_xcc_id() & 3u);
          for (int q = 0; q < 4; ++q) { const int bgq = (bg0 + q) & 3;
            for (;;) { if (tid == 0) *taskL = atomicAdd((int*)(ws + WS_CTL) + (rep ? CW_Q3B : CW_Q3) + bgq, 1); __syncthreads(); const int u = *taskL; __syncthreads();
                if (u >= 128) break;
                nsa_unit(A, u * 4 + bgq, lds); } } }
        __syncthreads();
        for (;;) { if (tid == 0) *taskL = atomicAdd((int*)(ws + WS_CTL) + (rep ? CW_Q3B : CW_Q3) + 8, 1); __syncthreads(); const int t = *taskL; __syncthreads();
            if (t >= 3072) break;
            expert_conv_task(A, t, lds); } } if (rep + 1 < REP(3)) grid.sync(); }
    SEAM(3);
    for (int rep = 0; rep < REP(4); ++rep) { if (IN(4)) phase_finalize(A); if (rep + 1 < REP(4)) grid.sync(); }
    SEAM(4);
    for (int rep = 0; rep < REP(5); ++rep) { if (IN(5)) { pg8::Gemm g{(const bf16_t*)(ws + WS_OCAT), (const bf16_t*)(ws + WS_WTOUT), NTOK, D, D}; pg8::StaticOrder S; S.init(NTOK, D, gridDim.x, blockIdx.x);
        pg8::EpiRes E{A.in[I_X], A.out, D}; pg8::gemm_phase<pg8::EpiRes, pg8::StaticOrder>((PG8_LAS unsigned char*)lds, g, S, E); } if (rep + 1 < REP(5)) grid.sync(); }
    SEAM(5);
    for (int rep = 0; rep < REP(6); ++rep) { if (IN(6)) phase_router(A, lds);
        if (rep + 1 < REP(6)) { grid.sync(); if (blockIdx.x == 0 && tid < 32) ((unsigned*)(ws + WS_CTL))[CW_CNT + 64 * tid] = 0u; grid.sync(); } }
    SEAM(6);
    for (int rep = 0; rep < REP(7); ++rep) { if (IN(7)) phase_gather(A, lds); if (rep + 1 < REP(7)) grid.sync(); }
    SEAM(7);
    for (int rep = 0; rep < REP(8); ++rep) { if (IN(8)) { const int* ctl = (const int*)(ws + WS_CTL); const int nM = ctl[CW_NT];
        pg8::Gemm g{(const bf16_t*)(ws + WS_H2), (const bf16_t*)(ws + WS_EXPGU), 0, 0, D}; pg8::MoeOrder S; S.init(nM, 8, gridDim.x, blockIdx.x, ctl + CW_TILEE);
        pg8::EpiSwiglu E{(bf16_t*)(ws + WS_HID), A.in[I_EBG], A.in[I_EBU]}; pg8::gemm_phase<pg8::EpiSwiglu, pg8::MoeOrder, true>((PG8_LAS unsigned char*)lds, g, S, E, (const int*)(ws + WS_ROWTOK)); } if (rep + 1 < REP(8)) grid.sync(); }
    SEAM(8);
    for (int rep = 0; rep < REP(9); ++rep) { if (IN(9)) { const int* ctl = (const int*)(ws + WS_CTL); const int nM = ctl[CW_NT];
        pg8::Gemm g{(const bf16_t*)(ws + WS_HID), (const bf16_t*)(ws + WS_EXPD), 0, 0, D}; pg8::MoeOrder S; S.init(nM, 4, gridDim.x, blockIdx.x, ctl + CW_TILEE);
        pg8::EpiDown E{(bf16_t*)(ws + WS_XS), A.in[I_EBD], (const float*)(ws + WS_ROWG)}; pg8::gemm_phase<pg8::EpiDown, pg8::MoeOrder>((PG8_LAS unsigned char*)lds, g, S, E); } if (rep + 1 < REP(9)) grid.sync(); }
    SEAM(9);
    if (IN(10)) phase_combine(A);
#undef IN
#undef SEAM
}

constexpr int NPHASE = 11;
#ifndef N_LAUNCHES
#define N_LAUNCHES 1
#endif
extern "C" void kernel_launch(void* const* d_in, const int* in_sizes, int n_in, void* d_out, int out_size, void* d_ws, size_t ws_size, hipStream_t stream) {
    static int grid = 0;
    if (grid == 0) {
        if (n_in != 32 || out_size != NTOK * D || ws_size < WS_END) { fprintf(stderr, "kernel_launch: unexpected shapes (n_in %d out %d ws %zu)\n", n_in, out_size, ws_size); grid = -1; return; }
        int dev = 0, cus = 0, per_cu = 0;
        hipGetDevice(&dev); hipDeviceGetAttribute(&cus, hipDeviceAttributeMultiprocessorCount, dev);
        hipFuncSetAttribute((const void*)mega, hipFuncAttributeMaxDynamicSharedMemorySize, LDS_BYTES);
        hipOccupancyMaxActiveBlocksPerMultiprocessor(&per_cu, (const void*)mega, 512, LDS_BYTES);
        if (per_cu < 1) { fprintf(stderr, "kernel_launch: occupancy query says %d blocks per CU\n", per_cu); per_cu = 1; }
        (void)hipGetLastError();
        grid = cus;
    }
    if (grid < 0) return;
    hipMemsetAsync((char*)d_ws + WS_CTL, 0, CTL_BYTES, stream);
    Args a{};
    for (int i = 0; i < 32; ++i) a.in[i] = (const float*)d_in[i];
    a.out = (float*)d_out; a.ws = (unsigned char*)d_ws;
    if (N_LAUNCHES == 1) { a.ph_lo = 0; a.ph_hi = NPHASE; void* args[] = {&a};
        hipError_t e = hipLaunchCooperativeKernel((const void*)mega, dim3(grid), dim3(512), args, LDS_BYTES, stream);
        if (e != hipSuccess) fprintf(stderr, "cooperative launch failed: %s (grid %d)\n", hipGetErrorString(e), grid); }
    else { for (int p = 0; p < NPHASE; ++p) { a.ph_lo = p; a.ph_hi = p + 1; void* args[] = {&a};
            hipError_t e = hipLaunchCooperativeKernel((const void*)mega, dim3(grid), dim3(512), args, LDS_BYTES, stream);
            if (e != hipSuccess) { fprintf(stderr, "launch %d failed: %s\n", p, hipGetErrorString(e)); break; } } }
}
```

```cpp
#include <hip/hip_runtime.h>
#include <hip/hip_cooperative_groups.h>
#include <cstdio>
#include <cstdint>
namespace cg = cooperative_groups;

#define DI __device__ __forceinline__
#define LAS __attribute__((address_space(3)))
typedef unsigned short bf16_t;
typedef short bf16x8 __attribute__((ext_vector_type(8)));
typedef float f32x4 __attribute__((ext_vector_type(4)));
typedef float f32x16 __attribute__((ext_vector_type(16)));
typedef unsigned u32x4 __attribute__((ext_vector_type(4)));
typedef unsigned u32x2 __attribute__((ext_vector_type(2)));
typedef float f32x2_t __attribute__((ext_vector_type(2)));
typedef __bf16 bf16x2_t __attribute__((ext_vector_type(2)));

constexpr int NB = 2, T = 8192, D = 1024, NTOK = NB * T, INWP = 3584;
constexpr int C_Q = 0, C_KC = 512, C_VC = 640, C_KS = 768, C_VS = 896, C_KW = 1024, C_VW = 1152, C_GATE = 1280,
              C_GQ = 1304, C_GK = 1816, C_GV = 2328, C_GZ = 2840, C_GA = 3352, C_GB = 3356, INW = 3360;
constexpr float EPS = 1e-6f, LOG2E = 1.4426950408889634f;
constexpr int NEXP = 32, MAXROWS = 65536 + NEXP * 256, MAXTILES = MAXROWS / 256;

constexpr size_t MiB = 1u << 20;
constexpr size_t WS_CTL = 0, CTL_BYTES = 64 * 1024;
constexpr size_t WS_WTIN = 1 * MiB, WS_WTOUT = 8 * MiB, WS_WTC1K = 10 * MiB, WS_WTC1V = 11 * MiB;
constexpr size_t WS_MISC = 12 * MiB;
constexpr size_t WS_WTC2K = WS_MISC, WS_WTC2V = WS_MISC + 32 * 1024, WS_RSTD2 = WS_MISC + 64 * 1024, WS_TOKE = WS_MISC + 128 * 1024,
                 WS_TOKG = WS_MISC + 384 * 1024, WS_TOKPOS = WS_MISC + 640 * 1024, WS_DEST = WS_MISC + 896 * 1024,
                 WS_ROWG = WS_MISC + 1152 * 1024, WS_GL = WS_MISC + 1536 * 1024, WS_PB1P = WS_MISC + 1600 * 1024  , WS_GATES = 14 * MiB;
constexpr size_t WS_EXPGU = 16 * MiB, WS_EXPD = 144 * MiB;
constexpr size_t WS_XN = 208 * MiB, WS_ONSA = 208 * MiB, WS_U = 240 * MiB, WS_QN = 352 * MiB, WS_KSN = 368 * MiB, WS_VST = 372 * MiB,
                 WS_KWN = 376 * MiB, WS_VWT = 380 * MiB, WS_KC = 384 * MiB, WS_VCT = 384 * MiB + 512 * 1024;
constexpr size_t WS_WP = 388 * MiB, WS_QGP = 404 * MiB, WS_KDTP = 420 * MiB, WS_QKP = 436 * MiB, WS_UP = 444 * MiB, WS_OG = 460 * MiB, WS_OCAT = 476 * MiB;
constexpr size_t WS_H2 = 208 * MiB  , WS_XS = 208 * MiB  , WS_HID = 352 * MiB, WS_END = 508 * MiB;
constexpr size_t WS_ROWTOK = 14 * MiB  ;
constexpr int CW_Q2 = 0, CW_Q3 = 64, CW_Q2B = 32, CW_Q3B = 96, CW_CNT = 2048  , CW_PB1 = 4096  , CW_NT = 1024, CW_TILEE = 1088  , CW_PSTART = 1536, CW_BAR = 12288;

constexpr int LDS_BYTES = 147456, LDS_MISC = 140 * 1024;

DI unsigned pk2(float lo, float hi) { f32x2_t v = {lo, hi}; bf16x2_t b = __builtin_convertvector(v, bf16x2_t); return __builtin_bit_cast(unsigned, b); }
DI float bflo(unsigned w) { return __uint_as_float(w << 16); }
DI float bfhi(unsigned w) { return __uint_as_float(w & 0xffff0000u); }
DI float bf2f(bf16_t v) { return __uint_as_float((unsigned)v << 16); }
DI bf16_t f2bf(float f) { return (bf16_t)(pk2(f, 0.f) & 0xffffu); }
DI bf16x8 pack8(float a0, float a1, float a2, float a3, float a4, float a5, float a6, float a7) {
    u32x4 w; w.x = pk2(a0, a1); w.y = pk2(a2, a3); w.z = pk2(a4, a5); w.w = pk2(a6, a7); return __builtin_bit_cast(bf16x8, w); }
DI float wave_sum(float v) {
#pragma unroll
    for (int o = 1; o < 64; o <<= 1) v += __shfl_xor(v, o);
    return v; }
DI float sigm(float x) { return __builtin_amdgcn_rcpf(1.f + __builtin_amdgcn_exp2f(-x * LOG2E)); }
DI int otid(int wv_) { unsigned z = 0u; asm volatile("" : "+v"(z));
    return wv_ * 64 + (int)__builtin_amdgcn_mbcnt_hi(~0u, __builtin_amdgcn_mbcnt_lo(~0u, z)); }
DI float xor1f(float v) { return __builtin_bit_cast(float, __builtin_amdgcn_update_dpp(0, __builtin_bit_cast(int, v), 0xB1, 0xF, 0xF, true)); }
DI float xor2f(float v) { return __builtin_bit_cast(float, __builtin_amdgcn_update_dpp(0, __builtin_bit_cast(int, v), 0x4E, 0xF, 0xF, true)); }
DI int crow(int r, int hi) { return (r & 3) + 8 * (r >> 2) + 4 * hi; }
DI int perm16(int p) { return 8 * ((p & 7) >> 2) + 4 * (p >> 3) + (p & 3); }
DI int perm16inv(int k) { return 8 * ((k >> 2) & 1) + 4 * (k >> 3) + (k & 3); }
#define MFMA32(a, b, c) __builtin_amdgcn_mfma_f32_32x32x16_bf16((a), (b), (c), 0, 0, 0)
#define MFMA16(a, b, c) __builtin_amdgcn_mfma_f32_16x16x32_bf16((a), (b), (c), 0, 0, 0)

namespace pg8 {
#define PG8_LAS __attribute__((address_space(3)))
constexpr int BM = 256, BK = 64, HALF = 128, HTB = HALF * BK * 2, STAGE_BYTES = 8 * HTB, NXCD = 8, WGM = 8;
__host__ __device__ __forceinline__ int lds_byte(int r, int c) { const int st = (r >> 4) * 2 + (c >> 5), rr = r & 15, cc = c & 31, ob = rr * 64 + cc * 2; return st * 1024 + (ob ^ (((ob >> 9) & 1) << 5)); }
__host__ __device__ __forceinline__ void stage_rc(int b, int& R, int& C) { const int st = b / 1024, sb = b % 1024, swz = sb ^ (((sb >> 9) & 1) << 5); R = (st >> 1) * 16 + swz / 64; C = (st & 1) * 32 + (swz % 64) / 2; }
__host__ __device__ __forceinline__ int perm32(int rho) { const int n = rho >> 4, i = rho & 15; return 8 * (i >> 2) + 4 * n + (i & 3); }
struct Unit { int pm, pn; };
struct Gemm { const bf16_t* A; const bf16_t* Bt; int M, N, K; };
struct StaticOrder {
    int nM, nN, nwg, G, c;
    __device__ void init(int M, int N, int G_, int c_) { nM = M / BM; nN = N / BM; nwg = nM * nN; G = G_; c = c_; }
    __device__ bool next(int i, Unit& u) const {
        const int L = i * G + c; if (L >= nwg) return false;
        int wgid = L; { const int q = nwg / NXCD, r = nwg % NXCD, xcd = wgid % NXCD, off = wgid / NXCD; wgid = (xcd < r ? xcd * (q + 1) : r * (q + 1) + (xcd - r) * q) + off; }
        const int nig = WGM * nN, gid = wgid / nig, fm = gid * WGM, gsz = (nM - fm) < WGM ? (nM - fm) : WGM;
        u.pm = fm + ((wgid % nig) % gsz); u.pn = (wgid % nig) / gsz; return true;
    }
};
struct MoeOrder {
    StaticOrder S; const int* tile_e;
    __device__ void init(int nM_, int nN_, int G_, int c_, const int* te) { S.nM = nM_; S.nN = nN_; S.nwg = nM_ * nN_; S.G = G_; S.c = c_; tile_e = te; }
    __device__ bool next(int i, Unit& u) const { if (!S.next(i, u)) return false; u.pn = __builtin_amdgcn_readfirstlane(tile_e[u.pm]) * S.nN + u.pn; return true; }
};

template <class Epi, class Sched, bool GATHER = false>
__device__ __forceinline__ void gemm_phase(PG8_LAS unsigned char* lds, const Gemm g, const Sched& S, const Epi& E, int wv_, const int* rowtok = nullptr) {
    const int tid = otid(wv_), wid = __builtin_amdgcn_readfirstlane(tid >> 6), lane = tid & 63, wr = wid >> 2, wc = wid & 3, fr = lane & 15, fq = lane >> 4;
    const int K = g.K, nt = K / BK;
    unsigned voffA[2], voffB[2]; int CA0 = 0;
#pragma unroll
    for (int i = 0; i < 2; ++i) { int R, C; stage_rc(tid * 16 + i * 8192, R, C); const int Rb = Epi::PERM ? ((R & ~31) + perm32(R & 31)) : R; if (i == 0) { CA0 = C; }
        voffA[i] = (unsigned)(R * K + C) * 2u; voffB[i] = (unsigned)(Rb * K + C) * 2u; }
    unsigned tc0 = 0u, tc1 = 0u;
#define PG8_GTOK(t0_, t1_, pm_) do { int _R, _C; stage_rc(otid(wv_) * 16, _R, _C); const int* _rt = rowtok + (pm_) * BM + _R; t0_ = (unsigned)_rt[0] | ((unsigned)_rt[64] << 16); t1_ = (unsigned)_rt[HALF] | ((unsigned)_rt[HALF + 64] << 16); } while (0)
    const size_t kstep = (size_t)(BK * 2);
    const size_t hstep = (size_t)HALF * K * 2;
    const size_t tstep = 2 * hstep;
    const unsigned ldsw = (unsigned)wid * 1024u;
    const int aoff = lds_byte(wr * 64 + fr, fq * 8), boff = lds_byte(wc * 32 + fr, fq * 8);
#define PG8_SA(b, h) (((b) * 2 + (h)) * HTB)
#define PG8_SB(b, h) ((4 + (b) * 2 + (h)) * HTB)
#define PG8_STAGE(bufoff, gbase, voff) do { _Pragma("unroll") for (int _i = 0; _i < 2; ++_i) \
        __builtin_amdgcn_global_load_lds((const unsigned*)((const char*)(gbase) + (voff)[_i]), (PG8_LAS unsigned*)(lds + (bufoff) + ldsw + _i * 8192), 16, 0, 0); } while (0)
#define PG8_STAGE_A(bufoff, plainptr, kt, h, nx) do { if constexpr (GATHER) { const char* _b = (const char*)g.A + (size_t)(kt) * kstep; \
        unsigned _t = (h) ? tc1 : tc0; asm volatile("" : "+v"(_t));     \
        unsigned _v[2]; _v[0] = ((_t & 0xffffu) * (unsigned)K + (unsigned)CA0) * 2u; _v[1] = ((_t >> 16) * (unsigned)K + (unsigned)CA0) * 2u; \
        PG8_STAGE(bufoff, _b, _v); } \
        else PG8_STAGE(bufoff, plainptr, voffA); } while (0)
#define PG8_LDA(dst, b, h) do { _Pragma("unroll") for (int m = 0; m < 4; ++m) _Pragma("unroll") for (int k = 0; k < 2; ++k) dst[m][k] = *(const PG8_LAS bf16x8*)(lds + PG8_SA(b, h) + aoff + m * 2048 + k * 1024); } while (0)
#define PG8_LDB(dst, b, h) do { _Pragma("unroll") for (int n = 0; n < 2; ++n) _Pragma("unroll") for (int k = 0; k < 2; ++k) dst[n][k] = *(const PG8_LAS bf16x8*)(lds + PG8_SB(b, h) + boff + n * 2048 + k * 1024); } while (0)
#define PG8_MMA(ai, bj, At, Bt) do { __builtin_amdgcn_s_setprio(1); _Pragma("unroll") for (int m = 0; m < 4; ++m) _Pragma("unroll") for (int n = 0; n < 2; ++n) _Pragma("unroll") for (int k = 0; k < 2; ++k) \
        acc[ai][bj][m][n] = __builtin_amdgcn_mfma_f32_16x16x32_bf16(Bt[n][k], At[m][k], acc[ai][bj][m][n], 0, 0, 0); __builtin_amdgcn_s_setprio(0); } while (0)
#define PG8_WAIT_V(n) asm volatile("s_waitcnt vmcnt(" #n ")" ::: "memory")
#define PG8_WAIT_L(n) asm volatile("s_waitcnt lgkmcnt(" #n ")" ::: "memory")
#define PG8_BAR __builtin_amdgcn_s_barrier()
#define PG8_SCHED __builtin_amdgcn_sched_barrier(0)
    Unit cur, nxt; int ui = 0;
    if (!S.next(0, cur)) return;
    f32x4 acc[2][2][4][2];
#pragma unroll
    for (int a = 0; a < 2; ++a)
#pragma unroll
        for (int b = 0; b < 2; ++b)
#pragma unroll
            for (int m = 0; m < 4; ++m)
#pragma unroll
                for (int n = 0; n < 2; ++n) acc[a][b][m][n] = (f32x4){0.f, 0.f, 0.f, 0.f};
    bf16x8 At[4][2], B0[2][2], B1[2][2];
    const char* cA = (const char*)g.A + (size_t)cur.pm * tstep; const char* cB = (const char*)g.Bt + (size_t)cur.pn * tstep;
    if constexpr (GATHER) { PG8_GTOK(tc0, tc1, cur.pm); }
    PG8_STAGE(PG8_SB(0, 0), cB, voffB); PG8_STAGE(PG8_SB(0, 1), cB + hstep, voffB); PG8_STAGE_A(PG8_SA(0, 0), cA, 0, 0, false); PG8_STAGE_A(PG8_SA(0, 1), cA + hstep, 0, 1, false);
    if (wr == 1) PG8_BAR;
    PG8_WAIT_V(2); PG8_BAR;
    PG8_STAGE(PG8_SB(1, 0), cB + kstep, voffB); PG8_STAGE_A(PG8_SA(1, 0), cA + kstep, 1, 0, false); PG8_STAGE(PG8_SB(1, 1), cB + hstep + kstep, voffB);
    PG8_WAIT_V(6); PG8_BAR;
    for (;;) {
        const bool has_next = S.next(ui + 1, nxt);
        const char* nA = has_next ? (const char*)g.A + (size_t)nxt.pm * tstep : cA; const char* nB = has_next ? (const char*)g.Bt + (size_t)nxt.pn * tstep : cB;
        unsigned tn0 = 0u, tn1 = 0u;
        if constexpr (GATHER) { if (has_next) { PG8_GTOK(tn0, tn1, nxt.pm); } }
        for (int t = 0; t < nt; t += 2) {
            const bool last = (t == nt - 2);
            const char* a1 = cA + (size_t)(t + 1) * kstep;
            const char* a2 = last ? nA : cA + (size_t)(t + 2) * kstep; const char* b2 = last ? nB : cB + (size_t)(t + 2) * kstep;
            const char* a3 = a2 + kstep; const char* b3 = b2 + kstep;
            const int k2 = last ? 0 : t + 2, k3 = k2 + 1;
            PG8_LDB(B0, 0, 0); PG8_LDB(B1, 0, 1); PG8_SCHED; PG8_LDA(At, 0, 0); PG8_STAGE_A(PG8_SA(1, 1), a1 + hstep, t + 1, 1, false);
            if constexpr (GATHER) { if (last && has_next) { tc0 = tn0; tc1 = tn1; } }
            if (GATHER && t == 0) { PG8_WAIT_V(12); } else { PG8_WAIT_V(8); } PG8_WAIT_L(0); PG8_BAR; PG8_MMA(0, 0, At, B0); PG8_MMA(0, 1, At, B1); PG8_BAR; PG8_SCHED;
            PG8_LDA(At, 0, 1); PG8_STAGE(PG8_SB(0, 0), b2, voffB); PG8_STAGE(PG8_SB(0, 1), b2 + hstep, voffB); PG8_STAGE_A(PG8_SA(0, 0), a2, k2, 0, last);
            PG8_WAIT_V(8); PG8_WAIT_L(0); PG8_BAR; PG8_MMA(1, 0, At, B0); PG8_MMA(1, 1, At, B1); PG8_BAR; PG8_SCHED;
            PG8_LDB(B0, 1, 0); PG8_LDB(B1, 1, 1); PG8_SCHED; PG8_LDA(At, 1, 0); PG8_STAGE_A(PG8_SA(0, 1), a2 + hstep, k2, 1, last);
            PG8_WAIT_V(8); PG8_WAIT_L(0); PG8_BAR; PG8_MMA(0, 0, At, B0); PG8_MMA(0, 1, At, B1); PG8_BAR; PG8_SCHED;
            PG8_LDA(At, 1, 1); PG8_STAGE(PG8_SB(1, 0), b3, voffB); PG8_STAGE(PG8_SB(1, 1), b3 + hstep, voffB); PG8_STAGE_A(PG8_SA(1, 0), a3, k3, 0, last);
            PG8_WAIT_V(8); PG8_WAIT_L(0); PG8_BAR; PG8_MMA(1, 0, At, B0); PG8_MMA(1, 1, At, B1); PG8_BAR; PG8_SCHED;
        }
        if (wr == 0) PG8_BAR;
        E(acc, cur, wr, wc, fr, fq);
        if (!has_next) break;
#pragma unroll
        for (int a = 0; a < 2; ++a)
#pragma unroll
            for (int b = 0; b < 2; ++b)
#pragma unroll
                for (int m = 0; m < 4; ++m)
#pragma unroll
                    for (int n = 0; n < 2; ++n) acc[a][b][m][n] = (f32x4){0.f, 0.f, 0.f, 0.f};
        cur = nxt; cA = nA; cB = nB; ++ui;
        if (wr == 1) PG8_BAR;
    }
    PG8_WAIT_V(0);
    PG8_BAR;
#undef PG8_SA
#undef PG8_SB
#undef PG8_STAGE
#undef PG8_STAGE_A
#undef PG8_GTOK
#undef PG8_LDA
#undef PG8_LDB
#undef PG8_MMA
#undef PG8_WAIT_V
#undef PG8_WAIT_L
#undef PG8_BAR
#undef PG8_SCHED
}

struct EpiU {
    static constexpr bool PERM = true;
    bf16_t* O; int ldc;
    __device__ __forceinline__ void operator()(const f32x4 (&acc)[2][2][4][2], const Unit& u, int wr, int wc, int fr, int fq) const {
        const int row0 = u.pm * BM + wr * 64 + fr, col0 = u.pn * BM + wc * 32 + 8 * fq;
#pragma unroll
        for (int ai = 0; ai < 2; ++ai)
#pragma unroll
            for (int m = 0; m < 4; ++m) { bf16_t* rowp = O + (size_t)(row0 + ai * HALF + m * 16) * ldc + col0;
#pragma unroll
                for (int bj = 0; bj < 2; ++bj) { const f32x4 v0 = acc[ai][bj][m][0], v1 = acc[ai][bj][m][1];
                    u32x4 w; w.x = pk2(v0[0], v0[1]); w.y = pk2(v0[2], v0[3]); w.z = pk2(v1[0], v1[1]); w.w = pk2(v1[2], v1[3]);
                    *(u32x4*)(rowp + bj * HALF) = w; } }
    }
};
struct EpiRes {
    static constexpr bool PERM = false;
    const float* base; float* out; int ldc;
    __device__ __forceinline__ void operator()(const f32x4 (&acc)[2][2][4][2], const Unit& u, int wr, int wc, int fr, int fq) const {
        const int col0 = u.pn * BM + wc * 32 + 4 * fq;
#pragma unroll
        for (int ai = 0; ai < 2; ++ai)
#pragma unroll
            for (int m = 0; m < 4; ++m) { const size_t off = (size_t)(u.pm * BM + ai * HALF + wr * 64 + m * 16 + fr) * ldc + col0;
#pragma unroll
                for (int bj = 0; bj < 2; ++bj)
#pragma unroll
                    for (int n = 0; n < 2; ++n) { const f32x4 bs = *(const f32x4*)(base + off + bj * HALF + n * 16); *(f32x4*)(out + off + bj * HALF + n * 16) = bs + acc[ai][bj][m][n]; } }
    }
};
struct EpiSwiglu {
    static constexpr bool PERM = true;
    bf16_t* H; const float* bg; const float* bu;
    __device__ __forceinline__ void operator()(const f32x4 (&acc)[2][2][4][2], const Unit& u, int wr, int wc, int fr, int fq) const {
        const int e = u.pn >> 3, pnl = u.pn & 7, hc0 = pnl * 128 + wc * 32 + 8 * fq, row0 = u.pm * BM + wr * 64 + fr;
        float gb[8], ub[8];
#pragma unroll
        for (int i = 0; i < 8; ++i) { gb[i] = bg[e * 1024 + hc0 + i]; ub[i] = bu[e * 1024 + hc0 + i]; }
#pragma unroll
        for (int ai = 0; ai < 2; ++ai)
#pragma unroll
            for (int m = 0; m < 4; ++m) {
                float o[8];
#pragma unroll
                for (int n = 0; n < 2; ++n)
#pragma unroll
                    for (int i = 0; i < 4; ++i) {
                        const float gg = fminf(acc[ai][0][m][n][i] + gb[4 * n + i], 7.0f);
                        const float uu = fminf(fmaxf(acc[ai][1][m][n][i] + ub[4 * n + i], -7.0f), 7.0f);
                        o[4 * n + i] = (uu + 1.0f) * gg * sigm(gg * 1.702f); }
                u32x4 w; w.x = pk2(o[0], o[1]); w.y = pk2(o[2], o[3]); w.z = pk2(o[4], o[5]); w.w = pk2(o[6], o[7]);
                *(u32x4*)(H + (size_t)(row0 + ai * HALF + m * 16) * 1024 + hc0) = w; }
    }
};
struct EpiDown {
    static constexpr bool PERM = true;
    bf16_t* Y; const float* bd; const float* rowg;
    __device__ __forceinline__ void operator()(const f32x4 (&acc)[2][2][4][2], const Unit& u, int wr, int wc, int fr, int fq) const {
        const int e = u.pn >> 2, pnl = u.pn & 3, col0 = pnl * BM + wc * 32 + 8 * fq, row0 = u.pm * BM + wr * 64 + fr;
        float bv[2][8];
#pragma unroll
        for (int bj = 0; bj < 2; ++bj)
#pragma unroll
            for (int i = 0; i < 8; ++i) bv[bj][i] = bd[e * 1024 + col0 + bj * HALF + i];
#pragma unroll
        for (int ai = 0; ai < 2; ++ai)
#pragma unroll
            for (int m = 0; m < 4; ++m) { const int row = row0 + ai * HALF + m * 16; const float sc = rowg[row];
#pragma unroll
                for (int bj = 0; bj < 2; ++bj) { const f32x4 v0 = acc[ai][bj][m][0], v1 = acc[ai][bj][m][1];
                    u32x4 w; w.x = pk2((v0[0] + bv[bj][0]) * sc, (v0[1] + bv[bj][1]) * sc); w.y = pk2((v0[2] + bv[bj][2]) * sc, (v0[3] + bv[bj][3]) * sc);
                    w.z = pk2((v1[0] + bv[bj][4]) * sc, (v1[1] + bv[bj][5]) * sc); w.w = pk2((v1[2] + bv[bj][6]) * sc, (v1[3] + bv[bj][7]) * sc);
                    *(u32x4*)(Y + (size_t)row * 1024 + col0 + bj * HALF) = w; } }
    }
};
}

struct Args { const float* in[32]; float* out; unsigned char* ws; int ph_lo, ph_hi; };
enum { I_X = 0, I_ANG, I_WIN, I_QG, I_KCG, I_KSG, I_KWG, I_CKPOS, I_CKW1, I_CKB1, I_CKW2, I_CKB2, I_CVPOS, I_CVW1, I_CVB1, I_CVW2, I_CVB2,
       I_NSAOG, I_CONVW, I_ALOG, I_DTB, I_GDNOG, I_WOUT, I_FFNG, I_RW, I_RB, I_EWG, I_EBG, I_EWU, I_EBU, I_EWD, I_EBD };

DI void p0_transpose_item(const float* W, int K, int N, bf16_t* WT, long row_off, float* scr, int item, int lane) {
    const int nblk = N / 32, kb = item / nblk, nb = item % nblk, k0 = 64 * kb, n0 = 32 * nb;
#pragma unroll 8
    for (int i = 0; i < 32; ++i) { const int kk = 2 * i + (lane >> 5); scr[kk * 33 + (lane & 31)] = W[(size_t)(k0 + kk) * N + n0 + (lane & 31)]; }
    __builtin_amdgcn_s_waitcnt(0xC07F); asm volatile("" ::: "memory");
    const int c = lane & 7;
#pragma unroll
    for (int j = 0; j < 4; ++j) { const int n = (lane >> 3) + 8 * j; const float* s = scr + (8 * c) * 33 + n;
        u32x4 o; o.x = pk2(s[0 * 33], s[1 * 33]); o.y = pk2(s[2 * 33], s[3 * 33]); o.z = pk2(s[4 * 33], s[5 * 33]); o.w = pk2(s[6 * 33], s[7 * 33]);
        *(u32x4*)(WT + (size_t)(row_off + n0 + n) * K + k0 + 8 * c) = o; }
    __builtin_amdgcn_s_waitcnt(0xC07F); asm volatile("" ::: "memory");
}

DI void p0_item64_load(f32x4 (&v)[16], const float* W, int N, int kb, int nb, int lane) {
    const int k0 = 64 * kb, n0 = 64 * nb, c4 = (lane & 15) * 4, kr = lane >> 4;
#pragma unroll
    for (int i = 0; i < 16; ++i) v[i] = *(const __attribute__((address_space(1))) f32x4*)(W + (size_t)(k0 + 4 * i + kr) * N + n0 + c4); }
DI void p0_item64_finish(const f32x4 (&v)[16], int K, bf16_t* WT, long row_off, float* scr, int kb, int nb, int lane) {
    const int k0 = 64 * kb, n0 = 64 * nb, c4 = (lane & 15) * 4, kr = lane >> 4;
#pragma unroll
    for (int i = 0; i < 16; ++i) { float* d = scr + (4 * i + kr) * 65 + c4; d[0] = v[i][0]; d[1] = v[i][1]; d[2] = v[i][2]; d[3] = v[i][3]; }
    __builtin_amdgcn_s_waitcnt(0xC07F); asm volatile("" ::: "memory");
    const int nn = lane >> 3, cc = lane & 7;
#pragma unroll
    for (int it = 0; it < 8; ++it) { const int n = 8 * it + nn; const float* s = scr + (8 * cc) * 65 + n;
        u32x4 o; o.x = pk2(s[0 * 65], s[1 * 65]); o.y = pk2(s[2 * 65], s[3 * 65]); o.z = pk2(s[4 * 65], s[5 * 65]); o.w = pk2(s[6 * 65], s[7 * 65]);
        *(u32x4*)(WT + (size_t)(row_off + n0 + n) * K + k0 + 8 * cc) = o; }
    __builtin_amdgcn_s_waitcnt(0xC07F); asm volatile("" ::: "memory");
}

DI void phase0(const Args& A, unsigned char* lds, bool first, int wv_) {
    const int tid = otid(wv_), lane = tid & 63, wave = tid >> 6, G = gridDim.x;
    const int gw = blockIdx.x * 8 + wave, NGW = G * 8;
    float* scr = (float*)(lds + wave * 17408);
    unsigned char* ws = A.ws;
    constexpr int I_IN = 16 * 105, I_OUT = 16 * 32, I_C1 = 32 * 8, I_C2 = 4 * 2, I_EX = 16 * 32;
    constexpr int NIT = I_IN + I_OUT + 2 * I_C2;
    for (int it = gw; it < NIT; it += NGW) {
        int r = it;
        if (r < I_IN) { p0_transpose_item(A.in[I_WIN], 1024, INW, (bf16_t*)(ws + WS_WTIN), 0, scr, r, lane); continue; } r -= I_IN;
        if (r < I_OUT) { p0_transpose_item(A.in[I_WOUT], 1024, 1024, (bf16_t*)(ws + WS_WTOUT), 0, scr, r, lane); continue; } r -= I_OUT;
        if (r < I_C2) { p0_transpose_item(A.in[I_CKW2], 256, 64, (bf16_t*)(ws + WS_WTC2K), 0, scr, r, lane); continue; } r -= I_C2;
        if (r < I_C2) { p0_transpose_item(A.in[I_CVW2], 256, 64, (bf16_t*)(ws + WS_WTC2V), 0, scr, r, lane); continue; }
    }
    for (int id = blockIdx.x * 512 + tid; id < 2 * 65536; id += G * 512) { const int kv = id >> 16, rem = id & 65535, ln = rem & 63, kk = (rem >> 6) & 127, jt = rem >> 13;
        const float* w = A.in[kv ? I_CVW1 : I_CKW1] + (size_t)(16 * kk + 8 * (ln >> 5)) * 256 + 32 * jt + (ln & 31);
        u32x4 o; o.x = pk2(w[0], w[256]); o.y = pk2(w[512], w[768]); o.z = pk2(w[1024], w[1280]); o.w = pk2(w[1536], w[1792]);
        *(u32x4*)((bf16_t*)(ws + (kv ? WS_WTC1V : WS_WTC1K)) + (size_t)rem * 8) = o; }
    { const float* gain = A.in[I_ANG]; f32x4 gv[4];
#pragma unroll
      for (int j = 0; j < 4; ++j) gv[j] = *(const f32x4*)(gain + 4 * lane + 256 * j);
      for (int m = gw; m < NTOK; m += NGW) { const f32x4* xr = (const f32x4*)(A.in[I_X] + (size_t)m * D) + lane; f32x4 v[4]; float s = 0.f;
#pragma unroll
        for (int j = 0; j < 4; ++j) { v[j] = xr[64 * j]; s += v[j].x * v[j].x + v[j].y * v[j].y + v[j].z * v[j].z + v[j].w * v[j].w; }
        const float rs = rsqrtf(wave_sum(s) * (1.f / D) + EPS);
        u32x2* o = (u32x2*)((bf16_t*)(ws + WS_XN) + (size_t)m * D) + lane;
#pragma unroll
        for (int j = 0; j < 4; ++j) { u32x2 w; w.x = pk2(v[j].x * rs * gv[j].x, v[j].y * rs * gv[j].y); w.y = pk2(v[j].z * rs * gv[j].z, v[j].w * rs * gv[j].w); o[64 * j] = w; } } }
    { u32x4* p = (u32x4*)((bf16_t*)(ws + WS_WTIN) + (size_t)INW * 1024); const int n16 = (INWP - INW) * 1024 * 2 / 16;
      for (int i = blockIdx.x * 512 + tid; i < n16; i += G * 512) p[i] = (u32x4){0u, 0u, 0u, 0u}; }
    if (first && tid < 256) { for (int task = blockIdx.x; task < 256; task += G) { const int kv = task >> 7, seg = task & 127, j = tid;
        const float* pos = A.in[kv ? I_CVPOS : I_CKPOS] + seg * 16; const float* w1 = A.in[kv ? I_CVW1 : I_CKW1] + (size_t)seg * 16 * 256 + j; float wv[16];
#pragma unroll
        for (int k = 0; k < 16; ++k) wv[k] = w1[k * 256];
        float s = 0.f;
#pragma unroll
        for (int k = 0; k < 16; ++k) s += pos[k] * wv[k];
        ((float*)(ws + WS_PB1P))[seg * 512 + kv * 256 + j] = s; } }
}

DI void nsa_prep_task(const Args& A, int task, unsigned char* lds, int wv_) {
    const int tid = otid(wv_), lane = tid & 63, wave = tid >> 6;
    const int b = task >> 7, n = task & 127;
    unsigned char* ws = A.ws; const bf16_t* U = (const bf16_t*)(ws + WS_U);
    bf16_t* vsL = (bf16_t*)lds;
    u32x4 wq[8], wkv[8]; float gt[8];
    const int kvcol = (lane < 16) ? C_KS + 8 * lane : (lane < 32) ? C_KW + 8 * (lane - 16) : (lane < 48) ? C_VS + 8 * (lane - 32) : C_VW + 8 * (lane - 48);
#pragma unroll
    for (int ti = 0; ti < 8; ++ti) { const bf16_t* ur = U + ((size_t)b * T + n * 64 + wave * 8 + ti) * INWP;
        wq[ti] = *(const u32x4*)(ur + C_Q + 8 * lane); wkv[ti] = *(const u32x4*)(ur + kvcol); gt[ti] = (lane < 24) ? bf2f(ur[C_GATE + lane]) : 0.f; }
#pragma unroll
    for (int ti = 0; ti < 8; ++ti) {
        const int tl = wave * 8 + ti, t = n * 64 + tl; const size_t tok = (size_t)b * T + t;
        { const u32x4 w = wq[ti]; float f[8] = {bflo(w.x), bfhi(w.x), bflo(w.y), bfhi(w.y), bflo(w.z), bfhi(w.z), bflo(w.w), bfhi(w.w)};
          float s = 0.f;
#pragma unroll
          for (int i = 0; i < 8; ++i) s += f[i] * f[i];
          s += xor1f(s); s += xor2f(s); s += __shfl_xor(s, 4);
          const float rs = rsqrtf(s * (1.f / 64.f) + EPS) * (0.125f * LOG2E); const float* gq = A.in[I_QG] + (8 * lane & 63);
          u32x4 o; o.x = pk2(f[0] * rs * gq[0], f[1] * rs * gq[1]); o.y = pk2(f[2] * rs * gq[2], f[3] * rs * gq[3]); o.z = pk2(f[4] * rs * gq[4], f[5] * rs * gq[5]); o.w = pk2(f[6] * rs * gq[6], f[7] * rs * gq[7]);
          *(u32x4*)((bf16_t*)(ws + WS_QN) + tok * 512 + 8 * lane) = o; }
        if (lane < 32) { const int sel = lane >> 4, l16 = lane & 15, g = l16 >> 3, d0 = (l16 & 7) * 8;
          const u32x4 w = wkv[ti]; float f[8] = {bflo(w.x), bfhi(w.x), bflo(w.y), bfhi(w.y), bflo(w.z), bfhi(w.z), bflo(w.w), bfhi(w.w)};
          float s = 0.f;
#pragma unroll
          for (int i = 0; i < 8; ++i) s += f[i] * f[i];
          s += xor1f(s); s += xor2f(s); s += __shfl_xor(s, 4);
          const float rs = rsqrtf(s * (1.f / 64.f) + EPS); const float* gk = A.in[sel ? I_KWG : I_KSG] + d0;
          u32x4 o; o.x = pk2(f[0] * rs * gk[0], f[1] * rs * gk[1]); o.y = pk2(f[2] * rs * gk[2], f[3] * rs * gk[3]); o.z = pk2(f[4] * rs * gk[4], f[5] * rs * gk[5]); o.w = pk2(f[6] * rs * gk[6], f[7] * rs * gk[7]);
          { const int c = l16 & 7; *(u32x4*)((bf16_t*)(ws + (sel ? WS_KWN : WS_KSN)) + (size_t)(b * 2 + g) * T * 64 + ((size_t)((t >> 5) * 4 + (c >> 1)) * 64 + (c & 1) * 32 + (t & 31)) * 8) = o; } }
        else { const int l32 = lane - 32, sel = l32 >> 4, l16 = l32 & 15, g = l16 >> 3, d0 = (l16 & 7) * 8;
          const u32x4 w = wkv[ti];
          const int pos = (tl & ~15) + perm16inv(tl & 15); bf16_t* dst = vsL + ((sel * 2 + g) * 64 + d0) * 64 + pos;
          dst[0 * 64] = (bf16_t)(w.x & 0xffff); dst[1 * 64] = (bf16_t)(w.x >> 16); dst[2 * 64] = (bf16_t)(w.y & 0xffff); dst[3 * 64] = (bf16_t)(w.y >> 16);
          dst[4 * 64] = (bf16_t)(w.z & 0xffff); dst[5 * 64] = (bf16_t)(w.z >> 16); dst[6 * 64] = (bf16_t)(w.w & 0xffff); dst[7 * 64] = (bf16_t)(w.w >> 16); }
        if (lane < 24) ((float*)(ws + WS_GATES))[tok * 24 + lane] = sigm(gt[ti]);
    }
    __syncthreads();
    for (int c = tid; c < 2048; c += 512) { const int sel = c >> 10, g = (c >> 9) & 1, rem = c & 511;
        const int r32 = rem & 31, hh = (rem >> 5) & 1, ks = (rem >> 6) & 1, dt = (rem >> 7) & 1, tb = rem >> 8;
        const u32x4 v = *(const u32x4*)(vsL + ((sel * 2 + g) * 64 + 32 * dt + r32) * 64 + 32 * tb + 16 * ks + 8 * hh);
        *(u32x4*)((bf16_t*)(ws + (sel ? WS_VWT : WS_VST)) + ((size_t)(b * 2 + g) * 128 + n) * 4096 + rem * 8) = v; }
    __syncthreads();
}

DI void compress_task(const Args& A, int task, unsigned char* lds, int wv_) {
    const int tid = otid(wv_), lane = tid & 63, wave = __builtin_amdgcn_readfirstlane(tid >> 6), r32 = lane & 31, hh = lane >> 5;
    const int kv = task >> 6, b = (task >> 5) & 1, g = (task >> 4) & 1, ct = task & 15, c0 = 32 * ct;
    unsigned char* ws = A.ws; const bf16_t* U = (const bf16_t*)(ws + WS_U);
    unsigned char* XU = lds;
    bf16_t* hidL = (bf16_t*)(lds + 67584);
    float* outL = (float*)(lds + 67584 + 16896);
    const int colbase = (kv ? C_VC : C_KC) + g * 64;
    const bf16_t* W1F = (const bf16_t*)(ws + (kv ? WS_WTC1V : WS_WTC1K)) + (size_t)wave * 128 * 512 + lane * 8;
    const bf16_t* W2T = (const bf16_t*)(ws + (kv ? WS_WTC2V : WS_WTC2K));
    {   u32x4 rv[9];
#pragma unroll
        for (int j = 0; j < 9; ++j) { const int id = tid + 512 * j, tk = id >> 3, ch = id & 7; rv[j] = (u32x4){0u, 0u, 0u, 0u};
            if (id < 528 * 8 && 16 * c0 + tk < T) rv[j] = *(const u32x4*)(U + ((size_t)b * T + 16 * c0 + tk) * INWP + colbase + ch * 8); }
#pragma unroll
        for (int j = 0; j < 9; ++j) { const int id = tid + 512 * j, tk = id >> 3, ch = id & 7; if (id < 528 * 8) *(u32x4*)(XU + tk * 128 + ((ch ^ ((tk >> 4) & 7)) * 16)) = rv[j]; } }
    __syncthreads();
    {   f32x16 acc; for (int i = 0; i < 16; ++i) acc[i] = 0.f;
#pragma unroll 8
        for (int kk = 0; kk < 128; ++kk) { const int l = kk >> 2, s = kk & 3, tk = 16 * r32 + l;
            const bf16x8 af = *(const bf16x8*)(XU + tk * 128 + (((2 * s + hh) ^ ((tk >> 4) & 7)) * 16));
            const bf16x8 bf = *(const bf16x8*)(W1F + (size_t)kk * 512);
            acc = MFMA32(af, bf, acc); }
        const int j = 32 * wave + r32; float pb = A.in[kv ? I_CVB1 : I_CKB1][j];
#pragma unroll
        for (int sg = 0; sg < 128; ++sg) pb += ((const float*)(ws + WS_PB1P))[sg * 512 + kv * 256 + j];
#pragma unroll
        for (int r = 0; r < 16; ++r) { const float x = acc[r] + pb; const float y = x * sigm(1.5957691216057308f * (x + 0.044715f * x * x * x)); hidL[crow(r, hh) * 264 + j] = f2bf(y); }
    }
    __syncthreads();
    if (wave < 2) { f32x16 acc; for (int i = 0; i < 16; ++i) acc[i] = 0.f;
#pragma unroll
        for (int s = 0; s < 16; ++s) { const bf16x8 af = *(const bf16x8*)(hidL + r32 * 264 + 16 * s + 8 * hh); const bf16x8 bf = *(const bf16x8*)(W2T + (size_t)(32 * wave + r32) * 256 + 16 * s + 8 * hh); acc = MFMA32(af, bf, acc); }
        const int d = 32 * wave + r32; const float b2 = A.in[kv ? I_CVB2 : I_CKB2][d];
#pragma unroll
        for (int r = 0; r < 16; ++r) outL[crow(r, hh) * 65 + d] = acc[r] + b2; }
    __syncthreads();
    if (kv == 0) { if (tid < 256) { const int cl = tid >> 3, sub = tid & 7; float f[8]; float s = 0.f;
#pragma unroll
            for (int i = 0; i < 8; ++i) { f[i] = outL[cl * 65 + 8 * sub + i]; s += f[i] * f[i]; }
            s += __shfl_xor(s, 1); s += __shfl_xor(s, 2); s += __shfl_xor(s, 4);
            const float rs = (c0 + cl > 510) ? 0.f : rsqrtf(s * (1.f / 64.f) + EPS); const float* gk = A.in[I_KCG] + 8 * sub;
            u32x4 o; o.x = pk2(f[0] * rs * gk[0], f[1] * rs * gk[1]); o.y = pk2(f[2] * rs * gk[2], f[3] * rs * gk[3]); o.z = pk2(f[4] * rs * gk[4], f[5] * rs * gk[5]); o.w = pk2(f[6] * rs * gk[6], f[7] * rs * gk[7]);
            *(u32x4*)((bf16_t*)(ws + WS_KC) + (size_t)(b * 2 + g) * 512 * 64 + ((size_t)(ct * 4 + (sub >> 1)) * 64 + (sub & 1) * 32 + cl) * 8) = o; } }
    else { const int d = tid >> 3, part = tid & 7, p0 = 4 * part, gi = p0 >> 4, cl0 = 16 * gi + perm16(p0 & 15); float f[4];
#pragma unroll
        for (int i = 0; i < 4; ++i) f[i] = (c0 + cl0 + i > 510) ? 0.f : outL[(cl0 + i) * 65 + d];
        u32x2 o; o.x = pk2(f[0], f[1]); o.y = pk2(f[2], f[3]);
        *(u32x2*)((bf16_t*)(ws + WS_VCT) + (size_t)(b * 2 + g) * 64 * 512 + ((size_t)((ct * 2 + (d >> 5)) * 2 + (p0 >> 4)) * 64 + ((p0 >> 3) & 1) * 32 + (d & 31)) * 8 + (p0 & 7)) = o; }
    __syncthreads();
}

DI void gdn_chunk_task(const Args& A, int task, unsigned char* lds, int wv_) {
    const int tid = otid(wv_), lane = tid & 63, wave = __builtin_amdgcn_readfirstlane(tid >> 6), r32 = lane & 31, hh = lane >> 5;
    const int b = task >> 9, h = (task >> 7) & 3, ch = task & 127, t0 = ch * 64; const size_t tok0 = (size_t)b * T + t0;
    unsigned char* ws = A.ws; const bf16_t* U = (const bf16_t*)(ws + WS_U);
    float* qL = (float*)lds; float* kL = qL + 64 * 132; float* vL = kL + 64 * 132; float* Lm = vL + 64 * 132; float* Qm = Lm + 64 * 68;
    float* gcL = Qm + 64 * 68; float* betaL = gcL + 64; float* egL = betaL + 64; float* kdsL = egL + 64;
    float ga = 0.f, gb = 0.f;
    if (tid < 64) { ga = bf2f(U[(tok0 + tid) * INWP + C_GA + h]); gb = bf2f(U[(tok0 + tid) * INWP + C_GB + h]); }
    {   u32x4 rv[7]; int rt[7], rc[7];
#pragma unroll
        for (int j = 0; j < 7; ++j) { const int id = tid + 512 * j; rt[j] = id / 48; rc[j] = id % 48; rv[j] = (u32x4){0u, 0u, 0u, 0u};
            if (id < 67 * 48 && t0 + rt[j] - 3 >= 0) { const int s = rc[j] >> 4, c8 = (rc[j] & 15) * 8; const int col = (s == 0 ? C_GQ : s == 1 ? C_GK : C_GV) + h * 128 + c8;
                rv[j] = *(const u32x4*)(U + (tok0 + rt[j] - 3) * INWP + col); } }
#pragma unroll
        for (int j = 0; j < 7; ++j) { const int id = tid + 512 * j; if (id < 67 * 48) { const int s = rc[j] >> 4, c8 = (rc[j] & 15) * 8; float* base = (s == 0 ? qL : s == 1 ? kL : vL);
                float* dst = (rt[j] >= 3) ? base + (rt[j] - 3) * 132 + c8 : Lm + (s * 3 + rt[j]) * 132 + c8;
                *(f32x4*)dst = (f32x4){bflo(rv[j].x), bfhi(rv[j].x), bflo(rv[j].y), bfhi(rv[j].y)}; *(f32x4*)(dst + 4) = (f32x4){bflo(rv[j].z), bfhi(rv[j].z), bflo(rv[j].w), bfhi(rv[j].w)}; } } }
    __syncthreads();
    if (tid < 384) { const int s = tid >> 7, c = tid & 127; float* col = (s == 0 ? qL : s == 1 ? kL : vL) + c; const float* halo = Lm + (s * 3) * 132 + c;
        const float* cw = A.in[I_CONVW] + s * 512 + h * 128 + c; const float w0 = cw[0], w1 = cw[1536], w2 = cw[3072], w3 = cw[4608];
        float x0 = col[63 * 132], x1 = col[62 * 132], x2 = col[61 * 132];
#pragma unroll 8
        for (int t = 63; t >= 0; --t) { const float x3 = (t >= 3) ? col[(t - 3) * 132] : halo[t * 132];
            const float y = w0 * x3 + w1 * x2 + w2 * x1 + w3 * x0; col[t * 132] = y * sigm(y); x0 = x1; x1 = x2; x2 = x3; } }
    if (tid < 64) { const int tl = tid;
        const float x = ga + A.in[I_DTB][h]; const float sp = (x > 20.f) ? x : log1pf(__expf(x)); float gt = -__expf(A.in[I_ALOG][h]) * sp;
#pragma unroll
        for (int o = 1; o < 64; o <<= 1) { const float v = __shfl_up(gt, o); if (lane >= o) gt += v; }
        const float g63 = __shfl(gt, 63);
        gcL[tl] = gt; betaL[tl] = sigm(gb); egL[tl] = __expf(gt); kdsL[tl] = __expf(g63 - gt);
        if (tl == 63) ((float*)(ws + WS_GL))[task] = __expf(gt); }
    __syncthreads();
    { const int tl = tid >> 3, sub = tid & 7; float sq = 0.f, sk = 0.f;
#pragma unroll
      for (int i = 0; i < 16; ++i) { const float a = qL[tl * 132 + sub * 16 + i], c = kL[tl * 132 + sub * 16 + i]; sq += a * a; sk += c * c; }
      sq += __shfl_xor(sq, 1); sq += __shfl_xor(sq, 2); sq += __shfl_xor(sq, 4); sk += __shfl_xor(sk, 1); sk += __shfl_xor(sk, 2); sk += __shfl_xor(sk, 4);
      const float rq = rsqrtf(sq + EPS) * 0.08838834764831845f, rk = rsqrtf(sk + EPS);
#pragma unroll
      for (int i = 0; i < 16; ++i) { qL[tl * 132 + sub * 16 + i] *= rq; kL[tl * 132 + sub * 16 + i] *= rk; } }
    __syncthreads();
    { const int mat = wave >> 2, mi = (wave >> 1) & 1, ni = wave & 1; const float* X = mat ? qL : kL;
      f32x16 acc; for (int i = 0; i < 16; ++i) acc[i] = 0.f;
#pragma unroll
      for (int s = 0; s < 8; ++s) { const f32x4 a0 = *(const f32x4*)(X + (32 * mi + r32) * 132 + 16 * s + 8 * hh), a1 = *(const f32x4*)(X + (32 * mi + r32) * 132 + 16 * s + 8 * hh + 4);
          const f32x4 b0 = *(const f32x4*)(kL + (32 * ni + r32) * 132 + 16 * s + 8 * hh), b1 = *(const f32x4*)(kL + (32 * ni + r32) * 132 + 16 * s + 8 * hh + 4);
          acc = MFMA32(pack8(a0[0], a0[1], a0[2], a0[3], a1[0], a1[1], a1[2], a1[3]), pack8(b0[0], b0[1], b0[2], b0[3], b1[0], b1[1], b1[2], b1[3]), acc); }
      const int sc = 32 * ni + r32; const float gs = gcL[sc];
#pragma unroll
      for (int r = 0; r < 16; ++r) { const int c = 32 * mi + crow(r, hh); const float dec = __expf(gcL[c] - gs);
          if (mat == 0) Lm[c * 68 + sc] = (c > sc) ? betaL[c] * acc[r] * dec : 0.f; else Qm[c * 68 + sc] = (c >= sc) ? acc[r] * dec : 0.f; } }
    __syncthreads();
    {   bf16_t* QGp = (bf16_t*)(ws + WS_QGP) + (size_t)task * 8192; bf16_t* KDTp = (bf16_t*)(ws + WS_KDTP) + (size_t)task * 8192; bf16_t* QKp = (bf16_t*)(ws + WS_QKP) + (size_t)task * 4096;
        for (int id = tid; id < 1024; id += 512) { const int c = id >> 4, chn = id & 15, ks = chn >> 2, q = chn & 3; const float e = egL[c];
            const f32x4 a = *(const f32x4*)(qL + c * 132 + 32 * ks + 4 * q), bq = *(const f32x4*)(qL + c * 132 + 32 * ks + 16 + 4 * q);
            *(bf16x8*)(QGp + id * 8) = pack8(a[0] * e, a[1] * e, a[2] * e, a[3] * e, bq[0] * e, bq[1] * e, bq[2] * e, bq[3] * e); }
        for (int id = tid; id < 1024; id += 512) { const int d = id >> 3, chn = id & 7, ks = chn >> 2, q = chn & 3; float f[8];
#pragma unroll
            for (int j = 0; j < 8; ++j) { const int s = 32 * ks + 16 * (j >> 2) + 4 * q + (j & 3); f[j] = kL[s * 132 + d] * kdsL[s]; }
            *(bf16x8*)(KDTp + id * 8) = pack8(f[0], f[1], f[2], f[3], f[4], f[5], f[6], f[7]); }
        { const int id = tid; const int c = id >> 3, chn = id & 7, ks = chn >> 2, q = chn & 3;
            const f32x4 a = *(const f32x4*)(Qm + c * 68 + 32 * ks + 4 * q), bq = *(const f32x4*)(Qm + c * 68 + 32 * ks + 16 + 4 * q);
            *(bf16x8*)(QKp + id * 8) = pack8(a[0], a[1], a[2], a[3], bq[0], bq[1], bq[2], bq[3]); } }
    __syncthreads();
    bf16_t* XT = (bf16_t*)qL;
    float* TK = Qm;
    {
        const int k = lane >> 4, c = lane & 15; float x[16];
#pragma unroll
        for (int i = 0; i < 16; ++i) x[i] = (i == c) ? 1.f : 0.f;
#pragma unroll
        for (int i = 1; i < 16; ++i) {
#pragma unroll
            for (int j4 = 0; j4 < (i + 3) / 4; ++j4) { const f32x4 l4 = *(const f32x4*)(Lm + (16 * k + i) * 68 + 16 * k + 4 * j4);
#pragma unroll
                for (int jj = 0; jj < 4; ++jj) if (4 * j4 + jj < i) x[i] -= l4[jj] * x[4 * j4 + jj]; } }
#pragma unroll
        for (int i = 0; i < 16; ++i) TK[(k * 16 + i) * 16 + c] = x[i];
        asm volatile("s_waitcnt lgkmcnt(0)" ::: "memory");
    }
    {   const int r16 = lane & 15, q4 = lane >> 4; const bf16x8 z8 = pack8(0.f, 0.f, 0.f, 0.f, 0.f, 0.f, 0.f, 0.f);
#pragma unroll 1
        for (int nt2 = 0; nt2 < 2; ++nt2) { const int nt = 2 * wave + nt2; const bool isW = nt >= 8; const float* srcc = (isW ? kL : vL) + ((16 * nt + r16) & 127);
            bf16_t* xcol = XT + (16 * nt + r16) * 64;
#pragma unroll
            for (int bi = 0; bi < 4; ++bi) {
                f32x4 acc = (f32x4){0.f, 0.f, 0.f, 0.f};
#pragma unroll
                for (int ks = 0; ks * 32 < 16 * bi; ++ks) { const int k0 = 32 * ks + 8 * q4; const bool ok = k0 < 16 * bi;
                    const f32x4 l0 = *(const f32x4*)(Lm + (16 * bi + r16) * 68 + k0), l1 = *(const f32x4*)(Lm + (16 * bi + r16) * 68 + k0 + 4);
                    const bf16x8 af = ok ? pack8(l0[0], l0[1], l0[2], l0[3], l1[0], l1[1], l1[2], l1[3]) : z8;
                    const bf16x8 xb = *(const bf16x8*)(xcol + k0); const bf16x8 bf = ok ? xb : z8;
                    acc = MFMA16(af, bf, acc); }
                float d[4];
#pragma unroll
                for (int r = 0; r < 4; ++r) { const int i = 16 * bi + 4 * q4 + r; float v = srcc[i * 132] * betaL[i]; if (isW) v *= egL[i]; d[r] = v - acc[r]; }
                const f32x4 t4 = *(const f32x4*)(TK + (bi * 16 + r16) * 16 + 4 * q4);
                const bf16x8 ta = pack8(t4[0], t4[1], t4[2], t4[3], 0.f, 0.f, 0.f, 0.f), db = pack8(d[0], d[1], d[2], d[3], 0.f, 0.f, 0.f, 0.f);
                const f32x4 xr = MFMA16(ta, db, ((f32x4){0.f, 0.f, 0.f, 0.f}));
                u32x2 o; o.x = pk2(xr[0], xr[1]); o.y = pk2(xr[2], xr[3]);
                *(u32x2*)(xcol + 16 * bi + 4 * q4) = o;
                asm volatile("s_waitcnt lgkmcnt(0)" ::: "memory"); } } }
    __syncthreads();
    { bf16_t* Wp = (bf16_t*)(ws + WS_WP) + (size_t)task * 8192; bf16_t* Up = (bf16_t*)(ws + WS_UP) + (size_t)task * 8192;
      for (int id = tid; id < 1024; id += 512) { const int c = id >> 4, chn = id & 15, ks = chn >> 2, q = chn & 3; unsigned short f[8];
#pragma unroll
          for (int j = 0; j < 8; ++j) { const int d = 32 * ks + 16 * (j >> 2) + 4 * q + (j & 3); f[j] = XT[(128 + d) * 64 + c]; }
          u32x4 o; o.x = f[0] | ((unsigned)f[1] << 16); o.y = f[2] | ((unsigned)f[3] << 16); o.z = f[4] | ((unsigned)f[5] << 16); o.w = f[6] | ((unsigned)f[7] << 16);
          *(u32x4*)(Wp + id * 8) = o; }
      for (int id = tid; id < 2048; id += 512) { const int ln = id & 63, mt = (id >> 6) & 3, es = id >> 8, q = ln >> 4, e = ln & 15; const int c = 16 * mt + 4 * q, col = 16 * es + e;
          *(u32x2*)(Up + id * 4) = *(const u32x2*)(XT + col * 64 + c); } }
    __syncthreads();
}

constexpr int SC_W = 0, SC_QG = 17408, SC_KD = 34816, SC_QK = 53248, SC_UP = 62464, SC_BUF = 64512, SC_OB = 2 * 64512  ,
              SC_SB = SC_OB + 4096  , SC_VB = SC_SB + 8192  ;
#define SC_BAR() do { asm volatile("s_waitcnt lgkmcnt(0)" ::: "memory"); __builtin_amdgcn_s_barrier(); asm volatile("" ::: "memory"); } while (0)
DI void gdn_scan_block(const Args& A, int sidx, unsigned char* lds, int wv_) {
    const int tid = otid(wv_), lane = tid & 63, wave = __builtin_amdgcn_readfirstlane(tid >> 6);
    const int bh = sidx & 7, es = sidx >> 3, b = bh >> 2, h = bh & 3, r16 = lane & 15, q = lane >> 4;
    unsigned char* ws = A.ws;
    const bf16_t* WP = (const bf16_t*)(ws + WS_WP) + (size_t)bh * 128 * 8192; const bf16_t* QGP = (const bf16_t*)(ws + WS_QGP) + (size_t)bh * 128 * 8192;
    const bf16_t* KDTP = (const bf16_t*)(ws + WS_KDTP) + (size_t)bh * 128 * 8192; const bf16_t* QKP = (const bf16_t*)(ws + WS_QKP) + (size_t)bh * 128 * 4096;
    const bf16_t* UP = (const bf16_t*)(ws + WS_UP) + (size_t)bh * 128 * 8192 + es * 1024;
    u32x4 R0[8], R1[8], R2[8];
    const int dW = (tid >> 4) * 272 + (tid & 15) * 16, dK = (tid >> 3) * 144 + (tid & 7) * 16; const bool upok = tid < 128;
#define SC_SRC(j, i_) ((j) < 2 ? WP + (size_t)(i_) * 8192 + (tid + 512 * (j)) * 8 : (j) < 4 ? QGP + (size_t)(i_) * 8192 + (tid + 512 * ((j) - 2)) * 8 : (j) < 6 ? KDTP + (size_t)(i_) * 8192 + (tid + 512 * ((j) - 4)) * 8 : \
                       (j) < 7 ? QKP + (size_t)(i_) * 4096 + tid * 8 : UP + (size_t)(i_) * 8192 + (upok ? tid : 0) * 8)
#define SC_DST(j) ((j) < 2 ? SC_W + dW + 32 * (j) * 272 : (j) < 4 ? SC_QG + dW + 32 * ((j) - 2) * 272 : (j) < 6 ? SC_KD + dK + 64 * ((j) - 4) * 144 : (j) < 7 ? SC_QK + dK : SC_UP + tid * 16)
#define SC_LOAD(R, i_) do { const int il_ = ((i_) < 128) ? (i_) : 127;     \
        _Pragma("unroll") for (int j = 0; j < 8; ++j) R[j] = *(const __attribute__((address_space(1))) u32x4*)(SC_SRC(j, il_)); } while (0)
#define SC_WRITE(R, bufi_) do { _Pragma("unroll") for (int j = 0; j < 8; ++j) if (j < 7 || upok) *(u32x4*)(lds + (bufi_) * SC_BUF + SC_DST(j)) = R[j]; } while (0)
    bf16_t* OGr = (bf16_t*)(ws + WS_OG) + ((size_t)b * T + lane) * 512 + h * 128 + es * 16;
    const int odump = SC_OB + (((lane >> 4) * 64 + ((lane >> 2) & 3) * 16) * 4 + (lane & 3)) * 2;
#define SC_OFLUSH(i_) do { if (wave == 4 && (i_) >= 0) { const unsigned char* ob = lds + odump + ((i_) & 1) * 2048; unsigned w_[8]; \
        _Pragma("unroll") for (int e2 = 0; e2 < 8; ++e2) w_[e2] = (unsigned)*(const bf16_t*)(ob + (2 * e2) * 8) | ((unsigned)*(const bf16_t*)(ob + (2 * e2 + 1) * 8) << 16); \
        u32x4* dst_ = (u32x4*)(OGr + (size_t)(i_) * 64 * 512); dst_[0] = (u32x4){w_[0], w_[1], w_[2], w_[3]}; dst_[1] = (u32x4){w_[4], w_[5], w_[6], w_[7]}; } } while (0)
    const int w = wave;
    const float* GLp = (const float*)(ws + WS_GL) + bh * 128; const float glA = GLp[lane], glB = GLp[64 + lane];
    f32x4 S0 = (f32x4){0.f, 0.f, 0.f, 0.f}, S1 = S0;
    if (wave < 4) *(u32x4*)(lds + SC_SB + (w * 64 + lane) * 16) = (u32x4){0u, 0u, 0u, 0u};
#define SC_COMPUTE_A(i_) \
        const unsigned char* bufp = lds + ((i_) & 1) * SC_BUF; \
        const unsigned char* wp = bufp + SC_W + (16 * w + r16) * 272 + 16 * q; const unsigned char* qgp = bufp + SC_QG + (16 * w + r16) * 272 + 16 * q; \
        const unsigned char* kdp = bufp + SC_KD + (32 * w + r16) * 144 + 16 * q; const unsigned char* qkp = bufp + SC_QK + (16 * w + r16) * 144 + 16 * q; \
        const float gl = __builtin_bit_cast(float, __builtin_amdgcn_readlane(__builtin_bit_cast(int, ((i_) < 64) ? glA : glB), (i_) & 63)); \
        bf16x8 Sb[4], fw[4], fk[4], fq[4], fqk[2]; \
        _Pragma("unroll") for (int ks = 0; ks < 4; ++ks) Sb[ks] = *(const bf16x8*)(lds + SC_SB + ((i_) & 1) * 4096 + (ks * 64 + lane) * 16); \
        _Pragma("unroll") for (int ks = 0; ks < 4; ++ks) fw[ks] = *(const bf16x8*)(wp + ks * 64); \
        const u32x2 uw = *(const u32x2*)(bufp + SC_UP + (w * 64 + lane) * 8); \
        _Pragma("unroll") for (int t2 = 0; t2 < 2; ++t2) _Pragma("unroll") for (int k2 = 0; k2 < 2; ++k2) fk[t2 * 2 + k2] = *(const bf16x8*)(kdp + t2 * 16 * 144 + k2 * 64); \
        f32x4 t1 = (f32x4){0.f, 0.f, 0.f, 0.f}; \
        _Pragma("unroll") for (int ks = 0; ks < 4; ++ks) t1 = MFMA16(fw[ks], Sb[ks], t1); \
        const f32x4 vn = (f32x4){bflo(uw.x) - t1[0], bfhi(uw.x) - t1[1], bflo(uw.y) - t1[2], bfhi(uw.y) - t1[3]}; \
        { u32x2 o2; o2.x = pk2(vn[0], vn[1]); o2.y = pk2(vn[2], vn[3]); *(u32x2*)(lds + SC_VB + ((w >> 1) * 64 + lane) * 16 + (w & 1) * 8) = o2; } \

#define SC_COMPUTE_B(i_) \
        bf16x8 Vb[2]; \
        _Pragma("unroll") for (int k2 = 0; k2 < 2; ++k2) Vb[k2] = *(const bf16x8*)(lds + SC_VB + (k2 * 64 + lane) * 16); \
        S0 = S0 * gl; S1 = S1 * gl; \
        _Pragma("unroll") for (int k2 = 0; k2 < 2; ++k2) { S0 = MFMA16(fk[k2], Vb[k2], S0); S1 = MFMA16(fk[2 + k2], Vb[k2], S1); } \
        _Pragma("unroll") for (int ks = 0; ks < 4; ++ks) fq[ks] = *(const bf16x8*)(qgp + ks * 64); \
        _Pragma("unroll") for (int k2 = 0; k2 < 2; ++k2) fqk[k2] = *(const bf16x8*)(qkp + k2 * 64); \
        *(bf16x8*)(lds + SC_SB + (((i_) + 1) & 1) * 4096 + (w * 64 + lane) * 16) = pack8(S0[0], S0[1], S0[2], S0[3], S1[0], S1[1], S1[2], S1[3]); \
        bf16x8 So[4]; \
        _Pragma("unroll") for (int ks = 0; ks < 4; ++ks) So[ks] = *(const bf16x8*)(lds + SC_SB + ((i_) & 1) * 4096 + (ks * 64 + lane) * 16); \
        f32x4 oa = (f32x4){0.f, 0.f, 0.f, 0.f}; \
        _Pragma("unroll") for (int ks = 0; ks < 4; ++ks) oa = MFMA16(fq[ks], So[ks], oa); \
        _Pragma("unroll") for (int k2 = 0; k2 < 2; ++k2) oa = MFMA16(fqk[k2], Vb[k2], oa); \
        { u32x2 o2; o2.x = pk2(oa[0], oa[1]); o2.y = pk2(oa[2], oa[3]); *(u32x2*)(lds + SC_OB + ((i_) & 1) * 2048 + (w * 64 + lane) * 8) = o2; }
#define SC_STEP(RN, i_) do { const int i__ = (i_); \
        SC_WRITE(RN, (i__ + 1) & 1);       \
        SC_LOAD(RN, i__ + 4); SC_OFLUSH(i__ - 1); \
        if (wave < 4) { SC_COMPUTE_A(i__) SC_BAR(); SC_COMPUTE_B(i__) SC_BAR(); } else { SC_BAR(); SC_BAR(); } } while (0)
    SC_LOAD(R0, 0); SC_LOAD(R1, 1); SC_LOAD(R2, 2); SC_WRITE(R0, 0); SC_LOAD(R0, 3);
    asm volatile("" ::: "memory");
    SC_BAR();
    for (int i = 0; i < 126; i += 3) { SC_STEP(R1, i); SC_STEP(R2, i + 1); SC_STEP(R0, i + 2); }
    SC_STEP(R1, 126); SC_STEP(R2, 127);
    SC_OFLUSH(127);
#undef SC_LOAD
#undef SC_WRITE
#undef SC_OFLUSH
#undef SC_SRC
#undef SC_DST
#undef SC_COMPUTE_A
#undef SC_COMPUTE_B
#undef SC_STEP
}

DI void tile_load_k(bf16x8 (&kf)[4], const bf16_t* __restrict__ KT, int lane) {
#pragma unroll
    for (int s = 0; s < 4; ++s) kf[s] = *(const bf16x8*)(KT + s * 512 + lane * 8); }
DI void tile_load_v(bf16x8 (&vf)[2][2], const bf16_t* __restrict__ VT, int lane) {
#pragma unroll
    for (int dt = 0; dt < 2; ++dt)
#pragma unroll
        for (int ks = 0; ks < 2; ++ks) vf[dt][ks] = *(const bf16x8*)(VT + (dt * 2 + ks) * 512 + lane * 8); }
DI f32x16 tile_scores(const bf16x8 (&kf)[4], const bf16x8 (&qf)[4], float negM, int hi2, int lo2, float& l) {
    f32x16 st;
#pragma unroll
    for (int i = 0; i < 16; ++i) st[i] = negM;
#pragma unroll
    for (int s = 0; s < 4; ++s) st = MFMA32(kf[s], qf[s], st);
#pragma unroll
    for (int r = 0; r < 16; ++r) { const int cr = (r & 3) + 8 * (r >> 2); float pv = __builtin_amdgcn_exp2f(st[r]); pv = (cr <= hi2 && cr > lo2) ? pv : 0.f; st[r] = pv; l += pv; }
    return st; }
DI void tile_pv(const f32x16& p, const bf16x8 (&vf)[2][2], f32x16 (&o)[2]) {
    const bf16x8 pb0 = pack8(p[0], p[1], p[2], p[3], p[4], p[5], p[6], p[7]), pb1 = pack8(p[8], p[9], p[10], p[11], p[12], p[13], p[14], p[15]);
#pragma unroll
    for (int dt = 0; dt < 2; ++dt) { o[dt] = MFMA32(vf[dt][0], pb0, o[dt]); o[dt] = MFMA32(vf[dt][1], pb1, o[dt]); } }

#define SS_BAR() do { asm volatile("s_waitcnt lgkmcnt(0)" ::: "memory"); __builtin_amdgcn_s_barrier(); asm volatile("" ::: "memory"); } while (0)
template <bool HASV, class StepFn, class CompFn>
DI void shared_stream(int nsteps, unsigned char* slots, int tid, StepFn sf, CompFn cf) {
    if (nsteps <= 0) return;
    u32x4 r0 = (u32x4){0u, 0u, 0u, 0u}, r1 = r0;
#define SS_LD(s_) do { const int sc_ = ((s_) < nsteps) ? (s_) : nsteps - 1; const bf16_t* Kp_; const bf16_t* Vp_; sf(sc_, Kp_, Vp_); \
        r0 = *(const __attribute__((address_space(1))) u32x4*)(Kp_ + tid * 8); if (HASV) r1 = *(const __attribute__((address_space(1))) u32x4*)(Vp_ + tid * 8); } while (0)
#define SS_WR(sl_) do { *(u32x4*)(slots + (sl_) * 16384 + tid * 16) = r0; if (HASV) *(u32x4*)(slots + (sl_) * 16384 + 8192 + tid * 16) = r1; } while (0)
    SS_LD(0); SS_WR(0); SS_LD(1);
    SS_BAR();
#pragma unroll 1
    for (int s = 0; s < nsteps; ++s) { SS_WR((s + 1) & 1); SS_LD(s + 2); cf(s, slots + (s & 1) * 16384); SS_BAR(); }
#undef SS_LD
#undef SS_WR
}
DI void lds_frag_k(bf16x8 (&kf)[4], const unsigned char* slot, int t, int lane) {
#pragma unroll
    for (int s = 0; s < 4; ++s) kf[s] = *(const bf16x8*)(slot + t * 4096 + s * 1024 + lane * 16); }
DI void lds_frag_v(bf16x8 (&vf)[2][2], const unsigned char* slot, int t, int lane) {
#pragma unroll
    for (int dt = 0; dt < 2; ++dt)
#pragma unroll
        for (int ks = 0; ks < 2; ++ks) vf[dt][ks] = *(const bf16x8*)(slot + 8192 + t * 4096 + (dt * 2 + ks) * 1024 + lane * 16); }

DI float maxabs64(const float* g, int lane) { float v = fabsf(g[lane]);
#pragma unroll
    for (int o = 1; o < 64; o <<= 1) v = fmaxf(v, __shfl_xor(v, o));
    return v; }

#define LOADQF(qf) do { _Pragma("unroll") for (int s_ = 0; s_ < 4; ++s_) qf[s_] = *(const bf16x8*)(QL + row * 72 + 16 * s_ + 8 * hh); } while (0)
DI void nsa_unit(const Args& A, int unit, unsigned char* lds, int wv_) {
    const int tid = otid(wv_), lane = tid & 63, wave = __builtin_amdgcn_readfirstlane(tid >> 6), r32 = lane & 31, hh = lane >> 5;
    const int ti = 127 - (unit >> 2), bg = unit & 3, b = bg >> 1, g = bg & 1;
    unsigned char* ws = A.ws;
    bf16_t* QL = (bf16_t*)lds;
    int* OL = (int*)(lds + 36864);
    int* LL = (int*)(lds + 36864 + 67584);
    unsigned* BM = (unsigned*)(lds + 36864 + 67584 + 1024);
    int* CNT = (int*)(lds + 36864 + 67584 + 2048);
    float* SCL = (float*)(lds + 36864 + 67584 + 2048 + 64);
    float* IMP = (float*)(lds + 108544);
    const int slot = r32 >> 2, hd = r32 & 3, tl = wave * 8 + slot, trow = ti * 64 + tl; const size_t tokg = (size_t)b * T + trow;
    const int row = wave * 32 + r32;
    bf16_t* PA = (bf16_t*)IMP + row * 64;
    const float mq = maxabs64(A.in[I_QG], lane) * 8.08f * LOG2E;
    for (int i = tid; i < 256 + 16; i += 512) BM[i] = 0u;
    { const bf16_t* qp = (const bf16_t*)(ws + WS_QN) + tokg * 512 + (g * 4 + hd) * 64 + 8 * hh;
#pragma unroll
      for (int s = 0; s < 4; ++s) *(bf16x8*)(QL + row * 72 + 16 * s + 8 * hh) = *(const bf16x8*)(qp + 16 * s); }
    const float* gp = (const float*)(ws + WS_GATES) + tokg * 24 + (g * 4 + hd) * 3;
    __syncthreads();
    {   const float negMc = -mq * maxabs64(A.in[I_KCG], lane);
        bf16x8 qf[4]; LOADQF(qf);
        const int cmax_row = (trow >= 31) ? ((trow - 31) >> 4) : -1; const int tmaxw = ti * 64 + wave * 8 + 7; const int ntc = (tmaxw >= 31) ? ((((tmaxw - 31) >> 4) >> 5) + 1) : 0;
        const bf16_t* Kc = (const bf16_t*)(ws + WS_KC) + (size_t)(b * 2 + g) * 512 * 64; const bf16_t* VcT = (const bf16_t*)(ws + WS_VCT) + (size_t)(b * 2 + g) * 64 * 512;
        float lc = 0.f;
        const int ntcb = ((((ti * 64 + 63 - 31) >> 4) >> 5) + 1);
        unsigned char* slots = (unsigned char*)OL;
        shared_stream<false>((ntcb + 1) >> 1, slots, tid,
            [&](int s, const bf16_t*& Kp, const bf16_t*& Vp) { Kp = Kc + (size_t)s * 4096; Vp = Kp; },
            [&](int s, const unsigned char* slot) {
#pragma unroll
                for (int t = 0; t < 2; ++t) { const int ct = 2 * s + t; if (ct < ntc) { bf16x8 kf[4]; lds_frag_k(kf, slot, t, lane); tile_scores(kf, qf, negMc, cmax_row - 32 * ct - 4 * hh, -1000000, lc); } } });
        lc += __shfl_xor(lc, 32);
        const float inv = (lc > 0.f) ? 1.f / lc : 0.f;
        f32x16 oc[2]; for (int i = 0; i < 16; ++i) { oc[0][i] = 0.f; oc[1][i] = 0.f; }
        float carry = 0.f, ldummy = 0.f;
#define CM_POST(p, ct_) do { float recv[4], bq[4]; \
            _Pragma("unroll") for (int jq = 0; jq < 4; ++jq) recv[jq] = __shfl_xor(p[4 * jq + 3], 32); \
            _Pragma("unroll") for (int jq = 0; jq < 4; ++jq) { const float pred = hh ? recv[jq] : (jq ? recv[jq - 1] : carry); float s_ = ((p[4 * jq] + p[4 * jq + 1]) + (p[4 * jq + 2] + p[4 * jq + 3]) + pred) * inv; \
                s_ += __shfl_xor(s_, 1); s_ += __shfl_xor(s_, 2); bq[jq] = s_; } \
            carry = recv[3]; \
            IMP[tl * 128 + 8 * (ct_) + 2 * hd + hh] = (hd == 0) ? bq[0] : (hd == 1) ? bq[1] : (hd == 2) ? bq[2] : bq[3]; } while (0)
        shared_stream<true>((ntcb + 1) >> 1, slots, tid,
            [&](int s, const bf16_t*& Kp, const bf16_t*& Vp) { Kp = Kc + (size_t)s * 4096; Vp = VcT + (size_t)s * 4096; },
            [&](int s, const unsigned char* slot) {
#pragma unroll
                for (int t = 0; t < 2; ++t) { const int ct = 2 * s + t; if (ct < ntc) { bf16x8 kf[4], vf[2][2]; lds_frag_k(kf, slot, t, lane); lds_frag_v(vf, slot, t, lane);
                        const f32x16 p = tile_scores(kf, qf, negMc, cmax_row - 32 * ct - 4 * hh, -1000000, ldummy); tile_pv(p, vf, oc); CM_POST(p, ct); } } });
#undef CM_POST
        for (int ct = ntc; ct < 16; ++ct) IMP[tl * 128 + 8 * ct + 2 * hd + hh] = 0.f;
        if (ti >= 3) {
            __builtin_amdgcn_s_waitcnt(0xC07F); asm volatile("" ::: "memory");
            unsigned key[16]; const int li = hd + 4 * hh;
#pragma unroll
            for (int i4 = 0; i4 < 4; ++i4) { const f32x4 v4 = *(const f32x4*)(IMP + tl * 128 + li * 16 + 4 * i4);
#pragma unroll
                for (int i = 0; i < 4; ++i) { const int n = li * 16 + 4 * i4 + i; key[4 * i4 + i] = (n >= 1 && n <= ti - 2) ? ((__float_as_uint(fmaxf(v4[i], 0.f)) & ~0xFFu) | (unsigned)(128 - n)) : 0u; } }
#pragma unroll 1
            for (int it = 0; it < 13; ++it) { unsigned m = key[0];
#pragma unroll
                for (int i = 1; i < 16; ++i) m = (key[i] > m) ? key[i] : m;
                { unsigned o_; o_ = __shfl_xor(m, 1); m = o_ > m ? o_ : m; o_ = __shfl_xor(m, 2); m = o_ > m ? o_ : m; o_ = __shfl_xor(m, 32); m = o_ > m ? o_ : m; }
#pragma unroll
                for (int i = 0; i < 16; ++i) key[i] = (key[i] == m) ? 0u : key[i];
                if (m != 0u && hd == 0 && hh == 0) { const int nsel = 128 - (int)(m & 0xFFu); atomicOr(&BM[nsel * 2 + (tl >> 5)], 1u << (tl & 31)); } }
        }
        __builtin_amdgcn_s_waitcnt(0xC07F); asm volatile("" ::: "memory");
        { const float sc = gp[0] * inv;
#pragma unroll
          for (int dt = 0; dt < 2; ++dt)
#pragma unroll
              for (int r4 = 0; r4 < 4; ++r4) { u32x2 o; o.x = pk2(oc[dt][4 * r4] * sc, oc[dt][4 * r4 + 1] * sc); o.y = pk2(oc[dt][4 * r4 + 2] * sc, oc[dt][4 * r4 + 3] * sc);
                  *(u32x2*)(PA + 32 * dt + 8 * r4 + 4 * hh) = o; } }
    }
    const float negMs = -mq * maxabs64(A.in[I_KSG], lane);
    const bf16_t* KS = (const bf16_t*)(ws + WS_KSN) + (size_t)(b * 2 + g) * T * 64; const bf16_t* VS = (const bf16_t*)(ws + WS_VST) + (size_t)(b * 2 + g) * 128 * 4096;
    { const bf16_t* KW = (const bf16_t*)(ws + WS_KWN) + (size_t)(b * 2 + g) * T * 64; const bf16_t* VW = (const bf16_t*)(ws + WS_VWT) + (size_t)(b * 2 + g) * 128 * 4096;
      const float negMw = -mq * maxabs64(A.in[I_KWG], lane);
      bf16x8 qf[4]; LOADQF(qf);
      f32x16 ow[2]; float lw = 0.f; for (int i = 0; i < 16; ++i) { ow[0][i] = 0.f; ow[1][i] = 0.f; }
      const int tw0 = ti * 64 + wave * 8; const int f0w = (tw0 - 511 > 0) ? ((tw0 - 511) >> 5) : 0, f1w = ((tw0 + 7) >> 5) + 1;
      const int nlob = (ti * 64 - 511 > 0) ? ((ti * 64 - 511) >> 6) : 0;
      shared_stream<true>(ti - nlob + 1, (unsigned char*)OL, tid,
          [&](int s, const bf16_t*& Kp, const bf16_t*& Vp) { Kp = KW + (size_t)(nlob + s) * 4096; Vp = VW + (size_t)(nlob + s) * 4096; },
          [&](int s, const unsigned char* slot) {
#pragma unroll
              for (int t = 0; t < 2; ++t) { const int f = 2 * (nlob + s) + t; if (f >= f0w && f < f1w) { bf16x8 kf[4], vf[2][2]; lds_frag_k(kf, slot, t, lane); lds_frag_v(vf, slot, t, lane);
                      const int k0 = 32 * f + 4 * hh; const f32x16 p = tile_scores(kf, qf, negMw, trow - k0, trow - 512 - k0, lw); tile_pv(p, vf, ow); } } });
      lw += __shfl_xor(lw, 32); const float sc = gp[2] / lw;
#pragma unroll
      for (int dt = 0; dt < 2; ++dt)
#pragma unroll
          for (int r4 = 0; r4 < 4; ++r4) { bf16_t* pp = PA + 32 * dt + 8 * r4 + 4 * hh; const u32x2 pa = *(const u32x2*)pp;
              u32x2 o; o.x = pk2(bflo(pa.x) + ow[dt][4 * r4] * sc, bfhi(pa.x) + ow[dt][4 * r4 + 1] * sc); o.y = pk2(bflo(pa.y) + ow[dt][4 * r4 + 2] * sc, bfhi(pa.y) + ow[dt][4 * r4 + 3] * sc);
              *(u32x2*)pp = o; } }
    { bf16x8 qf[4]; LOADQF(qf);
      f32x16 os[2]; float lsel = 0.f; for (int i = 0; i < 16; ++i) { os[0][i] = 0.f; os[1][i] = 0.f; }
      const int nf = (ti == 0) ? 1 : (ti == 1) ? 2 : 3; const int f1s = ((ti * 64 + wave * 8 + 7) >> 5) + 1;
      shared_stream<true>(nf, (unsigned char*)OL, tid,
          [&](int s, const bf16_t*& Kp, const bf16_t*& Vp) { const int n = (s == 0) ? ti : (s == 1) ? ti - 1 : 0; Kp = KS + (size_t)n * 4096; Vp = VS + (size_t)n * 4096; },
          [&](int s, const unsigned char* slot) { const int n = (s == 0) ? ti : (s == 1) ? ti - 1 : 0;
#pragma unroll
              for (int t = 0; t < 2; ++t) { const int f = 2 * n + t; if (f < f1s) { bf16x8 kf[4], vf[2][2]; lds_frag_k(kf, slot, t, lane); lds_frag_v(vf, slot, t, lane);
                      const int k0 = 32 * f + 4 * hh; const f32x16 p = tile_scores(kf, qf, negMs, trow - k0, -1000000, lsel); tile_pv(p, vf, os); } } });
      lsel += __shfl_xor(lsel, 32);
      const float scl = 1048576.0f / lsel;
#pragma unroll
      for (int dt = 0; dt < 2; ++dt)
#pragma unroll
          for (int r = 0; r < 16; ++r) OL[row * 66 + 32 * dt + crow(r, hh)] = __float2int_rn(os[dt][r] * scl);
      if (hh == 0) { LL[row] = __float2int_rn(lsel * scl); SCL[row] = scl; } }
    __syncthreads();
    if (ti >= 3) {
        unsigned long long m_cur = 0ull; int n_cur = 0;
        int n_a = 0, n_b = 0; unsigned long long m_a = 0ull, m_b = 0ull;
#define ADVANCE(n_it, m_it, ok) do { ok = true; while (m_cur == 0ull) { int k_ = 0; if (lane == 0) k_ = atomicAdd(CNT, 1); k_ = __builtin_amdgcn_readfirstlane(k_); \
                if (k_ >= ti - 2) { ok = false; break; } n_cur = ti - 2 - k_; \
                m_cur = ((unsigned long long)__builtin_amdgcn_readfirstlane(BM[n_cur * 2 + 1]) << 32) | (unsigned)__builtin_amdgcn_readfirstlane(BM[n_cur * 2]); } \
            if (ok) { n_it = n_cur; m_it = m_cur; for (int i_ = 0; i_ < 8; ++i_) m_cur &= m_cur - 1ull; } } while (0)
        bool have; ADVANCE(n_a, m_a, have);
        bf16x8 ka[2][4], kb[2][4];
        tile_load_k(ka[0], KS + (size_t)n_a * 4096, lane); tile_load_k(ka[1], KS + (size_t)n_a * 4096 + 2048, lane);
        while (have) {
            bool have_b; ADVANCE(n_b, m_b, have_b);
            { const int nb_ = have_b ? n_b : n_a; tile_load_k(kb[0], KS + (size_t)nb_ * 4096, lane); tile_load_k(kb[1], KS + (size_t)nb_ * 4096 + 2048, lane); }
            bf16x8 va[2][2][2];
            tile_load_v(va[0], VS + (size_t)n_a * 4096, lane); tile_load_v(va[1], VS + (size_t)n_a * 4096 + 2048, lane);
            unsigned long long mm = m_a; for (int i = 0; i < slot; ++i) mm &= mm - 1ull;
            const bool active = mm != 0ull; const int tt = active ? (__ffsll((long long)mm) - 1) : (__ffsll((long long)m_a) - 1);
            const int grow = tt * 4 + hd;
            bf16x8 qg[4];
#pragma unroll
            for (int s = 0; s < 4; ++s) qg[s] = *(const bf16x8*)(QL + grow * 72 + 16 * s + 8 * hh);
            f32x16 oo[2]; for (int i = 0; i < 16; ++i) { oo[0][i] = 0.f; oo[1][i] = 0.f; }
            float lp = 0.f; const int hi2 = active ? 1000000 : -1000000;
#pragma unroll
            for (int kt = 0; kt < 2; ++kt) { const f32x16 p = tile_scores(ka[kt], qg, negMs, hi2, -1000000, lp); tile_pv(p, va[kt], oo); }
            if (active) { const float scl = SCL[grow];
#pragma unroll
                for (int dt = 0; dt < 2; ++dt)
#pragma unroll
                    for (int r = 0; r < 16; ++r) atomicAdd(&OL[grow * 66 + 32 * dt + crow(r, hh)], __float2int_rn(oo[dt][r] * scl));
                atomicAdd(&LL[grow], __float2int_rn(lp * scl)); }
#pragma unroll
            for (int kt = 0; kt < 2; ++kt)
#pragma unroll
                for (int s = 0; s < 4; ++s) ka[kt][s] = kb[kt][s];
            n_a = n_b; m_a = m_b; have = have_b;
        }
#undef ADVANCE
    }
    __syncthreads();
    { const float sc = gp[1] / (float)LL[row];
      bf16_t* op = (bf16_t*)(ws + WS_ONSA) + tokg * 512 + (g * 4 + hd) * 64;
#pragma unroll
      for (int dt = 0; dt < 2; ++dt)
#pragma unroll
          for (int r4 = 0; r4 < 4; ++r4) { float f[4];
              const u32x2 pa = *(const u32x2*)(PA + 32 * dt + 8 * r4 + 4 * hh); const float pf[4] = {bflo(pa.x), bfhi(pa.x), bflo(pa.y), bfhi(pa.y)};
#pragma unroll
              for (int i = 0; i < 4; ++i) { const int r = 4 * r4 + i; f[i] = pf[i] + (float)OL[row * 66 + 32 * dt + crow(r, hh)] * sc; }
              u32x2 o; o.x = pk2(f[0], f[1]); o.y = pk2(f[2], f[3]);
              *(u32x2*)(op + 32 * dt + 8 * r4 + 4 * hh) = o; } }
    __syncthreads();
}

DI void phase_finalize(const Args& A, int wv_) {
    const int tid = otid(wv_), lane = tid & 63, wave = tid >> 6; const int gw = blockIdx.x * 8 + wave, NGW = gridDim.x * 8;
    unsigned char* ws = A.ws;
    for (int tok = gw; tok < NTOK; tok += NGW) {
        bf16_t* oc = (bf16_t*)(ws + WS_OCAT) + (size_t)tok * 1024;
        { const u32x4 w = *(const u32x4*)((const bf16_t*)(ws + WS_ONSA) + (size_t)tok * 512 + 8 * lane);
          float f[8] = {bflo(w.x), bfhi(w.x), bflo(w.y), bfhi(w.y), bflo(w.z), bfhi(w.z), bflo(w.w), bfhi(w.w)}; float s = 0.f;
#pragma unroll
          for (int i = 0; i < 8; ++i) s += f[i] * f[i];
          const float rs = rsqrtf(wave_sum(s) * (1.f / 512.f) + EPS); const float* gn = A.in[I_NSAOG] + 8 * lane;
          u32x4 o; o.x = pk2(f[0] * rs * gn[0], f[1] * rs * gn[1]); o.y = pk2(f[2] * rs * gn[2], f[3] * rs * gn[3]); o.z = pk2(f[4] * rs * gn[4], f[5] * rs * gn[5]); o.w = pk2(f[6] * rs * gn[6], f[7] * rs * gn[7]);
          *(u32x4*)(oc + 8 * lane) = o; }
        { const u32x4 w = *(const u32x4*)((const bf16_t*)(ws + WS_OG) + (size_t)tok * 512 + 8 * lane);
          const u32x4 zw = *(const u32x4*)((const bf16_t*)(ws + WS_U) + (size_t)tok * INWP + C_GZ + 8 * lane);
          float f[8] = {bflo(w.x), bfhi(w.x), bflo(w.y), bfhi(w.y), bflo(w.z), bfhi(w.z), bflo(w.w), bfhi(w.w)};
          float z[8] = {bflo(zw.x), bfhi(zw.x), bflo(zw.y), bfhi(zw.y), bflo(zw.z), bfhi(zw.z), bflo(zw.w), bfhi(zw.w)}; float s = 0.f;
#pragma unroll
          for (int i = 0; i < 8; ++i) s += f[i] * f[i];
          s += __shfl_xor(s, 1); s += __shfl_xor(s, 2); s += __shfl_xor(s, 4); s += __shfl_xor(s, 8);
          const float rs = rsqrtf(s * (1.f / 128.f) + EPS); const float* gn = A.in[I_GDNOG] + (8 * lane & 127); float o8[8];
#pragma unroll
          for (int i = 0; i < 8; ++i) o8[i] = f[i] * rs * gn[i] * z[i] * sigm(z[i]);
          u32x4 o; o.x = pk2(o8[0], o8[1]); o.y = pk2(o8[2], o8[3]); o.z = pk2(o8[4], o8[5]); o.w = pk2(o8[6], o8[7]);
          *(u32x4*)(oc + 512 + 8 * lane) = o; }
    }
}

DI void phase_router(const Args& A, unsigned char* lds, int wv_) {
    const int tid = otid(wv_), lane = tid & 63, wave = __builtin_amdgcn_readfirstlane(tid >> 6);
    unsigned char* ws = A.ws; const float* x1 = A.out; const float* rw = A.in[I_RW]; const float* fg = A.in[I_FFNG];
    float* partL = (float*)lds;
    float* ssL = partL + 8 * 32 * 33;
    unsigned* cntL = (unsigned*)(ssL + 256); unsigned* baseL = cntL + 32;
    const int i32 = lane & 31, kh = lane >> 5;
    for (int task = blockIdx.x; task < NTOK / 32; task += gridDim.x) {
        const int tok = task * 32 + i32; const float* xr = x1 + (size_t)tok * D + 128 * wave;
        f32x16 acc; for (int i = 0; i < 16; ++i) acc[i] = 0.f; float ss = 0.f;
#pragma unroll 8
        for (int kb = 0; kb < 16; ++kb) { const int k0 = 8 * kb + 4 * kh; const f32x4 av = *(const f32x4*)(xr + k0); const f32x4 gv = *(const f32x4*)(fg + 128 * wave + k0);
            ss += av[0] * av[0] + av[1] * av[1] + av[2] * av[2] + av[3] * av[3];
#pragma unroll
            for (int s = 0; s < 4; ++s) acc = __builtin_amdgcn_mfma_f32_32x32x2f32(av[s], rw[(size_t)(128 * wave + k0 + s) * 32 + i32] * gv[s], acc, 0, 0, 0); }
        ss += __shfl_xor(ss, 32);
        if (kh == 0) ssL[wave * 32 + i32] = ss;
#pragma unroll
        for (int r = 0; r < 16; ++r) partL[(wave * 32 + crow(r, kh)) * 33 + i32] = acc[r];
        __syncthreads();
        { const int tk = tid >> 4, e2 = tid & 15; float s0 = 0.f, s1 = 0.f;
#pragma unroll
          for (int w8 = 0; w8 < 8; ++w8) { s0 += partL[(w8 * 32 + tk) * 33 + e2]; s1 += partL[(w8 * 32 + tk) * 33 + e2 + 16]; }
          __syncthreads();
          partL[tk * 33 + e2] = s0; partL[tk * 33 + e2 + 16] = s1; }
        __syncthreads();
        if (wave == 0 && lane < 32) { float sst = 0.f;
#pragma unroll
            for (int w = 0; w < 8; ++w) sst += ssL[w * 32 + lane];
            const float rstd = rsqrtf(sst * (1.f / D) + EPS); ssL[256 + 64 + lane] = rstd;
            float v[4] = {-3.0e38f, -3.0e38f, -3.0e38f, -3.0e38f}; int id[4] = {0, 0, 0, 0}; const float* rb = A.in[I_RB];
            for (int e = 0; e < 32; ++e) { const float x = partL[lane * 33 + e] * rstd + rb[e];
                if (x > v[3]) { if (x > v[0]) { v[3] = v[2]; id[3] = id[2]; v[2] = v[1]; id[2] = id[1]; v[1] = v[0]; id[1] = id[0]; v[0] = x; id[0] = e; }
                    else if (x > v[1]) { v[3] = v[2]; id[3] = id[2]; v[2] = v[1]; id[2] = id[1]; v[1] = x; id[1] = e; }
                    else if (x > v[2]) { v[3] = v[2]; id[3] = id[2]; v[2] = x; id[2] = e; }
                    else { v[3] = x; id[3] = e; } } }
            const float e0 = 1.f, e1 = __expf(v[1] - v[0]), e2 = __expf(v[2] - v[0]), e3 = __expf(v[3] - v[0]); const float inv = 1.f / (e0 + e1 + e2 + e3);
            const float gt[4] = {e0 * inv, e1 * inv, e2 * inv, e3 * inv};
            cntL[lane] = 0u; asm volatile("s_waitcnt lgkmcnt(0)" ::: "memory");
            unsigned lp[4];
#pragma unroll
            for (int k = 0; k < 4; ++k) lp[k] = atomicAdd(&cntL[id[k]], 1u);
            asm volatile("s_waitcnt lgkmcnt(0)" ::: "memory");
            { const unsigned c = cntL[lane]; baseL[lane] = c ? atomicAdd((unsigned*)(ws + WS_CTL) + CW_CNT + 64 * lane, c) : 0u; }
            asm volatile("s_waitcnt vmcnt(0) lgkmcnt(0)" ::: "memory");
#pragma unroll
            for (int k = 0; k < 4; ++k) { const int pos = (int)(baseL[id[k]] + lp[k]);
                ((int*)(ws + WS_TOKE))[tok * 4 + k] = id[k]; ((float*)(ws + WS_TOKG))[tok * 4 + k] = gt[k]; ((int*)(ws + WS_TOKPOS))[tok * 4 + k] = pos; } }
        __syncthreads();
#pragma unroll
        for (int t4 = 0; t4 < 4; ++t4) { const int tk = task * 32 + 4 * wave + t4; const float rs = ((const volatile float*)ssL)[256 + 64 + 4 * wave + t4];
            const f32x4* xr4 = (const f32x4*)(x1 + (size_t)tk * D) + lane; u32x2* o = (u32x2*)((bf16_t*)(ws + WS_H2) + (size_t)tk * D) + lane;
#pragma unroll
            for (int j = 0; j < 4; ++j) { const f32x4 v = xr4[64 * j]; const f32x4 gv = *(const f32x4*)(fg + 4 * lane + 256 * j);
                u32x2 w; w.x = pk2(v.x * rs * gv.x, v.y * rs * gv.y); w.y = pk2(v.z * rs * gv.z, v.w * rs * gv.w); o[64 * j] = w; } }
        __syncthreads();
    }
}

DI void phase_gather(const Args& A, unsigned char* lds, int wv_) {
    const int tid = otid(wv_); const int gt = blockIdx.x * 512 + tid, NGT = gridDim.x * 512;
    unsigned char* ws = A.ws; int* psL = (int*)lds;
    if (tid == 0) { const unsigned* cnt = (const unsigned*)(ws + WS_CTL) + CW_CNT; int acc = 0;
        for (int e = 0; e < 32; ++e) { psL[e] = acc; psL[40 + e] = (int)cnt[64 * e]; acc += ((int)cnt[64 * e] + 255) & ~255; }
        psL[32] = acc;
        if (blockIdx.x == 0) { int* ctl = (int*)(ws + WS_CTL); ctl[CW_NT] = acc >> 8; int e = 0;
            for (int r = 0; r < (acc >> 8); ++r) { while (r * 256 >= psL[e + 1]) ++e; ctl[CW_TILEE + r] = e; } } }
    __syncthreads();
    int* rowtok = (int*)(ws + WS_ROWTOK);
    for (int pr = gt; pr < NTOK * 4; pr += NGT) { const int e = ((const int*)(ws + WS_TOKE))[pr], pos = ((const int*)(ws + WS_TOKPOS))[pr]; const int dest = psL[e] + pos;
        ((int*)(ws + WS_DEST))[pr] = dest; ((float*)(ws + WS_ROWG))[dest] = ((const float*)(ws + WS_TOKG))[pr]; rowtok[dest] = pr >> 2; }
    for (int r = gt; r < psL[32]; r += NGT) { int e = 0; while (r >= psL[e + 1]) ++e; if (r >= psL[e] + psL[40 + e]) { rowtok[r] = 0; ((float*)(ws + WS_ROWG))[r] = 0.f; } }
}

DI void phase_combine(const Args& A, int wv_) {
    const int tid = otid(wv_), lane = tid & 63, wave = tid >> 6; const int gw = blockIdx.x * 8 + wave, NGW = gridDim.x * 8;
    unsigned char* ws = A.ws; const bf16_t* YS = (const bf16_t*)(ws + WS_XS);
    for (int tok = gw; tok < NTOK; tok += NGW) { f32x4* xr = (f32x4*)(A.out + (size_t)tok * D) + lane; f32x4 v[4];
#pragma unroll
        for (int j = 0; j < 4; ++j) v[j] = xr[64 * j];
#pragma unroll
        for (int k = 0; k < 4; ++k) { const int dest = ((const int*)(ws + WS_DEST))[tok * 4 + k]; const u32x2* yr = (const u32x2*)(YS + (size_t)dest * D) + lane;
#pragma unroll
            for (int j = 0; j < 4; ++j) { const u32x2 w = yr[64 * j]; v[j].x += bflo(w.x); v[j].y += bfhi(w.x); v[j].z += bflo(w.y); v[j].w += bfhi(w.y); } }
#pragma unroll
        for (int j = 0; j < 4; ++j) xr[64 * j] = v[j]; }
}


DI void expert_conv_task(const Args& A, int task, unsigned char* lds, int wv_) {
    const int tid = otid(wv_), lane = tid & 63, wave = tid >> 6; unsigned char* ws = A.ws;
    float* scr = (float*)(lds + wave * 17408);
    f32x4 va[16], vb[16];
#define EC_SRC(it_) (A.in[((it_) >> 8) % 3 == 2 ? I_EWD : ((it_) >> 8) % 3 == 1 ? I_EWU : I_EWG] + (size_t)(((it_) >> 8) / 3) * 1048576)
#define EC_FIN(v, it_) do { const int mat_ = (it_) >> 8, item_ = (it_) & 255, kb_ = item_ >> 4, nb_ = item_ & 15, e_ = mat_ / 3, which_ = mat_ % 3; \
        if (which_ == 2) p0_item64_finish(v, 1024, (bf16_t*)(ws + WS_EXPD), (long)e_ * 1024, scr, kb_, nb_, lane); \
        else { const int n0_ = 64 * nb_; const long dest0_ = (long)e_ * 2048 + (n0_ >> 7) * 256 + (n0_ & 127) + (which_ ? 128 : 0); \
            p0_item64_finish(v, 1024, (bf16_t*)(ws + WS_EXPGU), dest0_ - n0_, scr, kb_, nb_, lane); } } while (0)
    const int it0 = task * 32 + wave;
    p0_item64_load(va, EC_SRC(it0), 1024, (it0 & 255) >> 4, it0 & 15, lane);
    p0_item64_load(vb, EC_SRC(it0 + 8), 1024, ((it0 + 8) & 255) >> 4, (it0 + 8) & 15, lane);
    EC_FIN(va, it0);
    p0_item64_load(va, EC_SRC(it0 + 16), 1024, ((it0 + 16) & 255) >> 4, (it0 + 16) & 15, lane);
    EC_FIN(vb, it0 + 8);
    p0_item64_load(vb, EC_SRC(it0 + 24), 1024, ((it0 + 24) & 255) >> 4, (it0 + 24) & 15, lane);
    EC_FIN(va, it0 + 16);
    EC_FIN(vb, it0 + 24);
#undef EC_SRC
#undef EC_FIN
}

#define XB_TMO      128
#define XB_XCNT(j)  (256  + 64 * (j))
#define XB_XSUB(j)  (1280 + 64 * (j))
#define XB_XGEN(j)  (2304 + 64 * (j))
#define XB_TOP      3328
#define XB_TOPGEN   3392
#define XCD_BAR_WORDS 3456
#define XB_SPIN_CAP (1u << 22)
DI unsigned xb_ld(unsigned* p)              { return __hip_atomic_load(p, __ATOMIC_RELAXED, __HIP_MEMORY_SCOPE_AGENT); }
DI unsigned xb_add(unsigned* p, unsigned v) { return __hip_atomic_fetch_add(p, v, __ATOMIC_RELAXED, __HIP_MEMORY_SCOPE_AGENT); }
DI unsigned xb_xcc_id() { return (unsigned)__builtin_amdgcn_s_getreg((3 << 11) | 20) & 0xFu; }
#define XB_SPIN(cond, bar) do { unsigned _sp = 0; while (cond) { __builtin_amdgcn_s_sleep(1); \
    if ((++_sp & 255u) == 0u) { if (xb_ld(&(bar)[XB_TMO])) break; if (_sp > XB_SPIN_CAP) { atomicAdd(&(bar)[XB_TMO], 1u); break; } } } } while (0)
struct XcdBarrier { unsigned* bar; unsigned x; volatile LAS unsigned* st; int wv; };
DI bool xb_thread0(int wv) { return otid(wv) == 0; }
DI XcdBarrier xcd_barrier_post(unsigned* bar, volatile LAS unsigned* st, int wv_) {
    XcdBarrier b; b.bar = bar; b.x = xb_xcc_id(); b.st = st; b.wv = wv_;
    if (xb_thread0(wv_)) (void)xb_add(&bar[XB_XCNT(b.x)], 1u);
    return b; }
DI void xcd_barrier_complete(unsigned* bar, unsigned x, unsigned& nloc, unsigned& nx) {
    const unsigned G = gridDim.x * gridDim.y * gridDim.z;
    unsigned sum, cnt, mine, sp = 0u;
    for (;;) {
        sum = 0u; cnt = 0u; mine = 0u;
#pragma unroll
        for (unsigned j = 0; j < 16; ++j) { const unsigned c = xb_ld(&bar[XB_XCNT(j)]); sum += c; cnt += (c > 0u) ? 1u : 0u; mine = (j == x) ? c : mine; }
        if (sum == G) break;
        __builtin_amdgcn_s_sleep(1);
        if ((++sp & 255u) == 0u) { if (xb_ld(&bar[XB_TMO])) break; if (sp > XB_SPIN_CAP) { atomicAdd(&bar[XB_TMO], 1u); break; } }
    }
    nloc = mine > 0u ? mine : 1u; nx = cnt > 0u ? cnt : 1u; }
DI void xcd_barrier(const XcdBarrier& b) {
    asm volatile("s_waitcnt vmcnt(0)" ::: "memory");
    __syncthreads();
    if (xb_thread0(b.wv)) {
        unsigned* bar = b.bar;
        __builtin_amdgcn_s_waitcnt(0);
        unsigned nloc = b.st[0], nx = b.st[1];
        if (nloc == 0u) { xcd_barrier_complete(bar, b.x, nloc, nx); b.st[0] = nloc; b.st[1] = nx; }
        const unsigned old = xb_add(&bar[XB_XSUB(b.x)], 1u);
        const unsigned gen = old / nloc;
        if (old + 1u == (gen + 1u) * nloc) {
            __builtin_amdgcn_fence(__ATOMIC_RELEASE, "agent");
            asm volatile("s_waitcnt vmcnt(0)" ::: "memory");
            const unsigned og = xb_add(&bar[XB_TOP], 1u);
            const unsigned tg = og / nx;
            if (og + 1u == (tg + 1u) * nx) xb_add(&bar[XB_TOPGEN], 1u);
            else XB_SPIN(xb_ld(&bar[XB_TOPGEN]) == tg, bar);
            __builtin_amdgcn_fence(__ATOMIC_ACQUIRE, "agent");
            xb_add(&bar[XB_XGEN(b.x)], 1u);
            asm volatile("s_waitcnt vmcnt(0)" ::: "memory");
        } else {
            XB_SPIN(xb_ld(&bar[XB_XGEN(b.x)]) == gen, bar);
            __builtin_amdgcn_fence(__ATOMIC_ACQUIRE, "agent");
            asm volatile("s_waitcnt vmcnt(0)" ::: "memory");
        }
    }
    __syncthreads();
}

__global__ void __launch_bounds__(512, 2) mega(Args A) {
    extern __shared__ __attribute__((aligned(16))) unsigned char lds[];
    cg::grid_group grid = cg::this_grid();
    const int wv_ = __builtin_amdgcn_readfirstlane(threadIdx.x >> 6);
    const int lo = A.ph_lo, hi = A.ph_hi; const int tid = otid(wv_);
    unsigned char* ws = A.ws;
    int* taskL = (int*)(lds + LDS_MISC);
    if (tid < 2) ((volatile LAS unsigned*)(lds + LDS_MISC + 16))[tid] = 0u;
    __syncthreads();
    XcdBarrier xbar = xcd_barrier_post((unsigned*)(ws + WS_CTL) + CW_BAR, (volatile LAS unsigned*)(lds + LDS_MISC + 16), wv_);
#define IN(k) (lo <= (k) && (k) < hi)
#define SEAM(k) do { if (IN(k) && IN((k) + 1)) { if (A.ph_lo < 0) grid.sync();     \
        xcd_barrier(xbar); } } while (0)

#ifndef REPEAT_PH
#define REPEAT_PH -1
#endif
#define REP(k) (REPEAT_PH == (k) ? 2 : 1)
    for (int rep = 0; rep < REP(0); ++rep) { if (IN(0)) phase0(A, lds, rep == 0, wv_); if (rep + 1 < REP(0)) grid.sync(); }
    SEAM(0);
    for (int rep = 0; rep < REP(1); ++rep) { if (IN(1)) { pg8::Gemm g{(const bf16_t*)(ws + WS_XN), (const bf16_t*)(ws + WS_WTIN), NTOK, INWP, D}; pg8::StaticOrder S; S.init(NTOK, INWP, gridDim.x, blockIdx.x);
        pg8::EpiU E{(bf16_t*)(ws + WS_U), INWP}; pg8::gemm_phase<pg8::EpiU, pg8::StaticOrder>((PG8_LAS unsigned char*)lds, g, S, E, wv_); } if (rep + 1 < REP(1)) grid.sync(); }
    SEAM(1);
    for (int rep = 0; rep < REP(2); ++rep) { if (IN(2)) {
        for (;;) { if (tid == 0) *taskL = atomicAdd((int*)(ws + WS_CTL) + (rep ? CW_Q2B : CW_Q2), 1); __syncthreads(); const int task = *taskL; __syncthreads();
            if (task >= 1408) break;
            if (task < 128) compress_task(A, task, lds, wv_); else if (task < 1152) gdn_chunk_task(A, task - 128, lds, wv_); else nsa_prep_task(A, task - 1152, lds, wv_); } } if (rep + 1 < REP(2)) grid.sync(); }
    SEAM(2);
    for (int rep = 0; rep < REP(3); ++rep) { if (IN(3)) {
        if (blockIdx.x < 64) { gdn_scan_block(A, blockIdx.x, lds, wv_); __syncthreads(); }
        { const int bg0 = (int)(xb_xcc_id() & 3u);
          for (int q = 0; q < 4; ++q) { const int bgq = (bg0 + q) & 3;
            for (;;) { if (tid == 0) *taskL = atomicAdd((int*)(ws + WS_CTL) + (rep ? CW_Q3B : CW_Q3) + bgq, 1); __syncthreads(); const int u = *taskL; __syncthreads();
                if (u >= 128) break;
                nsa_unit(A, u * 4 + bgq, lds, wv_); } } }
        __syncthreads();
        for (;;) { if (tid == 0) *taskL = atomicAdd((int*)(ws + WS_CTL) + (rep ? CW_Q3B : CW_Q3) + 8, 1); __syncthreads(); const int t = *taskL; __syncthreads();
            if (t >= 768) break;
            expert_conv_task(A, t, lds, wv_); } } if (rep + 1 < REP(3)) grid.sync(); }
    SEAM(3);
    for (int rep = 0; rep < REP(4); ++rep) { if (IN(4)) phase_finalize(A, wv_); if (rep + 1 < REP(4)) grid.sync(); }
    SEAM(4);
    for (int rep = 0; rep < REP(5); ++rep) { if (IN(5)) { pg8::Gemm g{(const bf16_t*)(ws + WS_OCAT), (const bf16_t*)(ws + WS_WTOUT), NTOK, D, D}; pg8::StaticOrder S; S.init(NTOK, D, gridDim.x, blockIdx.x);
        pg8::EpiRes E{A.in[I_X], A.out, D}; pg8::gemm_phase<pg8::EpiRes, pg8::StaticOrder>((PG8_LAS unsigned char*)lds, g, S, E, wv_); } if (rep + 1 < REP(5)) grid.sync(); }
    SEAM(5);
    for (int rep = 0; rep < REP(6); ++rep) { if (IN(6)) phase_router(A, lds, wv_);
        if (rep + 1 < REP(6)) { grid.sync(); if (blockIdx.x == 0 && tid < 32) ((unsigned*)(ws + WS_CTL))[CW_CNT + 64 * tid] = 0u; grid.sync(); } }
    SEAM(6);
    for (int rep = 0; rep < REP(7); ++rep) { if (IN(7)) phase_gather(A, lds, wv_); if (rep + 1 < REP(7)) grid.sync(); }
    SEAM(7);
    for (int rep = 0; rep < REP(8); ++rep) { if (IN(8)) { const int* ctl = (const int*)(ws + WS_CTL); const int nM = __builtin_amdgcn_readfirstlane(ctl[CW_NT]);
        pg8::Gemm g{(const bf16_t*)(ws + WS_H2), (const bf16_t*)(ws + WS_EXPGU), 0, 0, D}; pg8::MoeOrder S; S.init(nM, 8, gridDim.x, blockIdx.x, ctl + CW_TILEE);
        pg8::EpiSwiglu E{(bf16_t*)(ws + WS_HID), A.in[I_EBG], A.in[I_EBU]}; pg8::gemm_phase<pg8::EpiSwiglu, pg8::MoeOrder, true>((PG8_LAS unsigned char*)lds, g, S, E, wv_, (const int*)(ws + WS_ROWTOK)); } if (rep + 1 < REP(8)) grid.sync(); }
    SEAM(8);
    for (int rep = 0; rep < REP(9); ++rep) { if (IN(9)) { const int* ctl = (const int*)(ws + WS_CTL); const int nM = __builtin_amdgcn_readfirstlane(ctl[CW_NT]);
        pg8::Gemm g{(const bf16_t*)(ws + WS_HID), (const bf16_t*)(ws + WS_EXPD), 0, 0, D}; pg8::MoeOrder S; S.init(nM, 4, gridDim.x, blockIdx.x, ctl + CW_TILEE);
        pg8::EpiDown E{(bf16_t*)(ws + WS_XS), A.in[I_EBD], (const float*)(ws + WS_ROWG)}; pg8::gemm_phase<pg8::EpiDown, pg8::MoeOrder>((PG8_LAS unsigned char*)lds, g, S, E, wv_); } if (rep + 1 < REP(9)) grid.sync(); }
    SEAM(9);
    if (IN(10)) phase_combine(A, wv_);
#undef IN
#undef SEAM
}

constexpr int NPHASE = 11;
#ifndef N_LAUNCHES
#define N_LAUNCHES 1
#endif
extern "C" void kernel_launch(void* const* d_in, const int* in_sizes, int n_in, void* d_out, int out_size, void* d_ws, size_t ws_size, hipStream_t stream) {
    static int grid = 0;
    if (grid == 0) {
        if (n_in != 32 || out_size != NTOK * D || ws_size < WS_END) { fprintf(stderr, "kernel_launch: unexpected shapes (n_in %d out %d ws %zu)\n", n_in, out_size, ws_size); grid = -1; return; }
        int dev = 0, cus = 0, per_cu = 0;
        hipGetDevice(&dev); hipDeviceGetAttribute(&cus, hipDeviceAttributeMultiprocessorCount, dev);
        hipFuncSetAttribute((const void*)mega, hipFuncAttributeMaxDynamicSharedMemorySize, LDS_BYTES);
        hipOccupancyMaxActiveBlocksPerMultiprocessor(&per_cu, (const void*)mega, 512, LDS_BYTES);
        if (per_cu < 1) { fprintf(stderr, "kernel_launch: occupancy query says %d blocks per CU\n", per_cu); per_cu = 1; }
        (void)hipGetLastError();
        grid = cus;
    }
    if (grid < 0) return;
    hipMemsetAsync((char*)d_ws + WS_CTL, 0, CTL_BYTES, stream);
    Args a{};
    for (int i = 0; i < 32; ++i) a.in[i] = (const float*)d_in[i];
    a.out = (float*)d_out; a.ws = (unsigned char*)d_ws;
    if (N_LAUNCHES == 1) { a.ph_lo = 0; a.ph_hi = NPHASE; void* args[] = {&a};
        hipError_t e = hipLaunchCooperativeKernel((const void*)mega, dim3(grid), dim3(512), args, LDS_BYTES, stream);
        if (e != hipSuccess) fprintf(stderr, "cooperative launch failed: %s (grid %d)\n", hipGetErrorString(e), grid); }
    else { for (int p = 0; p < NPHASE; ++p) { a.ph_lo = p; a.ph_hi = p + 1; void* args[] = {&a};
            hipError_t e = hipLaunchCooperativeKernel((const void*)mega, dim3(grid), dim3(512), args, LDS_BYTES, stream);
            if (e != hipSuccess) { fprintf(stderr, "launch %d failed: %s\n", p, hipGetErrorString(e)); break; } } }
}
```
